# Optimizing an MI355X kernel written in HIP

```python
import jax, jax.numpy as jnp
from jax import lax
import numpy as np

D_MODEL = 1024
BATCH = 8
SEQ = 4096
DEPTH = 1

CHUNK = 64
LEFT_CHUNKS = 8
BAND = (LEFT_CHUNKS + 1) * CHUNK
N_HEADS = 8
HEAD_DIM = 64
ATTN_W = N_HEADS * HEAD_DIM
CONV_W = D_MODEL // 2
CONV_K = 3
MAX_REL_PAST = 256
NUM_REL = (CHUNK - 1) + MAX_REL_PAST + 1
PLE_DIM = 256
N_GROUPS = 4
EXPERTS_PER_GROUP = 8
N_EXPERTS = N_GROUPS * EXPERTS_PER_GROUP
TOP_K = 2
D_EXPERT = 512
BLK = 128
EPS = 1e-6

IN_WIDTHS = [ATTN_W, ATTN_W, ATTN_W, CONV_W, CONV_W, CONV_W, D_MODEL, D_MODEL]
IN_TOTAL = sum(IN_WIDTHS)
SPLITS = [int(v) for v in np.cumsum(IN_WIDTHS)[:-1]]

kernel_name = "hybrid_chunked_attn_shortconv_hmoe_block"


def rms_norm(x, g):
    xf = x.astype(jnp.float32)
    y = xf * lax.rsqrt(jnp.mean(xf * xf, axis=-1, keepdims=True) + EPS)
    return (y * g.astype(jnp.float32)).astype(x.dtype)


def chunked_rel_attention(q, k, v, g_q, g_k, rel_bias):
    b, s, h, dh = q.shape
    nc = s // CHUNK
    pad = LEFT_CHUNKS * CHUNK
    q = rms_norm(q, g_q)
    k = rms_norm(k, g_k)
    kp = jnp.pad(k, ((0, 0), (pad, 0), (0, 0), (0, 0)))
    vp = jnp.pad(v, ((0, 0), (pad, 0), (0, 0), (0, 0)))
    dist = jnp.arange(CHUNK)[:, None] - jnp.arange(BAND)[None, :] + pad
    idx = jnp.clip(dist, -(CHUNK - 1), MAX_REL_PAST) + (CHUNK - 1)
    bias = rel_bias[:, idx].astype(jnp.float32)
    qc = q.reshape(b, nc, CHUNK, h, dh).transpose(1, 0, 2, 3, 4)
    scale = dh ** -0.5

    def one_chunk(args):
        q_blk, c = args
        start = c * CHUNK
        kb = lax.dynamic_slice_in_dim(kp, start, BAND, axis=1)
        vb = lax.dynamic_slice_in_dim(vp, start, BAND, axis=1)
        sc = jnp.einsum('bqhd,bkhd->bhqk', q_blk, kb).astype(jnp.float32) * scale + bias
        valid = (start - pad + jnp.arange(BAND)) >= 0
        sc = jnp.where(valid[None, None, None, :], sc, -1e30)
        pr = jax.nn.softmax(sc, axis=-1).astype(vb.dtype)
        return jnp.einsum('bhqk,bkhd->bqhd', pr, vb)

    out = lax.map(one_chunk, (qc, jnp.arange(nc)))
    return out.transpose(1, 0, 2, 3, 4).reshape(b, s, h * dh)


def short_conv(u, bg, cg, w, bias):
    s = u.shape[1]
    zp = jnp.pad(cg * u, ((0, 0), (CONV_K - 1, 0), (0, 0)))
    y = bias
    for j in range(CONV_K):
        y = y + w[j] * zp[:, j:j + s]
    return bg * y


def hier_moe(xn, w_group, b_group, w_router, b_router, w1, w3, w2):
    t, d = xn.shape
    gl = (xn @ w_group).astype(jnp.float32) + b_group
    grp = jnp.argmax(gl, axis=-1)
    p_grp = jnp.take_along_axis(jax.nn.softmax(gl, axis=-1), grp[:, None], axis=1)
    el = ((xn @ w_router).astype(jnp.float32) + b_router).reshape(t, N_GROUPS, EXPERTS_PER_GROUP)
    el = jnp.take_along_axis(el, grp[:, None, None], axis=1)[:, 0]
    top_l, top_i = lax.top_k(el, TOP_K)
    wgt = (p_grp * jax.nn.softmax(top_l, axis=-1)).reshape(-1)
    eid = (grp[:, None] * EXPERTS_PER_GROUP + top_i).reshape(-1).astype(jnp.int32)
    tok = jnp.repeat(jnp.arange(t, dtype=jnp.int32), TOP_K)
    a = t * TOP_K
    order = jnp.argsort(eid)
    se = eid[order]
    counts = jnp.bincount(eid, length=N_EXPERTS)
    pcounts = (counts + BLK - 1) // BLK * BLK
    pends = jnp.cumsum(pcounts)
    pstarts = pends - pcounts
    starts = jnp.cumsum(counts) - counts
    dest = pstarts[se] + jnp.arange(a) - starts[se]
    n_rows = (a + BLK - 1) // BLK * BLK + N_EXPERTS * BLK
    n_blk = n_rows // BLK
    row_tok = jnp.zeros((n_rows,), jnp.int32).at[dest].set(tok[order])
    row_w = jnp.zeros((n_rows,), wgt.dtype).at[dest].set(wgt[order])
    blk_e = jnp.minimum(jnp.searchsorted(pends, jnp.arange(n_blk) * BLK, side='right'), N_EXPERTS - 1)
    xs = xn[row_tok].reshape(n_blk, BLK, d)

    def expert_block(args):
        xb, e = args
        hdn = jax.nn.silu(xb @ w1[e]) * (xb @ w3[e])
        return hdn @ w2[e]

    ys = lax.map(expert_block, (xs, blk_e)).reshape(n_rows, d)
    return jnp.zeros((t, d), xn.dtype).at[row_tok].add(ys * row_w[:, None].astype(ys.dtype))


def setup_inputs(seed: int = 0) -> dict:
    key = jax.random.key(seed)
    ks = jax.random.split(key, 32)
    nrm = lambda k, shape, sc: jax.random.normal(k, shape, jnp.float32) * sc
    L = DEPTH
    return {
        "x": nrm(ks[0], (BATCH, SEQ, D_MODEL), 1.0),
        "p": nrm(ks[1], (DEPTH, BATCH, SEQ, PLE_DIM), 1.0),
        "g_mix": 1.0 + nrm(ks[2], (L, D_MODEL), 0.02),
        "w_in": nrm(ks[3], (L, D_MODEL, IN_TOTAL), D_MODEL ** -0.5),
        "b_in": nrm(ks[4], (L, IN_TOTAL), 0.02),
        "g_q": 1.0 + nrm(ks[5], (L, HEAD_DIM), 0.02),
        "g_k": 1.0 + nrm(ks[6], (L, HEAD_DIM), 0.02),
        "rel_bias": nrm(ks[7], (L, N_HEADS, NUM_REL), 0.1),
        "conv_w": nrm(ks[8], (L, CONV_K, CONV_W), CONV_K ** -0.5),
        "conv_b": nrm(ks[9], (L, CONV_W), 0.02),
        "w_pa": nrm(ks[10], (L, ATTN_W, D_MODEL), ATTN_W ** -0.5),
        "w_pc": nrm(ks[11], (L, CONV_W, D_MODEL), CONV_W ** -0.5),
        "w_o": nrm(ks[12], (L, D_MODEL, D_MODEL), D_MODEL ** -0.5),
        "g_ffn": 1.0 + nrm(ks[13], (L, D_MODEL), 0.02),
        "w_group": nrm(ks[14], (L, D_MODEL, N_GROUPS), D_MODEL ** -0.5),
        "b_group": nrm(ks[15], (L, N_GROUPS), 0.01),
        "w_router": nrm(ks[16], (L, D_MODEL, N_EXPERTS), D_MODEL ** -0.5),
        "b_router": nrm(ks[17], (L, N_EXPERTS), 0.01),
        "w1": nrm(ks[18], (L, N_EXPERTS, D_MODEL, D_EXPERT), D_MODEL ** -0.5),
        "w3": nrm(ks[19], (L, N_EXPERTS, D_MODEL, D_EXPERT), D_MODEL ** -0.5),
        "w2": nrm(ks[20], (L, N_EXPERTS, D_EXPERT, D_MODEL), D_EXPERT ** -0.5),
        "g_ple": 1.0 + nrm(ks[21], (L, D_MODEL), 0.02),
        "w_ple_gate": nrm(ks[22], (L, D_MODEL, D_MODEL), D_MODEL ** -0.5),
        "b_ple_gate": nrm(ks[23], (L, D_MODEL), 0.02),
        "w_ple_proj": nrm(ks[24], (L, PLE_DIM, D_MODEL), PLE_DIM ** -0.5),
    }


def reference(x, p, g_mix, w_in, b_in, g_q, g_k, rel_bias, conv_w, conv_b, w_pa, w_pc, w_o,
              g_ffn, w_group, b_group, w_router, b_router, w1, w3, w2,
              g_ple, w_ple_gate, b_ple_gate, w_ple_proj):
    b, s, d = x.shape
    h = x
    for i in range(DEPTH):
        n = rms_norm(h, g_mix[i])
        z = n @ w_in[i] + b_in[i]
        q, k, v, u, bg, cg, ga, gc = jnp.split(z, SPLITS, axis=-1)
        ya = chunked_rel_attention(q.reshape(b, s, N_HEADS, HEAD_DIM),
                                   k.reshape(b, s, N_HEADS, HEAD_DIM),
                                   v.reshape(b, s, N_HEADS, HEAD_DIM),
                                   g_q[i], g_k[i], rel_bias[i])
        yc = short_conv(u, bg, cg, conv_w[i], conv_b[i])
        m = jax.nn.sigmoid(ga) * (ya @ w_pa[i]) + jax.nn.sigmoid(gc) * (yc @ w_pc[i])
        h = h + m @ w_o[i]
        n2 = rms_norm(h, g_ffn[i]).reshape(b * s, d)
        h = h + hier_moe(n2, w_group[i], b_group[i], w_router[i], b_router[i],
                         w1[i], w3[i], w2[i]).reshape(b, s, d)
        gate = jax.nn.sigmoid(rms_norm(h, g_ple[i]) @ w_ple_gate[i] + b_ple_gate[i])
        h = h + gate * (p[i] @ w_ple_proj[i])
    return h
```

```cpp
#include <hip/hip_runtime.h>
#include <hip/hip_cooperative_groups.h>
#include <cstdio>
#include <cstdint>
namespace cg = cooperative_groups;

#define GAS __attribute__((address_space(1)))
#define LAS __attribute__((address_space(3)))
typedef unsigned short bf16_t;
typedef short bf16x8 __attribute__((ext_vector_type(8)));
typedef float f32x4 __attribute__((ext_vector_type(4)));
typedef float f32x2 __attribute__((ext_vector_type(2)));
typedef unsigned u32x4 __attribute__((ext_vector_type(4)));
typedef unsigned u32x2 __attribute__((ext_vector_type(2)));
typedef GAS unsigned gu32;
#define RLX_AGENT __ATOMIC_RELAXED, __HIP_MEMORY_SCOPE_AGENT

constexpr int T = 32768, D = 1024, SEQ = 4096, NBATCH = 8;
constexpr int NIN = 5120, NH = 8, HD = 64, AW = 512, CW = 512;
constexpr int NE = 32, DE = 512, PLE = 256, NREL = 320;
constexpr int XS_ROWS = 65536 + NE * 256;
constexpr float EPS = 1e-6f;
constexpr float LOG2E = 1.4426950408889634f;
constexpr float C2 = 0.125f * LOG2E;

constexpr size_t MiB = 1u << 20;
constexpr size_t WS_CTL = 0, CTL_ZERO_BYTES = 64 * 1024;
constexpr int CW_BAR = 1024;
constexpr size_t WS_TAB = 1 * MiB;
constexpr size_t WS_ROUTE = 2 * MiB;
constexpr size_t WS_ROWMETA = 4 * MiB;
constexpr size_t WS_WIN = 6 * MiB;
constexpr size_t WS_WM = 16 * MiB;
constexpr size_t WS_WO = 18 * MiB;
constexpr size_t WS_WPG = 20 * MiB;
constexpr size_t WS_WPP = 22 * MiB;
constexpr size_t WS_PB = 24 * MiB;
constexpr size_t WS_NBUF = 40 * MiB;
constexpr size_t WS_Q = 104 * MiB, WS_K = 136 * MiB, WS_V = 168 * MiB, WS_U = 200 * MiB, WS_BG = 232 * MiB, WS_CG = 264 * MiB;
constexpr size_t WS_SGA = 296 * MiB, WS_SGC = 360 * MiB;
constexpr size_t WS_YAC = 424 * MiB;
constexpr size_t WS_M = 104 * MiB;
constexpr size_t WS_W13 = 168 * MiB;
constexpr size_t WS_W2 = 232 * MiB;
constexpr size_t WS_XS = 264 * MiB;
constexpr size_t WS_HDN = 408 * MiB;
constexpr size_t WS_CONTRIB = 264 * MiB;
constexpr size_t WS_PP = 104 * MiB;
constexpr size_t WS_END = 488 * MiB;

__device__ __forceinline__ unsigned f2bf(float f) { unsigned u = __builtin_bit_cast(unsigned, f); return (u + 0x7fffu + ((u >> 16) & 1u)) >> 16; }
__device__ __forceinline__ unsigned pk2(float lo, float hi) { return f2bf(lo) | (f2bf(hi) << 16); }
__device__ __forceinline__ float bf_lo(unsigned w) { return __builtin_bit_cast(float, w << 16); }
__device__ __forceinline__ float bf_hi(unsigned w) { return __builtin_bit_cast(float, w & 0xffff0000u); }
__device__ __forceinline__ float bf2f(bf16_t h) { return __builtin_bit_cast(float, (unsigned)h << 16); }
__device__ __forceinline__ float sigmoidf_(float x) { return __builtin_amdgcn_rcpf(1.0f + __builtin_amdgcn_exp2f(-LOG2E * x)); }
__device__ __forceinline__ float wave_sum(float v) {
#pragma unroll
    for (int o = 1; o < 64; o <<= 1) v += __shfl_xor(v, o);
    return v;
}
__device__ __forceinline__ int lane_id_fresh() { int l; asm volatile("v_mbcnt_lo_u32_b32 %0, -1, 0\n\tv_mbcnt_hi_u32_b32 %0, -1, %0" : "=v"(l)); return l; }
#define LDS_WAIT() asm volatile("s_waitcnt lgkmcnt(0)" ::: "memory")
#define VM_WAIT() asm volatile("s_waitcnt vmcnt(0)" ::: "memory")

namespace pg8 {
#define PG8_LAS __attribute__((address_space(3)))
constexpr int BM = 256, BK = 64, HALF = 128, HTB = HALF * BK * 2  , STAGE_BYTES = 8 * HTB, NXCD = 8, WGM = 8;

__host__ __device__ __forceinline__ int lds_byte(int r, int c) { const int st = (r >> 4) * 2 + (c >> 5), rr = r & 15, cc = c & 31, ob = rr * 64 + cc * 2; return st * 1024 + (ob ^ (((ob >> 9) & 1) << 5)); }
__host__ __device__ __forceinline__ void stage_rc(int b, int& R, int& C) { const int st = b / 1024, sb = b % 1024, swz = sb ^ (((sb >> 9) & 1) << 5); R = (st >> 1) * 16 + swz / 64; C = (st & 1) * 32 + (swz % 64) / 2; }
__host__ __device__ __forceinline__ int perm32(int rho) { const int n = rho >> 4, i = rho & 15; return 8 * (i >> 2) + 4 * n + (i & 3); }

struct Unit { int pm, pn; };
struct Gemm { const bf16_t* A; const bf16_t* Bt; int M, N, K, ld; };

struct StaticOrder {
    int nM, nN, nwg, G, c;
    __host__ __device__ void init(int M, int N, int G_, int c_) { nM = M / BM; nN = N / BM; nwg = nM * nN; G = G_; c = c_; }
    __host__ __device__ bool next(int i, Unit& u) const {
        const long L = (long)i * G + c; if (L >= nwg) return false;
        int wgid = (int)L; { const int q = nwg / NXCD, r = nwg % NXCD, xcd = wgid % NXCD, off = wgid / NXCD; wgid = (xcd < r ? xcd * (q + 1) : r * (q + 1) + (xcd - r) * q) + off; }
        const int nig = WGM * nN, gid = wgid / nig, fm = gid * WGM, gsz = (nM - fm) < WGM ? (nM - fm) : WGM;
        u.pm = fm + ((wgid % nig) % gsz); u.pn = (wgid % nig) / gsz; return true;
    }
    __device__ __forceinline__ void a_ready(const Unit&) const {}
    __device__ __forceinline__ void done(const Unit&) const {}
};
__device__ __forceinline__ unsigned cvt_pk_bf16(float lo, float hi) { unsigned r; asm volatile("v_cvt_pk_bf16_f32 %0, %1, %2" : "=v"(r) : "v"(lo), "v"(hi)); return r; }

template <class Epi, class Sched, bool ALIGN_EPI = false, bool SP2 = false>
__device__ __forceinline__ void gemm_phase(PG8_LAS unsigned char* lds, const Gemm g, const Sched& S, const Epi& E, int tid_) {
    asm volatile("" : "+v"(tid_));
    const int tid = tid_, wid = __builtin_amdgcn_readfirstlane(tid >> 6), lane = tid & 63, wr = wid >> 2, wc = wid & 3, fr = lane & 15, fq = lane >> 4;
    int K = g.K; asm volatile("" : "+s"(K));
    const int nt = K / BK; const int LD = g.ld;
    unsigned voffA[2], voffB[2];
#pragma unroll
    for (int i = 0; i < 2; ++i) { int R, C; stage_rc(tid * 16 + i * 8192, R, C); const int Rb = Epi::PERM ? ((R & ~31) + perm32(R & 31)) : R;
        voffA[i] = (unsigned)(R * LD + C) * 2u; voffB[i] = (unsigned)(Rb * LD + C) * 2u; }
    const size_t kstep = (size_t)(BK * 2);
    const size_t hstep = (size_t)HALF * LD * 2;
    const size_t tstep = 2 * hstep;
    const unsigned ldsw = (unsigned)wid * 1024u;
    const int aoff = lds_byte(wr * 64 + fr, fq * 8), boff = lds_byte(wc * 32 + fr, fq * 8);
#define PG8_SA(b, h) (((b) * 2 + (h)) * HTB)
#define PG8_SB(b, h) ((4 + (b) * 2 + (h)) * HTB)
#define PG8_STAGE(bufoff, gbase, voff) do { _Pragma("unroll") for (int _i = 0; _i < 2; ++_i) \
        __builtin_amdgcn_global_load_lds((const unsigned*)((const char*)(gbase) + (voff)[_i]), (PG8_LAS unsigned*)(lds + (bufoff) + ldsw + _i * 8192), 16, 0, 0); } while (0)
#define PG8_LDA(dst, b, h) do { _Pragma("unroll") for (int m = 0; m < 4; ++m) _Pragma("unroll") for (int k = 0; k < 2; ++k) dst[m][k] = *(const PG8_LAS bf16x8*)(lds + PG8_SA(b, h) + aoff + m * 2048 + k * 1024); } while (0)
#define PG8_LDB(dst, b, h) do { _Pragma("unroll") for (int n = 0; n < 2; ++n) _Pragma("unroll") for (int k = 0; k < 2; ++k) dst[n][k] = *(const PG8_LAS bf16x8*)(lds + PG8_SB(b, h) + boff + n * 2048 + k * 1024); } while (0)
#define PG8_MMA(ai, bj, At, Bt) do { __builtin_amdgcn_s_setprio(1); _Pragma("unroll") for (int m = 0; m < 4; ++m) _Pragma("unroll") for (int n = 0; n < 2; ++n) _Pragma("unroll") for (int k = 0; k < 2; ++k) \
        acc[ai][bj][m][n] = __builtin_amdgcn_mfma_f32_16x16x32_bf16(Bt[n][k], At[m][k], acc[ai][bj][m][n], 0, 0, 0); __builtin_amdgcn_s_setprio(0); } while (0)
#define PG8_WAIT_V(n) asm volatile("s_waitcnt vmcnt(" #n ")" ::: "memory")
#define PG8_WAIT_L(n) asm volatile("s_waitcnt lgkmcnt(" #n ")" ::: "memory")
#define PG8_BAR __builtin_amdgcn_s_barrier()
#define PG8_SCHED __builtin_amdgcn_sched_barrier(0)
    Unit cur, nxt; int ui = 0;
    if (!S.next(0, cur)) return;
    f32x4 acc[2][2][4][2];
#pragma unroll
    for (int a = 0; a < 2; ++a)
#pragma unroll
        for (int b = 0; b < 2; ++b)
#pragma unroll
            for (int m = 0; m < 4; ++m)
#pragma unroll
                for (int n = 0; n < 2; ++n) acc[a][b][m][n] = (f32x4){0.f, 0.f, 0.f, 0.f};
    bf16x8 At[4][2], B0[2][2], B1[2][2];
    const char* cA = (const char*)g.A + (size_t)cur.pm * tstep; const char* cB = (const char*)g.Bt + (size_t)cur.pn * tstep;
    S.a_ready(cur);
    if constexpr (SP2) {
        PG8_STAGE(PG8_SB(0, 0), cB, voffB); PG8_STAGE(PG8_SB(0, 1), cB + hstep, voffB); PG8_STAGE(PG8_SA(0, 0), cA, voffA); PG8_STAGE(PG8_SA(0, 1), cA + hstep, voffA);
        if (wr == 1) PG8_BAR;
        PG8_WAIT_V(2); PG8_BAR;
        PG8_STAGE(PG8_SB(1, 0), cB + kstep, voffB); PG8_STAGE(PG8_SA(1, 0), cA + kstep, voffA); PG8_STAGE(PG8_SB(1, 1), cB + hstep + kstep, voffB);
        PG8_WAIT_V(6); PG8_BAR;
    } else {
        PG8_STAGE(PG8_SB(0, 0), cB, voffB); PG8_STAGE(PG8_SA(0, 0), cA, voffA); PG8_STAGE(PG8_SB(0, 1), cB + hstep, voffB); PG8_STAGE(PG8_SA(0, 1), cA + hstep, voffA);
        if (wr == 1) PG8_BAR;
        PG8_WAIT_V(4); PG8_BAR;
        PG8_STAGE(PG8_SB(1, 0), cB + kstep, voffB); PG8_STAGE(PG8_SA(1, 0), cA + kstep, voffA); PG8_STAGE(PG8_SB(1, 1), cB + hstep + kstep, voffB);
        PG8_WAIT_V(6); PG8_BAR;
    }
    for (;;) {
        const bool has_next = S.next(ui + 1, nxt);
        const char* nA = has_next ? (const char*)g.A + (size_t)nxt.pm * tstep : cA; const char* nB = has_next ? (const char*)g.Bt + (size_t)nxt.pn * tstep : cB;
        for (int t = 0; t < nt; t += 2) {
            const bool last = (t == nt - 2);
            if constexpr (Epi::MID_T > 0) { if (t == Epi::MID_T) E.mid(acc, cur, wr, wc, fr, fq); }
            const char* a1 = cA + (size_t)(t + 1) * kstep;
            const char* a2 = last ? nA : cA + (size_t)(t + 2) * kstep; const char* b2 = last ? nB : cB + (size_t)(t + 2) * kstep;
            const char* a3 = a2 + kstep; const char* b3 = b2 + kstep;
            if (last && has_next) S.a_ready(nxt);
            if constexpr (SP2) {
            PG8_LDB(B0, 0, 0); PG8_LDB(B1, 0, 1); PG8_SCHED; PG8_LDA(At, 0, 0); PG8_STAGE(PG8_SA(1, 1), a1 + hstep, voffA);
            PG8_WAIT_V(8); PG8_WAIT_L(0); PG8_BAR; PG8_MMA(0, 0, At, B0); PG8_MMA(0, 1, At, B1); PG8_BAR; PG8_SCHED;
            PG8_LDA(At, 0, 1); PG8_STAGE(PG8_SB(0, 0), b2, voffB); PG8_STAGE(PG8_SB(0, 1), b2 + hstep, voffB); PG8_STAGE(PG8_SA(0, 0), a2, voffA);
            PG8_WAIT_V(8); PG8_WAIT_L(0); PG8_BAR; PG8_MMA(1, 0, At, B0); PG8_MMA(1, 1, At, B1); PG8_BAR; PG8_SCHED;
            PG8_LDB(B0, 1, 0); PG8_LDB(B1, 1, 1); PG8_SCHED; PG8_LDA(At, 1, 0); PG8_STAGE(PG8_SA(0, 1), a2 + hstep, voffA);
            PG8_WAIT_V(8); PG8_WAIT_L(0); PG8_BAR; PG8_MMA(0, 0, At, B0); PG8_MMA(0, 1, At, B1); PG8_BAR; PG8_SCHED;
            PG8_LDA(At, 1, 1); PG8_STAGE(PG8_SB(1, 0), b3, voffB); PG8_STAGE(PG8_SB(1, 1), b3 + hstep, voffB); PG8_STAGE(PG8_SA(1, 0), a3, voffA);
            PG8_WAIT_V(8); PG8_WAIT_L(0); PG8_BAR; PG8_MMA(1, 0, At, B0); PG8_MMA(1, 1, At, B1); PG8_BAR; PG8_SCHED;
            } else {
            PG8_LDB(B0, 0, 0); PG8_SCHED; PG8_LDA(At, 0, 0); PG8_STAGE(PG8_SA(1, 1), a1 + hstep, voffA);
            PG8_WAIT_L(8); PG8_BAR; PG8_WAIT_L(0); PG8_MMA(0, 0, At, B0); PG8_BAR; PG8_SCHED;
            PG8_LDB(B1, 0, 1); PG8_STAGE(PG8_SB(0, 0), b2, voffB);
            PG8_BAR; PG8_WAIT_L(0); PG8_MMA(0, 1, At, B1); PG8_BAR;
            PG8_LDA(At, 0, 1); PG8_STAGE(PG8_SA(0, 0), a2, voffA);
            PG8_BAR; PG8_WAIT_L(0); PG8_MMA(1, 0, At, B0); PG8_BAR; PG8_SCHED;
            PG8_STAGE(PG8_SB(0, 1), b2 + hstep, voffB);
            PG8_WAIT_V(6); PG8_BAR; PG8_MMA(1, 1, At, B1); PG8_BAR;
            PG8_LDB(B0, 1, 0); PG8_SCHED; PG8_LDA(At, 1, 0); PG8_STAGE(PG8_SA(0, 1), a2 + hstep, voffA);
            PG8_WAIT_L(8); PG8_BAR; PG8_WAIT_L(0); PG8_MMA(0, 0, At, B0); PG8_BAR; PG8_SCHED;
            PG8_LDB(B1, 1, 1); PG8_STAGE(PG8_SB(1, 0), b3, voffB);
            PG8_BAR; PG8_WAIT_L(0); PG8_MMA(0, 1, At, B1); PG8_BAR;
            PG8_LDA(At, 1, 1); PG8_STAGE(PG8_SA(1, 0), a3, voffA);
            PG8_BAR; PG8_WAIT_L(0); PG8_MMA(1, 0, At, B0); PG8_BAR; PG8_SCHED;
            PG8_STAGE(PG8_SB(1, 1), b3 + hstep, voffB);
            PG8_WAIT_V(6); PG8_BAR; PG8_MMA(1, 1, At, B1); PG8_BAR;
            }
        }
        if constexpr (ALIGN_EPI) { if (wr == 0) PG8_BAR; }
        if constexpr (!Epi::AFTER_DRAIN) { E(acc, cur, wr, wc, fr, fq); S.done(cur); }
        if (!has_next) break;
#pragma unroll
        for (int a = 0; a < 2; ++a)
#pragma unroll
            for (int b = 0; b < 2; ++b)
#pragma unroll
                for (int m = 0; m < 4; ++m)
#pragma unroll
                    for (int n = 0; n < 2; ++n) acc[a][b][m][n] = (f32x4){0.f, 0.f, 0.f, 0.f};
        cur = nxt; cA = nA; cB = nB; ++ui;
        if constexpr (ALIGN_EPI) { if (wr == 1) PG8_BAR; }
    }
    PG8_WAIT_V(0);
    if constexpr (!ALIGN_EPI) { if (wr == 0) PG8_BAR; }
    PG8_BAR;
#undef PG8_SA
#undef PG8_SB
#undef PG8_STAGE
#undef PG8_LDA
#undef PG8_LDB
#undef PG8_MMA
#undef PG8_WAIT_V
#undef PG8_WAIT_L
#undef PG8_BAR
#undef PG8_SCHED
}
}

typedef f32x4 acc_t[2][2][4][2];
using pg8::Unit; using pg8::HALF; using pg8::BM;

struct EpiInproj {
    static constexpr bool PERM = true, AFTER_DRAIN = false; static constexpr int MID_T = 0;
    unsigned char* ws; const float* b_in; const float* g_q; const float* g_k;
    __device__ __forceinline__ void operator()(const acc_t& acc, const Unit& u, int wr, int wc, int fr, int fq) const {
        const int pn = u.pn;
        int mode, pitch, col0; size_t off;
        if (pn < 12) { const int seg = pn >> 1; mode = seg == 0 ? 1 : (seg == 1 ? 2 : 0); pitch = 512; col0 = 256 * (pn & 1); off = WS_Q + (size_t)seg * (32 * MiB); }
        else if (pn < 16) { mode = 3; pitch = 1024; col0 = 256 * (pn - 12); off = WS_SGA; }
        else { mode = 3; pitch = 1024; col0 = 256 * (pn - 16); off = WS_SGC; }
        bf16_t* base = (bf16_t*)(ws + off);
        const int lc0 = 64 * wc + 8 * fq;
        f32x4 bv[2][2], gv[2][2];
#pragma unroll
        for (int bj = 0; bj < 2; ++bj)
#pragma unroll
            for (int n = 0; n < 2; ++n) {
                bv[bj][n] = *(const f32x4*)(b_in + 256 * pn + lc0 + 32 * bj + 4 * n);
                const float* g = (mode == 2) ? g_k : g_q;
                gv[bj][n] = *(const f32x4*)(g + 8 * fq + 32 * bj + 4 * n);
            }
        const float qs = (mode == 1) ? C2 : 1.0f;
#pragma unroll
        for (int ai = 0; ai < 2; ++ai)
#pragma unroll
            for (int m = 0; m < 4; ++m) {
                const int row = u.pm * BM + ai * HALF + wr * 64 + m * 16 + fr;
                f32x4 v[2][2];
#pragma unroll
                for (int bj = 0; bj < 2; ++bj)
#pragma unroll
                    for (int n = 0; n < 2; ++n) v[bj][n] = acc[ai][bj][m][n] + bv[bj][n];
                if (mode == 1 || mode == 2) {
                    float ss = 0.f;
#pragma unroll
                    for (int bj = 0; bj < 2; ++bj)
#pragma unroll
                        for (int n = 0; n < 2; ++n) { const f32x4 x = v[bj][n]; ss += (x[0] * x[0] + x[1] * x[1]) + (x[2] * x[2] + x[3] * x[3]); }
                    ss += __shfl_xor(ss, 16); ss += __shfl_xor(ss, 32);
                    const float rstd = __frsqrt_rn(ss * (1.0f / 64.0f) + EPS) * qs;
#pragma unroll
                    for (int bj = 0; bj < 2; ++bj)
#pragma unroll
                        for (int n = 0; n < 2; ++n) v[bj][n] = v[bj][n] * rstd * gv[bj][n];
                } else if (mode == 3) {
#pragma unroll
                    for (int bj = 0; bj < 2; ++bj)
#pragma unroll
                        for (int n = 0; n < 2; ++n)
#pragma unroll
                            for (int j = 0; j < 4; ++j) v[bj][n][j] = sigmoidf_(v[bj][n][j]);
                }
                bf16_t* rowp = base + (size_t)row * pitch + col0 + lc0;
#pragma unroll
                for (int bj = 0; bj < 2; ++bj) {
                    u32x4 w; w.x = pg8::cvt_pk_bf16(v[bj][0][0], v[bj][0][1]); w.y = pg8::cvt_pk_bf16(v[bj][0][2], v[bj][0][3]); w.z = pg8::cvt_pk_bf16(v[bj][1][0], v[bj][1][1]); w.w = pg8::cvt_pk_bf16(v[bj][1][2], v[bj][1][3]);
                    *(u32x4*)(rowp + 32 * bj) = w;
                }
            }
    }
};

template <bool SECOND> struct EpiMerge {
    static constexpr bool PERM = true, AFTER_DRAIN = false; static constexpr int MID_T = 0;
    const bf16_t* gate; bf16_t* mout;
    __device__ __forceinline__ void operator()(const acc_t& acc, const Unit& u, int wr, int wc, int fr, int fq) const {
        const int col0 = u.pn * BM + wc * 32 + 8 * fq;
#pragma unroll
        for (int ai = 0; ai < 2; ++ai)
#pragma unroll
            for (int m = 0; m < 4; ++m) {
                const size_t ro = (size_t)(u.pm * BM + ai * HALF + wr * 64 + m * 16 + fr) * D + col0;
#pragma unroll
                for (int bj = 0; bj < 2; ++bj) {
                    const u32x4 c = *(const u32x4*)(gate + ro + bj * HALF);
                    const f32x4 v0 = acc[ai][bj][m][0], v1 = acc[ai][bj][m][1];
                    float r[8] = {v0[0] * bf_lo(c.x), v0[1] * bf_hi(c.x), v0[2] * bf_lo(c.y), v0[3] * bf_hi(c.y), v1[0] * bf_lo(c.z), v1[1] * bf_hi(c.z), v1[2] * bf_lo(c.w), v1[3] * bf_hi(c.w)};
                    if (SECOND) { const u32x4 p = *(const u32x4*)(mout + ro + bj * HALF);
                        r[0] += bf_lo(p.x); r[1] += bf_hi(p.x); r[2] += bf_lo(p.y); r[3] += bf_hi(p.y); r[4] += bf_lo(p.z); r[5] += bf_hi(p.z); r[6] += bf_lo(p.w); r[7] += bf_hi(p.w); }
                    u32x4 w; w.x = pg8::cvt_pk_bf16(r[0], r[1]); w.y = pg8::cvt_pk_bf16(r[2], r[3]); w.z = pg8::cvt_pk_bf16(r[4], r[5]); w.w = pg8::cvt_pk_bf16(r[6], r[7]);
                    *(u32x4*)(mout + ro + bj * HALF) = w;
                }
                asm volatile("" ::: "memory");
            }
    }
};

struct EpiResF32 {
    static constexpr bool PERM = false, AFTER_DRAIN = false; static constexpr int MID_T = 0;
    const float* x; float* out;
    __device__ __forceinline__ void operator()(const acc_t& acc, const Unit& u, int wr, int wc, int fr, int fq) const {
        const int col0 = u.pn * BM + wc * 32 + 4 * fq;
#pragma unroll
        for (int ai = 0; ai < 2; ++ai)
#pragma unroll
            for (int m = 0; m < 4; ++m) {
                const size_t ro = (size_t)(u.pm * BM + ai * HALF + wr * 64 + m * 16 + fr) * D + col0;
#pragma unroll
                for (int bj = 0; bj < 2; ++bj)
#pragma unroll
                    for (int n = 0; n < 2; ++n) { const f32x4 b = *(const f32x4*)(x + ro + bj * HALF + n * 16); *(f32x4*)(out + ro + bj * HALF + n * 16) = b + acc[ai][bj][m][n]; }
                if (m & 1) asm volatile("" ::: "memory");
            }
    }
};

struct EpiSwiglu {
    static constexpr bool PERM = true, AFTER_DRAIN = false; static constexpr int MID_T = 0;
    bf16_t* hdn;
    __device__ __forceinline__ void operator()(const acc_t& acc, const Unit& u, int wr, int wc, int fr, int fq) const {
        const int col0 = 128 * (u.pn & 3) + wc * 32 + 8 * fq;
#pragma unroll
        for (int ai = 0; ai < 2; ++ai)
#pragma unroll
            for (int m = 0; m < 4; ++m) {
                const size_t ro = (size_t)(u.pm * BM + ai * HALF + wr * 64 + m * 16 + fr) * DE + col0;
                float h[8];
#pragma unroll
                for (int n = 0; n < 2; ++n)
#pragma unroll
                    for (int j = 0; j < 4; ++j) { const float a = acc[ai][0][m][n][j], b = acc[ai][1][m][n][j]; h[4 * n + j] = a * sigmoidf_(a) * b; }
                u32x4 w; w.x = pg8::cvt_pk_bf16(h[0], h[1]); w.y = pg8::cvt_pk_bf16(h[2], h[3]); w.z = pg8::cvt_pk_bf16(h[4], h[5]); w.w = pg8::cvt_pk_bf16(h[6], h[7]);
                *(u32x4*)(hdn + ro) = w;
            }
    }
};

struct EpiDown {
    static constexpr bool PERM = true, AFTER_DRAIN = false; static constexpr int MID_T = 0;
    const int* row_slot; const float* row_w; bf16_t* contrib;
    __device__ __forceinline__ void operator()(const acc_t& acc, const Unit& u, int wr, int wc, int fr, int fq) const {
        const int col0 = 256 * (u.pn & 3) + wc * 32 + 8 * fq;
#pragma unroll
        for (int ai = 0; ai < 2; ++ai)
#pragma unroll
            for (int m = 0; m < 4; ++m) {
                const int row = u.pm * BM + ai * HALF + wr * 64 + m * 16 + fr;
                const int slot = row_slot[row]; const float w = row_w[row];
                if (slot >= 0) {
#pragma unroll
                    for (int bj = 0; bj < 2; ++bj) {
                        const f32x4 v0 = acc[ai][bj][m][0] * w, v1 = acc[ai][bj][m][1] * w;
                        u32x4 o; o.x = pg8::cvt_pk_bf16(v0[0], v0[1]); o.y = pg8::cvt_pk_bf16(v0[2], v0[3]); o.z = pg8::cvt_pk_bf16(v1[0], v1[1]); o.w = pg8::cvt_pk_bf16(v1[2], v1[3]);
                        *(u32x4*)(contrib + (size_t)slot * D + col0 + bj * HALF) = o;
                    }
                }
            }
    }
};

struct EpiPP {
    static constexpr bool PERM = false, AFTER_DRAIN = false; static constexpr int MID_T = 0;
    bf16_t* pp;
    __device__ __forceinline__ void operator()(const acc_t& acc, const Unit& u, int wr, int wc, int fr, int fq) const {
        const int col0 = u.pn * BM + wc * 32 + 4 * fq;
#pragma unroll
        for (int ai = 0; ai < 2; ++ai)
#pragma unroll
            for (int m = 0; m < 4; ++m) {
                const size_t ro = (size_t)(u.pm * BM + ai * HALF + wr * 64 + m * 16 + fr) * D + col0;
#pragma unroll
                for (int bj = 0; bj < 2; ++bj)
#pragma unroll
                    for (int n = 0; n < 2; ++n) { const f32x4 v = acc[ai][bj][m][n]; u32x2 w; w.x = pg8::cvt_pk_bf16(v[0], v[1]); w.y = pg8::cvt_pk_bf16(v[2], v[3]); *(u32x2*)(pp + ro + bj * HALF + n * 16) = w; }
            }
    }
};
struct EpiGate {
    static constexpr bool PERM = false, AFTER_DRAIN = false; static constexpr int MID_T = 0;
    const bf16_t* pp; const float* bpg; float* out;
    __device__ __forceinline__ void operator()(const acc_t& acc, const Unit& u, int wr, int wc, int fr, int fq) const {
        const int col0 = u.pn * BM + wc * 32 + 4 * fq;
#pragma unroll
        for (int ai = 0; ai < 2; ++ai)
#pragma unroll
            for (int m = 0; m < 4; ++m) {
                const size_t ro = (size_t)(u.pm * BM + ai * HALF + wr * 64 + m * 16 + fr) * D + col0;
#pragma unroll
                for (int bj = 0; bj < 2; ++bj)
#pragma unroll
                    for (int n = 0; n < 2; ++n) {
                        const size_t o = ro + bj * HALF + n * 16;
                        const f32x4 h = *(const f32x4*)(out + o); const u32x2 pw = *(const u32x2*)(pp + o);
                        const f32x4 a = acc[ai][bj][m][n] + *(const f32x4*)(bpg + col0 + bj * HALF + n * 16);
                        f32x4 r;
                        r[0] = h[0] + sigmoidf_(a[0]) * bf_lo(pw.x); r[1] = h[1] + sigmoidf_(a[1]) * bf_hi(pw.x);
                        r[2] = h[2] + sigmoidf_(a[2]) * bf_lo(pw.y); r[3] = h[3] + sigmoidf_(a[3]) * bf_hi(pw.y);
                        *(f32x4*)(out + o) = r;
                    }
                asm volatile("" ::: "memory");
            }
    }
};

struct MoeOrder {
    const LAS int* pref;
    int nunits, G, c;
    __device__ __forceinline__ bool next(int i, Unit& u) const {
        const int L = i * G + c; if (L >= nunits) return false;
        const int rtg = L >> 2, pnl = L & 3; int e = 0;
#pragma unroll 4
        for (int k = 1; k < NE; ++k) e += (pref[k] <= rtg) ? 1 : 0;
        e = __builtin_amdgcn_readfirstlane(e);
        u.pm = rtg; u.pn = 4 * e + pnl; return true;
    }
    __device__ __forceinline__ void a_ready(const Unit&) const {}
    __device__ __forceinline__ void done(const Unit&) const {}
};

#define XB_TMO      128
#define XB_XCNT(j)  (256  + 64 * (j))
#define XB_XSUB(j)  (1280 + 64 * (j))
#define XB_XGEN(j)  (2304 + 64 * (j))
#define XB_TOP      3328
#define XB_TOPGEN   3392
#define XCD_BAR_WORDS 3456
#define XB_SPIN_CAP (1u << 18)

__device__ __forceinline__ unsigned xb_ld(unsigned* p)              { return __hip_atomic_load(p, __ATOMIC_RELAXED, __HIP_MEMORY_SCOPE_AGENT); }
__device__ __forceinline__ unsigned xb_add(unsigned* p, unsigned v) { return __hip_atomic_fetch_add(p, v, __ATOMIC_RELAXED, __HIP_MEMORY_SCOPE_AGENT); }
__device__ __forceinline__ unsigned xb_xcc_id() { return (unsigned)__builtin_amdgcn_s_getreg((3 << 11) | 20) & 0xFu; }
#define XB_SPIN(cond, bar) do { unsigned _sp = 0; while (cond) { __builtin_amdgcn_s_sleep(1); \
    if ((++_sp & 255u) == 0u) { if (xb_ld(&(bar)[XB_TMO])) break; if (_sp > XB_SPIN_CAP) { atomicAdd(&(bar)[XB_TMO], 1u); break; } } } } while (0)

struct XcdBarrier {
    unsigned* bar; unsigned x;
    volatile LAS unsigned* st;
};

__device__ __forceinline__ XcdBarrier xcd_barrier_post(unsigned* bar, volatile LAS unsigned* st) {
    XcdBarrier b; b.bar = bar; b.x = xb_xcc_id(); b.st = st;
    if (threadIdx.x == 0) (void)xb_add(&bar[XB_XCNT(b.x)], 1u);
    return b;
}
__device__ __forceinline__ void xcd_barrier_complete(unsigned* bar, unsigned x, unsigned& nloc, unsigned& nx) {
    const unsigned G = gridDim.x * gridDim.y * gridDim.z;
    unsigned sum, cnt, mine, sp = 0u;
    for (;;) {
        sum = 0u; cnt = 0u; mine = 0u;
#pragma unroll
        for (unsigned j = 0; j < 16; ++j) { const unsigned c = xb_ld(&bar[XB_XCNT(j)]); sum += c; cnt += (c > 0u) ? 1u : 0u; mine = (j == x) ? c : mine; }
        if (sum == G) break;
        __builtin_amdgcn_s_sleep(1);
        if ((++sp & 255u) == 0u) { if (xb_ld(&bar[XB_TMO])) break; if (sp > XB_SPIN_CAP) { atomicAdd(&bar[XB_TMO], 1u); break; } }
    }
    nloc = mine > 0u ? mine : 1u; nx = cnt > 0u ? cnt : 1u;
}

__device__ __forceinline__ void xcd_barrier(const XcdBarrier& b, int tid) {
    asm volatile("s_waitcnt vmcnt(0)" ::: "memory");
    __syncthreads();
    if (tid == 0) {
        unsigned* bar = b.bar;
        __builtin_amdgcn_s_waitcnt(0);
        unsigned nloc = b.st[0], nx = b.st[1];
        if (nloc == 0u) { xcd_barrier_complete(bar, b.x, nloc, nx); b.st[0] = nloc; b.st[1] = nx; }
        const unsigned old = xb_add(&bar[XB_XSUB(b.x)], 1u);
        const unsigned gen = old / nloc;
        if (old + 1u == (gen + 1u) * nloc) {
            __builtin_amdgcn_fence(__ATOMIC_RELEASE, "agent");
            asm volatile("s_waitcnt vmcnt(0)" ::: "memory");
            const unsigned og = xb_add(&bar[XB_TOP], 1u);
            const unsigned tg = og / nx;
            if (og + 1u == (tg + 1u) * nx) xb_add(&bar[XB_TOPGEN], 1u);
            else XB_SPIN(xb_ld(&bar[XB_TOPGEN]) == tg, bar);
            __builtin_amdgcn_fence(__ATOMIC_ACQUIRE, "agent");
            xb_add(&bar[XB_XGEN(b.x)], 1u);
            asm volatile("s_waitcnt vmcnt(0)" ::: "memory");
        } else {
            XB_SPIN(xb_ld(&bar[XB_XGEN(b.x)]) == gen, bar);
            __builtin_amdgcn_fence(__ATOMIC_ACQUIRE, "agent");
            asm volatile("s_waitcnt vmcnt(0)" ::: "memory");
        }
    }
    __syncthreads();
}

struct Args {
    const float *x, *p, *g_mix, *w_in, *b_in, *g_q, *g_k, *rel_bias, *conv_w, *conv_b, *w_pa, *w_pc, *w_o, *g_ffn, *w_group, *b_group, *w_router, *b_router, *w1, *w3, *w2, *g_ple, *w_pg, *b_pg, *w_pp;
    float* out; unsigned char* ws;
};
constexpr int NWAVES = 8, NTHREADS = 512;
constexpr int RING_BYTES = 131072, MISC_OFF = RING_BYTES;
constexpr int LDS_BYTES = 147456;

__device__ __forceinline__ void transpose_item(const float* src, int ldw, bf16_t* dst, int ldT, LAS float* scr, int lane) {
#pragma unroll 8
    for (int i = 0; i < 32; ++i) { const int kk = 2 * i + (lane >> 5); scr[kk * 33 + (lane & 31)] = src[(size_t)kk * ldw + (lane & 31)]; }
    LDS_WAIT(); asm volatile("" ::: "memory");
    const int c = lane & 7;
#pragma unroll
    for (int j = 0; j < 4; ++j) { const int n = (lane >> 3) + 8 * j; const LAS float* s = scr + (8 * c) * 33 + n;
        u32x4 o; o.x = pk2(s[0 * 33], s[1 * 33]); o.y = pk2(s[2 * 33], s[3 * 33]); o.z = pk2(s[4 * 33], s[5 * 33]); o.w = pk2(s[6 * 33], s[7 * 33]);
        *(u32x4*)(dst + (size_t)n * ldT + 8 * c) = o; }
    LDS_WAIT(); asm volatile("" ::: "memory");
}
__device__ __forceinline__ int win_phys_row(int n) { const int l = n & 255; return (n & ~255) | (((l >> 5) & 1) << 7) | (((l >> 6) & 3) << 5) | (l & 31); }

__device__ __forceinline__ void rms_row_to_bf16(const float* xrow, const float* g, bf16_t* orow, int lane) {
    const f32x4* xr = (const f32x4*)xrow + lane; const f32x4* gr = (const f32x4*)g + lane;
    f32x4 v[4]; float s = 0.f;
#pragma unroll
    for (int j = 0; j < 4; ++j) { v[j] = xr[64 * j]; s += (v[j].x * v[j].x + v[j].y * v[j].y) + (v[j].z * v[j].z + v[j].w * v[j].w); }
    const float rstd = rsqrtf(wave_sum(s) * (1.f / D) + EPS);
    unsigned long long* o8 = (unsigned long long*)orow + lane;
#pragma unroll
    for (int j = 0; j < 4; ++j) { const f32x4 gg = gr[64 * j]; o8[64 * j] = (unsigned long long)pk2(v[j].x * rstd * gg.x, v[j].y * rstd * gg.y) | ((unsigned long long)pk2(v[j].z * rstd * gg.z, v[j].w * rstd * gg.w) << 32); }
}

#ifndef FAST_G1
#define FAST_G1 1
#endif
#ifndef FAST_ATTN
#define FAST_ATTN 0
#endif
#ifndef FAST_G2
#define FAST_G2 1
#endif
#ifndef FAST_G3
#define FAST_G3 1
#endif
#ifndef FAST_G4
#define FAST_G4 1
#endif
#ifndef FAST_G5
#define FAST_G5 1
#endif
#ifndef FAST_G6
#define FAST_G6 1
#endif

template <class BRow>
__device__ __forceinline__ void naive_tile(const bf16_t* A, int lda, int K, BRow brow, LAS float* tile, bool accumulate) {
    const int tid = threadIdx.x, tr = tid >> 4, tc = tid & 15;
    float acc[2][4] = {{0.f, 0.f, 0.f, 0.f}, {0.f, 0.f, 0.f, 0.f}};
    const bf16_t* a0 = A + (size_t)(2 * tr) * lda; const bf16_t* a1 = a0 + lda;
    const bf16_t* b[4];
#pragma unroll
    for (int j = 0; j < 4; ++j) b[j] = brow(4 * tc + j);
    for (int k = 0; k < K; k += 8) {
        const u32x4 av0 = *(const u32x4*)(a0 + k), av1 = *(const u32x4*)(a1 + k);
#pragma unroll
        for (int j = 0; j < 4; ++j) {
            const u32x4 bv = *(const u32x4*)(b[j] + k);
#pragma unroll
            for (int e = 0; e < 4; ++e) {
                const float bl = bf_lo(bv[e]), bh = bf_hi(bv[e]);
                acc[0][j] += bf_lo(av0[e]) * bl + bf_hi(av0[e]) * bh;
                acc[1][j] += bf_lo(av1[e]) * bl + bf_hi(av1[e]) * bh;
            }
        }
    }
#pragma unroll
    for (int r = 0; r < 2; ++r)
#pragma unroll
        for (int j = 0; j < 4; ++j) { LAS float* t = tile + (2 * tr + r) * 65 + 4 * tc + j; *t = accumulate ? (*t + acc[r][j]) : acc[r][j]; }
}


typedef __attribute__((address_space(4))) const Args* KArgPtr;
__device__ __forceinline__ KArgPtr kargs() { KArgPtr p = (KArgPtr)__builtin_amdgcn_kernarg_segment_ptr(); asm volatile("" : "+s"(p)); return p; }
#define ctl ((unsigned*)(ws + WS_CTL))
#define wrt ((float*)(ws + WS_TAB))
#define rt_e ((int*)(ws + WS_ROUTE))
#define rt_pos (rt_e + 2 * T)
#define rt_w ((float*)(rt_pos + 2 * T))
#define row_slot ((int*)(ws + WS_ROWMETA))
#define row_w ((float*)(row_slot + XS_ROWS))
#define Win_t ((bf16_t*)(ws + WS_WIN))
#define Wm_t ((bf16_t*)(ws + WS_WM))
#define Wo_t ((bf16_t*)(ws + WS_WO))
#define Wpg_t ((bf16_t*)(ws + WS_WPG))
#define Wpp_t ((bf16_t*)(ws + WS_WPP))
#define pb ((bf16_t*)(ws + WS_PB))
#define nbuf ((bf16_t*)(ws + WS_NBUF))
#define qb ((bf16_t*)(ws + WS_Q))
#define kb ((bf16_t*)(ws + WS_K))
#define vb ((bf16_t*)(ws + WS_V))
#define ub ((bf16_t*)(ws + WS_U))
#define bgb ((bf16_t*)(ws + WS_BG))
#define cgb ((bf16_t*)(ws + WS_CG))
#define sga ((bf16_t*)(ws + WS_SGA))
#define sgc ((bf16_t*)(ws + WS_SGC))
#define yac ((bf16_t*)(ws + WS_YAC))
#define mbuf ((bf16_t*)(ws + WS_M))
#define W13_t ((bf16_t*)(ws + WS_W13))
#define W2_t ((bf16_t*)(ws + WS_W2))
#define xs ((bf16_t*)(ws + WS_XS))
#define hdn ((bf16_t*)(ws + WS_HDN))
#define contrib ((bf16_t*)(ws + WS_CONTRIB))
#define ppb ((bf16_t*)(ws + WS_PP))
#define tile0 ((LAS float*)lds)
#define tile1 (tile0 + 64 * 65)
#define pref ((LAS int*)(lds + MISC_OFF))
#define cnts (pref + 64)
__global__ void __launch_bounds__(NTHREADS, 2) fwd_kernel(Args a) {
    extern __shared__ __attribute__((aligned(16))) unsigned char lds_raw[];
    cg::grid_group grid = cg::this_grid();
    LAS unsigned char* lds = (LAS unsigned char*)lds_raw;
    const int G = gridDim.x, bx = blockIdx.x;
    const int wave_s = __builtin_amdgcn_readfirstlane((int)threadIdx.x >> 6);
    volatile LAS unsigned* bst = (volatile LAS unsigned*)(lds + MISC_OFF + 512);
    if (threadIdx.x < 2) bst[threadIdx.x] = 0u;
    __syncthreads();
    const XcdBarrier bar = xcd_barrier_post((unsigned*)(a.ws + WS_CTL) + CW_BAR, bst);
#define XBAR() do { int t_ = (wave_s << 6) | lane_id_fresh(); xcd_barrier(bar, t_); } while (0)
#define PHASE_VARS() const KArgPtr ap = kargs(); unsigned char* const ws = ap->ws; (void)ws; int tid = (wave_s << 6) | lane_id_fresh(); asm volatile("" : "+v"(tid)); const int lane = tid & 63, wave = __builtin_amdgcn_readfirstlane(tid >> 6); \
    const int gw = bx * NWAVES + wave, NGW = G * NWAVES; const size_t gtid = (size_t)bx * NTHREADS + tid, GT = (size_t)G * NTHREADS; (void)lane; (void)gw; (void)NGW; (void)gtid; (void)GT
    {
        PHASE_VARS();
        LAS float* scr = (LAS float*)(lds + wave * 16384);
        constexpr int I_IN = 16 * 160, I_PA = 8 * 32, I_PC = 8 * 32, I_O = 16 * 32, I_PG = 16 * 32, I_PP = 4 * 32;
        constexpr int NIT = I_IN + I_PA + I_PC + I_O + I_PG + I_PP;
        for (int it = gw; it < NIT; it += NGW) {
            int r = it;
            if (r < I_IN) { const int kb_ = r / 160, nb = r % 160; transpose_item(ap->w_in + (size_t)(kb_ * 64) * NIN + nb * 32, NIN, Win_t + (size_t)win_phys_row(nb * 32) * D + kb_ * 64, D, scr, lane); continue; } r -= I_IN;
            if (r < I_PA) { const int kb_ = r / 32, nb = r % 32; transpose_item(ap->w_pa + (size_t)(kb_ * 64) * D + nb * 32, D, Wm_t + (size_t)(nb * 32) * D + kb_ * 64, D, scr, lane); continue; } r -= I_PA;
            if (r < I_PC) { const int kb_ = r / 32, nb = r % 32; transpose_item(ap->w_pc + (size_t)(kb_ * 64) * D + nb * 32, D, Wm_t + (size_t)(nb * 32) * D + 512 + kb_ * 64, D, scr, lane); continue; } r -= I_PC;
            if (r < I_O) { const int kb_ = r / 32, nb = r % 32; transpose_item(ap->w_o + (size_t)(kb_ * 64) * D + nb * 32, D, Wo_t + (size_t)(nb * 32) * D + kb_ * 64, D, scr, lane); continue; } r -= I_O;
            if (r < I_PG) { const int kb_ = r / 32, nb = r % 32; transpose_item(ap->w_pg + (size_t)(kb_ * 64) * D + nb * 32, D, Wpg_t + (size_t)(nb * 32) * D + kb_ * 64, D, scr, lane); continue; } r -= I_PG;
            { const int kb_ = r / 32, nb = r % 32; transpose_item(ap->w_pp + (size_t)(kb_ * 64) * D + nb * 32, D, Wpp_t + (size_t)(nb * 32) * PLE + kb_ * 64, PLE, scr, lane); }
        }
        for (size_t i = gtid; i < (size_t)36 * D; i += GT) { const int c = (int)(i / D), k = (int)(i % D); wrt[i] = c < 4 ? ap->w_group[k * 4 + c] : ap->w_router[k * 32 + (c - 4)]; }
        for (int m = gw; m < T; m += NGW) rms_row_to_bf16(ap->x + (size_t)m * D, ap->g_mix, nbuf + (size_t)m * D, lane);
        for (size_t i = gtid; i < (size_t)T * PLE / 8; i += GT) { const f32x4 v0 = ((const f32x4*)ap->p)[2 * i], v1 = ((const f32x4*)ap->p)[2 * i + 1];
            u32x4 o; o.x = pk2(v0.x, v0.y); o.y = pk2(v0.z, v0.w); o.z = pk2(v1.x, v1.y); o.w = pk2(v1.z, v1.w); ((u32x4*)pb)[i] = o; }
    }
    grid.sync();

#if FAST_G1
    { PHASE_VARS(); pg8::Gemm g{nbuf, Win_t, T, NIN, D, D}; pg8::StaticOrder S; S.init(T, NIN, G, bx); EpiInproj E{ws, ap->b_in, ap->g_q, ap->g_k};
      pg8::gemm_phase<EpiInproj, pg8::StaticOrder, true, true>(lds, g, S, E, tid); }
#else
    { PHASE_VARS();
    for (int tl = bx; tl < 512 * 80; tl += G) {
        const int rt = tl / 80, ct = tl % 80;
        naive_tile(nbuf + (size_t)rt * 64 * D, D, D, [=](int i) { return (const bf16_t*)(Win_t + (size_t)win_phys_row(64 * ct + i) * D); }, tile0, false);
        __syncthreads();
        const int row = tid >> 3, c8 = (tid & 7) * 8; float v[8]; float ss = 0.f;
#pragma unroll
        for (int j = 0; j < 8; ++j) { v[j] = tile0[row * 65 + c8 + j] + ap->b_in[64 * ct + c8 + j]; ss += v[j] * v[j]; }
        ss += __shfl_xor(ss, 1); ss += __shfl_xor(ss, 2); ss += __shfl_xor(ss, 4);
        bf16_t* dst;
        if (ct < 48) { const int seg = ct >> 3; dst = (bf16_t*)(ws + WS_Q + (size_t)seg * (32 * MiB)) + (size_t)(rt * 64 + row) * 512 + 64 * (ct & 7) + c8;
            if (seg < 2) { const float rstd = rsqrtf(ss * (1.f / 64.f) + EPS) * (seg == 0 ? C2 : 1.f); const float* g = seg == 0 ? ap->g_q : ap->g_k;
#pragma unroll
                for (int j = 0; j < 8; ++j) v[j] = v[j] * rstd * g[c8 + j]; } }
        else { dst = (ct < 64 ? sga : sgc) + (size_t)(rt * 64 + row) * D + 64 * ((ct - 48) & 15) + c8;
#pragma unroll
            for (int j = 0; j < 8; ++j) v[j] = sigmoidf_(v[j]); }
        u32x4 o; o.x = pk2(v[0], v[1]); o.y = pk2(v[2], v[3]); o.z = pk2(v[4], v[5]); o.w = pk2(v[6], v[7]); *(u32x4*)dst = o;
        __syncthreads();
    } }
#endif
    XBAR();

    {
        PHASE_VARS();
        for (size_t i = gtid; i < (size_t)T * (CW / 8); i += GT) {
            const int t = (int)(i >> 6), c8 = (int)(i & 63) * 8, s = t & (SEQ - 1);
            const size_t o = (size_t)t * CW + c8;
            const u32x4 u0 = *(const u32x4*)(ub + o), g0 = *(const u32x4*)(cgb + o), b0 = *(const u32x4*)(bgb + o);
            u32x4 u1 = {0u, 0u, 0u, 0u}, g1 = u1, u2 = u1, g2 = u1;
            if (s >= 1) { u1 = *(const u32x4*)(ub + o - CW); g1 = *(const u32x4*)(cgb + o - CW); }
            if (s >= 2) { u2 = *(const u32x4*)(ub + o - 2 * CW); g2 = *(const u32x4*)(cgb + o - 2 * CW); }
            float y[8];
#pragma unroll
            for (int e = 0; e < 4; ++e) {
#pragma unroll
                for (int hh = 0; hh < 2; ++hh) {
                    const int c = c8 + 2 * e + hh;
                    const float cu0 = hh ? bf_hi(u0[e]) * bf_hi(g0[e]) : bf_lo(u0[e]) * bf_lo(g0[e]);
                    const float cu1 = hh ? bf_hi(u1[e]) * bf_hi(g1[e]) : bf_lo(u1[e]) * bf_lo(g1[e]);
                    const float cu2 = hh ? bf_hi(u2[e]) * bf_hi(g2[e]) : bf_lo(u2[e]) * bf_lo(g2[e]);
                    const float bgv = hh ? bf_hi(b0[e]) : bf_lo(b0[e]);
                    y[2 * e + hh] = bgv * (ap->conv_b[c] + ap->conv_w[c] * cu2 + ap->conv_w[CW + c] * cu1 + ap->conv_w[2 * CW + c] * cu0);
                }
            }
            u32x4 w; w.x = pk2(y[0], y[1]); w.y = pk2(y[2], y[3]); w.z = pk2(y[4], y[5]); w.w = pk2(y[6], y[7]);
            *(u32x4*)(yac + (size_t)t * D + 512 + c8) = w;
        }
#if FAST_ATTN
#else
        for (size_t i = gtid; i < (size_t)T * NH; i += GT) {
            const int h = (int)(i / T), t = (int)(i % T), s = t & (SEQ - 1), tb = t - s, c = s >> 6;
            float q[64], o[64];
#pragma unroll
            for (int d8 = 0; d8 < 8; ++d8) { const u32x4 w = *(const u32x4*)(qb + (size_t)t * AW + h * 64 + d8 * 8);
#pragma unroll
                for (int e = 0; e < 4; ++e) { q[d8 * 8 + 2 * e] = bf_lo(w[e]); q[d8 * 8 + 2 * e + 1] = bf_hi(w[e]); } }
#pragma unroll
            for (int d = 0; d < 64; ++d) o[d] = 0.f;
            float mrun = -1e30f, l = 0.f;
            int k0 = (c - 8) * 64; if (k0 < 0) k0 = 0;
            const int k1 = c * 64 + 63;
            for (int kp = k0; kp <= k1; ++kp) {
                const bf16_t* kr = kb + (size_t)(tb + kp) * AW + h * 64; float sc = 0.f;
#pragma unroll
                for (int d8 = 0; d8 < 8; ++d8) { const u32x4 w = *(const u32x4*)(kr + d8 * 8);
#pragma unroll
                    for (int e = 0; e < 4; ++e) sc += q[d8 * 8 + 2 * e] * bf_lo(w[e]) + q[d8 * 8 + 2 * e + 1] * bf_hi(w[e]); }
                int dd = s - kp; dd = dd < -63 ? -63 : (dd > 256 ? 256 : dd);
                sc += ap->rel_bias[h * NREL + dd + 63] * LOG2E;
                if (sc > mrun) { const float f = exp2f(mrun - sc); l *= f;
#pragma unroll
                    for (int d = 0; d < 64; ++d) o[d] *= f;
                    mrun = sc; }
                const float pr = exp2f(sc - mrun); l += pr;
                const bf16_t* vr = vb + (size_t)(tb + kp) * AW + h * 64;
#pragma unroll
                for (int d8 = 0; d8 < 8; ++d8) { const u32x4 w = *(const u32x4*)(vr + d8 * 8);
#pragma unroll
                    for (int e = 0; e < 4; ++e) { o[d8 * 8 + 2 * e] += pr * bf_lo(w[e]); o[d8 * 8 + 2 * e + 1] += pr * bf_hi(w[e]); } }
            }
            const float il = 1.f / l;
#pragma unroll
            for (int d8 = 0; d8 < 8; ++d8) { u32x4 w;
#pragma unroll
                for (int e = 0; e < 4; ++e) w[e] = pk2(o[d8 * 8 + 2 * e] * il, o[d8 * 8 + 2 * e + 1] * il);
                *(u32x4*)(yac + (size_t)t * D + h * 64 + d8 * 8) = w; }
        }
#endif
    }
    XBAR();

#if FAST_G2
    { PHASE_VARS(); pg8::StaticOrder S; S.init(T, D, G, bx);
      { pg8::Gemm g{yac, Wm_t, T, D, 512, D}; EpiMerge<false> E{sga, mbuf}; pg8::gemm_phase<EpiMerge<false>, pg8::StaticOrder, true, true>(lds, g, S, E, tid); }
      { pg8::Gemm g{yac + 512, Wm_t + 512, T, D, 512, D}; EpiMerge<true> E{sgc, mbuf}; pg8::gemm_phase<EpiMerge<true>, pg8::StaticOrder, true, true>(lds, g, S, E, tid); } }
#else
    { PHASE_VARS();
    for (int tl = bx; tl < 512 * 16; tl += G) {
        const int rt = tl / 16, ct = tl % 16;
        naive_tile(yac + (size_t)rt * 64 * D, D, 512, [=](int i) { return (const bf16_t*)(Wm_t + (size_t)(64 * ct + i) * D); }, tile0, false);
        naive_tile(yac + (size_t)rt * 64 * D + 512, D, 512, [=](int i) { return (const bf16_t*)(Wm_t + (size_t)(64 * ct + i) * D + 512); }, tile1, false);
        __syncthreads();
        const int row = tid >> 3, c8 = (tid & 7) * 8; const size_t o = (size_t)(rt * 64 + row) * D + 64 * ct + c8; float v[8];
#pragma unroll
        for (int j = 0; j < 8; ++j) v[j] = bf2f(sga[o + j]) * tile0[row * 65 + c8 + j] + bf2f(sgc[o + j]) * tile1[row * 65 + c8 + j];
        u32x4 w; w.x = pk2(v[0], v[1]); w.y = pk2(v[2], v[3]); w.z = pk2(v[4], v[5]); w.w = pk2(v[6], v[7]); *(u32x4*)(mbuf + o) = w;
        __syncthreads();
    } }
#endif
    XBAR();

#if FAST_G3
    { PHASE_VARS(); pg8::Gemm g{mbuf, Wo_t, T, D, D, D}; pg8::StaticOrder S; S.init(T, D, G, bx); EpiResF32 E{ap->x, ap->out};
      pg8::gemm_phase<EpiResF32, pg8::StaticOrder, true, true>(lds, g, S, E, tid); }
#else
    { PHASE_VARS();
    for (int tl = bx; tl < 512 * 16; tl += G) {
        const int rt = tl / 16, ct = tl % 16;
        naive_tile(mbuf + (size_t)rt * 64 * D, D, D, [=](int i) { return (const bf16_t*)(Wo_t + (size_t)(64 * ct + i) * D); }, tile0, false);
        __syncthreads();
        const int row = tid >> 3, c8 = (tid & 7) * 8; const size_t o = (size_t)(rt * 64 + row) * D + 64 * ct + c8;
#pragma unroll
        for (int j = 0; j < 8; ++j) ap->out[o + j] = ap->x[o + j] + tile0[row * 65 + c8 + j];
        __syncthreads();
    } }
#endif
    XBAR();

    {
        PHASE_VARS();
        for (int m = gw; m < T; m += NGW) {
            const f32x4* xr = (const f32x4*)(ap->out + (size_t)m * D) + lane; const f32x4* gr = (const f32x4*)ap->g_ffn + lane;
            f32x4 v[4]; float s = 0.f;
#pragma unroll
            for (int j = 0; j < 4; ++j) { v[j] = xr[64 * j]; s += (v[j].x * v[j].x + v[j].y * v[j].y) + (v[j].z * v[j].z + v[j].w * v[j].w); }
            const float rstd = rsqrtf(wave_sum(s) * (1.f / D) + EPS);
            unsigned long long* o8 = (unsigned long long*)(nbuf + (size_t)m * D) + lane;
#pragma unroll
            for (int j = 0; j < 4; ++j) { v[j] = v[j] * rstd * gr[64 * j]; o8[64 * j] = (unsigned long long)pk2(v[j].x, v[j].y) | ((unsigned long long)pk2(v[j].z, v[j].w) << 32); }
            float lg[36];
            const f32x4* wbase = (const f32x4*)wrt + lane; asm volatile("" : "+v"(wbase));
#pragma unroll
            for (int c = 0; c < 36; ++c) { const f32x4* wr_ = wbase + c * (D / 4); float d = 0.f;
#pragma unroll
                for (int j = 0; j < 4; ++j) { const f32x4 w = wr_[64 * j]; d += (v[j].x * w.x + v[j].y * w.y) + (v[j].z * w.z + v[j].w * w.w); }
                lg[c] = wave_sum(d); asm volatile("" ::: "memory"); }
            int grp = 0; float gmax = lg[0] + ap->b_group[0];
            float gl[4];
#pragma unroll
            for (int c = 0; c < 4; ++c) gl[c] = lg[c] + ap->b_group[c];
#pragma unroll
            for (int c = 1; c < 4; ++c) if (gl[c] > gmax) { gmax = gl[c]; grp = c; }
            float gs = 0.f;
#pragma unroll
            for (int c = 0; c < 4; ++c) gs += __expf(gl[c] - gmax);
            const float pgrp = 1.f / gs;
            float el[8];
#pragma unroll
            for (int c = 0; c < 8; ++c) { float x0 = lg[4 + c], x1 = lg[12 + c], x2 = lg[20 + c], x3 = lg[28 + c]; el[c] = (grp == 0 ? x0 : grp == 1 ? x1 : grp == 2 ? x2 : x3) + ap->b_router[grp * 8 + c]; }
            int i0 = 0; float l0 = el[0];
#pragma unroll
            for (int c = 1; c < 8; ++c) if (el[c] > l0) { l0 = el[c]; i0 = c; }
            int i1 = -1; float l1 = -3.0e38f;
#pragma unroll
            for (int c = 0; c < 8; ++c) if (c != i0 && el[c] > l1) { l1 = el[c]; i1 = c; }
            const float e1 = __expf(l1 - l0), w0 = pgrp / (1.f + e1), w1 = pgrp * e1 / (1.f + e1);
            if (lane == 0) {
                const int ea = grp * 8 + i0, eb = grp * 8 + i1;
                const int pa = (int)atomicAdd(&ctl[ea], 1u), pb_ = (int)atomicAdd(&ctl[eb], 1u);
                rt_e[2 * m] = ea; rt_e[2 * m + 1] = eb; rt_pos[2 * m] = pa; rt_pos[2 * m + 1] = pb_; rt_w[2 * m] = w0; rt_w[2 * m + 1] = w1;
            }
        }
        LAS float* scr = (LAS float*)(lds + wave * 16384);
        constexpr int I_13 = 16 * 16, I_2 = 8 * 32, PER_E = 2 * I_13 + I_2;
        for (int it = gw; it < NE * PER_E; it += NGW) {
            const int e = it / PER_E; int r = it % PER_E;
            if (r < 2 * I_13) { const int which = r / I_13; r %= I_13; const int kb_ = r / 16, nb = r % 16, j0 = nb * 32;
                const float* src = (which ? ap->w3 : ap->w1) + (size_t)e * D * DE + (size_t)(kb_ * 64) * DE + j0;
                transpose_item(src, DE, W13_t + (size_t)(e * 1024 + (j0 >> 7) * 256 + which * 128 + (j0 & 127)) * D + kb_ * 64, D, scr, lane); }
            else { r -= 2 * I_13; const int kb_ = r / 32, nb = r % 32;
                transpose_item(ap->w2 + (size_t)e * DE * D + (size_t)(kb_ * 64) * D + nb * 32, D, W2_t + (size_t)(e * 1024 + nb * 32) * DE + kb_ * 64, DE, scr, lane); }
        }
    }
    XBAR();

    {
        PHASE_VARS();
        if (tid < NE) cnts[tid] = (int)__hip_atomic_load(&ctl[tid], __ATOMIC_RELAXED, __HIP_MEMORY_SCOPE_AGENT);
        __syncthreads();
        if (tid == 0) { int acc_ = 0; for (int e = 0; e < NE; ++e) { pref[e] = acc_; acc_ += (cnts[e] + 255) >> 8; } pref[NE] = acc_; }
        __syncthreads();
        for (size_t i = gtid; i < (size_t)NE * 256; i += GT) { const int e = (int)(i >> 8), r = (int)(i & 255); const int c = cnts[e];
            if (c + r < (((c + 255) >> 8) << 8)) row_slot[pref[e] * 256 + c + r] = -1; }
        for (int it = gw; it < 2 * T; it += NGW) {
            const int e = rt_e[it], row = pref[e] * 256 + rt_pos[it];
            const u32x4* src = (const u32x4*)(nbuf + (size_t)(it >> 1) * D) + lane; u32x4* dst = (u32x4*)(xs + (size_t)row * D) + lane;
            const u32x4 v0 = src[0], v1 = src[64]; dst[0] = v0; dst[64] = v1;
            if (lane == 0) { row_slot[row] = it; row_w[row] = rt_w[it]; }
        }
    }
    XBAR();
    const int ntiles = __builtin_amdgcn_readfirstlane(pref[NE]);

#if FAST_G4
    { PHASE_VARS(); pg8::Gemm g{xs, W13_t, XS_ROWS, NE * 1024, D, D}; MoeOrder S{pref, ntiles * 4, G, bx}; EpiSwiglu E{hdn};
      pg8::gemm_phase<EpiSwiglu, MoeOrder, true, true>(lds, g, S, E, tid); }
#else
    { PHASE_VARS();
    for (int tl = bx; tl < ntiles * 4 * 8; tl += G) {
        const int rt = tl >> 3, ct = tl & 7, rtg = rt >> 2; int e = 0; for (int k = 1; k < NE; ++k) e += (pref[k] <= rtg) ? 1 : 0;
        naive_tile(xs + (size_t)rt * 64 * D, D, D, [=](int i) { const int j = 64 * ct + i; return (const bf16_t*)(W13_t + (size_t)(e * 1024 + (j >> 7) * 256 + (j & 127)) * D); }, tile0, false);
        naive_tile(xs + (size_t)rt * 64 * D, D, D, [=](int i) { const int j = 64 * ct + i; return (const bf16_t*)(W13_t + (size_t)(e * 1024 + (j >> 7) * 256 + 128 + (j & 127)) * D); }, tile1, false);
        __syncthreads();
        const int row = tid >> 3, c8 = (tid & 7) * 8; float v[8];
#pragma unroll
        for (int j = 0; j < 8; ++j) { const float x1 = tile0[row * 65 + c8 + j], x3 = tile1[row * 65 + c8 + j]; v[j] = x1 * sigmoidf_(x1) * x3; }
        u32x4 w; w.x = pk2(v[0], v[1]); w.y = pk2(v[2], v[3]); w.z = pk2(v[4], v[5]); w.w = pk2(v[6], v[7]); *(u32x4*)(hdn + (size_t)(rt * 64 + row) * DE + 64 * ct + c8) = w;
        __syncthreads();
    } }
#endif
    XBAR();

#if FAST_G5
    { PHASE_VARS(); pg8::Gemm g{hdn, W2_t, XS_ROWS, NE * 1024, DE, DE}; MoeOrder S{pref, ntiles * 4, G, bx}; EpiDown E{row_slot, row_w, contrib};
      pg8::gemm_phase<EpiDown, MoeOrder, true, true>(lds, g, S, E, tid); }
#else
    { PHASE_VARS();
    for (int tl = bx; tl < ntiles * 4 * 16; tl += G) {
        const int rt = tl >> 4, ct = tl & 15, rtg = rt >> 2; int e = 0; for (int k = 1; k < NE; ++k) e += (pref[k] <= rtg) ? 1 : 0;
        naive_tile(hdn + (size_t)rt * 64 * DE, DE, DE, [=](int i) { return (const bf16_t*)(W2_t + (size_t)(e * 1024 + 64 * ct + i) * DE); }, tile0, false);
        __syncthreads();
        const int row = tid >> 3, c8 = (tid & 7) * 8; const int grow = rt * 64 + row; const int slot = row_slot[grow];
        if (slot >= 0) { const float w_ = row_w[grow]; float v[8];
#pragma unroll
            for (int j = 0; j < 8; ++j) v[j] = tile0[row * 65 + c8 + j] * w_;
            u32x4 w; w.x = pk2(v[0], v[1]); w.y = pk2(v[2], v[3]); w.z = pk2(v[4], v[5]); w.w = pk2(v[6], v[7]); *(u32x4*)(contrib + (size_t)slot * D + 64 * ct + c8) = w; }
        __syncthreads();
    } }
#endif
    XBAR();

    { PHASE_VARS();
    for (int m = gw; m < T; m += NGW) {
        f32x4* xr = (f32x4*)(ap->out + (size_t)m * D) + lane; const f32x4* gr = (const f32x4*)ap->g_ple + lane;
        const u32x2* c0 = (const u32x2*)(contrib + (size_t)(2 * m) * D) + lane; const u32x2* c1 = (const u32x2*)(contrib + (size_t)(2 * m + 1) * D) + lane;
        f32x4 v[4]; float s = 0.f;
#pragma unroll
        for (int j = 0; j < 4; ++j) { v[j] = xr[64 * j]; const u32x2 p0 = c0[64 * j], p1 = c1[64 * j];
            v[j].x += bf_lo(p0.x) + bf_lo(p1.x); v[j].y += bf_hi(p0.x) + bf_hi(p1.x); v[j].z += bf_lo(p0.y) + bf_lo(p1.y); v[j].w += bf_hi(p0.y) + bf_hi(p1.y);
            xr[64 * j] = v[j]; s += (v[j].x * v[j].x + v[j].y * v[j].y) + (v[j].z * v[j].z + v[j].w * v[j].w); }
        const float rstd = rsqrtf(wave_sum(s) * (1.f / D) + EPS);
        unsigned long long* o8 = (unsigned long long*)(nbuf + (size_t)m * D) + lane;
#pragma unroll
        for (int j = 0; j < 4; ++j) { const f32x4 gg = gr[64 * j]; o8[64 * j] = (unsigned long long)pk2(v[j].x * rstd * gg.x, v[j].y * rstd * gg.y) | ((unsigned long long)pk2(v[j].z * rstd * gg.z, v[j].w * rstd * gg.w) << 32); }
    } }
    XBAR();

#if FAST_G6
    { PHASE_VARS(); pg8::StaticOrder S; S.init(T, D, G, bx);
      { pg8::Gemm g{pb, Wpp_t, T, D, PLE, PLE}; EpiPP E{ppb}; pg8::gemm_phase<EpiPP, pg8::StaticOrder, true, true>(lds, g, S, E, tid); }
      { pg8::Gemm g{nbuf, Wpg_t, T, D, D, D}; EpiGate E{ppb, ap->b_pg, ap->out}; pg8::gemm_phase<EpiGate, pg8::StaticOrder, true, true>(lds, g, S, E, tid); } }
#else
    { PHASE_VARS();
    for (int tl = bx; tl < 512 * 16; tl += G) {
        const int rt = tl / 16, ct = tl % 16;
        naive_tile(nbuf + (size_t)rt * 64 * D, D, D, [=](int i) { return (const bf16_t*)(Wpg_t + (size_t)(64 * ct + i) * D); }, tile0, false);
        naive_tile(pb + (size_t)rt * 64 * PLE, PLE, PLE, [=](int i) { return (const bf16_t*)(Wpp_t + (size_t)(64 * ct + i) * PLE); }, tile1, false);
        __syncthreads();
        const int row = tid >> 3, c8 = (tid & 7) * 8; const size_t o = (size_t)(rt * 64 + row) * D + 64 * ct + c8;
#pragma unroll
        for (int j = 0; j < 8; ++j) ap->out[o + j] = ap->out[o + j] + sigmoidf_(tile0[row * 65 + c8 + j] + ap->b_pg[64 * ct + c8 + j]) * tile1[row * 65 + c8 + j];
        __syncthreads();
    } }
#endif
}

extern "C" void kernel_launch(void* const* d_in, const int* in_sizes, int n_in, void* d_out, int out_size, void* d_ws, size_t ws_size, hipStream_t stream) {
    static int grid = 0;
    if (grid == 0) {
        if (n_in != 25 || out_size != T * D || ws_size < WS_END) { fprintf(stderr, "kernel_launch: unexpected shapes (n_in %d out %d ws %zu); nothing launched\n", n_in, out_size, ws_size); grid = -1; return; }
        int dev = 0, cus = 0, per_cu = 0;
        if (hipGetDevice(&dev) != hipSuccess || hipDeviceGetAttribute(&cus, hipDeviceAttributeMultiprocessorCount, dev) != hipSuccess) { grid = -1; return; }
        if (hipFuncSetAttribute((const void*)fwd_kernel, hipFuncAttributeMaxDynamicSharedMemorySize, LDS_BYTES) != hipSuccess) { fprintf(stderr, "kernel_launch: hipFuncSetAttribute failed\n"); grid = -1; return; }
        if (hipOccupancyMaxActiveBlocksPerMultiprocessor(&per_cu, (const void*)fwd_kernel, NTHREADS, LDS_BYTES) != hipSuccess || per_cu < 1) { fprintf(stderr, "kernel_launch: occupancy query says %d\n", per_cu); (void)hipGetLastError(); grid = -1; return; }
        grid = cus;
    }
    if (grid < 0) return;
    if (hipMemsetAsync((char*)d_ws + WS_CTL, 0, CTL_ZERO_BYTES, stream) != hipSuccess) { fprintf(stderr, "kernel_launch: memset failed\n"); return; }
    Args a{};
    const float** f = (const float**)&a;
    for (int i = 0; i < 25; ++i) f[i] = (const float*)d_in[i];
    a.out = (float*)d_out; a.ws = (unsigned char*)d_ws;
    void* args[] = {&a};
    hipError_t e = hipLaunchCooperativeKernel((const void*)fwd_kernel, dim3(grid), dim3(NTHREADS), args, LDS_BYTES, stream);
    if (e != hipSuccess) fprintf(stderr, "kernel_launch: cooperative launch failed: %s (grid %d)\n", hipGetErrorString(e), grid);
}
```

```cpp
#include <hip/hip_runtime.h>
#include <hip/hip_cooperative_groups.h>
#include <cstdio>
#include <cstdint>
namespace cg = cooperative_groups;

#define GAS __attribute__((address_space(1)))
#define LAS __attribute__((address_space(3)))
typedef unsigned short bf16_t;
typedef short bf16x8 __attribute__((ext_vector_type(8)));
typedef float f32x4 __attribute__((ext_vector_type(4)));
typedef float f32x2 __attribute__((ext_vector_type(2)));
typedef unsigned u32x4 __attribute__((ext_vector_type(4)));
typedef unsigned u32x2 __attribute__((ext_vector_type(2)));
typedef GAS unsigned gu32;
#define RLX_AGENT __ATOMIC_RELAXED, __HIP_MEMORY_SCOPE_AGENT

constexpr int T = 32768, D = 1024, SEQ = 4096, NBATCH = 8;
constexpr int NIN = 5120, NH = 8, HD = 64, AW = 512, CW = 512;
constexpr int NE = 32, DE = 512, PLE = 256, NREL = 320;
constexpr int XS_ROWS = 65536 + NE * 256;
constexpr float EPS = 1e-6f;
constexpr float LOG2E = 1.4426950408889634f;
constexpr float C2 = 0.125f * LOG2E;

constexpr size_t MiB = 1u << 20;
constexpr size_t WS_CTL = 0, CTL_ZERO_BYTES = 64 * 1024;
constexpr int CW_BAR = 1024;
constexpr size_t WS_TAB = 1 * MiB;
constexpr size_t WS_GTAB = WS_TAB + 160 * 1024;
constexpr size_t WS_GCINIT = WS_GTAB + 8 * 4 * 384 * 4;
constexpr size_t WS_ROUTE = 2 * MiB;
constexpr size_t WS_ROWMETA = 4 * MiB;
constexpr size_t WS_WIN = 6 * MiB;
constexpr size_t WS_WM = 16 * MiB;
constexpr size_t WS_WO = 18 * MiB;
constexpr size_t WS_WPG = 20 * MiB;
constexpr size_t WS_WPP = 22 * MiB;
constexpr size_t WS_PB = 24 * MiB;
constexpr size_t WS_NBUF = 40 * MiB;
constexpr size_t WS_Q = 104 * MiB, WS_K = 136 * MiB, WS_V = 168 * MiB, WS_U = 200 * MiB, WS_BG = 232 * MiB, WS_CG = 264 * MiB;
constexpr size_t WS_SGA = 296 * MiB, WS_SGC = 360 * MiB;
constexpr size_t WS_YAC = 424 * MiB;
constexpr size_t WS_M = 104 * MiB;
constexpr size_t WS_W13 = 168 * MiB;
constexpr size_t WS_W2 = 232 * MiB;
constexpr size_t WS_XS = 264 * MiB;
constexpr size_t WS_HDN = 408 * MiB;
constexpr size_t WS_CONTRIB = 264 * MiB;
constexpr size_t WS_PP = 104 * MiB;
constexpr size_t WS_END = 488 * MiB;

__device__ __forceinline__ unsigned f2bf(float f) { unsigned u = __builtin_bit_cast(unsigned, f); return (u + 0x7fffu + ((u >> 16) & 1u)) >> 16; }
__device__ __forceinline__ unsigned pk2(float lo, float hi) { return f2bf(lo) | (f2bf(hi) << 16); }
__device__ __forceinline__ float bf_lo(unsigned w) { return __builtin_bit_cast(float, w << 16); }
__device__ __forceinline__ float bf_hi(unsigned w) { return __builtin_bit_cast(float, w & 0xffff0000u); }
__device__ __forceinline__ float bf2f(bf16_t h) { return __builtin_bit_cast(float, (unsigned)h << 16); }
__device__ __forceinline__ float sigmoidf_(float x) { return __builtin_amdgcn_rcpf(1.0f + __builtin_amdgcn_exp2f(-LOG2E * x)); }
__device__ __forceinline__ float wave_sum(float v) {
#pragma unroll
    for (int o = 1; o < 64; o <<= 1) v += __shfl_xor(v, o);
    return v;
}
__device__ __forceinline__ int lane_id_fresh() { int l; asm volatile("v_mbcnt_lo_u32_b32 %0, -1, 0\n\tv_mbcnt_hi_u32_b32 %0, -1, %0" : "=v"(l)); return l; }
#define LDS_WAIT() asm volatile("s_waitcnt lgkmcnt(0)" ::: "memory")
#define VM_WAIT() asm volatile("s_waitcnt vmcnt(0)" ::: "memory")

namespace pg8 {
#define PG8_LAS __attribute__((address_space(3)))
constexpr int BM = 256, BK = 64, HALF = 128, HTB = HALF * BK * 2  , STAGE_BYTES = 8 * HTB, NXCD = 8, WGM = 8;

__host__ __device__ __forceinline__ int lds_byte(int r, int c) { const int st = (r >> 4) * 2 + (c >> 5), rr = r & 15, cc = c & 31, ob = rr * 64 + cc * 2; return st * 1024 + (ob ^ (((ob >> 9) & 1) << 5)); }
__host__ __device__ __forceinline__ void stage_rc(int b, int& R, int& C) { const int st = b / 1024, sb = b % 1024, swz = sb ^ (((sb >> 9) & 1) << 5); R = (st >> 1) * 16 + swz / 64; C = (st & 1) * 32 + (swz % 64) / 2; }
__host__ __device__ __forceinline__ int perm32(int rho) { const int n = rho >> 4, i = rho & 15; return 8 * (i >> 2) + 4 * n + (i & 3); }

struct Unit { int pm, pn; };
struct Gemm { const bf16_t* A; const bf16_t* Bt; int M, N, K, ld; };

struct StaticOrder {
    int nM, nN, nwg, G, c;
    __host__ __device__ void init(int M, int N, int G_, int c_) { nM = M / BM; nN = N / BM; nwg = nM * nN; G = G_; c = c_; }
    __host__ __device__ bool next(int i, Unit& u) const {
        const long L = (long)i * G + c; if (L >= nwg) return false;
        int wgid = (int)L; { const int q = nwg / NXCD, r = nwg % NXCD, xcd = wgid % NXCD, off = wgid / NXCD; wgid = (xcd < r ? xcd * (q + 1) : r * (q + 1) + (xcd - r) * q) + off; }
        const int nig = WGM * nN, gid = wgid / nig, fm = gid * WGM, gsz = (nM - fm) < WGM ? (nM - fm) : WGM;
        u.pm = fm + ((wgid % nig) % gsz); u.pn = (wgid % nig) / gsz; return true;
    }
    __device__ __forceinline__ void a_ready(const Unit&) const {}
    __device__ __forceinline__ void done(const Unit&) const {}
};
__device__ __forceinline__ unsigned cvt_pk_bf16(float lo, float hi) { unsigned r; asm volatile("v_cvt_pk_bf16_f32 %0, %1, %2" : "=v"(r) : "v"(lo), "v"(hi)); return r; }

template <class Epi, class Sched, bool ALIGN_EPI = false, bool SP2 = false>
__device__ __forceinline__ void gemm_phase(PG8_LAS unsigned char* lds, const Gemm g, const Sched& S, const Epi& E, int tid_) {
    asm volatile("" : "+v"(tid_));
    const int tid = tid_, wid = __builtin_amdgcn_readfirstlane(tid >> 6), lane = tid & 63, wr = wid >> 2, wc = wid & 3, fr = lane & 15, fq = lane >> 4;
    int K = g.K; asm volatile("" : "+s"(K));
    const int nt = K / BK; const int LD = g.ld;
    unsigned voffA[2], voffB[2];
#pragma unroll
    for (int i = 0; i < 2; ++i) { int R, C; stage_rc(tid * 16 + i * 8192, R, C); const int Rb = Epi::PERM ? ((R & ~31) + perm32(R & 31)) : R;
        voffA[i] = (unsigned)(R * LD + C) * 2u; voffB[i] = (unsigned)(Rb * LD + C) * 2u; }
    const size_t kstep = (size_t)(BK * 2);
    const size_t hstep = (size_t)HALF * LD * 2;
    const size_t tstep = 2 * hstep;
    const unsigned ldsw = (unsigned)wid * 1024u;
    const int aoff = lds_byte(wr * 64 + fr, fq * 8), boff = lds_byte(wc * 32 + fr, fq * 8);
#define PG8_SA(b, h) (((b) * 2 + (h)) * HTB)
#define PG8_SB(b, h) ((4 + (b) * 2 + (h)) * HTB)
#define PG8_STAGE(bufoff, gbase, voff) do { _Pragma("unroll") for (int _i = 0; _i < 2; ++_i) \
        __builtin_amdgcn_global_load_lds((const unsigned*)((const char*)(gbase) + (voff)[_i]), (PG8_LAS unsigned*)(lds + (bufoff) + ldsw + _i * 8192), 16, 0, 0); } while (0)
#define PG8_LDA(dst, b, h) do { _Pragma("unroll") for (int m = 0; m < 4; ++m) _Pragma("unroll") for (int k = 0; k < 2; ++k) dst[m][k] = *(const PG8_LAS bf16x8*)(lds + PG8_SA(b, h) + aoff + m * 2048 + k * 1024); } while (0)
#define PG8_LDB(dst, b, h) do { _Pragma("unroll") for (int n = 0; n < 2; ++n) _Pragma("unroll") for (int k = 0; k < 2; ++k) dst[n][k] = *(const PG8_LAS bf16x8*)(lds + PG8_SB(b, h) + boff + n * 2048 + k * 1024); } while (0)
#define PG8_MMA(ai, bj, At, Bt) do { __builtin_amdgcn_s_setprio(1); _Pragma("unroll") for (int m = 0; m < 4; ++m) _Pragma("unroll") for (int n = 0; n < 2; ++n) _Pragma("unroll") for (int k = 0; k < 2; ++k) \
        acc[ai][bj][m][n] = __builtin_amdgcn_mfma_f32_16x16x32_bf16(Bt[n][k], At[m][k], acc[ai][bj][m][n], 0, 0, 0); __builtin_amdgcn_s_setprio(0); } while (0)
#define PG8_WAIT_V(n) asm volatile("s_waitcnt vmcnt(" #n ")" ::: "memory")
#define PG8_WAIT_L(n) asm volatile("s_waitcnt lgkmcnt(" #n ")" ::: "memory")
#define PG8_BAR __builtin_amdgcn_s_barrier()
#define PG8_SCHED __builtin_amdgcn_sched_barrier(0)
    Unit cur, nxt; int ui = 0;
    if (!S.next(0, cur)) return;
    f32x4 acc[2][2][4][2];
#pragma unroll
    for (int a = 0; a < 2; ++a)
#pragma unroll
        for (int b = 0; b < 2; ++b)
#pragma unroll
            for (int m = 0; m < 4; ++m)
#pragma unroll
                for (int n = 0; n < 2; ++n) acc[a][b][m][n] = (f32x4){0.f, 0.f, 0.f, 0.f};
    bf16x8 At[4][2], B0[2][2], B1[2][2];
    const char* cA = (const char*)g.A + (size_t)cur.pm * tstep; const char* cB = (const char*)g.Bt + (size_t)cur.pn * tstep;
    S.a_ready(cur);
    if constexpr (SP2) {
        PG8_STAGE(PG8_SB(0, 0), cB, voffB); PG8_STAGE(PG8_SB(0, 1), cB + hstep, voffB); PG8_STAGE(PG8_SA(0, 0), cA, voffA); PG8_STAGE(PG8_SA(0, 1), cA + hstep, voffA);
        if (wr == 1) PG8_BAR;
        PG8_WAIT_V(2); PG8_BAR;
        PG8_STAGE(PG8_SB(1, 0), cB + kstep, voffB); PG8_STAGE(PG8_SA(1, 0), cA + kstep, voffA); PG8_STAGE(PG8_SB(1, 1), cB + hstep + kstep, voffB);
        PG8_WAIT_V(6); PG8_BAR;
    } else {
        PG8_STAGE(PG8_SB(0, 0), cB, voffB); PG8_STAGE(PG8_SA(0, 0), cA, voffA); PG8_STAGE(PG8_SB(0, 1), cB + hstep, voffB); PG8_STAGE(PG8_SA(0, 1), cA + hstep, voffA);
        if (wr == 1) PG8_BAR;
        PG8_WAIT_V(4); PG8_BAR;
        PG8_STAGE(PG8_SB(1, 0), cB + kstep, voffB); PG8_STAGE(PG8_SA(1, 0), cA + kstep, voffA); PG8_STAGE(PG8_SB(1, 1), cB + hstep + kstep, voffB);
        PG8_WAIT_V(6); PG8_BAR;
    }
    for (;;) {
        const bool has_next = S.next(ui + 1, nxt);
        const char* nA = has_next ? (const char*)g.A + (size_t)nxt.pm * tstep : cA; const char* nB = has_next ? (const char*)g.Bt + (size_t)nxt.pn * tstep : cB;
        for (int t = 0; t < nt; t += 2) {
            const bool last = (t == nt - 2);
            if constexpr (Epi::MID_T > 0) { if (t == Epi::MID_T) E.mid(acc, cur, wr, wc, fr, fq); }
            const char* a1 = cA + (size_t)(t + 1) * kstep;
            const char* a2 = last ? nA : cA + (size_t)(t + 2) * kstep; const char* b2 = last ? nB : cB + (size_t)(t + 2) * kstep;
            const char* a3 = a2 + kstep; const char* b3 = b2 + kstep;
            if (last && has_next) S.a_ready(nxt);
            if constexpr (SP2) {
            PG8_LDB(B0, 0, 0); PG8_LDB(B1, 0, 1); PG8_SCHED; PG8_LDA(At, 0, 0); PG8_STAGE(PG8_SA(1, 1), a1 + hstep, voffA);
            PG8_WAIT_V(8); PG8_WAIT_L(0); PG8_BAR; PG8_MMA(0, 0, At, B0); PG8_MMA(0, 1, At, B1); PG8_BAR; PG8_SCHED;
            PG8_LDA(At, 0, 1); PG8_STAGE(PG8_SB(0, 0), b2, voffB); PG8_STAGE(PG8_SB(0, 1), b2 + hstep, voffB); PG8_STAGE(PG8_SA(0, 0), a2, voffA);
            PG8_WAIT_V(8); PG8_WAIT_L(0); PG8_BAR; PG8_MMA(1, 0, At, B0); PG8_MMA(1, 1, At, B1); PG8_BAR; PG8_SCHED;
            PG8_LDB(B0, 1, 0); PG8_LDB(B1, 1, 1); PG8_SCHED; PG8_LDA(At, 1, 0); PG8_STAGE(PG8_SA(0, 1), a2 + hstep, voffA);
            PG8_WAIT_V(8); PG8_WAIT_L(0); PG8_BAR; PG8_MMA(0, 0, At, B0); PG8_MMA(0, 1, At, B1); PG8_BAR; PG8_SCHED;
            PG8_LDA(At, 1, 1); PG8_STAGE(PG8_SB(1, 0), b3, voffB); PG8_STAGE(PG8_SB(1, 1), b3 + hstep, voffB); PG8_STAGE(PG8_SA(1, 0), a3, voffA);
            PG8_WAIT_V(8); PG8_WAIT_L(0); PG8_BAR; PG8_MMA(1, 0, At, B0); PG8_MMA(1, 1, At, B1); PG8_BAR; PG8_SCHED;
            } else {
            PG8_LDB(B0, 0, 0); PG8_SCHED; PG8_LDA(At, 0, 0); PG8_STAGE(PG8_SA(1, 1), a1 + hstep, voffA);
            PG8_WAIT_L(8); PG8_BAR; PG8_WAIT_L(0); PG8_MMA(0, 0, At, B0); PG8_BAR; PG8_SCHED;
            PG8_LDB(B1, 0, 1); PG8_STAGE(PG8_SB(0, 0), b2, voffB);
            PG8_BAR; PG8_WAIT_L(0); PG8_MMA(0, 1, At, B1); PG8_BAR;
            PG8_LDA(At, 0, 1); PG8_STAGE(PG8_SA(0, 0), a2, voffA);
            PG8_BAR; PG8_WAIT_L(0); PG8_MMA(1, 0, At, B0); PG8_BAR; PG8_SCHED;
            PG8_STAGE(PG8_SB(0, 1), b2 + hstep, voffB);
            PG8_WAIT_V(6); PG8_BAR; PG8_MMA(1, 1, At, B1); PG8_BAR;
            PG8_LDB(B0, 1, 0); PG8_SCHED; PG8_LDA(At, 1, 0); PG8_STAGE(PG8_SA(0, 1), a2 + hstep, voffA);
            PG8_WAIT_L(8); PG8_BAR; PG8_WAIT_L(0); PG8_MMA(0, 0, At, B0); PG8_BAR; PG8_SCHED;
            PG8_LDB(B1, 1, 1); PG8_STAGE(PG8_SB(1, 0), b3, voffB);
            PG8_BAR; PG8_WAIT_L(0); PG8_MMA(0, 1, At, B1); PG8_BAR;
            PG8_LDA(At, 1, 1); PG8_STAGE(PG8_SA(1, 0), a3, voffA);
            PG8_BAR; PG8_WAIT_L(0); PG8_MMA(1, 0, At, B0); PG8_BAR; PG8_SCHED;
            PG8_STAGE(PG8_SB(1, 1), b3 + hstep, voffB);
            PG8_WAIT_V(6); PG8_BAR; PG8_MMA(1, 1, At, B1); PG8_BAR;
            }
        }
        if constexpr (ALIGN_EPI) { if (wr == 0) PG8_BAR; }
        if constexpr (!Epi::AFTER_DRAIN) { E(acc, cur, wr, wc, fr, fq); S.done(cur); }
        if (!has_next) break;
#pragma unroll
        for (int a = 0; a < 2; ++a)
#pragma unroll
            for (int b = 0; b < 2; ++b)
#pragma unroll
                for (int m = 0; m < 4; ++m)
#pragma unroll
                    for (int n = 0; n < 2; ++n) acc[a][b][m][n] = (f32x4){0.f, 0.f, 0.f, 0.f};
        cur = nxt; cA = nA; cB = nB; ++ui;
        if constexpr (ALIGN_EPI) { if (wr == 1) PG8_BAR; }
    }
    PG8_WAIT_V(0);
    if constexpr (!ALIGN_EPI) { if (wr == 0) PG8_BAR; }
    PG8_BAR;
#undef PG8_SA
#undef PG8_SB
#undef PG8_STAGE
#undef PG8_LDA
#undef PG8_LDB
#undef PG8_MMA
#undef PG8_WAIT_V
#undef PG8_WAIT_L
#undef PG8_BAR
#undef PG8_SCHED
}
}

typedef f32x4 acc_t[2][2][4][2];
using pg8::Unit; using pg8::HALF; using pg8::BM;

struct EpiInproj {
    static constexpr bool PERM = true, AFTER_DRAIN = false; static constexpr int MID_T = 0;
    unsigned char* ws; const float* b_in; const float* g_q; const float* g_k;
    __device__ __forceinline__ void operator()(const acc_t& acc, const Unit& u, int wr, int wc, int fr, int fq) const {
        const int pn = u.pn;
        int mode, pitch, col0; size_t off;
        if (pn < 12) { const int seg = pn >> 1; mode = seg == 0 ? 1 : (seg == 1 ? 2 : 0); pitch = 512; col0 = 256 * (pn & 1); off = WS_Q + (size_t)seg * (32 * MiB); }
        else if (pn < 16) { mode = 3; pitch = 1024; col0 = 256 * (pn - 12); off = WS_SGA; }
        else { mode = 3; pitch = 1024; col0 = 256 * (pn - 16); off = WS_SGC; }
        bf16_t* base = (bf16_t*)(ws + off);
        const int lc0 = 64 * wc + 8 * fq;
        f32x4 bv[2][2], gv[2][2];
#pragma unroll
        for (int bj = 0; bj < 2; ++bj)
#pragma unroll
            for (int n = 0; n < 2; ++n) {
                bv[bj][n] = *(const f32x4*)(b_in + 256 * pn + lc0 + 32 * bj + 4 * n);
                const float* g = (mode == 2) ? g_k : g_q;
                gv[bj][n] = *(const f32x4*)(g + 8 * fq + 32 * bj + 4 * n);
            }
        const float qs = (mode == 1) ? C2 : 1.0f;
#pragma unroll
        for (int ai = 0; ai < 2; ++ai)
#pragma unroll
            for (int m = 0; m < 4; ++m) {
                const int row = u.pm * BM + ai * HALF + wr * 64 + m * 16 + fr;
                f32x4 v[2][2];
#pragma unroll
                for (int bj = 0; bj < 2; ++bj)
#pragma unroll
                    for (int n = 0; n < 2; ++n) v[bj][n] = acc[ai][bj][m][n] + bv[bj][n];
                if (mode == 1 || mode == 2) {
                    float ss = 0.f;
#pragma unroll
                    for (int bj = 0; bj < 2; ++bj)
#pragma unroll
                        for (int n = 0; n < 2; ++n) { const f32x4 x = v[bj][n]; ss += (x[0] * x[0] + x[1] * x[1]) + (x[2] * x[2] + x[3] * x[3]); }
                    ss += __shfl_xor(ss, 16); ss += __shfl_xor(ss, 32);
                    const float rstd = __frsqrt_rn(ss * (1.0f / 64.0f) + EPS) * qs;
#pragma unroll
                    for (int bj = 0; bj < 2; ++bj)
#pragma unroll
                        for (int n = 0; n < 2; ++n) v[bj][n] = v[bj][n] * rstd * gv[bj][n];
                } else if (mode == 3) {
#pragma unroll
                    for (int bj = 0; bj < 2; ++bj)
#pragma unroll
                        for (int n = 0; n < 2; ++n)
#pragma unroll
                            for (int j = 0; j < 4; ++j) v[bj][n][j] = sigmoidf_(v[bj][n][j]);
                }
                bf16_t* rowp = base + (size_t)row * pitch + col0 + lc0;
#pragma unroll
                for (int bj = 0; bj < 2; ++bj) {
                    u32x4 w; w.x = pg8::cvt_pk_bf16(v[bj][0][0], v[bj][0][1]); w.y = pg8::cvt_pk_bf16(v[bj][0][2], v[bj][0][3]); w.z = pg8::cvt_pk_bf16(v[bj][1][0], v[bj][1][1]); w.w = pg8::cvt_pk_bf16(v[bj][1][2], v[bj][1][3]);
                    *(u32x4*)(rowp + 32 * bj) = w;
                }
            }
    }
};

template <bool SECOND> struct EpiMerge {
    static constexpr bool PERM = true, AFTER_DRAIN = false; static constexpr int MID_T = 0;
    const bf16_t* gate; bf16_t* mout;
    __device__ __forceinline__ void operator()(const acc_t& acc, const Unit& u, int wr, int wc, int fr, int fq) const {
        const int col0 = u.pn * BM + wc * 32 + 8 * fq;
#pragma unroll
        for (int ai = 0; ai < 2; ++ai)
#pragma unroll
            for (int m = 0; m < 4; ++m) {
                const size_t ro = (size_t)(u.pm * BM + ai * HALF + wr * 64 + m * 16 + fr) * D + col0;
#pragma unroll
                for (int bj = 0; bj < 2; ++bj) {
                    const u32x4 c = *(const u32x4*)(gate + ro + bj * HALF);
                    const f32x4 v0 = acc[ai][bj][m][0], v1 = acc[ai][bj][m][1];
                    float r[8] = {v0[0] * bf_lo(c.x), v0[1] * bf_hi(c.x), v0[2] * bf_lo(c.y), v0[3] * bf_hi(c.y), v1[0] * bf_lo(c.z), v1[1] * bf_hi(c.z), v1[2] * bf_lo(c.w), v1[3] * bf_hi(c.w)};
                    if (SECOND) { const u32x4 p = *(const u32x4*)(mout + ro + bj * HALF);
                        r[0] += bf_lo(p.x); r[1] += bf_hi(p.x); r[2] += bf_lo(p.y); r[3] += bf_hi(p.y); r[4] += bf_lo(p.z); r[5] += bf_hi(p.z); r[6] += bf_lo(p.w); r[7] += bf_hi(p.w); }
                    u32x4 w; w.x = pg8::cvt_pk_bf16(r[0], r[1]); w.y = pg8::cvt_pk_bf16(r[2], r[3]); w.z = pg8::cvt_pk_bf16(r[4], r[5]); w.w = pg8::cvt_pk_bf16(r[6], r[7]);
                    *(u32x4*)(mout + ro + bj * HALF) = w;
                }
                asm volatile("" ::: "memory");
            }
    }
};

struct EpiResF32 {
    static constexpr bool PERM = false, AFTER_DRAIN = false; static constexpr int MID_T = 0;
    const float* x; float* out;
    __device__ __forceinline__ void operator()(const acc_t& acc, const Unit& u, int wr, int wc, int fr, int fq) const {
        const int col0 = u.pn * BM + wc * 32 + 4 * fq;
#pragma unroll
        for (int ai = 0; ai < 2; ++ai)
#pragma unroll
            for (int m = 0; m < 4; ++m) {
                const size_t ro = (size_t)(u.pm * BM + ai * HALF + wr * 64 + m * 16 + fr) * D + col0;
#pragma unroll
                for (int bj = 0; bj < 2; ++bj)
#pragma unroll
                    for (int n = 0; n < 2; ++n) { const f32x4 b = *(const f32x4*)(x + ro + bj * HALF + n * 16); *(f32x4*)(out + ro + bj * HALF + n * 16) = b + acc[ai][bj][m][n]; }
                if (m & 1) asm volatile("" ::: "memory");
            }
    }
};

struct EpiSwiglu {
    static constexpr bool PERM = true, AFTER_DRAIN = false; static constexpr int MID_T = 0;
    bf16_t* hdn;
    __device__ __forceinline__ void operator()(const acc_t& acc, const Unit& u, int wr, int wc, int fr, int fq) const {
        const int col0 = 128 * (u.pn & 3) + wc * 32 + 8 * fq;
#pragma unroll
        for (int ai = 0; ai < 2; ++ai)
#pragma unroll
            for (int m = 0; m < 4; ++m) {
                const size_t ro = (size_t)(u.pm * BM + ai * HALF + wr * 64 + m * 16 + fr) * DE + col0;
                float h[8];
#pragma unroll
                for (int n = 0; n < 2; ++n)
#pragma unroll
                    for (int j = 0; j < 4; ++j) { const float a = acc[ai][0][m][n][j], b = acc[ai][1][m][n][j]; h[4 * n + j] = a * sigmoidf_(a) * b; }
                u32x4 w; w.x = pg8::cvt_pk_bf16(h[0], h[1]); w.y = pg8::cvt_pk_bf16(h[2], h[3]); w.z = pg8::cvt_pk_bf16(h[4], h[5]); w.w = pg8::cvt_pk_bf16(h[6], h[7]);
                *(u32x4*)(hdn + ro) = w;
            }
    }
};

struct EpiDown {
    static constexpr bool PERM = true, AFTER_DRAIN = false; static constexpr int MID_T = 0;
    const int* row_slot; const float* row_w; bf16_t* contrib;
    __device__ __forceinline__ void operator()(const acc_t& acc, const Unit& u, int wr, int wc, int fr, int fq) const {
        const int col0 = 256 * (u.pn & 3) + wc * 32 + 8 * fq;
#pragma unroll
        for (int ai = 0; ai < 2; ++ai)
#pragma unroll
            for (int m = 0; m < 4; ++m) {
                const int row = u.pm * BM + ai * HALF + wr * 64 + m * 16 + fr;
                const int slot = row_slot[row]; const float w = row_w[row];
                if (slot >= 0) {
#pragma unroll
                    for (int bj = 0; bj < 2; ++bj) {
                        const f32x4 v0 = acc[ai][bj][m][0] * w, v1 = acc[ai][bj][m][1] * w;
                        u32x4 o; o.x = pg8::cvt_pk_bf16(v0[0], v0[1]); o.y = pg8::cvt_pk_bf16(v0[2], v0[3]); o.z = pg8::cvt_pk_bf16(v1[0], v1[1]); o.w = pg8::cvt_pk_bf16(v1[2], v1[3]);
                        *(u32x4*)(contrib + (size_t)slot * D + col0 + bj * HALF) = o;
                    }
                }
            }
    }
};

struct EpiPP {
    static constexpr bool PERM = false, AFTER_DRAIN = false; static constexpr int MID_T = 0;
    bf16_t* pp;
    __device__ __forceinline__ void operator()(const acc_t& acc, const Unit& u, int wr, int wc, int fr, int fq) const {
        const int col0 = u.pn * BM + wc * 32 + 4 * fq;
#pragma unroll
        for (int ai = 0; ai < 2; ++ai)
#pragma unroll
            for (int m = 0; m < 4; ++m) {
                const size_t ro = (size_t)(u.pm * BM + ai * HALF + wr * 64 + m * 16 + fr) * D + col0;
#pragma unroll
                for (int bj = 0; bj < 2; ++bj)
#pragma unroll
                    for (int n = 0; n < 2; ++n) { const f32x4 v = acc[ai][bj][m][n]; u32x2 w; w.x = pg8::cvt_pk_bf16(v[0], v[1]); w.y = pg8::cvt_pk_bf16(v[2], v[3]); *(u32x2*)(pp + ro + bj * HALF + n * 16) = w; }
            }
    }
};
struct EpiGate {
    static constexpr bool PERM = false, AFTER_DRAIN = false; static constexpr int MID_T = 0;
    const bf16_t* pp; const float* bpg; float* out;
    __device__ __forceinline__ void operator()(const acc_t& acc, const Unit& u, int wr, int wc, int fr, int fq) const {
        const int col0 = u.pn * BM + wc * 32 + 4 * fq;
#pragma unroll
        for (int ai = 0; ai < 2; ++ai)
#pragma unroll
            for (int m = 0; m < 4; ++m) {
                const size_t ro = (size_t)(u.pm * BM + ai * HALF + wr * 64 + m * 16 + fr) * D + col0;
#pragma unroll
                for (int bj = 0; bj < 2; ++bj)
#pragma unroll
                    for (int n = 0; n < 2; ++n) {
                        const size_t o = ro + bj * HALF + n * 16;
                        const f32x4 h = *(const f32x4*)(out + o); const u32x2 pw = *(const u32x2*)(pp + o);
                        const f32x4 a = acc[ai][bj][m][n] + *(const f32x4*)(bpg + col0 + bj * HALF + n * 16);
                        f32x4 r;
                        r[0] = h[0] + sigmoidf_(a[0]) * bf_lo(pw.x); r[1] = h[1] + sigmoidf_(a[1]) * bf_hi(pw.x);
                        r[2] = h[2] + sigmoidf_(a[2]) * bf_lo(pw.y); r[3] = h[3] + sigmoidf_(a[3]) * bf_hi(pw.y);
                        *(f32x4*)(out + o) = r;
                    }
                asm volatile("" ::: "memory");
            }
    }
};

struct MoeOrder {
    const LAS int* pref;
    int nunits, G, c;
    __device__ __forceinline__ bool next(int i, Unit& u) const {
        const int L = i * G + c; if (L >= nunits) return false;
        const int rtg = L >> 2, pnl = L & 3; int e = 0;
#pragma unroll 4
        for (int k = 1; k < NE; ++k) e += (pref[k] <= rtg) ? 1 : 0;
        e = __builtin_amdgcn_readfirstlane(e);
        u.pm = rtg; u.pn = 4 * e + pnl; return true;
    }
    __device__ __forceinline__ void a_ready(const Unit&) const {}
    __device__ __forceinline__ void done(const Unit&) const {}
};

#define XB_TMO      128
#define XB_XCNT(j)  (256  + 64 * (j))
#define XB_XSUB(j)  (1280 + 64 * (j))
#define XB_XGEN(j)  (2304 + 64 * (j))
#define XB_TOP      3328
#define XB_TOPGEN   3392
#define XCD_BAR_WORDS 3456
#define XB_SPIN_CAP (1u << 18)

__device__ __forceinline__ unsigned xb_ld(unsigned* p)              { return __hip_atomic_load(p, __ATOMIC_RELAXED, __HIP_MEMORY_SCOPE_AGENT); }
__device__ __forceinline__ unsigned xb_add(unsigned* p, unsigned v) { return __hip_atomic_fetch_add(p, v, __ATOMIC_RELAXED, __HIP_MEMORY_SCOPE_AGENT); }
__device__ __forceinline__ unsigned xb_xcc_id() { return (unsigned)__builtin_amdgcn_s_getreg((3 << 11) | 20) & 0xFu; }
#define XB_SPIN(cond, bar) do { unsigned _sp = 0; while (cond) { __builtin_amdgcn_s_sleep(1); \
    if ((++_sp & 255u) == 0u) { if (xb_ld(&(bar)[XB_TMO])) break; if (_sp > XB_SPIN_CAP) { atomicAdd(&(bar)[XB_TMO], 1u); break; } } } } while (0)

struct XcdBarrier {
    unsigned* bar; unsigned x;
    volatile LAS unsigned* st;
};

__device__ __forceinline__ XcdBarrier xcd_barrier_post(unsigned* bar, volatile LAS unsigned* st) {
    XcdBarrier b; b.bar = bar; b.x = xb_xcc_id(); b.st = st;
    if (threadIdx.x == 0) (void)xb_add(&bar[XB_XCNT(b.x)], 1u);
    return b;
}
__device__ __forceinline__ void xcd_barrier_complete(unsigned* bar, unsigned x, unsigned& nloc, unsigned& nx) {
    const unsigned G = gridDim.x * gridDim.y * gridDim.z;
    unsigned sum, cnt, mine, sp = 0u;
    for (;;) {
        sum = 0u; cnt = 0u; mine = 0u;
#pragma unroll
        for (unsigned j = 0; j < 16; ++j) { const unsigned c = xb_ld(&bar[XB_XCNT(j)]); sum += c; cnt += (c > 0u) ? 1u : 0u; mine = (j == x) ? c : mine; }
        if (sum == G) break;
        __builtin_amdgcn_s_sleep(1);
        if ((++sp & 255u) == 0u) { if (xb_ld(&bar[XB_TMO])) break; if (sp > XB_SPIN_CAP) { atomicAdd(&bar[XB_TMO], 1u); break; } }
    }
    nloc = mine > 0u ? mine : 1u; nx = cnt > 0u ? cnt : 1u;
}

__device__ __forceinline__ void xcd_barrier(const XcdBarrier& b, int tid) {
    asm volatile("s_waitcnt vmcnt(0)" ::: "memory");
    __syncthreads();
    if (tid == 0) {
        unsigned* bar = b.bar;
        __builtin_amdgcn_s_waitcnt(0);
        unsigned nloc = b.st[0], nx = b.st[1];
        if (nloc == 0u) { xcd_barrier_complete(bar, b.x, nloc, nx); b.st[0] = nloc; b.st[1] = nx; }
        const unsigned old = xb_add(&bar[XB_XSUB(b.x)], 1u);
        const unsigned gen = old / nloc;
        if (old + 1u == (gen + 1u) * nloc) {
            __builtin_amdgcn_fence(__ATOMIC_RELEASE, "agent");
            asm volatile("s_waitcnt vmcnt(0)" ::: "memory");
            const unsigned og = xb_add(&bar[XB_TOP], 1u);
            const unsigned tg = og / nx;
            if (og + 1u == (tg + 1u) * nx) xb_add(&bar[XB_TOPGEN], 1u);
            else XB_SPIN(xb_ld(&bar[XB_TOPGEN]) == tg, bar);
            __builtin_amdgcn_fence(__ATOMIC_ACQUIRE, "agent");
            xb_add(&bar[XB_XGEN(b.x)], 1u);
            asm volatile("s_waitcnt vmcnt(0)" ::: "memory");
        } else {
            XB_SPIN(xb_ld(&bar[XB_XGEN(b.x)]) == gen, bar);
            __builtin_amdgcn_fence(__ATOMIC_ACQUIRE, "agent");
            asm volatile("s_waitcnt vmcnt(0)" ::: "memory");
        }
    }
    __syncthreads();
}

#include <hip/hip_bf16.h>
#include <cmath>
namespace attn_body {
using bf16=__hip_bfloat16;
using bf16x8=__attribute__((ext_vector_type(8)))short;
using s16x4=__attribute__((ext_vector_type(4)))short;
using f32x16=__attribute__((ext_vector_type(16)))float;
using u32x4=__attribute__((ext_vector_type(4)))unsigned;
constexpr int BATCH=8,NHEAD=8,SEQ=4096,D=64,DM=NHEAD*D,OPITCH=1024;
constexpr int NW=8,QBLK=32,QB=QBLK*NW,KVBLK=64,NQB=SEQ/QB;
constexpr int ATTN_PITCH=DM, ATTN_UNIT_ROWS=QB;
constexpr int BT_COPY=384, BT_BYTES=4*BT_COPY*4;
__device__ __forceinline__ int crow(int r,int hi){return (r&3)+8*(r>>2)+4*hi;}
#define SBAR() __builtin_amdgcn_sched_barrier(0)
constexpr int NSLOT=3, SLOTB=8192;
constexpr int LDS_K=0, LDS_V=NSLOT*SLOTB, LDS_WS=2*NSLOT*SLOTB, LDS_OST=LDS_WS+NW*64*4, LDS_BT=LDS_OST+NW*4096, LDS_BYTES=LDS_BT+BT_BYTES;
__device__ __forceinline__ void glds16(const void*gsrc,unsigned lds_dst){unsigned keep;
  asm volatile("s_mov_b32 %0, m0\n\ts_mov_b32 m0, %2\n\ts_nop 0\n\tglobal_load_lds_dwordx4 %1, off\n\ts_mov_b32 m0, %0":"=&s"(keep):"v"(gsrc),"s"(lds_dst):"memory");}
__device__ __forceinline__ float max3f(float a,float b,float c){float r;asm("v_max3_f32 %0, %1, %2, %3":"=v"(r):"v"(a),"v"(b),"v"(c));return r;}
__device__ __forceinline__ float max2f(float a,float b){float r;asm("v_max_f32_e32 %0, %1, %2":"=v"(r):"v"(a),"v"(b));return r;}
__device__ __forceinline__ float fadd_s(float a,float b){float r;asm("v_add_f32_e32 %0, %1, %2":"=v"(r):"v"(a),"v"(b));return r;}
__device__ __forceinline__ float fsub_s(float a,float b){float r;asm("v_sub_f32_e32 %0, %1, %2":"=v"(r):"v"(a),"v"(b));return r;}
typedef float f32x2_t __attribute__((ext_vector_type(2))); typedef float f32x4_t __attribute__((ext_vector_type(4))); typedef __bf16 bf16x2_t __attribute__((ext_vector_type(2)));
__device__ __forceinline__ unsigned cvtpk_s(float lo,float hi){f32x2_t v={lo,hi};bf16x2_t b=__builtin_convertvector(v,bf16x2_t);return __builtin_bit_cast(unsigned,b);}
#define WAIT_BAR(N) asm volatile("s_waitcnt vmcnt(" #N ") lgkmcnt(0)\n\ts_barrier":::"memory")

__device__ __forceinline__ void qkt(f32x16&p0,f32x16&p1,const char*Kslot,const bf16x8*qr,const f32x16&negm,int r32,int hi){
  const char*kb=Kslot+hi*1024+r32*16;
  #pragma unroll
  for(int d0=0;d0<4;++d0){
    const bf16x8 b0=*reinterpret_cast<const bf16x8*>(kb+d0*2048);
    const bf16x8 b1=*reinterpret_cast<const bf16x8*>(kb+d0*2048+512);
    if(d0==0){p0=__builtin_amdgcn_mfma_f32_32x32x16_bf16(b0,qr[0],negm,0,0,0);p1=__builtin_amdgcn_mfma_f32_32x32x16_bf16(b1,qr[0],negm,0,0,0);}
    else{p0=__builtin_amdgcn_mfma_f32_32x32x16_bf16(b0,qr[d0],p0,0,0,0);p1=__builtin_amdgcn_mfma_f32_32x32x16_bf16(b1,qr[d0],p1,0,0,0);}}
}
typedef __attribute__((address_space(3))) const char* lds_cptr;
typedef short v4i16_t __attribute__((ext_vector_type(4)));
__device__ __forceinline__ void kload8(bf16x8*kf,lds_cptr kp){
  kf[0]=*(const __attribute__((address_space(3))) bf16x8*)(kp);      kf[1]=*(const __attribute__((address_space(3))) bf16x8*)(kp+512);
  kf[2]=*(const __attribute__((address_space(3))) bf16x8*)(kp+2048); kf[3]=*(const __attribute__((address_space(3))) bf16x8*)(kp+2560);
  kf[4]=*(const __attribute__((address_space(3))) bf16x8*)(kp+4096); kf[5]=*(const __attribute__((address_space(3))) bf16x8*)(kp+4608);
  kf[6]=*(const __attribute__((address_space(3))) bf16x8*)(kp+6144); kf[7]=*(const __attribute__((address_space(3))) bf16x8*)(kp+6656);
}
__device__ __forceinline__ void kload2(bf16x8*kf,lds_cptr kp,int j){ kf[2*j]=*(const __attribute__((address_space(3))) bf16x8*)(kp+j*2048); kf[2*j+1]=*(const __attribute__((address_space(3))) bf16x8*)(kp+j*2048+512); }
__device__ __forceinline__ s16x4 vtr(lds_cptr p){ return __builtin_bit_cast(s16x4,__builtin_amdgcn_ds_read_tr16_b64_v4i16((__attribute__((address_space(3))) v4i16_t*)p)); }
__device__ __forceinline__ float rowmax(const f32x16&p0,const f32x16&p1){
  float a=max3f(p0[0],p0[1],p1[0]),b=max3f(p0[2],p0[3],p1[1]);a=max3f(a,p1[2],p1[3]);
  #pragma unroll
  for(int r=4;r<16;r+=4){a=max3f(a,p0[r],p0[r+1]);b=max3f(b,p0[r+2],p0[r+3]);a=max3f(a,p1[r],p1[r+1]);b=max3f(b,p1[r+2],p1[r+3]);}
  const float m=max2f(a,b);
  auto rr=__builtin_amdgcn_permlane32_swap(__float_as_uint(m),__float_as_uint(m),false,false);
  return max2f(__uint_as_float(rr[0]),__uint_as_float(rr[1]));
}
__device__ __forceinline__ void pv(f32x16*o,int vb,bf16x8 pa0,bf16x8 pa1,bf16x8 pa2,bf16x8 pa3){
  #pragma unroll
  for(int d0=0;d0<2;++d0){s16x4 lo[4],hi[4];
    #pragma unroll
    for(int ks=0;ks<4;++ks){
      asm volatile("ds_read_b64_tr_b16 %0,%1 offset:%c2":"=&v"(lo[ks]):"v"(vb),"i"(d0*4096+ks*1024):"memory");
      asm volatile("ds_read_b64_tr_b16 %0,%1 offset:%c2":"=&v"(hi[ks]):"v"(vb),"i"(d0*4096+ks*1024+512):"memory");}
    asm volatile("s_waitcnt lgkmcnt(0)":::"memory");SBAR();
    #define PK(k) (bf16x8){lo[k][0],lo[k][1],lo[k][2],lo[k][3],hi[k][0],hi[k][1],hi[k][2],hi[k][3]}
    o[d0]=__builtin_amdgcn_mfma_f32_32x32x16_bf16(pa0,PK(0),o[d0],0,0,0);
    o[d0]=__builtin_amdgcn_mfma_f32_32x32x16_bf16(pa1,PK(1),o[d0],0,0,0);
    o[d0]=__builtin_amdgcn_mfma_f32_32x32x16_bf16(pa2,PK(2),o[d0],0,0,0);
    o[d0]=__builtin_amdgcn_mfma_f32_32x32x16_bf16(pa3,PK(3),o[d0],0,0,0);
    #undef PK
  }
}

#ifndef ATTN_STORE16
#define ATTN_STORE16(p,v) (*(u32x4*)(p)=(v))
#endif
__device__ __forceinline__ void attn_unit(int b,int h,int qb,const bf16*Q,const bf16*K,const bf16*V,bf16*O,char*shm,float cinit,int tid){
  asm volatile("":"+v"(tid));
  const int lane=tid&63,r32=lane&31,hi=lane>>5; const int wid=__builtin_amdgcn_readfirstlane(tid>>6);
  const long rowbase=(long)b*SEQ; const int q0=qb*QB;
  const bf16*Qw=Q+(rowbase+q0+wid*QBLK)*DM+h*D;
  const int t0=(4*qb-8)>0?(4*qb-8):0;
  const bf16*Kh=K+(rowbase+(long)t0*KVBLK)*DM+h*D,*Vh=V+(rowbase+(long)t0*KVBLK)*DM+h*D;
  const int tb=t0-4*qb-(wid>>1)+8;
  const unsigned lds0=(unsigned)(uintptr_t)shm;
  float*wsf=(float*)(shm+LDS_WS)+wid*64;
  const bf16*ksrc=Kh+(long)lane*DM+wid*8;
  const bf16*vsrc=Vh+(long)(16*(wid&3)+(lane>>2))*DM+(wid>>2)*32+(lane&3)*8;
  const unsigned kdst=lds0+LDS_K+wid*1024, vdst=lds0+LDS_V+wid*1024;
  #define DMA_K(t,slot) glds16(ksrc+(long)(t)*KVBLK*DM,(unsigned)__builtin_amdgcn_readfirstlane(kdst+(slot)))
  #define DMA_V(t,slot) glds16(vsrc+(long)(t)*KVBLK*DM,(unsigned)__builtin_amdgcn_readfirstlane(vdst+(slot)))
  const int vb0=(int)(lds0+LDS_V)+((lane>>4)&1)*32+(lane&3)*8+(4*hi+((lane&15)>>2))*64;
  const char*Kbase=shm+LDS_K; bf16x8 kf[8];
  const lds_cptr shm3=(lds_cptr)shm; const lds_cptr kp0=shm3+LDS_K+hi*1024+r32*16; const lds_cptr vp0=shm3+LDS_V+((lane>>4)&1)*32+(lane&3)*8+(4*hi+((lane&15)>>2))*64;
  const int NT=4*qb+4-t0;
  const lds_cptr btl=shm3+LDS_BT+((3-r32)&3)*(BT_COPY*4)+4*(-193-32*(wid&1)-r32-((3-r32)&3)+4*hi);
  DMA_K(0,0);DMA_V(0,0);DMA_K(1,SLOTB);
  bf16x8 qr[4];
  #pragma unroll
  for(int d0=0;d0<4;++d0)qr[d0]=*reinterpret_cast<const bf16x8*>(&Qw[(long)r32*DM+d0*16+hi*8]);
  float l_reg=0.f;f32x16 o[2];o[0]=f32x16{};o[1]=f32x16{};f32x16 negm;
  asm volatile("":"+s"(cinit));
  _Pragma("unroll") for(int r=0;r<16;++r)negm[r]=cinit; asm volatile("":"+v"(negm));
  #define BIASMASK(P0,P1,t) do{ const int tau_=(t)+tb; \
    if(tau_<0||tau_>8){ _Pragma("unroll") for(int r=0;r<16;++r){P0[r]=-INFINITY;P1[r]=-INFINITY;} } \
    else if(tau_>=4){ const lds_cptr bp_=btl+256*tau_; \
      _Pragma("unroll") for(int g=0;g<4;++g){ const f32x4_t d0_=*(const __attribute__((address_space(3))) f32x4_t*)(bp_+32*g), d1_=*(const __attribute__((address_space(3))) f32x4_t*)(bp_+32*g+128); \
        _Pragma("unroll") for(int j=0;j<4;++j){P0[4*g+j]+=d0_[j];P1[4*g+j]+=d1_[j];} } } }while(0)
  #define START(P0,P1) do{ _Pragma("unroll") for(int r=0;r<16;++r)P0[r]=__builtin_amdgcn_exp2f(P0[r]); }while(0)
  #define RESC() do{}while(0)
  f32x16 pA0,pA1,pB0,pB1;
  int sl_prev=0,sl_cur=0,sl_next=SLOTB;
  #define ROT() do{sl_prev=sl_cur;sl_cur=sl_next;sl_next=(sl_next==(NSLOT-1)*SLOTB)?0:sl_next+SLOTB;}while(0)
  DMA_K(2,2*SLOTB);
  WAIT_BAR(3);
  qkt(pA0,pA1,Kbase,qr,negm,r32,hi);asm volatile("s_nop 15\n\ts_nop 7":"+v"(pA0),"+v"(pA1));BIASMASK(pA0,pA1,0);
  START(pA0,pA1);
  _Pragma("unroll") for(int r=0;r<16;++r)pA1[r]=__builtin_amdgcn_exp2f(pA1[r]);
  WAIT_BAR(0);
  DMA_K(3,0);DMA_V(1,SLOTB);
  ROT();
  kload8(kf,kp0+sl_cur);
  WAIT_BAR(2);
  s16x4 vlo[8],vhi[8]; u32x4 pw0,pw1,pw2,pw3;
  #define PKW(P,B) cvtpk_s(P[B],P[B+1])
  #define PAF(k) __builtin_bit_cast(bf16x8,pw##k)
  #define VFR(i) (bf16x8){vlo[i][0],vlo[i][1],vlo[i][2],vlo[i][3],vhi[i][0],vhi[i][1],vhi[i][2],vhi[i][3]}
  #define PIN(x) asm volatile("":"+v"(x))
  #define MX3(a,b,c) __builtin_fmaxf(__builtin_fmaxf((a),(b)),(c))
  #define GAPA(MF,A0,A1,A2,A3,W0,W1,PW) do{ MF; sacc+=A0; sacc+=A1; sacc+=A2; sacc+=A3; PIN(sacc); W0; W1; PIN(PW); SBAR(); }while(0)
  #define EX(v) __builtin_amdgcn_exp2f(v)
  #define GAPB(MF,X,B) do{ MF; X[B]=EX(X[B]); X[B+1]=EX(X[B+1]); X[B+2]=EX(X[B+2]); X[B+3]=EX(X[B+3]); PIN(X); SBAR(); }while(0)
  #define VRD(i) do{ vlo[i]=vtr(vp_+(((i)>>2)*4096+((i)&3)*1024)); vhi[i]=vtr(vp_+(((i)>>2)*4096+((i)&3)*1024+512)); }while(0)
  #define KRD(G,j) do{ if(G){ kload2(kf,kp0+sl_next,j); SBAR(); } }while(0)
  #define STEP(C0,C1,P0,P1,t,GK,GV,GL) do{ SBAR(); \
    const lds_cptr vp_=vp0+sl_prev; \
    VRD(0); SBAR(); float sacc=(P0[0]+P0[1]); \
    GAPA(C0=__builtin_amdgcn_mfma_f32_32x32x16_bf16(kf[0],qr[0],negm,0,0,0), P0[2],P0[3],P0[4],P0[5],     pw0[0]=PKW(P0,0), pw0[1]=PKW(P0,2), pw0); \
    VRD(4); SBAR(); GAPA(C1=__builtin_amdgcn_mfma_f32_32x32x16_bf16(kf[1],qr[0],negm,0,0,0), P0[6],P0[7],P0[8],P0[9],     pw0[2]=PKW(P0,4), pw0[3]=PKW(P0,6), pw0); \
    VRD(1); SBAR(); GAPA(C0=__builtin_amdgcn_mfma_f32_32x32x16_bf16(kf[2],qr[1],C0,0,0,0),   P0[10],P0[11],P0[12],P0[13], pw1[0]=PKW(P0,8), pw1[1]=PKW(P0,10), pw1); \
    VRD(5); SBAR(); GAPA(C1=__builtin_amdgcn_mfma_f32_32x32x16_bf16(kf[3],qr[1],C1,0,0,0),   P0[14],P0[15],P1[0],P1[1],   pw1[2]=PKW(P0,12),pw1[3]=PKW(P0,14), pw1); \
    VRD(2); SBAR(); GAPA(C0=__builtin_amdgcn_mfma_f32_32x32x16_bf16(kf[4],qr[2],C0,0,0,0),   P1[2],P1[3],P1[4],P1[5],     pw2[0]=PKW(P1,0), pw2[1]=PKW(P1,2), pw2); \
    VRD(6); SBAR(); GAPA(C1=__builtin_amdgcn_mfma_f32_32x32x16_bf16(kf[5],qr[2],C1,0,0,0),   P1[6],P1[7],P1[8],P1[9],     pw2[2]=PKW(P1,4), pw2[3]=PKW(P1,6), pw2); \
    VRD(3); SBAR(); GAPA(C0=__builtin_amdgcn_mfma_f32_32x32x16_bf16(kf[6],qr[3],C0,0,0,0),   P1[10],P1[11],P1[12],P1[13], pw3[0]=PKW(P1,8), pw3[1]=PKW(P1,10), pw3); \
    VRD(7); SBAR(); GAPA(C1=__builtin_amdgcn_mfma_f32_32x32x16_bf16(kf[7],qr[3],C1,0,0,0),   P1[14],P1[15],0.f,0.f,       pw3[2]=PKW(P1,12),pw3[3]=PKW(P1,14), pw3); \
    l_reg+=sacc; \
    if(GK){DMA_K((t)+3,sl_cur);} if(GV){DMA_V((t)+1,sl_next);} \
    BIASMASK(C0,C1,t); \
    SBAR(); \
    GAPB(o[0]=__builtin_amdgcn_mfma_f32_32x32x16_bf16(PAF(0),VFR(0),o[0],0,0,0), C0,0); \
    GAPB(o[1]=__builtin_amdgcn_mfma_f32_32x32x16_bf16(PAF(0),VFR(4),o[1],0,0,0), C0,4); \
    KRD(GL,0); GAPB(o[0]=__builtin_amdgcn_mfma_f32_32x32x16_bf16(PAF(1),VFR(1),o[0],0,0,0), C0,8); \
    KRD(GL,1); GAPB(o[1]=__builtin_amdgcn_mfma_f32_32x32x16_bf16(PAF(1),VFR(5),o[1],0,0,0), C0,12); \
    KRD(GL,2); GAPB(o[0]=__builtin_amdgcn_mfma_f32_32x32x16_bf16(PAF(2),VFR(2),o[0],0,0,0), C1,0); \
    KRD(GL,3); GAPB(o[1]=__builtin_amdgcn_mfma_f32_32x32x16_bf16(PAF(2),VFR(6),o[1],0,0,0), C1,4); \
    GAPB(o[0]=__builtin_amdgcn_mfma_f32_32x32x16_bf16(PAF(3),VFR(3),o[0],0,0,0), C1,8); \
    GAPB(o[1]=__builtin_amdgcn_mfma_f32_32x32x16_bf16(PAF(3),VFR(7),o[1],0,0,0), C1,12); \
    }while(0)
  int t=1;
  for(;t+5<NT;t+=2){
    STEP(pB0,pB1,pA0,pA1,t,true,true,true);     WAIT_BAR(2); RESC(); ROT();
    STEP(pA0,pA1,pB0,pB1,t+1,true,true,true);   WAIT_BAR(2); RESC(); ROT();
  }
  #define ENDW(tt) do{ if((tt)+3<NT){WAIT_BAR(2);} else if((tt)+2<NT){WAIT_BAR(1);} else {WAIT_BAR(0);} }while(0)
  for(;t+1<NT;t+=2){
    STEP(pB0,pB1,pA0,pA1,t,(t+3<NT),(t+1<NT),(t+1<NT));       ENDW(t);   RESC(); ROT();
    STEP(pA0,pA1,pB0,pB1,t+1,(t+4<NT),(t+2<NT),(t+2<NT));     ENDW(t+1); RESC(); ROT();
  }
  STEP(pB0,pB1,pA0,pA1,NT-1,false,false,false); RESC();
  { float sacc=pB0[0]+pB0[1]; _Pragma("unroll") for(int r=2;r<16;++r)sacc+=pB0[r]; _Pragma("unroll") for(int r=0;r<16;++r)sacc+=pB1[r]; l_reg+=sacc;
    pw0=(u32x4){PKW(pB0,0),PKW(pB0,2),PKW(pB0,4),PKW(pB0,6)};pw1=(u32x4){PKW(pB0,8),PKW(pB0,10),PKW(pB0,12),PKW(pB0,14)};pw2=(u32x4){PKW(pB1,0),PKW(pB1,2),PKW(pB1,4),PKW(pB1,6)};pw3=(u32x4){PKW(pB1,8),PKW(pB1,10),PKW(pB1,12),PKW(pB1,14)};
    SBAR(); pv(o,vb0+sl_cur,PAF(0),PAF(1),PAF(2),PAF(3)); }
  #undef PKW
  #undef PAF
  #undef VFR
  #undef PIN
  #undef MX3
  #undef GAPA
  #undef GAPB
  #undef EX
  #undef VRD
  #undef KRD
  #undef STEP
  #undef ENDW
  {auto rr=__builtin_amdgcn_permlane32_swap(__float_as_uint(l_reg),__float_as_uint(l_reg),false,false);l_reg=__uint_as_float(rr[0])+__uint_as_float(rr[1]);}
  if(hi==0)wsf[32+r32]=l_reg;asm volatile("s_waitcnt lgkmcnt(0)":::"memory");
  float rli[16];
  #pragma unroll
  for(int r=0;r<16;++r)rli[r]=__builtin_amdgcn_rcpf(wsf[32+crow(r,hi)]);
  bf16*Ow=O+(rowbase+q0+wid*QBLK)*OPITCH+h*D;
  { bf16*stg=(bf16*)(shm+LDS_OST)+wid*2048;
    #pragma unroll
    for(int r=0;r<16;++r){const int orow=crow(r,hi);
      #pragma unroll
      for(int d0=0;d0<2;++d0)stg[orow*64+d0*32+r32]=__float2bfloat16(o[d0][r]*rli[r]);}
    asm volatile("s_waitcnt lgkmcnt(0)":::"memory");
    #pragma unroll
    for(int i=0;i<4;++i){const int row=i*8+(lane>>3),ch=lane&7; const u32x4 v=*(const u32x4*)(stg+row*64+ch*8); ATTN_STORE16(Ow+(long)row*OPITCH+ch*8,v);} }
  asm volatile("s_waitcnt lgkmcnt(0)\n\ts_barrier":::"memory");
  #undef DMA_K
  #undef DMA_V
  #undef BIASMASK
  #undef START
  #undef RESC
  #undef ROT
}
constexpr int ATTN_LDS_BYTES=LDS_BYTES;
struct AttnUnit { int bh; int qb; };
__device__ __forceinline__ void attn_phase(char*lds,const bf16*Q,const bf16*K,const bf16*V,bf16*O,const float*gtab,const float*gcinit,int grid,int block,int tid){
  const int vcu=(block%8)*(grid/8)+block/8, s_=vcu&3, bh=vcu>>2, h=bh&7, b=bh>>3;
  { const f32x4_t* src=(const f32x4_t*)(gtab+(size_t)h*(4*BT_COPY)); __attribute__((address_space(3))) f32x4_t* dst=(__attribute__((address_space(3))) f32x4_t*)((lds_cptr)lds+LDS_BT);
    if(tid<BT_BYTES/16)dst[tid]=src[tid]; }
  const float cinit=__builtin_bit_cast(float,__builtin_amdgcn_readfirstlane(__builtin_bit_cast(int,gcinit[h])));
  asm volatile("s_waitcnt vmcnt(0) lgkmcnt(0)\n\ts_barrier":::"memory");
  for(int i=0;i<4;++i){ const int qb=(i==0)?s_:(i==1)?7-s_:(i==2)?8+s_:15-s_; attn_unit(b,h,qb,Q,K,V,O,lds,cinit,tid); }
}
#undef SBAR
#undef WAIT_BAR
}

struct Args {
    const float *x, *p, *g_mix, *w_in, *b_in, *g_q, *g_k, *rel_bias, *conv_w, *conv_b, *w_pa, *w_pc, *w_o, *g_ffn, *w_group, *b_group, *w_router, *b_router, *w1, *w3, *w2, *g_ple, *w_pg, *b_pg, *w_pp;
    float* out; unsigned char* ws;
};
constexpr int NWAVES = 8, NTHREADS = 512;
constexpr int RING_BYTES = 131072, MISC_OFF = RING_BYTES;
constexpr int LDS_BYTES = 147456;

__device__ __forceinline__ void transpose_item(const float* src, int ldw, bf16_t* dst, int ldT, LAS float* scr, int lane) {
#pragma unroll 8
    for (int i = 0; i < 32; ++i) { const int kk = 2 * i + (lane >> 5); scr[kk * 33 + (lane & 31)] = src[(size_t)kk * ldw + (lane & 31)]; }
    LDS_WAIT(); asm volatile("" ::: "memory");
    const int c = lane & 7;
#pragma unroll
    for (int j = 0; j < 4; ++j) { const int n = (lane >> 3) + 8 * j; const LAS float* s = scr + (8 * c) * 33 + n;
        u32x4 o; o.x = pk2(s[0 * 33], s[1 * 33]); o.y = pk2(s[2 * 33], s[3 * 33]); o.z = pk2(s[4 * 33], s[5 * 33]); o.w = pk2(s[6 * 33], s[7 * 33]);
        *(u32x4*)(dst + (size_t)n * ldT + 8 * c) = o; }
    LDS_WAIT(); asm volatile("" ::: "memory");
}
__device__ __forceinline__ int win_phys_row(int n) { const int l = n & 255; return (n & ~255) | (((l >> 5) & 1) << 7) | (((l >> 6) & 3) << 5) | (l & 31); }

__device__ __forceinline__ void rms_row_to_bf16(const float* xrow, const float* g, bf16_t* orow, int lane) {
    const f32x4* xr = (const f32x4*)xrow + lane; const f32x4* gr = (const f32x4*)g + lane;
    f32x4 v[4]; float s = 0.f;
#pragma unroll
    for (int j = 0; j < 4; ++j) { v[j] = xr[64 * j]; s += (v[j].x * v[j].x + v[j].y * v[j].y) + (v[j].z * v[j].z + v[j].w * v[j].w); }
    const float rstd = rsqrtf(wave_sum(s) * (1.f / D) + EPS);
    unsigned long long* o8 = (unsigned long long*)orow + lane;
#pragma unroll
    for (int j = 0; j < 4; ++j) { const f32x4 gg = gr[64 * j]; o8[64 * j] = (unsigned long long)pk2(v[j].x * rstd * gg.x, v[j].y * rstd * gg.y) | ((unsigned long long)pk2(v[j].z * rstd * gg.z, v[j].w * rstd * gg.w) << 32); }
}

#ifndef FAST_G1
#define FAST_G1 1
#endif
#ifndef FAST_ATTN
#define FAST_ATTN 1
#endif
#ifndef FAST_G2
#define FAST_G2 1
#endif
#ifndef FAST_G3
#define FAST_G3 1
#endif
#ifndef FAST_G4
#define FAST_G4 1
#endif
#ifndef FAST_G5
#define FAST_G5 1
#endif
#ifndef FAST_G6
#define FAST_G6 1
#endif

template <class BRow>
__device__ __forceinline__ void naive_tile(const bf16_t* A, int lda, int K, BRow brow, LAS float* tile, bool accumulate) {
    const int tid = threadIdx.x, tr = tid >> 4, tc = tid & 15;
    float acc[2][4] = {{0.f, 0.f, 0.f, 0.f}, {0.f, 0.f, 0.f, 0.f}};
    const bf16_t* a0 = A + (size_t)(2 * tr) * lda; const bf16_t* a1 = a0 + lda;
    const bf16_t* b[4];
#pragma unroll
    for (int j = 0; j < 4; ++j) b[j] = brow(4 * tc + j);
    for (int k = 0; k < K; k += 8) {
        const u32x4 av0 = *(const u32x4*)(a0 + k), av1 = *(const u32x4*)(a1 + k);
#pragma unroll
        for (int j = 0; j < 4; ++j) {
            const u32x4 bv = *(const u32x4*)(b[j] + k);
#pragma unroll
            for (int e = 0; e < 4; ++e) {
                const float bl = bf_lo(bv[e]), bh = bf_hi(bv[e]);
                acc[0][j] += bf_lo(av0[e]) * bl + bf_hi(av0[e]) * bh;
                acc[1][j] += bf_lo(av1[e]) * bl + bf_hi(av1[e]) * bh;
            }
        }
    }
#pragma unroll
    for (int r = 0; r < 2; ++r)
#pragma unroll
        for (int j = 0; j < 4; ++j) { LAS float* t = tile + (2 * tr + r) * 65 + 4 * tc + j; *t = accumulate ? (*t + acc[r][j]) : acc[r][j]; }
}


typedef __attribute__((address_space(4))) const Args* KArgPtr;
__device__ __forceinline__ KArgPtr kargs() { KArgPtr p = (KArgPtr)__builtin_amdgcn_kernarg_segment_ptr(); asm volatile("" : "+s"(p)); return p; }
#define ctl ((unsigned*)(ws + WS_CTL))
#define wrt ((float*)(ws + WS_TAB))
#define rt_e ((int*)(ws + WS_ROUTE))
#define rt_pos (rt_e + 2 * T)
#define rt_w ((float*)(rt_pos + 2 * T))
#define row_slot ((int*)(ws + WS_ROWMETA))
#define row_w ((float*)(row_slot + XS_ROWS))
#define Win_t ((bf16_t*)(ws + WS_WIN))
#define Wm_t ((bf16_t*)(ws + WS_WM))
#define Wo_t ((bf16_t*)(ws + WS_WO))
#define Wpg_t ((bf16_t*)(ws + WS_WPG))
#define Wpp_t ((bf16_t*)(ws + WS_WPP))
#define pb ((bf16_t*)(ws + WS_PB))
#define nbuf ((bf16_t*)(ws + WS_NBUF))
#define qb ((bf16_t*)(ws + WS_Q))
#define kb ((bf16_t*)(ws + WS_K))
#define vb ((bf16_t*)(ws + WS_V))
#define ub ((bf16_t*)(ws + WS_U))
#define bgb ((bf16_t*)(ws + WS_BG))
#define cgb ((bf16_t*)(ws + WS_CG))
#define sga ((bf16_t*)(ws + WS_SGA))
#define sgc ((bf16_t*)(ws + WS_SGC))
#define yac ((bf16_t*)(ws + WS_YAC))
#define mbuf ((bf16_t*)(ws + WS_M))
#define W13_t ((bf16_t*)(ws + WS_W13))
#define W2_t ((bf16_t*)(ws + WS_W2))
#define xs ((bf16_t*)(ws + WS_XS))
#define hdn ((bf16_t*)(ws + WS_HDN))
#define contrib ((bf16_t*)(ws + WS_CONTRIB))
#define ppb ((bf16_t*)(ws + WS_PP))
#define tile0 ((LAS float*)lds)
#define tile1 (tile0 + 64 * 65)
#define pref ((LAS int*)(lds + MISC_OFF))
#define cnts (pref + 64)
__global__ void __launch_bounds__(NTHREADS, 2) fwd_kernel(Args a) {
    extern __shared__ __attribute__((aligned(16))) unsigned char lds_raw[];
    cg::grid_group grid = cg::this_grid();
    LAS unsigned char* lds = (LAS unsigned char*)lds_raw;
    const int G = gridDim.x, bx = blockIdx.x;
    const int wave_s = __builtin_amdgcn_readfirstlane((int)threadIdx.x >> 6);
    volatile LAS unsigned* bst = (volatile LAS unsigned*)(lds + MISC_OFF + 512);
    if (threadIdx.x < 2) bst[threadIdx.x] = 0u;
    __syncthreads();
    const XcdBarrier bar = xcd_barrier_post((unsigned*)(a.ws + WS_CTL) + CW_BAR, bst);
#define XBAR() do { int t_ = (wave_s << 6) | lane_id_fresh(); xcd_barrier(bar, t_); } while (0)
#define PHASE_VARS() const KArgPtr ap = kargs(); unsigned char* const ws = ap->ws; (void)ws; int tid = (wave_s << 6) | lane_id_fresh(); asm volatile("" : "+v"(tid)); const int lane = tid & 63, wave = __builtin_amdgcn_readfirstlane(tid >> 6); \
    const int gw = bx * NWAVES + wave, NGW = G * NWAVES; const size_t gtid = (size_t)bx * NTHREADS + tid, GT = (size_t)G * NTHREADS; (void)lane; (void)gw; (void)NGW; (void)gtid; (void)GT
    {
        PHASE_VARS();
        LAS float* scr = (LAS float*)(lds + wave * 16384);
        constexpr int I_IN = 16 * 160, I_PA = 8 * 32, I_PC = 8 * 32, I_O = 16 * 32, I_PG = 16 * 32, I_PP = 4 * 32;
        constexpr int NIT = I_IN + I_PA + I_PC + I_O + I_PG + I_PP;
        for (int it = gw; it < NIT; it += NGW) {
            int r = it;
            if (r < I_IN) { const int kb_ = r / 160, nb = r % 160; transpose_item(ap->w_in + (size_t)(kb_ * 64) * NIN + nb * 32, NIN, Win_t + (size_t)win_phys_row(nb * 32) * D + kb_ * 64, D, scr, lane); continue; } r -= I_IN;
            if (r < I_PA) { const int kb_ = r / 32, nb = r % 32; transpose_item(ap->w_pa + (size_t)(kb_ * 64) * D + nb * 32, D, Wm_t + (size_t)(nb * 32) * D + kb_ * 64, D, scr, lane); continue; } r -= I_PA;
            if (r < I_PC) { const int kb_ = r / 32, nb = r % 32; transpose_item(ap->w_pc + (size_t)(kb_ * 64) * D + nb * 32, D, Wm_t + (size_t)(nb * 32) * D + 512 + kb_ * 64, D, scr, lane); continue; } r -= I_PC;
            if (r < I_O) { const int kb_ = r / 32, nb = r % 32; transpose_item(ap->w_o + (size_t)(kb_ * 64) * D + nb * 32, D, Wo_t + (size_t)(nb * 32) * D + kb_ * 64, D, scr, lane); continue; } r -= I_O;
            if (r < I_PG) { const int kb_ = r / 32, nb = r % 32; transpose_item(ap->w_pg + (size_t)(kb_ * 64) * D + nb * 32, D, Wpg_t + (size_t)(nb * 32) * D + kb_ * 64, D, scr, lane); continue; } r -= I_PG;
            { const int kb_ = r / 32, nb = r % 32; transpose_item(ap->w_pp + (size_t)(kb_ * 64) * D + nb * 32, D, Wpp_t + (size_t)(nb * 32) * PLE + kb_ * 64, PLE, scr, lane); }
        }
        for (size_t i = gtid; i < (size_t)36 * D; i += GT) { const int c = (int)(i / D), k = (int)(i % D); wrt[i] = c < 4 ? ap->w_group[k * 4 + c] : ap->w_router[k * 32 + (c - 4)]; }
        { float* gtab = (float*)(ws + WS_GTAB); float* gcinit = (float*)(ws + WS_GCINIT);
          for (size_t i = gtid; i < (size_t)NH * 4 * 384; i += GT) { const int h = (int)(i / 1536), s_ = (int)((i / 384) & 3), y = (int)(i % 384), x = y + s_;
              int dd = 319 - x; dd = dd < -63 ? -63 : (dd > 256 ? 256 : dd);
              gtab[i] = x <= 382 ? (ap->rel_bias[h * NREL + dd + 63] - ap->rel_bias[h * NREL + 319]) * LOG2E : 0.f; }
          if (gtid < NH) { const int h = (int)gtid; float gq = 0.f, gk = 0.f, mb = -3.0e38f;
              for (int d = 0; d < HD; ++d) { gq = fmaxf(gq, fabsf(ap->g_q[d])); gk = fmaxf(gk, fabsf(ap->g_k[d])); }
              for (int d = 0; d < NREL; ++d) mb = fmaxf(mb, ap->rel_bias[h * NREL + d]);
              gcinit[h] = ap->rel_bias[h * NREL + 319] * LOG2E - (64.f * C2 * gq * gk + mb * LOG2E); } }
        for (int m = gw; m < T; m += NGW) rms_row_to_bf16(ap->x + (size_t)m * D, ap->g_mix, nbuf + (size_t)m * D, lane);
        for (size_t i = gtid; i < (size_t)T * PLE / 8; i += GT) { const f32x4 v0 = ((const f32x4*)ap->p)[2 * i], v1 = ((const f32x4*)ap->p)[2 * i + 1];
            u32x4 o; o.x = pk2(v0.x, v0.y); o.y = pk2(v0.z, v0.w); o.z = pk2(v1.x, v1.y); o.w = pk2(v1.z, v1.w); ((u32x4*)pb)[i] = o; }
    }
    grid.sync();

#if FAST_G1
    { PHASE_VARS(); pg8::Gemm g{nbuf, Win_t, T, NIN, D, D}; pg8::StaticOrder S; S.init(T, NIN, G, bx); EpiInproj E{ws, ap->b_in, ap->g_q, ap->g_k};
      pg8::gemm_phase<EpiInproj, pg8::StaticOrder, true, true>(lds, g, S, E, tid); }
#else
    { PHASE_VARS();
    for (int tl = bx; tl < 512 * 80; tl += G) {
        const int rt = tl / 80, ct = tl % 80;
        naive_tile(nbuf + (size_t)rt * 64 * D, D, D, [=](int i) { return (const bf16_t*)(Win_t + (size_t)win_phys_row(64 * ct + i) * D); }, tile0, false);
        __syncthreads();
        const int row = tid >> 3, c8 = (tid & 7) * 8; float v[8]; float ss = 0.f;
#pragma unroll
        for (int j = 0; j < 8; ++j) { v[j] = tile0[row * 65 + c8 + j] + ap->b_in[64 * ct + c8 + j]; ss += v[j] * v[j]; }
        ss += __shfl_xor(ss, 1); ss += __shfl_xor(ss, 2); ss += __shfl_xor(ss, 4);
        bf16_t* dst;
        if (ct < 48) { const int seg = ct >> 3; dst = (bf16_t*)(ws + WS_Q + (size_t)seg * (32 * MiB)) + (size_t)(rt * 64 + row) * 512 + 64 * (ct & 7) + c8;
            if (seg < 2) { const float rstd = rsqrtf(ss * (1.f / 64.f) + EPS) * (seg == 0 ? C2 : 1.f); const float* g = seg == 0 ? ap->g_q : ap->g_k;
#pragma unroll
                for (int j = 0; j < 8; ++j) v[j] = v[j] * rstd * g[c8 + j]; } }
        else { dst = (ct < 64 ? sga : sgc) + (size_t)(rt * 64 + row) * D + 64 * ((ct - 48) & 15) + c8;
#pragma unroll
            for (int j = 0; j < 8; ++j) v[j] = sigmoidf_(v[j]); }
        u32x4 o; o.x = pk2(v[0], v[1]); o.y = pk2(v[2], v[3]); o.z = pk2(v[4], v[5]); o.w = pk2(v[6], v[7]); *(u32x4*)dst = o;
        __syncthreads();
    } }
#endif
    XBAR();

    {
        PHASE_VARS();
        for (size_t i = gtid; i < (size_t)T * (CW / 8); i += GT) {
            const int t = (int)(i >> 6), c8 = (int)(i & 63) * 8, s = t & (SEQ - 1);
            const size_t o = (size_t)t * CW + c8;
            const u32x4 u0 = *(const u32x4*)(ub + o), g0 = *(const u32x4*)(cgb + o), b0 = *(const u32x4*)(bgb + o);
            u32x4 u1 = {0u, 0u, 0u, 0u}, g1 = u1, u2 = u1, g2 = u1;
            if (s >= 1) { u1 = *(const u32x4*)(ub + o - CW); g1 = *(const u32x4*)(cgb + o - CW); }
            if (s >= 2) { u2 = *(const u32x4*)(ub + o - 2 * CW); g2 = *(const u32x4*)(cgb + o - 2 * CW); }
            float y[8];
#pragma unroll
            for (int e = 0; e < 4; ++e) {
#pragma unroll
                for (int hh = 0; hh < 2; ++hh) {
                    const int c = c8 + 2 * e + hh;
                    const float cu0 = hh ? bf_hi(u0[e]) * bf_hi(g0[e]) : bf_lo(u0[e]) * bf_lo(g0[e]);
                    const float cu1 = hh ? bf_hi(u1[e]) * bf_hi(g1[e]) : bf_lo(u1[e]) * bf_lo(g1[e]);
                    const float cu2 = hh ? bf_hi(u2[e]) * bf_hi(g2[e]) : bf_lo(u2[e]) * bf_lo(g2[e]);
                    const float bgv = hh ? bf_hi(b0[e]) : bf_lo(b0[e]);
                    y[2 * e + hh] = bgv * (ap->conv_b[c] + ap->conv_w[c] * cu2 + ap->conv_w[CW + c] * cu1 + ap->conv_w[2 * CW + c] * cu0);
                }
            }
            u32x4 w; w.x = pk2(y[0], y[1]); w.y = pk2(y[2], y[3]); w.z = pk2(y[4], y[5]); w.w = pk2(y[6], y[7]);
            *(u32x4*)(yac + (size_t)t * D + 512 + c8) = w;
        }
#if FAST_ATTN
        __syncthreads();
        attn_body::attn_phase((char*)lds_raw, (const attn_body::bf16*)qb, (const attn_body::bf16*)kb, (const attn_body::bf16*)vb, (attn_body::bf16*)yac, (const float*)(ws + WS_GTAB), (const float*)(ws + WS_GCINIT), G, bx, tid);
#else
        for (size_t i = gtid; i < (size_t)T * NH; i += GT) {
            const int h = (int)(i / T), t = (int)(i % T), s = t & (SEQ - 1), tb = t - s, c = s >> 6;
            float q[64], o[64];
#pragma unroll
            for (int d8 = 0; d8 < 8; ++d8) { const u32x4 w = *(const u32x4*)(qb + (size_t)t * AW + h * 64 + d8 * 8);
#pragma unroll
                for (int e = 0; e < 4; ++e) { q[d8 * 8 + 2 * e] = bf_lo(w[e]); q[d8 * 8 + 2 * e + 1] = bf_hi(w[e]); } }
#pragma unroll
            for (int d = 0; d < 64; ++d) o[d] = 0.f;
            float mrun = -1e30f, l = 0.f;
            int k0 = (c - 8) * 64; if (k0 < 0) k0 = 0;
            const int k1 = c * 64 + 63;
            for (int kp = k0; kp <= k1; ++kp) {
                const bf16_t* kr = kb + (size_t)(tb + kp) * AW + h * 64; float sc = 0.f;
#pragma unroll
                for (int d8 = 0; d8 < 8; ++d8) { const u32x4 w = *(const u32x4*)(kr + d8 * 8);
#pragma unroll
                    for (int e = 0; e < 4; ++e) sc += q[d8 * 8 + 2 * e] * bf_lo(w[e]) + q[d8 * 8 + 2 * e + 1] * bf_hi(w[e]); }
                int dd = s - kp; dd = dd < -63 ? -63 : (dd > 256 ? 256 : dd);
                sc += ap->rel_bias[h * NREL + dd + 63] * LOG2E;
                if (sc > mrun) { const float f = exp2f(mrun - sc); l *= f;
#pragma unroll
                    for (int d = 0; d < 64; ++d) o[d] *= f;
                    mrun = sc; }
                const float pr = exp2f(sc - mrun); l += pr;
                const bf16_t* vr = vb + (size_t)(tb + kp) * AW + h * 64;
#pragma unroll
                for (int d8 = 0; d8 < 8; ++d8) { const u32x4 w = *(const u32x4*)(vr + d8 * 8);
#pragma unroll
                    for (int e = 0; e < 4; ++e) { o[d8 * 8 + 2 * e] += pr * bf_lo(w[e]); o[d8 * 8 + 2 * e + 1] += pr * bf_hi(w[e]); } }
            }
            const float il = 1.f / l;
#pragma unroll
            for (int d8 = 0; d8 < 8; ++d8) { u32x4 w;
#pragma unroll
                for (int e = 0; e < 4; ++e) w[e] = pk2(o[d8 * 8 + 2 * e] * il, o[d8 * 8 + 2 * e + 1] * il);
                *(u32x4*)(yac + (size_t)t * D + h * 64 + d8 * 8) = w; }
        }
#endif
    }
    XBAR();

#if FAST_G2
    { PHASE_VARS(); pg8::StaticOrder S; S.init(T, D, G, bx);
      { pg8::Gemm g{yac, Wm_t, T, D, 512, D}; EpiMerge<false> E{sga, mbuf}; pg8::gemm_phase<EpiMerge<false>, pg8::StaticOrder, true, true>(lds, g, S, E, tid); }
      { pg8::Gemm g{yac + 512, Wm_t + 512, T, D, 512, D}; EpiMerge<true> E{sgc, mbuf}; pg8::gemm_phase<EpiMerge<true>, pg8::StaticOrder, true, true>(lds, g, S, E, tid); } }
#else
    { PHASE_VARS();
    for (int tl = bx; tl < 512 * 16; tl += G) {
        const int rt = tl / 16, ct = tl % 16;
        naive_tile(yac + (size_t)rt * 64 * D, D, 512, [=](int i) { return (const bf16_t*)(Wm_t + (size_t)(64 * ct + i) * D); }, tile0, false);
        naive_tile(yac + (size_t)rt * 64 * D + 512, D, 512, [=](int i) { return (const bf16_t*)(Wm_t + (size_t)(64 * ct + i) * D + 512); }, tile1, false);
        __syncthreads();
        const int row = tid >> 3, c8 = (tid & 7) * 8; const size_t o = (size_t)(rt * 64 + row) * D + 64 * ct + c8; float v[8];
#pragma unroll
        for (int j = 0; j < 8; ++j) v[j] = bf2f(sga[o + j]) * tile0[row * 65 + c8 + j] + bf2f(sgc[o + j]) * tile1[row * 65 + c8 + j];
        u32x4 w; w.x = pk2(v[0], v[1]); w.y = pk2(v[2], v[3]); w.z = pk2(v[4], v[5]); w.w = pk2(v[6], v[7]); *(u32x4*)(mbuf + o) = w;
        __syncthreads();
    } }
#endif
    XBAR();

#if FAST_G3
    { PHASE_VARS(); pg8::Gemm g{mbuf, Wo_t, T, D, D, D}; pg8::StaticOrder S; S.init(T, D, G, bx); EpiResF32 E{ap->x, ap->out};
      pg8::gemm_phase<EpiResF32, pg8::StaticOrder, true, true>(lds, g, S, E, tid); }
#else
    { PHASE_VARS();
    for (int tl = bx; tl < 512 * 16; tl += G) {
        const int rt = tl / 16, ct = tl % 16;
        naive_tile(mbuf + (size_t)rt * 64 * D, D, D, [=](int i) { return (const bf16_t*)(Wo_t + (size_t)(64 * ct + i) * D); }, tile0, false);
        __syncthreads();
        const int row = tid >> 3, c8 = (tid & 7) * 8; const size_t o = (size_t)(rt * 64 + row) * D + 64 * ct + c8;
#pragma unroll
        for (int j = 0; j < 8; ++j) ap->out[o + j] = ap->x[o + j] + tile0[row * 65 + c8 + j];
        __syncthreads();
    } }
#endif
    XBAR();

    {
        PHASE_VARS();
        for (int m = gw; m < T; m += NGW) {
            const f32x4* xr = (const f32x4*)(ap->out + (size_t)m * D) + lane; const f32x4* gr = (const f32x4*)ap->g_ffn + lane;
            f32x4 v[4]; float s = 0.f;
#pragma unroll
            for (int j = 0; j < 4; ++j) { v[j] = xr[64 * j]; s += (v[j].x * v[j].x + v[j].y * v[j].y) + (v[j].z * v[j].z + v[j].w * v[j].w); }
            const float rstd = rsqrtf(wave_sum(s) * (1.f / D) + EPS);
            unsigned long long* o8 = (unsigned long long*)(nbuf + (size_t)m * D) + lane;
#pragma unroll
            for (int j = 0; j < 4; ++j) { v[j] = v[j] * rstd * gr[64 * j]; o8[64 * j] = (unsigned long long)pk2(v[j].x, v[j].y) | ((unsigned long long)pk2(v[j].z, v[j].w) << 32); }
            float lg[36];
            const GAS f32x4* wbase = (const GAS f32x4*)wrt + lane; asm volatile("" : "+v"(wbase));
#pragma unroll
            for (int c = 0; c < 36; ++c) { const GAS f32x4* wr_ = wbase + c * (D / 4); float d = 0.f;
#pragma unroll
                for (int j = 0; j < 4; ++j) { const f32x4 w = wr_[64 * j]; d += (v[j].x * w.x + v[j].y * w.y) + (v[j].z * w.z + v[j].w * w.w); }
                lg[c] = wave_sum(d); asm volatile("" ::: "memory"); }
            int grp = 0; float gmax = lg[0] + ap->b_group[0];
            float gl[4];
#pragma unroll
            for (int c = 0; c < 4; ++c) gl[c] = lg[c] + ap->b_group[c];
#pragma unroll
            for (int c = 1; c < 4; ++c) if (gl[c] > gmax) { gmax = gl[c]; grp = c; }
            float gs = 0.f;
#pragma unroll
            for (int c = 0; c < 4; ++c) gs += __expf(gl[c] - gmax);
            const float pgrp = 1.f / gs;
            float el[8];
#pragma unroll
            for (int c = 0; c < 8; ++c) { float x0 = lg[4 + c], x1 = lg[12 + c], x2 = lg[20 + c], x3 = lg[28 + c]; el[c] = (grp == 0 ? x0 : grp == 1 ? x1 : grp == 2 ? x2 : x3) + ap->b_router[grp * 8 + c]; }
            int i0 = 0; float l0 = el[0];
#pragma unroll
            for (int c = 1; c < 8; ++c) if (el[c] > l0) { l0 = el[c]; i0 = c; }
            int i1 = -1; float l1 = -3.0e38f;
#pragma unroll
            for (int c = 0; c < 8; ++c) if (c != i0 && el[c] > l1) { l1 = el[c]; i1 = c; }
            const float e1 = __expf(l1 - l0), w0 = pgrp / (1.f + e1), w1 = pgrp * e1 / (1.f + e1);
            if (lane == 0) {
                const int ea = grp * 8 + i0, eb = grp * 8 + i1;
                const int pa = (int)atomicAdd(&ctl[ea], 1u), pb_ = (int)atomicAdd(&ctl[eb], 1u);
                rt_e[2 * m] = ea; rt_e[2 * m + 1] = eb; rt_pos[2 * m] = pa; rt_pos[2 * m + 1] = pb_; rt_w[2 * m] = w0; rt_w[2 * m + 1] = w1;
            }
        }
        LAS float* scr = (LAS float*)(lds + wave * 16384);
        constexpr int I_13 = 16 * 16, I_2 = 8 * 32, PER_E = 2 * I_13 + I_2;
        for (int it = gw; it < NE * PER_E; it += NGW) {
            const int e = it / PER_E; int r = it % PER_E;
            if (r < 2 * I_13) { const int which = r / I_13; r %= I_13; const int kb_ = r / 16, nb = r % 16, j0 = nb * 32;
                const float* src = (which ? ap->w3 : ap->w1) + (size_t)e * D * DE + (size_t)(kb_ * 64) * DE + j0;
                transpose_item(src, DE, W13_t + (size_t)(e * 1024 + (j0 >> 7) * 256 + which * 128 + (j0 & 127)) * D + kb_ * 64, D, scr, lane); }
            else { r -= 2 * I_13; const int kb_ = r / 32, nb = r % 32;
                transpose_item(ap->w2 + (size_t)e * DE * D + (size_t)(kb_ * 64) * D + nb * 32, D, W2_t + (size_t)(e * 1024 + nb * 32) * DE + kb_ * 64, DE, scr, lane); }
        }
    }
    XBAR();

    {
        PHASE_VARS();
        if (tid < NE) cnts[tid] = (int)__hip_atomic_load(&ctl[tid], __ATOMIC_RELAXED, __HIP_MEMORY_SCOPE_AGENT);
        __syncthreads();
        if (tid == 0) { int acc_ = 0; for (int e = 0; e < NE; ++e) { pref[e] = acc_; acc_ += (cnts[e] + 255) >> 8; } pref[NE] = acc_; }
        __syncthreads();
        for (size_t i = gtid; i < (size_t)NE * 256; i += GT) { const int e = (int)(i >> 8), r = (int)(i & 255); const int c = cnts[e];
            if (c + r < (((c + 255) >> 8) << 8)) row_slot[pref[e] * 256 + c + r] = -1; }
        for (int it = gw; it < 2 * T; it += NGW) {
            const int e = rt_e[it], row = pref[e] * 256 + rt_pos[it];
            const u32x4* src = (const u32x4*)(nbuf + (size_t)(it >> 1) * D) + lane; u32x4* dst = (u32x4*)(xs + (size_t)row * D) + lane;
            const u32x4 v0 = src[0], v1 = src[64]; dst[0] = v0; dst[64] = v1;
            if (lane == 0) { row_slot[row] = it; row_w[row] = rt_w[it]; }
        }
    }
    XBAR();
    const int ntiles = __builtin_amdgcn_readfirstlane(pref[NE]);

#if FAST_G4
    { PHASE_VARS(); pg8::Gemm g{xs, W13_t, XS_ROWS, NE * 1024, D, D}; MoeOrder S{pref, ntiles * 4, G, bx}; EpiSwiglu E{hdn};
      pg8::gemm_phase<EpiSwiglu, MoeOrder, true, true>(lds, g, S, E, tid); }
#else
    { PHASE_VARS();
    for (int tl = bx; tl < ntiles * 4 * 8; tl += G) {
        const int rt = tl >> 3, ct = tl & 7, rtg = rt >> 2; int e = 0; for (int k = 1; k < NE; ++k) e += (pref[k] <= rtg) ? 1 : 0;
        naive_tile(xs + (size_t)rt * 64 * D, D, D, [=](int i) { const int j = 64 * ct + i; return (const bf16_t*)(W13_t + (size_t)(e * 1024 + (j >> 7) * 256 + (j & 127)) * D); }, tile0, false);
        naive_tile(xs + (size_t)rt * 64 * D, D, D, [=](int i) { const int j = 64 * ct + i; return (const bf16_t*)(W13_t + (size_t)(e * 1024 + (j >> 7) * 256 + 128 + (j & 127)) * D); }, tile1, false);
        __syncthreads();
        const int row = tid >> 3, c8 = (tid & 7) * 8; float v[8];
#pragma unroll
        for (int j = 0; j < 8; ++j) { const float x1 = tile0[row * 65 + c8 + j], x3 = tile1[row * 65 + c8 + j]; v[j] = x1 * sigmoidf_(x1) * x3; }
        u32x4 w; w.x = pk2(v[0], v[1]); w.y = pk2(v[2], v[3]); w.z = pk2(v[4], v[5]); w.w = pk2(v[6], v[7]); *(u32x4*)(hdn + (size_t)(rt * 64 + row) * DE + 64 * ct + c8) = w;
        __syncthreads();
    } }
#endif
    XBAR();

#if FAST_G5
    { PHASE_VARS(); pg8::Gemm g{hdn, W2_t, XS_ROWS, NE * 1024, DE, DE}; MoeOrder S{pref, ntiles * 4, G, bx}; EpiDown E{row_slot, row_w, contrib};
      pg8::gemm_phase<EpiDown, MoeOrder, true, true>(lds, g, S, E, tid); }
#else
    { PHASE_VARS();
    for (int tl = bx; tl < ntiles * 4 * 16; tl += G) {
        const int rt = tl >> 4, ct = tl & 15, rtg = rt >> 2; int e = 0; for (int k = 1; k < NE; ++k) e += (pref[k] <= rtg) ? 1 : 0;
        naive_tile(hdn + (size_t)rt * 64 * DE, DE, DE, [=](int i) { return (const bf16_t*)(W2_t + (size_t)(e * 1024 + 64 * ct + i) * DE); }, tile0, false);
        __syncthreads();
        const int row = tid >> 3, c8 = (tid & 7) * 8; const int grow = rt * 64 + row; const int slot = row_slot[grow];
        if (slot >= 0) { const float w_ = row_w[grow]; float v[8];
#pragma unroll
            for (int j = 0; j < 8; ++j) v[j] = tile0[row * 65 + c8 + j] * w_;
            u32x4 w; w.x = pk2(v[0], v[1]); w.y = pk2(v[2], v[3]); w.z = pk2(v[4], v[5]); w.w = pk2(v[6], v[7]); *(u32x4*)(contrib + (size_t)slot * D + 64 * ct + c8) = w; }
        __syncthreads();
    } }
#endif
    XBAR();

    { PHASE_VARS();
    for (int m = gw; m < T; m += NGW) {
        f32x4* xr = (f32x4*)(ap->out + (size_t)m * D) + lane; const f32x4* gr = (const f32x4*)ap->g_ple + lane;
        const u32x2* c0 = (const u32x2*)(contrib + (size_t)(2 * m) * D) + lane; const u32x2* c1 = (const u32x2*)(contrib + (size_t)(2 * m + 1) * D) + lane;
        f32x4 v[4]; float s = 0.f;
#pragma unroll
        for (int j = 0; j < 4; ++j) { v[j] = xr[64 * j]; const u32x2 p0 = c0[64 * j], p1 = c1[64 * j];
            v[j].x += bf_lo(p0.x) + bf_lo(p1.x); v[j].y += bf_hi(p0.x) + bf_hi(p1.x); v[j].z += bf_lo(p0.y) + bf_lo(p1.y); v[j].w += bf_hi(p0.y) + bf_hi(p1.y);
            xr[64 * j] = v[j]; s += (v[j].x * v[j].x + v[j].y * v[j].y) + (v[j].z * v[j].z + v[j].w * v[j].w); }
        const float rstd = rsqrtf(wave_sum(s) * (1.f / D) + EPS);
        unsigned long long* o8 = (unsigned long long*)(nbuf + (size_t)m * D) + lane;
#pragma unroll
        for (int j = 0; j < 4; ++j) { const f32x4 gg = gr[64 * j]; o8[64 * j] = (unsigned long long)pk2(v[j].x * rstd * gg.x, v[j].y * rstd * gg.y) | ((unsigned long long)pk2(v[j].z * rstd * gg.z, v[j].w * rstd * gg.w) << 32); }
    } }
    XBAR();

#if FAST_G6
    { PHASE_VARS(); pg8::StaticOrder S; S.init(T, D, G, bx);
      { pg8::Gemm g{pb, Wpp_t, T, D, PLE, PLE}; EpiPP E{ppb}; pg8::gemm_phase<EpiPP, pg8::StaticOrder, true, true>(lds, g, S, E, tid); }
      { pg8::Gemm g{nbuf, Wpg_t, T, D, D, D}; EpiGate E{ppb, ap->b_pg, ap->out}; pg8::gemm_phase<EpiGate, pg8::StaticOrder, true, true>(lds, g, S, E, tid); } }
#else
    { PHASE_VARS();
    for (int tl = bx; tl < 512 * 16; tl += G) {
        const int rt = tl / 16, ct = tl % 16;
        naive_tile(nbuf + (size_t)rt * 64 * D, D, D, [=](int i) { return (const bf16_t*)(Wpg_t + (size_t)(64 * ct + i) * D); }, tile0, false);
        naive_tile(pb + (size_t)rt * 64 * PLE, PLE, PLE, [=](int i) { return (const bf16_t*)(Wpp_t + (size_t)(64 * ct + i) * PLE); }, tile1, false);
        __syncthreads();
        const int row = tid >> 3, c8 = (tid & 7) * 8; const size_t o = (size_t)(rt * 64 + row) * D + 64 * ct + c8;
#pragma unroll
        for (int j = 0; j < 8; ++j) ap->out[o + j] = ap->out[o + j] + sigmoidf_(tile0[row * 65 + c8 + j] + ap->b_pg[64 * ct + c8 + j]) * tile1[row * 65 + c8 + j];
        __syncthreads();
    } }
#endif
}

extern "C" void kernel_launch(void* const* d_in, const int* in_sizes, int n_in, void* d_out, int out_size, void* d_ws, size_t ws_size, hipStream_t stream) {
    static int grid = 0;
    if (grid == 0) {
        if (n_in != 25 || out_size != T * D || ws_size < WS_END) { fprintf(stderr, "kernel_launch: unexpected shapes (n_in %d out %d ws %zu); nothing launched\n", n_in, out_size, ws_size); grid = -1; return; }
        int dev = 0, cus = 0, per_cu = 0;
        if (hipGetDevice(&dev) != hipSuccess || hipDeviceGetAttribute(&cus, hipDeviceAttributeMultiprocessorCount, dev) != hipSuccess) { grid = -1; return; }
        if (hipFuncSetAttribute((const void*)fwd_kernel, hipFuncAttributeMaxDynamicSharedMemorySize, LDS_BYTES) != hipSuccess) { fprintf(stderr, "kernel_launch: hipFuncSetAttribute failed\n"); grid = -1; return; }
        if (hipOccupancyMaxActiveBlocksPerMultiprocessor(&per_cu, (const void*)fwd_kernel, NTHREADS, LDS_BYTES) != hipSuccess || per_cu < 1) { fprintf(stderr, "kernel_launch: occupancy query says %d\n", per_cu); (void)hipGetLastError(); grid = -1; return; }
        grid = cus;
    }
    if (grid < 0) return;
    if (hipMemsetAsync((char*)d_ws + WS_CTL, 0, CTL_ZERO_BYTES, stream) != hipSuccess) { fprintf(stderr, "kernel_launch: memset failed\n"); return; }
    Args a{};
    const float** f = (const float**)&a;
    for (int i = 0; i < 25; ++i) f[i] = (const float*)d_in[i];
    a.out = (float*)d_out; a.ws = (unsigned char*)d_ws;
    void* args[] = {&a};
    hipError_t e = hipLaunchCooperativeKernel((const void*)fwd_kernel, dim3(grid), dim3(NTHREADS), args, LDS_BYTES, stream);
    if (e != hipSuccess) fprintf(stderr, "kernel_launch: cooperative launch failed: %s (grid %d)\n", hipGetErrorString(e), grid);
}
```

```cpp
#include <hip/hip_runtime.h>
#include <hip/hip_cooperative_groups.h>
#include <cstdio>
#include <cstdint>
namespace cg = cooperative_groups;

#define GAS __attribute__((address_space(1)))
#define LAS __attribute__((address_space(3)))
typedef unsigned short bf16_t;
typedef short bf16x8 __attribute__((ext_vector_type(8)));
typedef float f32x4 __attribute__((ext_vector_type(4)));
typedef float f32x2 __attribute__((ext_vector_type(2)));
typedef unsigned u32x4 __attribute__((ext_vector_type(4)));
typedef unsigned u32x2 __attribute__((ext_vector_type(2)));
typedef GAS unsigned gu32;
#define RLX_AGENT __ATOMIC_RELAXED, __HIP_MEMORY_SCOPE_AGENT

constexpr int T = 32768, D = 1024, SEQ = 4096, NBATCH = 8;
constexpr int NIN = 5120, NH = 8, HD = 64, AW = 512, CW = 512;
constexpr int NE = 32, DE = 512, PLE = 256, NREL = 320;
constexpr int XS_ROWS = 65536 + NE * 256;
constexpr float EPS = 1e-6f;
constexpr float LOG2E = 1.4426950408889634f;
constexpr float C2 = 0.125f * LOG2E;

constexpr size_t MiB = 1u << 20;
constexpr size_t WS_CTL = 0, CTL_ZERO_BYTES = 64 * 1024;
constexpr int CW_BAR = 1024;
constexpr size_t WS_TAB = 1 * MiB;
constexpr size_t WS_GTAB = WS_TAB + 192 * 1024;
constexpr size_t WS_GCINIT = WS_GTAB + 8 * 4 * 384 * 4;
constexpr size_t WS_ROUTE = 2 * MiB;
constexpr size_t WS_RSTD = 3 * MiB;
constexpr size_t WS_ROWMETA = 4 * MiB;
constexpr size_t WS_WIN = 6 * MiB;
constexpr size_t WS_WM = 16 * MiB;
constexpr size_t WS_WO = 18 * MiB;
constexpr size_t WS_WPG = 20 * MiB;
constexpr size_t WS_WPP = 22 * MiB;
constexpr size_t WS_PB = 24 * MiB;
constexpr size_t WS_NBUF = 40 * MiB;
constexpr size_t WS_Q = 104 * MiB, WS_K = 136 * MiB, WS_V = 168 * MiB, WS_U = 200 * MiB, WS_BG = 232 * MiB, WS_CG = 264 * MiB;
constexpr size_t WS_SGA = 296 * MiB, WS_SGC = 360 * MiB;
constexpr size_t WS_YAC = 424 * MiB;
constexpr size_t WS_M = 104 * MiB;
constexpr size_t WS_W13 = 168 * MiB;
constexpr size_t WS_W2 = 232 * MiB;
constexpr size_t WS_XS = 264 * MiB;
constexpr size_t WS_HDN = 408 * MiB;
constexpr size_t WS_CONTRIB = 264 * MiB;
constexpr size_t WS_PP = 104 * MiB;
constexpr size_t WS_END = 488 * MiB;

__device__ __forceinline__ unsigned f2bf(float f) { unsigned u = __builtin_bit_cast(unsigned, f); return (u + 0x7fffu + ((u >> 16) & 1u)) >> 16; }
__device__ __forceinline__ unsigned pk2(float lo, float hi) { return f2bf(lo) | (f2bf(hi) << 16); }
__device__ __forceinline__ float bf_lo(unsigned w) { return __builtin_bit_cast(float, w << 16); }
__device__ __forceinline__ float bf_hi(unsigned w) { return __builtin_bit_cast(float, w & 0xffff0000u); }
__device__ __forceinline__ float bf2f(bf16_t h) { return __builtin_bit_cast(float, (unsigned)h << 16); }
__device__ __forceinline__ float sigmoidf_(float x) { return __builtin_amdgcn_rcpf(1.0f + __builtin_amdgcn_exp2f(-LOG2E * x)); }
__device__ __forceinline__ float wave_sum(float v) {
#pragma unroll
    for (int o = 1; o < 64; o <<= 1) v += __shfl_xor(v, o);
    return v;
}
__device__ __forceinline__ int lane_id_fresh() { int l; asm volatile("v_mbcnt_lo_u32_b32 %0, -1, 0\n\tv_mbcnt_hi_u32_b32 %0, -1, %0" : "=v"(l)); return l; }
#define LDS_WAIT() asm volatile("s_waitcnt lgkmcnt(0)" ::: "memory")
#define VM_WAIT() asm volatile("s_waitcnt vmcnt(0)" ::: "memory")

namespace pg8 {
#define PG8_LAS __attribute__((address_space(3)))
constexpr int BM = 256, BK = 64, HALF = 128, HTB = HALF * BK * 2  , STAGE_BYTES = 8 * HTB, NXCD = 8, WGM = 8;

__host__ __device__ __forceinline__ int lds_byte(int r, int c) { const int st = (r >> 4) * 2 + (c >> 5), rr = r & 15, cc = c & 31, ob = rr * 64 + cc * 2; return st * 1024 + (ob ^ (((ob >> 9) & 1) << 5)); }
__host__ __device__ __forceinline__ void stage_rc(int b, int& R, int& C) { const int st = b / 1024, sb = b % 1024, swz = sb ^ (((sb >> 9) & 1) << 5); R = (st >> 1) * 16 + swz / 64; C = (st & 1) * 32 + (swz % 64) / 2; }
__host__ __device__ __forceinline__ int perm32(int rho) { const int n = rho >> 4, i = rho & 15; return 8 * (i >> 2) + 4 * n + (i & 3); }

struct Unit { int pm, pn; };
struct Gemm { const bf16_t* A; const bf16_t* Bt; int M, N, K, ld; };

struct StaticOrder {
    int nM, nN, nwg, G, c;
    __host__ __device__ void init(int M, int N, int G_, int c_) { nM = M / BM; nN = N / BM; nwg = nM * nN; G = G_; c = c_; }
    __host__ __device__ bool next(int i, Unit& u) const {
        const long L = (long)i * G + c; if (L >= nwg) return false;
        int wgid = (int)L; { const int q = nwg / NXCD, r = nwg % NXCD, xcd = wgid % NXCD, off = wgid / NXCD; wgid = (xcd < r ? xcd * (q + 1) : r * (q + 1) + (xcd - r) * q) + off; }
        const int nig = WGM * nN, gid = wgid / nig, fm = gid * WGM, gsz = (nM - fm) < WGM ? (nM - fm) : WGM;
        u.pm = fm + ((wgid % nig) % gsz); u.pn = (wgid % nig) / gsz; return true;
    }
    __device__ __forceinline__ void a_ready(const Unit&) const {}
    __device__ __forceinline__ void done(const Unit&) const {}
};
__device__ __forceinline__ unsigned cvt_pk_bf16(float lo, float hi) { unsigned r; asm volatile("v_cvt_pk_bf16_f32 %0, %1, %2" : "=v"(r) : "v"(lo), "v"(hi)); return r; }

template <class Epi, class Sched, bool ALIGN_EPI = false, bool SP2 = false>
__device__ __forceinline__ void gemm_phase(PG8_LAS unsigned char* lds, const Gemm g, const Sched& S, const Epi& E, int tid_) {
    asm volatile("" : "+v"(tid_));
    const int tid = tid_, wid = __builtin_amdgcn_readfirstlane(tid >> 6), lane = tid & 63, wr = wid >> 2, wc = wid & 3, fr = lane & 15, fq = lane >> 4;
    int K = g.K; asm volatile("" : "+s"(K));
    const int nt = K / BK; const int LD = g.ld;
    unsigned voffA[2], voffB[2];
#pragma unroll
    for (int i = 0; i < 2; ++i) { int R, C; stage_rc(tid * 16 + i * 8192, R, C); const int Rb = Epi::PERM ? ((R & ~31) + perm32(R & 31)) : R;
        voffA[i] = (unsigned)(R * LD + C) * 2u; voffB[i] = (unsigned)(Rb * LD + C) * 2u; }
    const size_t kstep = (size_t)(BK * 2);
    const size_t hstep = (size_t)HALF * LD * 2;
    const size_t tstep = 2 * hstep;
    const unsigned ldsw = (unsigned)wid * 1024u;
    const int aoff = lds_byte(wr * 64 + fr, fq * 8), boff = lds_byte(wc * 32 + fr, fq * 8);
#define PG8_SA(b, h) (((b) * 2 + (h)) * HTB)
#define PG8_SB(b, h) ((4 + (b) * 2 + (h)) * HTB)
#define PG8_STAGE(bufoff, gbase, voff) do { _Pragma("unroll") for (int _i = 0; _i < 2; ++_i) \
        __builtin_amdgcn_global_load_lds((const unsigned*)((const char*)(gbase) + (voff)[_i]), (PG8_LAS unsigned*)(lds + (bufoff) + ldsw + _i * 8192), 16, 0, 0); } while (0)
#define PG8_LDA(dst, b, h) do { _Pragma("unroll") for (int m = 0; m < 4; ++m) _Pragma("unroll") for (int k = 0; k < 2; ++k) dst[m][k] = *(const PG8_LAS bf16x8*)(lds + PG8_SA(b, h) + aoff + m * 2048 + k * 1024); } while (0)
#define PG8_LDB(dst, b, h) do { _Pragma("unroll") for (int n = 0; n < 2; ++n) _Pragma("unroll") for (int k = 0; k < 2; ++k) dst[n][k] = *(const PG8_LAS bf16x8*)(lds + PG8_SB(b, h) + boff + n * 2048 + k * 1024); } while (0)
#define PG8_MMA(ai, bj, At, Bt) do { __builtin_amdgcn_s_setprio(1); _Pragma("unroll") for (int m = 0; m < 4; ++m) _Pragma("unroll") for (int n = 0; n < 2; ++n) _Pragma("unroll") for (int k = 0; k < 2; ++k) \
        acc[ai][bj][m][n] = __builtin_amdgcn_mfma_f32_16x16x32_bf16(Bt[n][k], At[m][k], acc[ai][bj][m][n], 0, 0, 0); __builtin_amdgcn_s_setprio(0); } while (0)
#define PG8_WAIT_V(n) asm volatile("s_waitcnt vmcnt(" #n ")" ::: "memory")
#define PG8_WAIT_L(n) asm volatile("s_waitcnt lgkmcnt(" #n ")" ::: "memory")
#define PG8_BAR __builtin_amdgcn_s_barrier()
#define PG8_SCHED __builtin_amdgcn_sched_barrier(0)
    Unit cur, nxt; int ui = 0;
    if (!S.next(0, cur)) return;
    f32x4 acc[2][2][4][2];
#pragma unroll
    for (int a = 0; a < 2; ++a)
#pragma unroll
        for (int b = 0; b < 2; ++b)
#pragma unroll
            for (int m = 0; m < 4; ++m)
#pragma unroll
                for (int n = 0; n < 2; ++n) acc[a][b][m][n] = (f32x4){0.f, 0.f, 0.f, 0.f};
    bf16x8 At[4][2], B0[2][2], B1[2][2];
    const char* cA = (const char*)g.A + (size_t)cur.pm * tstep; const char* cB = (const char*)g.Bt + (size_t)cur.pn * tstep;
    S.a_ready(cur);
    if constexpr (SP2) {
        PG8_STAGE(PG8_SB(0, 0), cB, voffB); PG8_STAGE(PG8_SB(0, 1), cB + hstep, voffB); PG8_STAGE(PG8_SA(0, 0), cA, voffA); PG8_STAGE(PG8_SA(0, 1), cA + hstep, voffA);
        if (wr == 1) PG8_BAR;
        PG8_WAIT_V(2); PG8_BAR;
        PG8_STAGE(PG8_SB(1, 0), cB + kstep, voffB); PG8_STAGE(PG8_SA(1, 0), cA + kstep, voffA); PG8_STAGE(PG8_SB(1, 1), cB + hstep + kstep, voffB);
        PG8_WAIT_V(6); PG8_BAR;
    } else {
        PG8_STAGE(PG8_SB(0, 0), cB, voffB); PG8_STAGE(PG8_SA(0, 0), cA, voffA); PG8_STAGE(PG8_SB(0, 1), cB + hstep, voffB); PG8_STAGE(PG8_SA(0, 1), cA + hstep, voffA);
        if (wr == 1) PG8_BAR;
        PG8_WAIT_V(4); PG8_BAR;
        PG8_STAGE(PG8_SB(1, 0), cB + kstep, voffB); PG8_STAGE(PG8_SA(1, 0), cA + kstep, voffA); PG8_STAGE(PG8_SB(1, 1), cB + hstep + kstep, voffB);
        PG8_WAIT_V(6); PG8_BAR;
    }
    for (;;) {
        const bool has_next = S.next(ui + 1, nxt);
        const char* nA = has_next ? (const char*)g.A + (size_t)nxt.pm * tstep : cA; const char* nB = has_next ? (const char*)g.Bt + (size_t)nxt.pn * tstep : cB;
        for (int t = 0; t < nt; t += 2) {
            const bool last = (t == nt - 2);
            if constexpr (Epi::MID_T > 0) { if (t == Epi::MID_T) E.mid(acc, cur, wr, wc, fr, fq); }
            const char* a1 = cA + (size_t)(t + 1) * kstep;
            const char* a2 = last ? nA : cA + (size_t)(t + 2) * kstep; const char* b2 = last ? nB : cB + (size_t)(t + 2) * kstep;
            const char* a3 = a2 + kstep; const char* b3 = b2 + kstep;
            if (last && has_next) S.a_ready(nxt);
            if constexpr (SP2) {
            PG8_LDB(B0, 0, 0); PG8_LDB(B1, 0, 1); PG8_SCHED; PG8_LDA(At, 0, 0); PG8_STAGE(PG8_SA(1, 1), a1 + hstep, voffA);
            PG8_WAIT_V(8); PG8_WAIT_L(0); PG8_BAR; PG8_MMA(0, 0, At, B0); PG8_MMA(0, 1, At, B1); PG8_BAR; PG8_SCHED;
            PG8_LDA(At, 0, 1); PG8_STAGE(PG8_SB(0, 0), b2, voffB); PG8_STAGE(PG8_SB(0, 1), b2 + hstep, voffB); PG8_STAGE(PG8_SA(0, 0), a2, voffA);
            PG8_WAIT_V(8); PG8_WAIT_L(0); PG8_BAR; PG8_MMA(1, 0, At, B0); PG8_MMA(1, 1, At, B1); PG8_BAR; PG8_SCHED;
            PG8_LDB(B0, 1, 0); PG8_LDB(B1, 1, 1); PG8_SCHED; PG8_LDA(At, 1, 0); PG8_STAGE(PG8_SA(0, 1), a2 + hstep, voffA);
            PG8_WAIT_V(8); PG8_WAIT_L(0); PG8_BAR; PG8_MMA(0, 0, At, B0); PG8_MMA(0, 1, At, B1); PG8_BAR; PG8_SCHED;
            PG8_LDA(At, 1, 1); PG8_STAGE(PG8_SB(1, 0), b3, voffB); PG8_STAGE(PG8_SB(1, 1), b3 + hstep, voffB); PG8_STAGE(PG8_SA(1, 0), a3, voffA);
            PG8_WAIT_V(8); PG8_WAIT_L(0); PG8_BAR; PG8_MMA(1, 0, At, B0); PG8_MMA(1, 1, At, B1); PG8_BAR; PG8_SCHED;
            } else {
            PG8_LDB(B0, 0, 0); PG8_SCHED; PG8_LDA(At, 0, 0); PG8_STAGE(PG8_SA(1, 1), a1 + hstep, voffA);
            PG8_WAIT_L(8); PG8_BAR; PG8_WAIT_L(0); PG8_MMA(0, 0, At, B0); PG8_BAR; PG8_SCHED;
            PG8_LDB(B1, 0, 1); PG8_STAGE(PG8_SB(0, 0), b2, voffB);
            PG8_BAR; PG8_WAIT_L(0); PG8_MMA(0, 1, At, B1); PG8_BAR;
            PG8_LDA(At, 0, 1); PG8_STAGE(PG8_SA(0, 0), a2, voffA);
            PG8_BAR; PG8_WAIT_L(0); PG8_MMA(1, 0, At, B0); PG8_BAR; PG8_SCHED;
            PG8_STAGE(PG8_SB(0, 1), b2 + hstep, voffB);
            PG8_WAIT_V(6); PG8_BAR; PG8_MMA(1, 1, At, B1); PG8_BAR;
            PG8_LDB(B0, 1, 0); PG8_SCHED; PG8_LDA(At, 1, 0); PG8_STAGE(PG8_SA(0, 1), a2 + hstep, voffA);
            PG8_WAIT_L(8); PG8_BAR; PG8_WAIT_L(0); PG8_MMA(0, 0, At, B0); PG8_BAR; PG8_SCHED;
            PG8_LDB(B1, 1, 1); PG8_STAGE(PG8_SB(1, 0), b3, voffB);
            PG8_BAR; PG8_WAIT_L(0); PG8_MMA(0, 1, At, B1); PG8_BAR;
            PG8_LDA(At, 1, 1); PG8_STAGE(PG8_SA(1, 0), a3, voffA);
            PG8_BAR; PG8_WAIT_L(0); PG8_MMA(1, 0, At, B0); PG8_BAR; PG8_SCHED;
            PG8_STAGE(PG8_SB(1, 1), b3 + hstep, voffB);
            PG8_WAIT_V(6); PG8_BAR; PG8_MMA(1, 1, At, B1); PG8_BAR;
            }
        }
        if constexpr (ALIGN_EPI) { if (wr == 0) PG8_BAR; }
        if constexpr (!Epi::AFTER_DRAIN) { E(acc, cur, wr, wc, fr, fq); S.done(cur); }
        if (!has_next) break;
#pragma unroll
        for (int a = 0; a < 2; ++a)
#pragma unroll
            for (int b = 0; b < 2; ++b)
#pragma unroll
                for (int m = 0; m < 4; ++m)
#pragma unroll
                    for (int n = 0; n < 2; ++n) acc[a][b][m][n] = (f32x4){0.f, 0.f, 0.f, 0.f};
        cur = nxt; cA = nA; cB = nB; ++ui;
        if constexpr (ALIGN_EPI) { if (wr == 1) PG8_BAR; }
    }
    PG8_WAIT_V(0);
    if constexpr (!ALIGN_EPI) { if (wr == 0) PG8_BAR; }
    PG8_BAR;
#undef PG8_SA
#undef PG8_SB
#undef PG8_STAGE
#undef PG8_LDA
#undef PG8_LDB
#undef PG8_MMA
#undef PG8_WAIT_V
#undef PG8_WAIT_L
#undef PG8_BAR
#undef PG8_SCHED
}
}

typedef f32x4 acc_t[2][2][4][2];
using pg8::Unit; using pg8::HALF; using pg8::BM;

struct EpiInproj {
    static constexpr bool PERM = true, AFTER_DRAIN = false; static constexpr int MID_T = 0;
    unsigned char* ws; const float* b_in; const float* g_q; const float* g_k;
    __device__ __forceinline__ void operator()(const acc_t& acc, const Unit& u, int wr, int wc, int fr, int fq) const {
        const int pn = u.pn;
        int mode, pitch, col0; size_t off;
        if (pn < 12) { const int seg = pn >> 1; mode = seg == 0 ? 1 : (seg == 1 ? 2 : 0); pitch = 512; col0 = 256 * (pn & 1); off = WS_Q + (size_t)seg * (32 * MiB); }
        else if (pn < 16) { mode = 3; pitch = 1024; col0 = 256 * (pn - 12); off = WS_SGA; }
        else { mode = 3; pitch = 1024; col0 = 256 * (pn - 16); off = WS_SGC; }
        bf16_t* base = (bf16_t*)(ws + off);
        const int lc0 = 64 * wc + 8 * fq;
        f32x4 bv[2][2], gv[2][2];
#pragma unroll
        for (int bj = 0; bj < 2; ++bj)
#pragma unroll
            for (int n = 0; n < 2; ++n) {
                bv[bj][n] = *(const f32x4*)(b_in + 256 * pn + lc0 + 32 * bj + 4 * n);
                const float* g = (mode == 2) ? g_k : g_q;
                gv[bj][n] = *(const f32x4*)(g + 8 * fq + 32 * bj + 4 * n);
            }
        const float qs = (mode == 1) ? C2 : 1.0f;
#pragma unroll
        for (int ai = 0; ai < 2; ++ai)
#pragma unroll
            for (int m = 0; m < 4; ++m) {
                const int row = u.pm * BM + ai * HALF + wr * 64 + m * 16 + fr;
                f32x4 v[2][2];
#pragma unroll
                for (int bj = 0; bj < 2; ++bj)
#pragma unroll
                    for (int n = 0; n < 2; ++n) v[bj][n] = acc[ai][bj][m][n] + bv[bj][n];
                if (mode == 1 || mode == 2) {
                    float ss = 0.f;
#pragma unroll
                    for (int bj = 0; bj < 2; ++bj)
#pragma unroll
                        for (int n = 0; n < 2; ++n) { const f32x4 x = v[bj][n]; ss += (x[0] * x[0] + x[1] * x[1]) + (x[2] * x[2] + x[3] * x[3]); }
                    ss += __shfl_xor(ss, 16); ss += __shfl_xor(ss, 32);
                    const float rstd = __frsqrt_rn(ss * (1.0f / 64.0f) + EPS) * qs;
#pragma unroll
                    for (int bj = 0; bj < 2; ++bj)
#pragma unroll
                        for (int n = 0; n < 2; ++n) v[bj][n] = v[bj][n] * rstd * gv[bj][n];
                } else if (mode == 3) {
#pragma unroll
                    for (int bj = 0; bj < 2; ++bj)
#pragma unroll
                        for (int n = 0; n < 2; ++n)
#pragma unroll
                            for (int j = 0; j < 4; ++j) v[bj][n][j] = sigmoidf_(v[bj][n][j]);
                }
                bf16_t* rowp = base + (size_t)row * pitch + col0 + lc0;
#pragma unroll
                for (int bj = 0; bj < 2; ++bj) {
                    u32x4 w; w.x = pg8::cvt_pk_bf16(v[bj][0][0], v[bj][0][1]); w.y = pg8::cvt_pk_bf16(v[bj][0][2], v[bj][0][3]); w.z = pg8::cvt_pk_bf16(v[bj][1][0], v[bj][1][1]); w.w = pg8::cvt_pk_bf16(v[bj][1][2], v[bj][1][3]);
                    *(u32x4*)(rowp + 32 * bj) = w;
                }
            }
    }
};

template <bool SECOND> struct EpiMerge {
    static constexpr bool PERM = true, AFTER_DRAIN = false; static constexpr int MID_T = 0;
    const bf16_t* gate; bf16_t* mout;
    __device__ __forceinline__ void operator()(const acc_t& acc, const Unit& u, int wr, int wc, int fr, int fq) const {
        const int col0 = u.pn * BM + wc * 32 + 8 * fq;
#pragma unroll
        for (int ai = 0; ai < 2; ++ai)
#pragma unroll
            for (int m = 0; m < 4; ++m) {
                const size_t ro = (size_t)(u.pm * BM + ai * HALF + wr * 64 + m * 16 + fr) * D + col0;
#pragma unroll
                for (int bj = 0; bj < 2; ++bj) {
                    const u32x4 c = *(const u32x4*)(gate + ro + bj * HALF);
                    const f32x4 v0 = acc[ai][bj][m][0], v1 = acc[ai][bj][m][1];
                    float r[8] = {v0[0] * bf_lo(c.x), v0[1] * bf_hi(c.x), v0[2] * bf_lo(c.y), v0[3] * bf_hi(c.y), v1[0] * bf_lo(c.z), v1[1] * bf_hi(c.z), v1[2] * bf_lo(c.w), v1[3] * bf_hi(c.w)};
                    if (SECOND) { const u32x4 p = *(const u32x4*)(mout + ro + bj * HALF);
                        r[0] += bf_lo(p.x); r[1] += bf_hi(p.x); r[2] += bf_lo(p.y); r[3] += bf_hi(p.y); r[4] += bf_lo(p.z); r[5] += bf_hi(p.z); r[6] += bf_lo(p.w); r[7] += bf_hi(p.w); }
                    u32x4 w; w.x = pg8::cvt_pk_bf16(r[0], r[1]); w.y = pg8::cvt_pk_bf16(r[2], r[3]); w.z = pg8::cvt_pk_bf16(r[4], r[5]); w.w = pg8::cvt_pk_bf16(r[6], r[7]);
                    *(u32x4*)(mout + ro + bj * HALF) = w;
                }
                asm volatile("" ::: "memory");
            }
    }
};

struct EpiResF32 {
    static constexpr bool PERM = false, AFTER_DRAIN = false; static constexpr int MID_T = 0;
    const float* x; float* out;
    __device__ __forceinline__ void operator()(const acc_t& acc, const Unit& u, int wr, int wc, int fr, int fq) const {
        const int col0 = u.pn * BM + wc * 32 + 4 * fq;
#pragma unroll
        for (int ai = 0; ai < 2; ++ai)
#pragma unroll
            for (int m = 0; m < 4; ++m) {
                const size_t ro = (size_t)(u.pm * BM + ai * HALF + wr * 64 + m * 16 + fr) * D + col0;
#pragma unroll
                for (int bj = 0; bj < 2; ++bj)
#pragma unroll
                    for (int n = 0; n < 2; ++n) { const f32x4 b = *(const f32x4*)(x + ro + bj * HALF + n * 16); *(f32x4*)(out + ro + bj * HALF + n * 16) = b + acc[ai][bj][m][n]; }
                if (m & 1) asm volatile("" ::: "memory");
            }
    }
};

struct EpiSwiglu {
    static constexpr bool PERM = true, AFTER_DRAIN = false; static constexpr int MID_T = 0;
    bf16_t* hdn;
    __device__ __forceinline__ void operator()(const acc_t& acc, const Unit& u, int wr, int wc, int fr, int fq) const {
        const int col0 = 128 * (u.pn & 3) + wc * 32 + 8 * fq;
#pragma unroll
        for (int ai = 0; ai < 2; ++ai)
#pragma unroll
            for (int m = 0; m < 4; ++m) {
                const size_t ro = (size_t)(u.pm * BM + ai * HALF + wr * 64 + m * 16 + fr) * DE + col0;
                float h[8];
#pragma unroll
                for (int n = 0; n < 2; ++n)
#pragma unroll
                    for (int j = 0; j < 4; ++j) { const float a = acc[ai][0][m][n][j], b = acc[ai][1][m][n][j]; h[4 * n + j] = a * sigmoidf_(a) * b; }
                u32x4 w; w.x = pg8::cvt_pk_bf16(h[0], h[1]); w.y = pg8::cvt_pk_bf16(h[2], h[3]); w.z = pg8::cvt_pk_bf16(h[4], h[5]); w.w = pg8::cvt_pk_bf16(h[6], h[7]);
                *(u32x4*)(hdn + ro) = w;
            }
    }
};

struct EpiDown {
    static constexpr bool PERM = true, AFTER_DRAIN = false; static constexpr int MID_T = 0;
    const int* row_slot; const float* row_w; bf16_t* contrib;
    __device__ __forceinline__ void operator()(const acc_t& acc, const Unit& u, int wr, int wc, int fr, int fq) const {
        const int col0 = 256 * (u.pn & 3) + wc * 32 + 8 * fq;
#pragma unroll
        for (int ai = 0; ai < 2; ++ai)
#pragma unroll
            for (int m = 0; m < 4; ++m) {
                const int row = u.pm * BM + ai * HALF + wr * 64 + m * 16 + fr;
                const int slot = row_slot[row]; const float w = row_w[row];
                if (slot >= 0) {
#pragma unroll
                    for (int bj = 0; bj < 2; ++bj) {
                        const f32x4 v0 = acc[ai][bj][m][0] * w, v1 = acc[ai][bj][m][1] * w;
                        u32x4 o; o.x = pg8::cvt_pk_bf16(v0[0], v0[1]); o.y = pg8::cvt_pk_bf16(v0[2], v0[3]); o.z = pg8::cvt_pk_bf16(v1[0], v1[1]); o.w = pg8::cvt_pk_bf16(v1[2], v1[3]);
                        *(u32x4*)(contrib + (size_t)slot * D + col0 + bj * HALF) = o;
                    }
                }
            }
    }
};

struct EpiPP {
    static constexpr bool PERM = false, AFTER_DRAIN = false; static constexpr int MID_T = 0;
    bf16_t* pp;
    __device__ __forceinline__ void operator()(const acc_t& acc, const Unit& u, int wr, int wc, int fr, int fq) const {
        const int col0 = u.pn * BM + wc * 32 + 4 * fq;
#pragma unroll
        for (int ai = 0; ai < 2; ++ai)
#pragma unroll
            for (int m = 0; m < 4; ++m) {
                const size_t ro = (size_t)(u.pm * BM + ai * HALF + wr * 64 + m * 16 + fr) * D + col0;
#pragma unroll
                for (int bj = 0; bj < 2; ++bj)
#pragma unroll
                    for (int n = 0; n < 2; ++n) { const f32x4 v = acc[ai][bj][m][n]; u32x2 w; w.x = pg8::cvt_pk_bf16(v[0], v[1]); w.y = pg8::cvt_pk_bf16(v[2], v[3]); *(u32x2*)(pp + ro + bj * HALF + n * 16) = w; }
            }
    }
};
struct EpiGate {
    static constexpr bool PERM = false, AFTER_DRAIN = false; static constexpr int MID_T = 0;
    const bf16_t* pp; const float* bpg; float* out;
    __device__ __forceinline__ void operator()(const acc_t& acc, const Unit& u, int wr, int wc, int fr, int fq) const {
        const int col0 = u.pn * BM + wc * 32 + 4 * fq;
#pragma unroll
        for (int ai = 0; ai < 2; ++ai)
#pragma unroll
            for (int m = 0; m < 4; ++m) {
                const size_t ro = (size_t)(u.pm * BM + ai * HALF + wr * 64 + m * 16 + fr) * D + col0;
#pragma unroll
                for (int bj = 0; bj < 2; ++bj)
#pragma unroll
                    for (int n = 0; n < 2; ++n) {
                        const size_t o = ro + bj * HALF + n * 16;
                        const f32x4 h = *(const f32x4*)(out + o); const u32x2 pw = *(const u32x2*)(pp + o);
                        const f32x4 a = acc[ai][bj][m][n] + *(const f32x4*)(bpg + col0 + bj * HALF + n * 16);
                        f32x4 r;
                        r[0] = h[0] + sigmoidf_(a[0]) * bf_lo(pw.x); r[1] = h[1] + sigmoidf_(a[1]) * bf_hi(pw.x);
                        r[2] = h[2] + sigmoidf_(a[2]) * bf_lo(pw.y); r[3] = h[3] + sigmoidf_(a[3]) * bf_hi(pw.y);
                        *(f32x4*)(out + o) = r;
                    }
                asm volatile("" ::: "memory");
            }
    }
};

struct MoeOrder {
    const LAS int* pref;
    int nunits, G, c;
    __device__ __forceinline__ bool next(int i, Unit& u) const {
        const int L = i * G + c; if (L >= nunits) return false;
        const int rtg = L >> 2, pnl = L & 3; int e = 0;
#pragma unroll 4
        for (int k = 1; k < NE; ++k) e += (pref[k] <= rtg) ? 1 : 0;
        e = __builtin_amdgcn_readfirstlane(e);
        u.pm = rtg; u.pn = 4 * e + pnl; return true;
    }
    __device__ __forceinline__ void a_ready(const Unit&) const {}
    __device__ __forceinline__ void done(const Unit&) const {}
};

#define XB_TMO      128
#define XB_XCNT(j)  (256  + 64 * (j))
#define XB_XSUB(j)  (1280 + 64 * (j))
#define XB_XGEN(j)  (2304 + 64 * (j))
#define XB_TOP      3328
#define XB_TOPGEN   3392
#define XCD_BAR_WORDS 3456
#define XB_SPIN_CAP (1u << 18)

__device__ __forceinline__ unsigned xb_ld(unsigned* p)              { return __hip_atomic_load(p, __ATOMIC_RELAXED, __HIP_MEMORY_SCOPE_AGENT); }
__device__ __forceinline__ unsigned xb_add(unsigned* p, unsigned v) { return __hip_atomic_fetch_add(p, v, __ATOMIC_RELAXED, __HIP_MEMORY_SCOPE_AGENT); }
__device__ __forceinline__ unsigned xb_xcc_id() { return (unsigned)__builtin_amdgcn_s_getreg((3 << 11) | 20) & 0xFu; }
#define XB_SPIN(cond, bar) do { unsigned _sp = 0; while (cond) { __builtin_amdgcn_s_sleep(1); \
    if ((++_sp & 255u) == 0u) { if (xb_ld(&(bar)[XB_TMO])) break; if (_sp > XB_SPIN_CAP) { atomicAdd(&(bar)[XB_TMO], 1u); break; } } } } while (0)

struct XcdBarrier {
    unsigned* bar; unsigned x;
    volatile LAS unsigned* st;
};

__device__ __forceinline__ XcdBarrier xcd_barrier_post(unsigned* bar, volatile LAS unsigned* st) {
    XcdBarrier b; b.bar = bar; b.x = xb_xcc_id(); b.st = st;
    if (threadIdx.x == 0) (void)xb_add(&bar[XB_XCNT(b.x)], 1u);
    return b;
}
__device__ __forceinline__ void xcd_barrier_complete(unsigned* bar, unsigned x, unsigned& nloc, unsigned& nx) {
    const unsigned G = gridDim.x * gridDim.y * gridDim.z;
    unsigned sum, cnt, mine, sp = 0u;
    for (;;) {
        sum = 0u; cnt = 0u; mine = 0u;
#pragma unroll
        for (unsigned j = 0; j < 16; ++j) { const unsigned c = xb_ld(&bar[XB_XCNT(j)]); sum += c; cnt += (c > 0u) ? 1u : 0u; mine = (j == x) ? c : mine; }
        if (sum == G) break;
        __builtin_amdgcn_s_sleep(1);
        if ((++sp & 255u) == 0u) { if (xb_ld(&bar[XB_TMO])) break; if (sp > XB_SPIN_CAP) { atomicAdd(&bar[XB_TMO], 1u); break; } }
    }
    nloc = mine > 0u ? mine : 1u; nx = cnt > 0u ? cnt : 1u;
}

__device__ __forceinline__ void xcd_barrier(const XcdBarrier& b, int tid) {
    asm volatile("s_waitcnt vmcnt(0)" ::: "memory");
    __syncthreads();
    if (tid == 0) {
        unsigned* bar = b.bar;
        __builtin_amdgcn_s_waitcnt(0);
        unsigned nloc = b.st[0], nx = b.st[1];
        if (nloc == 0u) { xcd_barrier_complete(bar, b.x, nloc, nx); b.st[0] = nloc; b.st[1] = nx; }
        const unsigned old = xb_add(&bar[XB_XSUB(b.x)], 1u);
        const unsigned gen = old / nloc;
        if (old + 1u == (gen + 1u) * nloc) {
            __builtin_amdgcn_fence(__ATOMIC_RELEASE, "agent");
            asm volatile("s_waitcnt vmcnt(0)" ::: "memory");
            const unsigned og = xb_add(&bar[XB_TOP], 1u);
            const unsigned tg = og / nx;
            if (og + 1u == (tg + 1u) * nx) xb_add(&bar[XB_TOPGEN], 1u);
            else XB_SPIN(xb_ld(&bar[XB_TOPGEN]) == tg, bar);
            __builtin_amdgcn_fence(__ATOMIC_ACQUIRE, "agent");
            xb_add(&bar[XB_XGEN(b.x)], 1u);
            asm volatile("s_waitcnt vmcnt(0)" ::: "memory");
        } else {
            XB_SPIN(xb_ld(&bar[XB_XGEN(b.x)]) == gen, bar);
            __builtin_amdgcn_fence(__ATOMIC_ACQUIRE, "agent");
            asm volatile("s_waitcnt vmcnt(0)" ::: "memory");
        }
    }
    __syncthreads();
}

#include <hip/hip_bf16.h>
#include <cmath>
namespace attn_body {
using bf16=__hip_bfloat16;
using bf16x8=__attribute__((ext_vector_type(8)))short;
using s16x4=__attribute__((ext_vector_type(4)))short;
using f32x16=__attribute__((ext_vector_type(16)))float;
using u32x4=__attribute__((ext_vector_type(4)))unsigned;
constexpr int BATCH=8,NHEAD=8,SEQ=4096,D=64,DM=NHEAD*D,OPITCH=1024;
constexpr int NW=8,QBLK=32,QB=QBLK*NW,KVBLK=64,NQB=SEQ/QB;
constexpr int ATTN_PITCH=DM, ATTN_UNIT_ROWS=QB;
constexpr int BT_COPY=384, BT_BYTES=4*BT_COPY*4;
__device__ __forceinline__ int crow(int r,int hi){return (r&3)+8*(r>>2)+4*hi;}
#define SBAR() __builtin_amdgcn_sched_barrier(0)
constexpr int NSLOT=3, SLOTB=8192;
constexpr int LDS_K=0, LDS_V=NSLOT*SLOTB, LDS_WS=2*NSLOT*SLOTB, LDS_OST=LDS_WS+NW*64*4, LDS_BT=LDS_OST+NW*4096, LDS_BYTES=LDS_BT+BT_BYTES;
__device__ __forceinline__ void glds16(const void*gsrc,unsigned lds_dst){unsigned keep;
  asm volatile("s_mov_b32 %0, m0\n\ts_mov_b32 m0, %2\n\ts_nop 0\n\tglobal_load_lds_dwordx4 %1, off\n\ts_mov_b32 m0, %0":"=&s"(keep):"v"(gsrc),"s"(lds_dst):"memory");}
__device__ __forceinline__ float max3f(float a,float b,float c){float r;asm("v_max3_f32 %0, %1, %2, %3":"=v"(r):"v"(a),"v"(b),"v"(c));return r;}
__device__ __forceinline__ float max2f(float a,float b){float r;asm("v_max_f32_e32 %0, %1, %2":"=v"(r):"v"(a),"v"(b));return r;}
__device__ __forceinline__ float fadd_s(float a,float b){float r;asm("v_add_f32_e32 %0, %1, %2":"=v"(r):"v"(a),"v"(b));return r;}
__device__ __forceinline__ float fsub_s(float a,float b){float r;asm("v_sub_f32_e32 %0, %1, %2":"=v"(r):"v"(a),"v"(b));return r;}
typedef float f32x2_t __attribute__((ext_vector_type(2))); typedef float f32x4_t __attribute__((ext_vector_type(4))); typedef __bf16 bf16x2_t __attribute__((ext_vector_type(2)));
__device__ __forceinline__ unsigned cvtpk_s(float lo,float hi){f32x2_t v={lo,hi};bf16x2_t b=__builtin_convertvector(v,bf16x2_t);return __builtin_bit_cast(unsigned,b);}
#define WAIT_BAR(N) asm volatile("s_waitcnt vmcnt(" #N ") lgkmcnt(0)\n\ts_barrier":::"memory")

__device__ __forceinline__ void qkt(f32x16&p0,f32x16&p1,const char*Kslot,const bf16x8*qr,const f32x16&negm,int r32,int hi){
  const char*kb=Kslot+hi*1024+r32*16;
  #pragma unroll
  for(int d0=0;d0<4;++d0){
    const bf16x8 b0=*reinterpret_cast<const bf16x8*>(kb+d0*2048);
    const bf16x8 b1=*reinterpret_cast<const bf16x8*>(kb+d0*2048+512);
    if(d0==0){p0=__builtin_amdgcn_mfma_f32_32x32x16_bf16(b0,qr[0],negm,0,0,0);p1=__builtin_amdgcn_mfma_f32_32x32x16_bf16(b1,qr[0],negm,0,0,0);}
    else{p0=__builtin_amdgcn_mfma_f32_32x32x16_bf16(b0,qr[d0],p0,0,0,0);p1=__builtin_amdgcn_mfma_f32_32x32x16_bf16(b1,qr[d0],p1,0,0,0);}}
}
typedef __attribute__((address_space(3))) const char* lds_cptr;
typedef short v4i16_t __attribute__((ext_vector_type(4)));
__device__ __forceinline__ void kload8(bf16x8*kf,lds_cptr kp){
  kf[0]=*(const __attribute__((address_space(3))) bf16x8*)(kp);      kf[1]=*(const __attribute__((address_space(3))) bf16x8*)(kp+512);
  kf[2]=*(const __attribute__((address_space(3))) bf16x8*)(kp+2048); kf[3]=*(const __attribute__((address_space(3))) bf16x8*)(kp+2560);
  kf[4]=*(const __attribute__((address_space(3))) bf16x8*)(kp+4096); kf[5]=*(const __attribute__((address_space(3))) bf16x8*)(kp+4608);
  kf[6]=*(const __attribute__((address_space(3))) bf16x8*)(kp+6144); kf[7]=*(const __attribute__((address_space(3))) bf16x8*)(kp+6656);
}
__device__ __forceinline__ void kload2(bf16x8*kf,lds_cptr kp,int j){ kf[2*j]=*(const __attribute__((address_space(3))) bf16x8*)(kp+j*2048); kf[2*j+1]=*(const __attribute__((address_space(3))) bf16x8*)(kp+j*2048+512); }
__device__ __forceinline__ s16x4 vtr(lds_cptr p){ return __builtin_bit_cast(s16x4,__builtin_amdgcn_ds_read_tr16_b64_v4i16((__attribute__((address_space(3))) v4i16_t*)p)); }
__device__ __forceinline__ float rowmax(const f32x16&p0,const f32x16&p1){
  float a=max3f(p0[0],p0[1],p1[0]),b=max3f(p0[2],p0[3],p1[1]);a=max3f(a,p1[2],p1[3]);
  #pragma unroll
  for(int r=4;r<16;r+=4){a=max3f(a,p0[r],p0[r+1]);b=max3f(b,p0[r+2],p0[r+3]);a=max3f(a,p1[r],p1[r+1]);b=max3f(b,p1[r+2],p1[r+3]);}
  const float m=max2f(a,b);
  auto rr=__builtin_amdgcn_permlane32_swap(__float_as_uint(m),__float_as_uint(m),false,false);
  return max2f(__uint_as_float(rr[0]),__uint_as_float(rr[1]));
}
__device__ __forceinline__ void pv(f32x16*o,int vb,bf16x8 pa0,bf16x8 pa1,bf16x8 pa2,bf16x8 pa3){
  #pragma unroll
  for(int d0=0;d0<2;++d0){s16x4 lo[4],hi[4];
    #pragma unroll
    for(int ks=0;ks<4;++ks){
      asm volatile("ds_read_b64_tr_b16 %0,%1 offset:%c2":"=&v"(lo[ks]):"v"(vb),"i"(d0*4096+ks*1024):"memory");
      asm volatile("ds_read_b64_tr_b16 %0,%1 offset:%c2":"=&v"(hi[ks]):"v"(vb),"i"(d0*4096+ks*1024+512):"memory");}
    asm volatile("s_waitcnt lgkmcnt(0)":::"memory");SBAR();
    #define PK(k) (bf16x8){lo[k][0],lo[k][1],lo[k][2],lo[k][3],hi[k][0],hi[k][1],hi[k][2],hi[k][3]}
    o[d0]=__builtin_amdgcn_mfma_f32_32x32x16_bf16(pa0,PK(0),o[d0],0,0,0);
    o[d0]=__builtin_amdgcn_mfma_f32_32x32x16_bf16(pa1,PK(1),o[d0],0,0,0);
    o[d0]=__builtin_amdgcn_mfma_f32_32x32x16_bf16(pa2,PK(2),o[d0],0,0,0);
    o[d0]=__builtin_amdgcn_mfma_f32_32x32x16_bf16(pa3,PK(3),o[d0],0,0,0);
    #undef PK
  }
}

#ifndef ATTN_STORE16
#define ATTN_STORE16(p,v) (*(u32x4*)(p)=(v))
#endif
__device__ __forceinline__ void attn_unit(int b,int h,int qb,const bf16*Q,const bf16*K,const bf16*V,bf16*O,char*shm,float cinit,int tid){
  asm volatile("":"+v"(tid));
  const int lane=tid&63,r32=lane&31,hi=lane>>5; const int wid=__builtin_amdgcn_readfirstlane(tid>>6);
  const long rowbase=(long)b*SEQ; const int q0=qb*QB;
  const bf16*Qw=Q+(rowbase+q0+wid*QBLK)*DM+h*D;
  const int t0=(4*qb-8)>0?(4*qb-8):0;
  const bf16*Kh=K+(rowbase+(long)t0*KVBLK)*DM+h*D,*Vh=V+(rowbase+(long)t0*KVBLK)*DM+h*D;
  const int tb=t0-4*qb-(wid>>1)+8;
  const unsigned lds0=(unsigned)(uintptr_t)shm;
  float*wsf=(float*)(shm+LDS_WS)+wid*64;
  const bf16*ksrc=Kh+(long)lane*DM+wid*8;
  const bf16*vsrc=Vh+(long)(16*(wid&3)+(lane>>2))*DM+(wid>>2)*32+(lane&3)*8;
  const unsigned kdst=lds0+LDS_K+wid*1024, vdst=lds0+LDS_V+wid*1024;
  #define DMA_K(t,slot) glds16(ksrc+(long)(t)*KVBLK*DM,(unsigned)__builtin_amdgcn_readfirstlane(kdst+(slot)))
  #define DMA_V(t,slot) glds16(vsrc+(long)(t)*KVBLK*DM,(unsigned)__builtin_amdgcn_readfirstlane(vdst+(slot)))
  const int vb0=(int)(lds0+LDS_V)+((lane>>4)&1)*32+(lane&3)*8+(4*hi+((lane&15)>>2))*64;
  const char*Kbase=shm+LDS_K; bf16x8 kf[8];
  const lds_cptr shm3=(lds_cptr)shm; const lds_cptr kp0=shm3+LDS_K+hi*1024+r32*16; const lds_cptr vp0=shm3+LDS_V+((lane>>4)&1)*32+(lane&3)*8+(4*hi+((lane&15)>>2))*64;
  const int NT=4*qb+4-t0;
  const lds_cptr btl=shm3+LDS_BT+((3-r32)&3)*(BT_COPY*4)+4*(-193-32*(wid&1)-r32-((3-r32)&3)+4*hi);
  DMA_K(0,0);DMA_V(0,0);DMA_K(1,SLOTB);
  bf16x8 qr[4];
  #pragma unroll
  for(int d0=0;d0<4;++d0)qr[d0]=*reinterpret_cast<const bf16x8*>(&Qw[(long)r32*DM+d0*16+hi*8]);
  float l_reg=0.f;f32x16 o[2];o[0]=f32x16{};o[1]=f32x16{};f32x16 negm;
  asm volatile("":"+s"(cinit));
  _Pragma("unroll") for(int r=0;r<16;++r)negm[r]=cinit; asm volatile("":"+v"(negm));
  #define BIASMASK(P0,P1,t) do{ const int tau_=(t)+tb; \
    if(tau_<0||tau_>8){ _Pragma("unroll") for(int r=0;r<16;++r){P0[r]=-INFINITY;P1[r]=-INFINITY;} } \
    else if(tau_>=4){ const lds_cptr bp_=btl+256*tau_; \
      _Pragma("unroll") for(int g=0;g<4;++g){ const f32x4_t d0_=*(const __attribute__((address_space(3))) f32x4_t*)(bp_+32*g), d1_=*(const __attribute__((address_space(3))) f32x4_t*)(bp_+32*g+128); \
        _Pragma("unroll") for(int j=0;j<4;++j){P0[4*g+j]+=d0_[j];P1[4*g+j]+=d1_[j];} } } }while(0)
  #define START(P0,P1) do{ _Pragma("unroll") for(int r=0;r<16;++r)P0[r]=__builtin_amdgcn_exp2f(P0[r]); }while(0)
  #define RESC() do{}while(0)
  f32x16 pA0,pA1,pB0,pB1;
  int sl_prev=0,sl_cur=0,sl_next=SLOTB;
  #define ROT() do{sl_prev=sl_cur;sl_cur=sl_next;sl_next=(sl_next==(NSLOT-1)*SLOTB)?0:sl_next+SLOTB;}while(0)
  DMA_K(2,2*SLOTB);
  WAIT_BAR(3);
  qkt(pA0,pA1,Kbase,qr,negm,r32,hi);asm volatile("s_nop 15\n\ts_nop 7":"+v"(pA0),"+v"(pA1));BIASMASK(pA0,pA1,0);
  START(pA0,pA1);
  _Pragma("unroll") for(int r=0;r<16;++r)pA1[r]=__builtin_amdgcn_exp2f(pA1[r]);
  WAIT_BAR(0);
  DMA_K(3,0);DMA_V(1,SLOTB);
  ROT();
  kload8(kf,kp0+sl_cur);
  WAIT_BAR(2);
  s16x4 vlo[8],vhi[8]; u32x4 pw0,pw1,pw2,pw3;
  #define PKW(P,B) cvtpk_s(P[B],P[B+1])
  #define PAF(k) __builtin_bit_cast(bf16x8,pw##k)
  #define VFR(i) (bf16x8){vlo[i][0],vlo[i][1],vlo[i][2],vlo[i][3],vhi[i][0],vhi[i][1],vhi[i][2],vhi[i][3]}
  #define PIN(x) asm volatile("":"+v"(x))
  #define MX3(a,b,c) __builtin_fmaxf(__builtin_fmaxf((a),(b)),(c))
  #define GAPA(MF,A0,A1,A2,A3,W0,W1,PW) do{ MF; sacc+=A0; sacc+=A1; sacc+=A2; sacc+=A3; PIN(sacc); W0; W1; PIN(PW); SBAR(); }while(0)
  #define EX(v) __builtin_amdgcn_exp2f(v)
  #define GAPB(MF,X,B) do{ MF; X[B]=EX(X[B]); X[B+1]=EX(X[B+1]); X[B+2]=EX(X[B+2]); X[B+3]=EX(X[B+3]); PIN(X); SBAR(); }while(0)
  #define VRD(i) do{ vlo[i]=vtr(vp_+(((i)>>2)*4096+((i)&3)*1024)); vhi[i]=vtr(vp_+(((i)>>2)*4096+((i)&3)*1024+512)); }while(0)
  #define KRD(G,j) do{ if(G){ kload2(kf,kp0+sl_next,j); SBAR(); } }while(0)
  #define STEP(C0,C1,P0,P1,t,GK,GV,GL) do{ SBAR(); \
    const lds_cptr vp_=vp0+sl_prev; \
    VRD(0); SBAR(); float sacc=(P0[0]+P0[1]); \
    GAPA(C0=__builtin_amdgcn_mfma_f32_32x32x16_bf16(kf[0],qr[0],negm,0,0,0), P0[2],P0[3],P0[4],P0[5],     pw0[0]=PKW(P0,0), pw0[1]=PKW(P0,2), pw0); \
    VRD(4); SBAR(); GAPA(C1=__builtin_amdgcn_mfma_f32_32x32x16_bf16(kf[1],qr[0],negm,0,0,0), P0[6],P0[7],P0[8],P0[9],     pw0[2]=PKW(P0,4), pw0[3]=PKW(P0,6), pw0); \
    VRD(1); SBAR(); GAPA(C0=__builtin_amdgcn_mfma_f32_32x32x16_bf16(kf[2],qr[1],C0,0,0,0),   P0[10],P0[11],P0[12],P0[13], pw1[0]=PKW(P0,8), pw1[1]=PKW(P0,10), pw1); \
    VRD(5); SBAR(); GAPA(C1=__builtin_amdgcn_mfma_f32_32x32x16_bf16(kf[3],qr[1],C1,0,0,0),   P0[14],P0[15],P1[0],P1[1],   pw1[2]=PKW(P0,12),pw1[3]=PKW(P0,14), pw1); \
    VRD(2); SBAR(); GAPA(C0=__builtin_amdgcn_mfma_f32_32x32x16_bf16(kf[4],qr[2],C0,0,0,0),   P1[2],P1[3],P1[4],P1[5],     pw2[0]=PKW(P1,0), pw2[1]=PKW(P1,2), pw2); \
    VRD(6); SBAR(); GAPA(C1=__builtin_amdgcn_mfma_f32_32x32x16_bf16(kf[5],qr[2],C1,0,0,0),   P1[6],P1[7],P1[8],P1[9],     pw2[2]=PKW(P1,4), pw2[3]=PKW(P1,6), pw2); \
    VRD(3); SBAR(); GAPA(C0=__builtin_amdgcn_mfma_f32_32x32x16_bf16(kf[6],qr[3],C0,0,0,0),   P1[10],P1[11],P1[12],P1[13], pw3[0]=PKW(P1,8), pw3[1]=PKW(P1,10), pw3); \
    VRD(7); SBAR(); GAPA(C1=__builtin_amdgcn_mfma_f32_32x32x16_bf16(kf[7],qr[3],C1,0,0,0),   P1[14],P1[15],0.f,0.f,       pw3[2]=PKW(P1,12),pw3[3]=PKW(P1,14), pw3); \
    l_reg+=sacc; \
    if(GK){DMA_K((t)+3,sl_cur);} if(GV){DMA_V((t)+1,sl_next);} \
    BIASMASK(C0,C1,t); \
    SBAR(); \
    GAPB(o[0]=__builtin_amdgcn_mfma_f32_32x32x16_bf16(PAF(0),VFR(0),o[0],0,0,0), C0,0); \
    GAPB(o[1]=__builtin_amdgcn_mfma_f32_32x32x16_bf16(PAF(0),VFR(4),o[1],0,0,0), C0,4); \
    KRD(GL,0); GAPB(o[0]=__builtin_amdgcn_mfma_f32_32x32x16_bf16(PAF(1),VFR(1),o[0],0,0,0), C0,8); \
    KRD(GL,1); GAPB(o[1]=__builtin_amdgcn_mfma_f32_32x32x16_bf16(PAF(1),VFR(5),o[1],0,0,0), C0,12); \
    KRD(GL,2); GAPB(o[0]=__builtin_amdgcn_mfma_f32_32x32x16_bf16(PAF(2),VFR(2),o[0],0,0,0), C1,0); \
    KRD(GL,3); GAPB(o[1]=__builtin_amdgcn_mfma_f32_32x32x16_bf16(PAF(2),VFR(6),o[1],0,0,0), C1,4); \
    GAPB(o[0]=__builtin_amdgcn_mfma_f32_32x32x16_bf16(PAF(3),VFR(3),o[0],0,0,0), C1,8); \
    GAPB(o[1]=__builtin_amdgcn_mfma_f32_32x32x16_bf16(PAF(3),VFR(7),o[1],0,0,0), C1,12); \
    }while(0)
  int t=1;
  for(;t+5<NT;t+=2){
    STEP(pB0,pB1,pA0,pA1,t,true,true,true);     WAIT_BAR(2); RESC(); ROT();
    STEP(pA0,pA1,pB0,pB1,t+1,true,true,true);   WAIT_BAR(2); RESC(); ROT();
  }
  #define ENDW(tt) do{ if((tt)+3<NT){WAIT_BAR(2);} else if((tt)+2<NT){WAIT_BAR(1);} else {WAIT_BAR(0);} }while(0)
  for(;t+1<NT;t+=2){
    STEP(pB0,pB1,pA0,pA1,t,(t+3<NT),(t+1<NT),(t+1<NT));       ENDW(t);   RESC(); ROT();
    STEP(pA0,pA1,pB0,pB1,t+1,(t+4<NT),(t+2<NT),(t+2<NT));     ENDW(t+1); RESC(); ROT();
  }
  STEP(pB0,pB1,pA0,pA1,NT-1,false,false,false); RESC();
  { float sacc=pB0[0]+pB0[1]; _Pragma("unroll") for(int r=2;r<16;++r)sacc+=pB0[r]; _Pragma("unroll") for(int r=0;r<16;++r)sacc+=pB1[r]; l_reg+=sacc;
    pw0=(u32x4){PKW(pB0,0),PKW(pB0,2),PKW(pB0,4),PKW(pB0,6)};pw1=(u32x4){PKW(pB0,8),PKW(pB0,10),PKW(pB0,12),PKW(pB0,14)};pw2=(u32x4){PKW(pB1,0),PKW(pB1,2),PKW(pB1,4),PKW(pB1,6)};pw3=(u32x4){PKW(pB1,8),PKW(pB1,10),PKW(pB1,12),PKW(pB1,14)};
    SBAR(); pv(o,vb0+sl_cur,PAF(0),PAF(1),PAF(2),PAF(3)); }
  #undef PKW
  #undef PAF
  #undef VFR
  #undef PIN
  #undef MX3
  #undef GAPA
  #undef GAPB
  #undef EX
  #undef VRD
  #undef KRD
  #undef STEP
  #undef ENDW
  {auto rr=__builtin_amdgcn_permlane32_swap(__float_as_uint(l_reg),__float_as_uint(l_reg),false,false);l_reg=__uint_as_float(rr[0])+__uint_as_float(rr[1]);}
  if(hi==0)wsf[32+r32]=l_reg;asm volatile("s_waitcnt lgkmcnt(0)":::"memory");
  float rli[16];
  #pragma unroll
  for(int r=0;r<16;++r)rli[r]=__builtin_amdgcn_rcpf(wsf[32+crow(r,hi)]);
  bf16*Ow=O+(rowbase+q0+wid*QBLK)*OPITCH+h*D;
  { bf16*stg=(bf16*)(shm+LDS_OST)+wid*2048;
    #pragma unroll
    for(int r=0;r<16;++r){const int orow=crow(r,hi);
      #pragma unroll
      for(int d0=0;d0<2;++d0)stg[orow*64+d0*32+r32]=__float2bfloat16(o[d0][r]*rli[r]);}
    asm volatile("s_waitcnt lgkmcnt(0)":::"memory");
    #pragma unroll
    for(int i=0;i<4;++i){const int row=i*8+(lane>>3),ch=lane&7; const u32x4 v=*(const u32x4*)(stg+row*64+ch*8); ATTN_STORE16(Ow+(long)row*OPITCH+ch*8,v);} }
  asm volatile("s_waitcnt lgkmcnt(0)\n\ts_barrier":::"memory");
  #undef DMA_K
  #undef DMA_V
  #undef BIASMASK
  #undef START
  #undef RESC
  #undef ROT
}
constexpr int ATTN_LDS_BYTES=LDS_BYTES;
struct AttnUnit { int bh; int qb; };
__device__ __forceinline__ void attn_phase(char*lds,const bf16*Q,const bf16*K,const bf16*V,bf16*O,const float*gtab,const float*gcinit,int grid,int block,int tid){
  const int vcu=(block%8)*(grid/8)+block/8, s_=vcu&3, bh=vcu>>2, h=bh&7, b=bh>>3;
  { const f32x4_t* src=(const f32x4_t*)(gtab+(size_t)h*(4*BT_COPY)); __attribute__((address_space(3))) f32x4_t* dst=(__attribute__((address_space(3))) f32x4_t*)((lds_cptr)lds+LDS_BT);
    if(tid<BT_BYTES/16)dst[tid]=src[tid]; }
  const float cinit=__builtin_bit_cast(float,__builtin_amdgcn_readfirstlane(__builtin_bit_cast(int,gcinit[h])));
  asm volatile("s_waitcnt vmcnt(0) lgkmcnt(0)\n\ts_barrier":::"memory");
  for(int i=0;i<4;++i){ const int qb=(i==0)?s_:(i==1)?7-s_:(i==2)?8+s_:15-s_; attn_unit(b,h,qb,Q,K,V,O,lds,cinit,tid); }
}
#undef SBAR
#undef WAIT_BAR
}

struct Args {
    const float *x, *p, *g_mix, *w_in, *b_in, *g_q, *g_k, *rel_bias, *conv_w, *conv_b, *w_pa, *w_pc, *w_o, *g_ffn, *w_group, *b_group, *w_router, *b_router, *w1, *w3, *w2, *g_ple, *w_pg, *b_pg, *w_pp;
    float* out; unsigned char* ws;
};
constexpr int NWAVES = 8, NTHREADS = 512;
constexpr int RING_BYTES = 131072, MISC_OFF = RING_BYTES;
constexpr int LDS_BYTES = 147456;

__device__ __forceinline__ void transpose_item(const float* src, int ldw, bf16_t* dst, int ldT, LAS float* scr, int lane) {
#pragma unroll 8
    for (int i = 0; i < 32; ++i) { const int kk = 2 * i + (lane >> 5); scr[kk * 33 + (lane & 31)] = src[(size_t)kk * ldw + (lane & 31)]; }
    LDS_WAIT(); asm volatile("" ::: "memory");
    const int c = lane & 7;
#pragma unroll
    for (int j = 0; j < 4; ++j) { const int n = (lane >> 3) + 8 * j; const LAS float* s = scr + (8 * c) * 33 + n;
        u32x4 o; o.x = pk2(s[0 * 33], s[1 * 33]); o.y = pk2(s[2 * 33], s[3 * 33]); o.z = pk2(s[4 * 33], s[5 * 33]); o.w = pk2(s[6 * 33], s[7 * 33]);
        *(u32x4*)(dst + (size_t)n * ldT + 8 * c) = o; }
    LDS_WAIT(); asm volatile("" ::: "memory");
}
__device__ __forceinline__ int win_phys_row(int n) { const int l = n & 255; return (n & ~255) | (((l >> 5) & 1) << 7) | (((l >> 6) & 3) << 5) | (l & 31); }

__device__ __forceinline__ void rms_row_to_bf16(const float* xrow, const float* g, bf16_t* orow, int lane) {
    const f32x4* xr = (const f32x4*)xrow + lane; const f32x4* gr = (const f32x4*)g + lane;
    f32x4 v[4]; float s = 0.f;
#pragma unroll
    for (int j = 0; j < 4; ++j) { v[j] = xr[64 * j]; s += (v[j].x * v[j].x + v[j].y * v[j].y) + (v[j].z * v[j].z + v[j].w * v[j].w); }
    const float rstd = rsqrtf(wave_sum(s) * (1.f / D) + EPS);
    unsigned long long* o8 = (unsigned long long*)orow + lane;
#pragma unroll
    for (int j = 0; j < 4; ++j) { const f32x4 gg = gr[64 * j]; o8[64 * j] = (unsigned long long)pk2(v[j].x * rstd * gg.x, v[j].y * rstd * gg.y) | ((unsigned long long)pk2(v[j].z * rstd * gg.z, v[j].w * rstd * gg.w) << 32); }
}

#ifndef FAST_G1
#define FAST_G1 1
#endif
#ifndef FAST_ATTN
#define FAST_ATTN 1
#endif
#ifndef FAST_G2
#define FAST_G2 1
#endif
#ifndef FAST_G3
#define FAST_G3 1
#endif
#ifndef FAST_G4
#define FAST_G4 1
#endif
#ifndef FAST_G5
#define FAST_G5 1
#endif
#ifndef FAST_G6
#define FAST_G6 1
#endif

template <class BRow>
__device__ __forceinline__ void naive_tile(const bf16_t* A, int lda, int K, BRow brow, LAS float* tile, bool accumulate) {
    const int tid = threadIdx.x, tr = tid >> 4, tc = tid & 15;
    float acc[2][4] = {{0.f, 0.f, 0.f, 0.f}, {0.f, 0.f, 0.f, 0.f}};
    const bf16_t* a0 = A + (size_t)(2 * tr) * lda; const bf16_t* a1 = a0 + lda;
    const bf16_t* b[4];
#pragma unroll
    for (int j = 0; j < 4; ++j) b[j] = brow(4 * tc + j);
    for (int k = 0; k < K; k += 8) {
        const u32x4 av0 = *(const u32x4*)(a0 + k), av1 = *(const u32x4*)(a1 + k);
#pragma unroll
        for (int j = 0; j < 4; ++j) {
            const u32x4 bv = *(const u32x4*)(b[j] + k);
#pragma unroll
            for (int e = 0; e < 4; ++e) {
                const float bl = bf_lo(bv[e]), bh = bf_hi(bv[e]);
                acc[0][j] += bf_lo(av0[e]) * bl + bf_hi(av0[e]) * bh;
                acc[1][j] += bf_lo(av1[e]) * bl + bf_hi(av1[e]) * bh;
            }
        }
    }
#pragma unroll
    for (int r = 0; r < 2; ++r)
#pragma unroll
        for (int j = 0; j < 4; ++j) { LAS float* t = tile + (2 * tr + r) * 65 + 4 * tc + j; *t = accumulate ? (*t + acc[r][j]) : acc[r][j]; }
}


typedef __attribute__((address_space(4))) const Args* KArgPtr;
__device__ __forceinline__ KArgPtr kargs() { KArgPtr p = (KArgPtr)__builtin_amdgcn_kernarg_segment_ptr(); asm volatile("" : "+s"(p)); return p; }
#define ctl ((unsigned*)(ws + WS_CTL))
#define wrt ((float*)(ws + WS_TAB))
#define rt_e ((int*)(ws + WS_ROUTE))
#define rt_pos (rt_e + 2 * T)
#define rt_w ((float*)(rt_pos + 2 * T))
#define row_slot ((int*)(ws + WS_ROWMETA))
#define row_w ((float*)(row_slot + XS_ROWS))
#define Win_t ((bf16_t*)(ws + WS_WIN))
#define Wm_t ((bf16_t*)(ws + WS_WM))
#define Wo_t ((bf16_t*)(ws + WS_WO))
#define Wpg_t ((bf16_t*)(ws + WS_WPG))
#define Wpp_t ((bf16_t*)(ws + WS_WPP))
#define pb ((bf16_t*)(ws + WS_PB))
#define nbuf ((bf16_t*)(ws + WS_NBUF))
#define qb ((bf16_t*)(ws + WS_Q))
#define kb ((bf16_t*)(ws + WS_K))
#define vb ((bf16_t*)(ws + WS_V))
#define ub ((bf16_t*)(ws + WS_U))
#define bgb ((bf16_t*)(ws + WS_BG))
#define cgb ((bf16_t*)(ws + WS_CG))
#define sga ((bf16_t*)(ws + WS_SGA))
#define sgc ((bf16_t*)(ws + WS_SGC))
#define yac ((bf16_t*)(ws + WS_YAC))
#define mbuf ((bf16_t*)(ws + WS_M))
#define W13_t ((bf16_t*)(ws + WS_W13))
#define W2_t ((bf16_t*)(ws + WS_W2))
#define xs ((bf16_t*)(ws + WS_XS))
#define hdn ((bf16_t*)(ws + WS_HDN))
#define contrib ((bf16_t*)(ws + WS_CONTRIB))
#define ppb ((bf16_t*)(ws + WS_PP))
#define tile0 ((LAS float*)lds)
#define tile1 (tile0 + 64 * 65)
#define pref ((LAS int*)(lds + MISC_OFF))
#define cnts (pref + 64)
__global__ void __launch_bounds__(NTHREADS, 2) fwd_kernel(Args a) {
    extern __shared__ __attribute__((aligned(16))) unsigned char lds_raw[];
    cg::grid_group grid = cg::this_grid();
    LAS unsigned char* lds = (LAS unsigned char*)lds_raw;
    const int G = gridDim.x, bx = blockIdx.x;
    const int wave_s = __builtin_amdgcn_readfirstlane((int)threadIdx.x >> 6);
    volatile LAS unsigned* bst = (volatile LAS unsigned*)(lds + MISC_OFF + 512);
    if (threadIdx.x < 2) bst[threadIdx.x] = 0u;
    __syncthreads();
    const XcdBarrier bar = xcd_barrier_post((unsigned*)(a.ws + WS_CTL) + CW_BAR, bst);
#define XBAR() do { int t_ = (wave_s << 6) | lane_id_fresh(); xcd_barrier(bar, t_); } while (0)
#define PHASE_VARS() const KArgPtr ap = kargs(); unsigned char* const ws = ap->ws; (void)ws; int tid = (wave_s << 6) | lane_id_fresh(); asm volatile("" : "+v"(tid)); const int lane = tid & 63, wave = __builtin_amdgcn_readfirstlane(tid >> 6); \
    const int gw = bx * NWAVES + wave, NGW = G * NWAVES; const size_t gtid = (size_t)bx * NTHREADS + tid, GT = (size_t)G * NTHREADS; (void)lane; (void)gw; (void)NGW; (void)gtid; (void)GT
    {
        PHASE_VARS();
        LAS float* scr = (LAS float*)(lds + wave * 16384);
        constexpr int I_IN = 16 * 160, I_PA = 8 * 32, I_PC = 8 * 32, I_O = 16 * 32, I_PG = 16 * 32, I_PP = 4 * 32;
        constexpr int NIT = I_IN + I_PA + I_PC + I_O + I_PG + I_PP;
        for (int it = gw; it < NIT; it += NGW) {
            int r = it;
            if (r < I_IN) { const int kb_ = r / 160, nb = r % 160; transpose_item(ap->w_in + (size_t)(kb_ * 64) * NIN + nb * 32, NIN, Win_t + (size_t)win_phys_row(nb * 32) * D + kb_ * 64, D, scr, lane); continue; } r -= I_IN;
            if (r < I_PA) { const int kb_ = r / 32, nb = r % 32; transpose_item(ap->w_pa + (size_t)(kb_ * 64) * D + nb * 32, D, Wm_t + (size_t)(nb * 32) * D + kb_ * 64, D, scr, lane); continue; } r -= I_PA;
            if (r < I_PC) { const int kb_ = r / 32, nb = r % 32; transpose_item(ap->w_pc + (size_t)(kb_ * 64) * D + nb * 32, D, Wm_t + (size_t)(nb * 32) * D + 512 + kb_ * 64, D, scr, lane); continue; } r -= I_PC;
            if (r < I_O) { const int kb_ = r / 32, nb = r % 32; transpose_item(ap->w_o + (size_t)(kb_ * 64) * D + nb * 32, D, Wo_t + (size_t)(nb * 32) * D + kb_ * 64, D, scr, lane); continue; } r -= I_O;
            if (r < I_PG) { const int kb_ = r / 32, nb = r % 32; transpose_item(ap->w_pg + (size_t)(kb_ * 64) * D + nb * 32, D, Wpg_t + (size_t)(nb * 32) * D + kb_ * 64, D, scr, lane); continue; } r -= I_PG;
            { const int kb_ = r / 32, nb = r % 32; transpose_item(ap->w_pp + (size_t)(kb_ * 64) * D + nb * 32, D, Wpp_t + (size_t)(nb * 32) * PLE + kb_ * 64, PLE, scr, lane); }
        }
        for (size_t i = gtid; i < (size_t)3 * 64 * 64 * 4; i += GT) { const int j = (int)(i & 3), ln = (int)((i >> 2) & 63), s_ = (int)((i >> 8) & 63), nt = (int)(i >> 14);
            const int k = 16 * s_ + 4 * (ln >> 4) + j, col = 16 * nt + (ln & 15);
            wrt[i] = col < 4 ? ap->w_group[k * 4 + col] : (col < 36 ? ap->w_router[k * 32 + (col - 4)] : 0.f); }
        { float* gtab = (float*)(ws + WS_GTAB); float* gcinit = (float*)(ws + WS_GCINIT);
          for (size_t i = gtid; i < (size_t)NH * 4 * 384; i += GT) { const int h = (int)(i / 1536), s_ = (int)((i / 384) & 3), y = (int)(i % 384), x = y + s_;
              int dd = 319 - x; dd = dd < -63 ? -63 : (dd > 256 ? 256 : dd);
              gtab[i] = x <= 382 ? (ap->rel_bias[h * NREL + dd + 63] - ap->rel_bias[h * NREL + 319]) * LOG2E : 0.f; }
          if (gtid < NH) { const int h = (int)gtid; float gq = 0.f, gk = 0.f, mb = -3.0e38f;
              for (int d = 0; d < HD; ++d) { gq = fmaxf(gq, fabsf(ap->g_q[d])); gk = fmaxf(gk, fabsf(ap->g_k[d])); }
              for (int d = 0; d < NREL; ++d) mb = fmaxf(mb, ap->rel_bias[h * NREL + d]);
              gcinit[h] = ap->rel_bias[h * NREL + 319] * LOG2E - (64.f * C2 * gq * gk + mb * LOG2E); } }
        for (int m = gw; m < T; m += NGW) rms_row_to_bf16(ap->x + (size_t)m * D, ap->g_mix, nbuf + (size_t)m * D, lane);
        for (size_t i = gtid; i < (size_t)T * PLE / 8; i += GT) { const f32x4 v0 = ((const f32x4*)ap->p)[2 * i], v1 = ((const f32x4*)ap->p)[2 * i + 1];
            u32x4 o; o.x = pk2(v0.x, v0.y); o.y = pk2(v0.z, v0.w); o.z = pk2(v1.x, v1.y); o.w = pk2(v1.z, v1.w); ((u32x4*)pb)[i] = o; }
    }
    grid.sync();

#if FAST_G1
    { PHASE_VARS(); pg8::Gemm g{nbuf, Win_t, T, NIN, D, D}; pg8::StaticOrder S; S.init(T, NIN, G, bx); EpiInproj E{ws, ap->b_in, ap->g_q, ap->g_k};
      pg8::gemm_phase<EpiInproj, pg8::StaticOrder, true, true>(lds, g, S, E, tid); }
#else
    { PHASE_VARS();
    for (int tl = bx; tl < 512 * 80; tl += G) {
        const int rt = tl / 80, ct = tl % 80;
        naive_tile(nbuf + (size_t)rt * 64 * D, D, D, [=](int i) { return (const bf16_t*)(Win_t + (size_t)win_phys_row(64 * ct + i) * D); }, tile0, false);
        __syncthreads();
        const int row = tid >> 3, c8 = (tid & 7) * 8; float v[8]; float ss = 0.f;
#pragma unroll
        for (int j = 0; j < 8; ++j) { v[j] = tile0[row * 65 + c8 + j] + ap->b_in[64 * ct + c8 + j]; ss += v[j] * v[j]; }
        ss += __shfl_xor(ss, 1); ss += __shfl_xor(ss, 2); ss += __shfl_xor(ss, 4);
        bf16_t* dst;
        if (ct < 48) { const int seg = ct >> 3; dst = (bf16_t*)(ws + WS_Q + (size_t)seg * (32 * MiB)) + (size_t)(rt * 64 + row) * 512 + 64 * (ct & 7) + c8;
            if (seg < 2) { const float rstd = rsqrtf(ss * (1.f / 64.f) + EPS) * (seg == 0 ? C2 : 1.f); const float* g = seg == 0 ? ap->g_q : ap->g_k;
#pragma unroll
                for (int j = 0; j < 8; ++j) v[j] = v[j] * rstd * g[c8 + j]; } }
        else { dst = (ct < 64 ? sga : sgc) + (size_t)(rt * 64 + row) * D + 64 * ((ct - 48) & 15) + c8;
#pragma unroll
            for (int j = 0; j < 8; ++j) v[j] = sigmoidf_(v[j]); }
        u32x4 o; o.x = pk2(v[0], v[1]); o.y = pk2(v[2], v[3]); o.z = pk2(v[4], v[5]); o.w = pk2(v[6], v[7]); *(u32x4*)dst = o;
        __syncthreads();
    } }
#endif
    XBAR();

    {
        PHASE_VARS();
        for (size_t i = gtid; i < (size_t)T * (CW / 8); i += GT) {
            const int t = (int)(i >> 6), c8 = (int)(i & 63) * 8, s = t & (SEQ - 1);
            const size_t o = (size_t)t * CW + c8;
            const u32x4 u0 = *(const u32x4*)(ub + o), g0 = *(const u32x4*)(cgb + o), b0 = *(const u32x4*)(bgb + o);
            u32x4 u1 = {0u, 0u, 0u, 0u}, g1 = u1, u2 = u1, g2 = u1;
            if (s >= 1) { u1 = *(const u32x4*)(ub + o - CW); g1 = *(const u32x4*)(cgb + o - CW); }
            if (s >= 2) { u2 = *(const u32x4*)(ub + o - 2 * CW); g2 = *(const u32x4*)(cgb + o - 2 * CW); }
            float y[8];
#pragma unroll
            for (int e = 0; e < 4; ++e) {
#pragma unroll
                for (int hh = 0; hh < 2; ++hh) {
                    const int c = c8 + 2 * e + hh;
                    const float cu0 = hh ? bf_hi(u0[e]) * bf_hi(g0[e]) : bf_lo(u0[e]) * bf_lo(g0[e]);
                    const float cu1 = hh ? bf_hi(u1[e]) * bf_hi(g1[e]) : bf_lo(u1[e]) * bf_lo(g1[e]);
                    const float cu2 = hh ? bf_hi(u2[e]) * bf_hi(g2[e]) : bf_lo(u2[e]) * bf_lo(g2[e]);
                    const float bgv = hh ? bf_hi(b0[e]) : bf_lo(b0[e]);
                    y[2 * e + hh] = bgv * (ap->conv_b[c] + ap->conv_w[c] * cu2 + ap->conv_w[CW + c] * cu1 + ap->conv_w[2 * CW + c] * cu0);
                }
            }
            u32x4 w; w.x = pk2(y[0], y[1]); w.y = pk2(y[2], y[3]); w.z = pk2(y[4], y[5]); w.w = pk2(y[6], y[7]);
            *(u32x4*)(yac + (size_t)t * D + 512 + c8) = w;
        }
#if FAST_ATTN
        __syncthreads();
        attn_body::attn_phase((char*)lds_raw, (const attn_body::bf16*)qb, (const attn_body::bf16*)kb, (const attn_body::bf16*)vb, (attn_body::bf16*)yac, (const float*)(ws + WS_GTAB), (const float*)(ws + WS_GCINIT), G, bx, tid);
#else
        for (size_t i = gtid; i < (size_t)T * NH; i += GT) {
            const int h = (int)(i / T), t = (int)(i % T), s = t & (SEQ - 1), tb = t - s, c = s >> 6;
            float q[64], o[64];
#pragma unroll
            for (int d8 = 0; d8 < 8; ++d8) { const u32x4 w = *(const u32x4*)(qb + (size_t)t * AW + h * 64 + d8 * 8);
#pragma unroll
                for (int e = 0; e < 4; ++e) { q[d8 * 8 + 2 * e] = bf_lo(w[e]); q[d8 * 8 + 2 * e + 1] = bf_hi(w[e]); } }
#pragma unroll
            for (int d = 0; d < 64; ++d) o[d] = 0.f;
            float mrun = -1e30f, l = 0.f;
            int k0 = (c - 8) * 64; if (k0 < 0) k0 = 0;
            const int k1 = c * 64 + 63;
            for (int kp = k0; kp <= k1; ++kp) {
                const bf16_t* kr = kb + (size_t)(tb + kp) * AW + h * 64; float sc = 0.f;
#pragma unroll
                for (int d8 = 0; d8 < 8; ++d8) { const u32x4 w = *(const u32x4*)(kr + d8 * 8);
#pragma unroll
                    for (int e = 0; e < 4; ++e) sc += q[d8 * 8 + 2 * e] * bf_lo(w[e]) + q[d8 * 8 + 2 * e + 1] * bf_hi(w[e]); }
                int dd = s - kp; dd = dd < -63 ? -63 : (dd > 256 ? 256 : dd);
                sc += ap->rel_bias[h * NREL + dd + 63] * LOG2E;
                if (sc > mrun) { const float f = exp2f(mrun - sc); l *= f;
#pragma unroll
                    for (int d = 0; d < 64; ++d) o[d] *= f;
                    mrun = sc; }
                const float pr = exp2f(sc - mrun); l += pr;
                const bf16_t* vr = vb + (size_t)(tb + kp) * AW + h * 64;
#pragma unroll
                for (int d8 = 0; d8 < 8; ++d8) { const u32x4 w = *(const u32x4*)(vr + d8 * 8);
#pragma unroll
                    for (int e = 0; e < 4; ++e) { o[d8 * 8 + 2 * e] += pr * bf_lo(w[e]); o[d8 * 8 + 2 * e + 1] += pr * bf_hi(w[e]); } }
            }
            const float il = 1.f / l;
#pragma unroll
            for (int d8 = 0; d8 < 8; ++d8) { u32x4 w;
#pragma unroll
                for (int e = 0; e < 4; ++e) w[e] = pk2(o[d8 * 8 + 2 * e] * il, o[d8 * 8 + 2 * e + 1] * il);
                *(u32x4*)(yac + (size_t)t * D + h * 64 + d8 * 8) = w; }
        }
#endif
    }
    XBAR();

#if FAST_G2
    { PHASE_VARS(); pg8::StaticOrder S; S.init(T, D, G, bx);
      { pg8::Gemm g{yac, Wm_t, T, D, 512, D}; EpiMerge<false> E{sga, mbuf}; pg8::gemm_phase<EpiMerge<false>, pg8::StaticOrder, true, true>(lds, g, S, E, tid); }
      { pg8::Gemm g{yac + 512, Wm_t + 512, T, D, 512, D}; EpiMerge<true> E{sgc, mbuf}; pg8::gemm_phase<EpiMerge<true>, pg8::StaticOrder, true, true>(lds, g, S, E, tid); } }
#else
    { PHASE_VARS();
    for (int tl = bx; tl < 512 * 16; tl += G) {
        const int rt = tl / 16, ct = tl % 16;
        naive_tile(yac + (size_t)rt * 64 * D, D, 512, [=](int i) { return (const bf16_t*)(Wm_t + (size_t)(64 * ct + i) * D); }, tile0, false);
        naive_tile(yac + (size_t)rt * 64 * D + 512, D, 512, [=](int i) { return (const bf16_t*)(Wm_t + (size_t)(64 * ct + i) * D + 512); }, tile1, false);
        __syncthreads();
        const int row = tid >> 3, c8 = (tid & 7) * 8; const size_t o = (size_t)(rt * 64 + row) * D + 64 * ct + c8; float v[8];
#pragma unroll
        for (int j = 0; j < 8; ++j) v[j] = bf2f(sga[o + j]) * tile0[row * 65 + c8 + j] + bf2f(sgc[o + j]) * tile1[row * 65 + c8 + j];
        u32x4 w; w.x = pk2(v[0], v[1]); w.y = pk2(v[2], v[3]); w.z = pk2(v[4], v[5]); w.w = pk2(v[6], v[7]); *(u32x4*)(mbuf + o) = w;
        __syncthreads();
    } }
#endif
    XBAR();

#if FAST_G3
    { PHASE_VARS(); pg8::Gemm g{mbuf, Wo_t, T, D, D, D}; pg8::StaticOrder S; S.init(T, D, G, bx); EpiResF32 E{ap->x, ap->out};
      pg8::gemm_phase<EpiResF32, pg8::StaticOrder, true, true>(lds, g, S, E, tid); }
#else
    { PHASE_VARS();
    for (int tl = bx; tl < 512 * 16; tl += G) {
        const int rt = tl / 16, ct = tl % 16;
        naive_tile(mbuf + (size_t)rt * 64 * D, D, D, [=](int i) { return (const bf16_t*)(Wo_t + (size_t)(64 * ct + i) * D); }, tile0, false);
        __syncthreads();
        const int row = tid >> 3, c8 = (tid & 7) * 8; const size_t o = (size_t)(rt * 64 + row) * D + 64 * ct + c8;
#pragma unroll
        for (int j = 0; j < 8; ++j) ap->out[o + j] = ap->x[o + j] + tile0[row * 65 + c8 + j];
        __syncthreads();
    } }
#endif
    XBAR();

    {
        PHASE_VARS();
        {
            LAS float* lsc = (LAS float*)(lds + wave * 4096);
            const int r = lane & 15, q = lane >> 4;
            for (int task = gw; task < T / 16; task += NGW) {
                const int row0 = task * 16;
                const GAS float* arow = (const GAS float*)ap->out + (size_t)(row0 + r) * D + 4 * q;
                const GAS float* gp = (const GAS float*)ap->g_ffn + 4 * q;
                const GAS f32x4* bp = (const GAS f32x4*)wrt + lane;
                f32x4 acc0 = {0.f, 0.f, 0.f, 0.f}, acc1 = acc0, acc2 = acc0; float ss = 0.f;
#pragma unroll 4
                for (int s_ = 0; s_ < 64; ++s_) {
                    f32x4 av = *(const GAS f32x4*)(arow + 16 * s_); const f32x4 gv = *(const GAS f32x4*)(gp + 16 * s_);
                    const f32x4 b0 = bp[(0 * 64 + s_) * 64], b1 = bp[(1 * 64 + s_) * 64], b2 = bp[(2 * 64 + s_) * 64];
                    ss += (av.x * av.x + av.y * av.y) + (av.z * av.z + av.w * av.w);
                    av = av * gv;
#pragma unroll
                    for (int j = 0; j < 4; ++j) {
                        acc0 = __builtin_amdgcn_mfma_f32_16x16x4f32(av[j], b0[j], acc0, 0, 0, 0);
                        acc1 = __builtin_amdgcn_mfma_f32_16x16x4f32(av[j], b1[j], acc1, 0, 0, 0);
                        acc2 = __builtin_amdgcn_mfma_f32_16x16x4f32(av[j], b2[j], acc2, 0, 0, 0);
                    }
                }
                ss += __shfl_xor(ss, 16); ss += __shfl_xor(ss, 32);
                const float rstd = rsqrtf(ss * (1.f / D) + EPS);
#pragma unroll
                for (int g_ = 0; g_ < 4; ++g_) { const float rs = __shfl(rstd, 4 * q + g_);
                    lsc[(4 * q + g_) * 48 + r] = acc0[g_] * rs; lsc[(4 * q + g_) * 48 + 16 + r] = acc1[g_] * rs; lsc[(4 * q + g_) * 48 + 32 + r] = acc2[g_] * rs; }
                LDS_WAIT(); asm volatile("" ::: "memory");
                if (lane < 16) {
                    const int m = row0 + lane; float lg[36];
#pragma unroll
                    for (int c = 0; c < 36; ++c) lg[c] = lsc[lane * 48 + c];
                    float gl[4];
#pragma unroll
                    for (int c = 0; c < 4; ++c) gl[c] = lg[c] + ap->b_group[c];
                    int grp = 0; float gmax = gl[0];
#pragma unroll
                    for (int c = 1; c < 4; ++c) if (gl[c] > gmax) { gmax = gl[c]; grp = c; }
                    float gs = 0.f;
#pragma unroll
                    for (int c = 0; c < 4; ++c) gs += __expf(gl[c] - gmax);
                    const float pgrp = 1.f / gs;
                    float el[8];
#pragma unroll
                    for (int c = 0; c < 8; ++c) { const float x0 = lg[4 + c], x1 = lg[12 + c], x2 = lg[20 + c], x3 = lg[28 + c]; el[c] = (grp == 0 ? x0 : grp == 1 ? x1 : grp == 2 ? x2 : x3) + ap->b_router[grp * 8 + c]; }
                    int i0 = 0; float l0 = el[0];
#pragma unroll
                    for (int c = 1; c < 8; ++c) if (el[c] > l0) { l0 = el[c]; i0 = c; }
                    int i1 = -1; float l1 = -3.0e38f;
#pragma unroll
                    for (int c = 0; c < 8; ++c) if (c != i0 && el[c] > l1) { l1 = el[c]; i1 = c; }
                    const float e1 = __expf(l1 - l0), w0 = pgrp / (1.f + e1), w1 = pgrp * e1 / (1.f + e1);
                    const int ea = grp * 8 + i0, eb = grp * 8 + i1;
                    const int pa = (int)atomicAdd(&ctl[ea], 1u), pb_ = (int)atomicAdd(&ctl[eb], 1u);
                    rt_e[2 * m] = ea; rt_e[2 * m + 1] = eb; rt_pos[2 * m] = pa; rt_pos[2 * m + 1] = pb_; rt_w[2 * m] = w0; rt_w[2 * m + 1] = w1;
                    ((float*)(ws + WS_RSTD))[m] = rstd;
                }
                LDS_WAIT(); asm volatile("" ::: "memory");
            }
        }
        __syncthreads();
        LAS float* scr = (LAS float*)(lds + wave * 16384);
        constexpr int I_13 = 16 * 16, I_2 = 8 * 32, PER_E = 2 * I_13 + I_2;
        for (int it = gw; it < NE * PER_E; it += NGW) {
            const int e = it / PER_E; int r = it % PER_E;
            if (r < 2 * I_13) { const int which = r / I_13; r %= I_13; const int kb_ = r / 16, nb = r % 16, j0 = nb * 32;
                const float* src = (which ? ap->w3 : ap->w1) + (size_t)e * D * DE + (size_t)(kb_ * 64) * DE + j0;
                transpose_item(src, DE, W13_t + (size_t)(e * 1024 + (j0 >> 7) * 256 + which * 128 + (j0 & 127)) * D + kb_ * 64, D, scr, lane); }
            else { r -= 2 * I_13; const int kb_ = r / 32, nb = r % 32;
                transpose_item(ap->w2 + (size_t)e * DE * D + (size_t)(kb_ * 64) * D + nb * 32, D, W2_t + (size_t)(e * 1024 + nb * 32) * DE + kb_ * 64, DE, scr, lane); }
        }
    }
    XBAR();

    {
        PHASE_VARS();
        if (tid < NE) cnts[tid] = (int)__hip_atomic_load(&ctl[tid], __ATOMIC_RELAXED, __HIP_MEMORY_SCOPE_AGENT);
        __syncthreads();
        if (tid == 0) { int acc_ = 0; for (int e = 0; e < NE; ++e) { pref[e] = acc_; acc_ += (cnts[e] + 255) >> 8; } pref[NE] = acc_; }
        __syncthreads();
        for (size_t i = gtid; i < (size_t)NE * 256; i += GT) { const int e = (int)(i >> 8), r = (int)(i & 255); const int c = cnts[e];
            if (c + r < (((c + 255) >> 8) << 8)) row_slot[pref[e] * 256 + c + r] = -1; }
        for (int tk = gw; tk < T; tk += NGW) {
            const float rs = ((const float*)(ws + WS_RSTD))[tk];
            const int e0 = rt_e[2 * tk], e1 = rt_e[2 * tk + 1], r0 = pref[e0] * 256 + rt_pos[2 * tk], r1 = pref[e1] * 256 + rt_pos[2 * tk + 1];
            const f32x4* src = (const f32x4*)(ap->out + (size_t)tk * D) + 2 * lane; const f32x4* gs = (const f32x4*)ap->g_ffn + 2 * lane;
            u32x4* d0 = (u32x4*)(xs + (size_t)r0 * D) + lane; u32x4* d1 = (u32x4*)(xs + (size_t)r1 * D) + lane;
#pragma unroll
            for (int j = 0; j < 2; ++j) { const f32x4 a0 = src[128 * j], a1 = src[128 * j + 1], g0 = gs[128 * j], g1 = gs[128 * j + 1];
                u32x4 o; o.x = pk2(a0.x * rs * g0.x, a0.y * rs * g0.y); o.y = pk2(a0.z * rs * g0.z, a0.w * rs * g0.w); o.z = pk2(a1.x * rs * g1.x, a1.y * rs * g1.y); o.w = pk2(a1.z * rs * g1.z, a1.w * rs * g1.w);
                d0[64 * j] = o; d1[64 * j] = o; }
            if (lane == 0) { row_slot[r0] = 2 * tk; row_w[r0] = rt_w[2 * tk]; row_slot[r1] = 2 * tk + 1; row_w[r1] = rt_w[2 * tk + 1]; }
        }
    }
    XBAR();
    const int ntiles = __builtin_amdgcn_readfirstlane(pref[NE]);

#if FAST_G4
    { PHASE_VARS(); pg8::Gemm g{xs, W13_t, XS_ROWS, NE * 1024, D, D}; MoeOrder S{pref, ntiles * 4, G, bx}; EpiSwiglu E{hdn};
      pg8::gemm_phase<EpiSwiglu, MoeOrder, true, true>(lds, g, S, E, tid); }
#else
    { PHASE_VARS();
    for (int tl = bx; tl < ntiles * 4 * 8; tl += G) {
        const int rt = tl >> 3, ct = tl & 7, rtg = rt >> 2; int e = 0; for (int k = 1; k < NE; ++k) e += (pref[k] <= rtg) ? 1 : 0;
        naive_tile(xs + (size_t)rt * 64 * D, D, D, [=](int i) { const int j = 64 * ct + i; return (const bf16_t*)(W13_t + (size_t)(e * 1024 + (j >> 7) * 256 + (j & 127)) * D); }, tile0, false);
        naive_tile(xs + (size_t)rt * 64 * D, D, D, [=](int i) { const int j = 64 * ct + i; return (const bf16_t*)(W13_t + (size_t)(e * 1024 + (j >> 7) * 256 + 128 + (j & 127)) * D); }, tile1, false);
        __syncthreads();
        const int row = tid >> 3, c8 = (tid & 7) * 8; float v[8];
#pragma unroll
        for (int j = 0; j < 8; ++j) { const float x1 = tile0[row * 65 + c8 + j], x3 = tile1[row * 65 + c8 + j]; v[j] = x1 * sigmoidf_(x1) * x3; }
        u32x4 w; w.x = pk2(v[0], v[1]); w.y = pk2(v[2], v[3]); w.z = pk2(v[4], v[5]); w.w = pk2(v[6], v[7]); *(u32x4*)(hdn + (size_t)(rt * 64 + row) * DE + 64 * ct + c8) = w;
        __syncthreads();
    } }
#endif
    XBAR();

#if FAST_G5
    { PHASE_VARS(); pg8::Gemm g{hdn, W2_t, XS_ROWS, NE * 1024, DE, DE}; MoeOrder S{pref, ntiles * 4, G, bx}; EpiDown E{row_slot, row_w, contrib};
      pg8::gemm_phase<EpiDown, MoeOrder, true, true>(lds, g, S, E, tid); }
#else
    { PHASE_VARS();
    for (int tl = bx; tl < ntiles * 4 * 16; tl += G) {
        const int rt = tl >> 4, ct = tl & 15, rtg = rt >> 2; int e = 0; for (int k = 1; k < NE; ++k) e += (pref[k] <= rtg) ? 1 : 0;
        naive_tile(hdn + (size_t)rt * 64 * DE, DE, DE, [=](int i) { return (const bf16_t*)(W2_t + (size_t)(e * 1024 + 64 * ct + i) * DE); }, tile0, false);
        __syncthreads();
        const int row = tid >> 3, c8 = (tid & 7) * 8; const int grow = rt * 64 + row; const int slot = row_slot[grow];
        if (slot >= 0) { const float w_ = row_w[grow]; float v[8];
#pragma unroll
            for (int j = 0; j < 8; ++j) v[j] = tile0[row * 65 + c8 + j] * w_;
            u32x4 w; w.x = pk2(v[0], v[1]); w.y = pk2(v[2], v[3]); w.z = pk2(v[4], v[5]); w.w = pk2(v[6], v[7]); *(u32x4*)(contrib + (size_t)slot * D + 64 * ct + c8) = w; }
        __syncthreads();
    } }
#endif
    XBAR();

    { PHASE_VARS();
    for (int m = gw; m < T; m += NGW) {
        f32x4* xr = (f32x4*)(ap->out + (size_t)m * D) + lane; const f32x4* gr = (const f32x4*)ap->g_ple + lane;
        const u32x2* c0 = (const u32x2*)(contrib + (size_t)(2 * m) * D) + lane; const u32x2* c1 = (const u32x2*)(contrib + (size_t)(2 * m + 1) * D) + lane;
        f32x4 v[4]; float s = 0.f;
#pragma unroll
        for (int j = 0; j < 4; ++j) { v[j] = xr[64 * j]; const u32x2 p0 = c0[64 * j], p1 = c1[64 * j];
            v[j].x += bf_lo(p0.x) + bf_lo(p1.x); v[j].y += bf_hi(p0.x) + bf_hi(p1.x); v[j].z += bf_lo(p0.y) + bf_lo(p1.y); v[j].w += bf_hi(p0.y) + bf_hi(p1.y);
            xr[64 * j] = v[j]; s += (v[j].x * v[j].x + v[j].y * v[j].y) + (v[j].z * v[j].z + v[j].w * v[j].w); }
        const float rstd = rsqrtf(wave_sum(s) * (1.f / D) + EPS);
        unsigned long long* o8 = (unsigned long long*)(nbuf + (size_t)m * D) + lane;
#pragma unroll
        for (int j = 0; j < 4; ++j) { const f32x4 gg = gr[64 * j]; o8[64 * j] = (unsigned long long)pk2(v[j].x * rstd * gg.x, v[j].y * rstd * gg.y) | ((unsigned long long)pk2(v[j].z * rstd * gg.z, v[j].w * rstd * gg.w) << 32); }
    } }
    XBAR();

#if FAST_G6
    { PHASE_VARS(); pg8::StaticOrder S; S.init(T, D, G, bx);
      { pg8::Gemm g{pb, Wpp_t, T, D, PLE, PLE}; EpiPP E{ppb}; pg8::gemm_phase<EpiPP, pg8::StaticOrder, true, true>(lds, g, S, E, tid); }
      { pg8::Gemm g{nbuf, Wpg_t, T, D, D, D}; EpiGate E{ppb, ap->b_pg, ap->out}; pg8::gemm_phase<EpiGate, pg8::StaticOrder, true, true>(lds, g, S, E, tid); } }
#else
    { PHASE_VARS();
    for (int tl = bx; tl < 512 * 16; tl += G) {
        const int rt = tl / 16, ct = tl % 16;
        naive_tile(nbuf + (size_t)rt * 64 * D, D, D, [=](int i) { return (const bf16_t*)(Wpg_t + (size_t)(64 * ct + i) * D); }, tile0, false);
        naive_tile(pb + (size_t)rt * 64 * PLE, PLE, PLE, [=](int i) { return (const bf16_t*)(Wpp_t + (size_t)(64 * ct + i) * PLE); }, tile1, false);
        __syncthreads();
        const int row = tid >> 3, c8 = (tid & 7) * 8; const size_t o = (size_t)(rt * 64 + row) * D + 64 * ct + c8;
#pragma unroll
        for (int j = 0; j < 8; ++j) ap->out[o + j] = ap->out[o + j] + sigmoidf_(tile0[row * 65 + c8 + j] + ap->b_pg[64 * ct + c8 + j]) * tile1[row * 65 + c8 + j];
        __syncthreads();
    } }
#endif
}

extern "C" void kernel_launch(void* const* d_in, const int* in_sizes, int n_in, void* d_out, int out_size, void* d_ws, size_t ws_size, hipStream_t stream) {
    static int grid = 0;
    if (grid == 0) {
        if (n_in != 25 || out_size != T * D || ws_size < WS_END) { fprintf(stderr, "kernel_launch: unexpected shapes (n_in %d out %d ws %zu); nothing launched\n", n_in, out_size, ws_size); grid = -1; return; }
        int dev = 0, cus = 0, per_cu = 0;
        if (hipGetDevice(&dev) != hipSuccess || hipDeviceGetAttribute(&cus, hipDeviceAttributeMultiprocessorCount, dev) != hipSuccess) { grid = -1; return; }
        if (hipFuncSetAttribute((const void*)fwd_kernel, hipFuncAttributeMaxDynamicSharedMemorySize, LDS_BYTES) != hipSuccess) { fprintf(stderr, "kernel_launch: hipFuncSetAttribute failed\n"); grid = -1; return; }
        if (hipOccupancyMaxActiveBlocksPerMultiprocessor(&per_cu, (const void*)fwd_kernel, NTHREADS, LDS_BYTES) != hipSuccess || per_cu < 1) { fprintf(stderr, "kernel_launch: occupancy query says %d\n", per_cu); (void)hipGetLastError(); grid = -1; return; }
        grid = cus;
    }
    if (grid < 0) return;
    if (hipMemsetAsync((char*)d_ws + WS_CTL, 0, CTL_ZERO_BYTES, stream) != hipSuccess) { fprintf(stderr, "kernel_launch: memset failed\n"); return; }
    Args a{};
    const float** f = (const float**)&a;
    for (int i = 0; i < 25; ++i) f[i] = (const float*)d_in[i];
    a.out = (float*)d_out; a.ws = (unsigned char*)d_ws;
    void* args[] = {&a};
    hipError_t e = hipLaunchCooperativeKernel((const void*)fwd_kernel, dim3(grid), dim3(NTHREADS), args, LDS_BYTES, stream);
    if (e != hipSuccess) fprintf(stderr, "kernel_launch: cooperative launch failed: %s (grid %d)\n", hipGetErrorString(e), grid);
}
```

```cpp
#include <hip/hip_runtime.h>
#include <hip/hip_cooperative_groups.h>
#include <cstdio>
#include <cstdint>
namespace cg = cooperative_groups;

#define GAS __attribute__((address_space(1)))
#define LAS __attribute__((address_space(3)))
typedef unsigned short bf16_t;
typedef short bf16x8 __attribute__((ext_vector_type(8)));
typedef float f32x4 __attribute__((ext_vector_type(4)));
typedef float f32x2 __attribute__((ext_vector_type(2)));
typedef unsigned u32x4 __attribute__((ext_vector_type(4)));
typedef unsigned u32x2 __attribute__((ext_vector_type(2)));
typedef GAS unsigned gu32;
#define RLX_AGENT __ATOMIC_RELAXED, __HIP_MEMORY_SCOPE_AGENT

constexpr int T = 32768, D = 1024, SEQ = 4096, NBATCH = 8;
constexpr int NIN = 5120, NH = 8, HD = 64, AW = 512, CW = 512;
constexpr int NE = 32, DE = 512, PLE = 256, NREL = 320;
constexpr int XS_ROWS = 65536 + NE * 256;
constexpr float EPS = 1e-6f;
constexpr float LOG2E = 1.4426950408889634f;
constexpr float C2 = 0.125f * LOG2E;

constexpr size_t MiB = 1u << 20;
constexpr size_t WS_CTL = 0, CTL_ZERO_BYTES = 64 * 1024;
constexpr int CW_BAR = 1024;
constexpr size_t WS_TAB = 1 * MiB;
constexpr size_t WS_GTAB = WS_TAB + 192 * 1024;
constexpr size_t WS_GCINIT = WS_GTAB + 8 * 4 * 384 * 4;
constexpr size_t WS_ROUTE = 2 * MiB;
constexpr size_t WS_RSTD = 3 * MiB;
constexpr size_t WS_ROWMETA = 4 * MiB;
constexpr size_t WS_WIN = 6 * MiB;
constexpr size_t WS_WM = 16 * MiB;
constexpr size_t WS_WO = 18 * MiB;
constexpr size_t WS_WPG = 20 * MiB;
constexpr size_t WS_WPP = 22 * MiB;
constexpr size_t WS_PB = 24 * MiB;
constexpr size_t WS_NBUF = 40 * MiB;
constexpr size_t WS_Q = 104 * MiB, WS_K = 136 * MiB, WS_V = 168 * MiB, WS_U = 200 * MiB, WS_BG = 232 * MiB, WS_CG = 264 * MiB;
constexpr size_t WS_SGA = 296 * MiB, WS_SGC = 360 * MiB;
constexpr size_t WS_YAC = 424 * MiB;
constexpr size_t WS_M = 104 * MiB;
constexpr size_t WS_W13 = 168 * MiB;
constexpr size_t WS_W2 = 232 * MiB;
constexpr size_t WS_XS = 264 * MiB;
constexpr size_t WS_HDN = 408 * MiB;
constexpr size_t WS_CONTRIB = 264 * MiB;
constexpr size_t WS_PP = 104 * MiB;
constexpr size_t WS_END = 488 * MiB;

__device__ __forceinline__ unsigned f2bf(float f) { unsigned u = __builtin_bit_cast(unsigned, f); return (u + 0x7fffu + ((u >> 16) & 1u)) >> 16; }
__device__ __forceinline__ unsigned pk2(float lo, float hi) { return f2bf(lo) | (f2bf(hi) << 16); }
__device__ __forceinline__ float bf_lo(unsigned w) { return __builtin_bit_cast(float, w << 16); }
__device__ __forceinline__ float bf_hi(unsigned w) { return __builtin_bit_cast(float, w & 0xffff0000u); }
__device__ __forceinline__ float bf2f(bf16_t h) { return __builtin_bit_cast(float, (unsigned)h << 16); }
__device__ __forceinline__ float sigmoidf_(float x) { return __builtin_amdgcn_rcpf(1.0f + __builtin_amdgcn_exp2f(-LOG2E * x)); }
__device__ __forceinline__ float wave_sum(float v) {
#pragma unroll
    for (int o = 1; o < 64; o <<= 1) v += __shfl_xor(v, o);
    return v;
}
__device__ __forceinline__ int lane_id_fresh() { int l; asm volatile("v_mbcnt_lo_u32_b32 %0, -1, 0\n\tv_mbcnt_hi_u32_b32 %0, -1, %0" : "=v"(l)); return l; }
#define LDS_WAIT() asm volatile("s_waitcnt lgkmcnt(0)" ::: "memory")
#define VM_WAIT() asm volatile("s_waitcnt vmcnt(0)" ::: "memory")

namespace pg8 {
#define PG8_LAS __attribute__((address_space(3)))
constexpr int BM = 256, BK = 64, HALF = 128, HTB = HALF * BK * 2  , STAGE_BYTES = 8 * HTB, NXCD = 8, WGM = 8;

__host__ __device__ __forceinline__ int lds_byte(int r, int c) { const int st = (r >> 4) * 2 + (c >> 5), rr = r & 15, cc = c & 31, ob = rr * 64 + cc * 2; return st * 1024 + (ob ^ (((ob >> 9) & 1) << 5)); }
__host__ __device__ __forceinline__ void stage_rc(int b, int& R, int& C) { const int st = b / 1024, sb = b % 1024, swz = sb ^ (((sb >> 9) & 1) << 5); R = (st >> 1) * 16 + swz / 64; C = (st & 1) * 32 + (swz % 64) / 2; }
__host__ __device__ __forceinline__ int perm32(int rho) { const int n = rho >> 4, i = rho & 15; return 8 * (i >> 2) + 4 * n + (i & 3); }

struct Unit { int pm, pn; };
struct Gemm { const bf16_t* A; const bf16_t* Bt; int M, N, K, ld; };

struct StaticOrder {
    int nM, nN, nwg, G, c;
    __host__ __device__ void init(int M, int N, int G_, int c_) { nM = M / BM; nN = N / BM; nwg = nM * nN; G = G_; c = c_; }
    __host__ __device__ bool next(int i, Unit& u) const {
        const long L = (long)i * G + c; if (L >= nwg) return false;
        int wgid = (int)L; { const int q = nwg / NXCD, r = nwg % NXCD, xcd = wgid % NXCD, off = wgid / NXCD; wgid = (xcd < r ? xcd * (q + 1) : r * (q + 1) + (xcd - r) * q) + off; }
        const int nig = WGM * nN, gid = wgid / nig, fm = gid * WGM, gsz = (nM - fm) < WGM ? (nM - fm) : WGM;
        u.pm = fm + ((wgid % nig) % gsz); u.pn = (wgid % nig) / gsz; return true;
    }
    __device__ __forceinline__ void a_ready(const Unit&) const {}
    __device__ __forceinline__ void done(const Unit&) const {}
};
__device__ __forceinline__ unsigned cvt_pk_bf16(float lo, float hi) { unsigned r; asm volatile("v_cvt_pk_bf16_f32 %0, %1, %2" : "=v"(r) : "v"(lo), "v"(hi)); return r; }

template <class Epi, class Sched, bool ALIGN_EPI = false, bool SP2 = false>
__device__ __forceinline__ void gemm_phase(PG8_LAS unsigned char* lds, const Gemm g, const Sched& S, const Epi& E, int tid_) {
    asm volatile("" : "+v"(tid_));
    const int tid = tid_, wid = __builtin_amdgcn_readfirstlane(tid >> 6), lane = tid & 63, wr = wid >> 2, wc = wid & 3, fr = lane & 15, fq = lane >> 4;
    int K = g.K; asm volatile("" : "+s"(K));
    const int nt = K / BK; const int LD = g.ld;
    unsigned voffA[2], voffB[2];
#pragma unroll
    for (int i = 0; i < 2; ++i) { int R, C; stage_rc(tid * 16 + i * 8192, R, C); const int Rb = Epi::PERM ? ((R & ~31) + perm32(R & 31)) : R;
        voffA[i] = (unsigned)(R * LD + C) * 2u; voffB[i] = (unsigned)(Rb * LD + C) * 2u; }
    const size_t kstep = (size_t)(BK * 2);
    const size_t hstep = (size_t)HALF * LD * 2;
    const size_t tstep = 2 * hstep;
    const unsigned ldsw = (unsigned)wid * 1024u;
    const int aoff = lds_byte(wr * 64 + fr, fq * 8), boff = lds_byte(wc * 32 + fr, fq * 8);
#define PG8_SA(b, h) (((b) * 2 + (h)) * HTB)
#define PG8_SB(b, h) ((4 + (b) * 2 + (h)) * HTB)
#define PG8_STAGE(bufoff, gbase, voff) do { _Pragma("unroll") for (int _i = 0; _i < 2; ++_i) \
        __builtin_amdgcn_global_load_lds((const unsigned*)((const char*)(gbase) + (voff)[_i]), (PG8_LAS unsigned*)(lds + (bufoff) + ldsw + _i * 8192), 16, 0, 0); } while (0)
#define PG8_LDA(dst, b, h) do { _Pragma("unroll") for (int m = 0; m < 4; ++m) _Pragma("unroll") for (int k = 0; k < 2; ++k) dst[m][k] = *(const PG8_LAS bf16x8*)(lds + PG8_SA(b, h) + aoff + m * 2048 + k * 1024); } while (0)
#define PG8_LDB(dst, b, h) do { _Pragma("unroll") for (int n = 0; n < 2; ++n) _Pragma("unroll") for (int k = 0; k < 2; ++k) dst[n][k] = *(const PG8_LAS bf16x8*)(lds + PG8_SB(b, h) + boff + n * 2048 + k * 1024); } while (0)
#define PG8_MMA(ai, bj, At, Bt) do { __builtin_amdgcn_s_setprio(1); _Pragma("unroll") for (int m = 0; m < 4; ++m) _Pragma("unroll") for (int n = 0; n < 2; ++n) _Pragma("unroll") for (int k = 0; k < 2; ++k) \
        acc[ai][bj][m][n] = __builtin_amdgcn_mfma_f32_16x16x32_bf16(Bt[n][k], At[m][k], acc[ai][bj][m][n], 0, 0, 0); __builtin_amdgcn_s_setprio(0); } while (0)
#define PG8_WAIT_V(n) asm volatile("s_waitcnt vmcnt(" #n ")" ::: "memory")
#define PG8_WAIT_L(n) asm volatile("s_waitcnt lgkmcnt(" #n ")" ::: "memory")
#define PG8_BAR __builtin_amdgcn_s_barrier()
#define PG8_SCHED __builtin_amdgcn_sched_barrier(0)
    Unit cur, nxt; int ui = 0;
    if (!S.next(0, cur)) return;
    f32x4 acc[2][2][4][2];
#pragma unroll
    for (int a = 0; a < 2; ++a)
#pragma unroll
        for (int b = 0; b < 2; ++b)
#pragma unroll
            for (int m = 0; m < 4; ++m)
#pragma unroll
                for (int n = 0; n < 2; ++n) acc[a][b][m][n] = (f32x4){0.f, 0.f, 0.f, 0.f};
    bf16x8 At[4][2], B0[2][2], B1[2][2];
    const char* cA = (const char*)g.A + (size_t)cur.pm * tstep; const char* cB = (const char*)g.Bt + (size_t)cur.pn * tstep;
    S.a_ready(cur);
    if constexpr (SP2) {
        PG8_STAGE(PG8_SB(0, 0), cB, voffB); PG8_STAGE(PG8_SB(0, 1), cB + hstep, voffB); PG8_STAGE(PG8_SA(0, 0), cA, voffA); PG8_STAGE(PG8_SA(0, 1), cA + hstep, voffA);
        if (wr == 1) PG8_BAR;
        PG8_WAIT_V(2); PG8_BAR;
        PG8_STAGE(PG8_SB(1, 0), cB + kstep, voffB); PG8_STAGE(PG8_SA(1, 0), cA + kstep, voffA); PG8_STAGE(PG8_SB(1, 1), cB + hstep + kstep, voffB);
        PG8_WAIT_V(6); PG8_BAR;
    } else {
        PG8_STAGE(PG8_SB(0, 0), cB, voffB); PG8_STAGE(PG8_SA(0, 0), cA, voffA); PG8_STAGE(PG8_SB(0, 1), cB + hstep, voffB); PG8_STAGE(PG8_SA(0, 1), cA + hstep, voffA);
        if (wr == 1) PG8_BAR;
        PG8_WAIT_V(4); PG8_BAR;
        PG8_STAGE(PG8_SB(1, 0), cB + kstep, voffB); PG8_STAGE(PG8_SA(1, 0), cA + kstep, voffA); PG8_STAGE(PG8_SB(1, 1), cB + hstep + kstep, voffB);
        PG8_WAIT_V(6); PG8_BAR;
    }
    for (;;) {
        const bool has_next = S.next(ui + 1, nxt);
        const char* nA = has_next ? (const char*)g.A + (size_t)nxt.pm * tstep : cA; const char* nB = has_next ? (const char*)g.Bt + (size_t)nxt.pn * tstep : cB;
        for (int t = 0; t < nt; t += 2) {
            const bool last = (t == nt - 2);
            if constexpr (Epi::MID_T > 0) { if (t == Epi::MID_T) E.mid(acc, cur, wr, wc, fr, fq); }
            const char* a1 = cA + (size_t)(t + 1) * kstep;
            const char* a2 = last ? nA : cA + (size_t)(t + 2) * kstep; const char* b2 = last ? nB : cB + (size_t)(t + 2) * kstep;
            const char* a3 = a2 + kstep; const char* b3 = b2 + kstep;
            if (last && has_next) S.a_ready(nxt);
            if constexpr (SP2) {
            PG8_LDB(B0, 0, 0); PG8_LDB(B1, 0, 1); PG8_SCHED; PG8_LDA(At, 0, 0); PG8_STAGE(PG8_SA(1, 1), a1 + hstep, voffA);
            PG8_WAIT_V(8); PG8_WAIT_L(0); PG8_BAR; PG8_MMA(0, 0, At, B0); PG8_MMA(0, 1, At, B1); PG8_BAR; PG8_SCHED;
            PG8_LDA(At, 0, 1); PG8_STAGE(PG8_SB(0, 0), b2, voffB); PG8_STAGE(PG8_SB(0, 1), b2 + hstep, voffB); PG8_STAGE(PG8_SA(0, 0), a2, voffA);
            PG8_WAIT_V(8); PG8_WAIT_L(0); PG8_BAR; PG8_MMA(1, 0, At, B0); PG8_MMA(1, 1, At, B1); PG8_BAR; PG8_SCHED;
            PG8_LDB(B0, 1, 0); PG8_LDB(B1, 1, 1); PG8_SCHED; PG8_LDA(At, 1, 0); PG8_STAGE(PG8_SA(0, 1), a2 + hstep, voffA);
            PG8_WAIT_V(8); PG8_WAIT_L(0); PG8_BAR; PG8_MMA(0, 0, At, B0); PG8_MMA(0, 1, At, B1); PG8_BAR; PG8_SCHED;
            PG8_LDA(At, 1, 1); PG8_STAGE(PG8_SB(1, 0), b3, voffB); PG8_STAGE(PG8_SB(1, 1), b3 + hstep, voffB); PG8_STAGE(PG8_SA(1, 0), a3, voffA);
            PG8_WAIT_V(8); PG8_WAIT_L(0); PG8_BAR; PG8_MMA(1, 0, At, B0); PG8_MMA(1, 1, At, B1); PG8_BAR; PG8_SCHED;
            } else {
            PG8_LDB(B0, 0, 0); PG8_SCHED; PG8_LDA(At, 0, 0); PG8_STAGE(PG8_SA(1, 1), a1 + hstep, voffA);
            PG8_WAIT_L(8); PG8_BAR; PG8_WAIT_L(0); PG8_MMA(0, 0, At, B0); PG8_BAR; PG8_SCHED;
            PG8_LDB(B1, 0, 1); PG8_STAGE(PG8_SB(0, 0), b2, voffB);
            PG8_BAR; PG8_WAIT_L(0); PG8_MMA(0, 1, At, B1); PG8_BAR;
            PG8_LDA(At, 0, 1); PG8_STAGE(PG8_SA(0, 0), a2, voffA);
            PG8_BAR; PG8_WAIT_L(0); PG8_MMA(1, 0, At, B0); PG8_BAR; PG8_SCHED;
            PG8_STAGE(PG8_SB(0, 1), b2 + hstep, voffB);
            PG8_WAIT_V(6); PG8_BAR; PG8_MMA(1, 1, At, B1); PG8_BAR;
            PG8_LDB(B0, 1, 0); PG8_SCHED; PG8_LDA(At, 1, 0); PG8_STAGE(PG8_SA(0, 1), a2 + hstep, voffA);
            PG8_WAIT_L(8); PG8_BAR; PG8_WAIT_L(0); PG8_MMA(0, 0, At, B0); PG8_BAR; PG8_SCHED;
            PG8_LDB(B1, 1, 1); PG8_STAGE(PG8_SB(1, 0), b3, voffB);
            PG8_BAR; PG8_WAIT_L(0); PG8_MMA(0, 1, At, B1); PG8_BAR;
            PG8_LDA(At, 1, 1); PG8_STAGE(PG8_SA(1, 0), a3, voffA);
            PG8_BAR; PG8_WAIT_L(0); PG8_MMA(1, 0, At, B0); PG8_BAR; PG8_SCHED;
            PG8_STAGE(PG8_SB(1, 1), b3 + hstep, voffB);
            PG8_WAIT_V(6); PG8_BAR; PG8_MMA(1, 1, At, B1); PG8_BAR;
            }
        }
        if constexpr (ALIGN_EPI) { if (wr == 0) PG8_BAR; }
        if constexpr (!Epi::AFTER_DRAIN) { E(acc, cur, wr, wc, fr, fq); S.done(cur); }
        if (!has_next) break;
#pragma unroll
        for (int a = 0; a < 2; ++a)
#pragma unroll
            for (int b = 0; b < 2; ++b)
#pragma unroll
                for (int m = 0; m < 4; ++m)
#pragma unroll
                    for (int n = 0; n < 2; ++n) acc[a][b][m][n] = (f32x4){0.f, 0.f, 0.f, 0.f};
        cur = nxt; cA = nA; cB = nB; ++ui;
        if constexpr (ALIGN_EPI) { if (wr == 1) PG8_BAR; }
    }
    PG8_WAIT_V(0);
    if constexpr (!ALIGN_EPI) { if (wr == 0) PG8_BAR; }
    PG8_BAR;
#undef PG8_SA
#undef PG8_SB
#undef PG8_STAGE
#undef PG8_LDA
#undef PG8_LDB
#undef PG8_MMA
#undef PG8_WAIT_V
#undef PG8_WAIT_L
#undef PG8_BAR
#undef PG8_SCHED
}
}

typedef f32x4 acc_t[2][2][4][2];
using pg8::Unit; using pg8::HALF; using pg8::BM;

struct EpiInproj {
    static constexpr bool PERM = true, AFTER_DRAIN = false; static constexpr int MID_T = 0;
    unsigned char* ws; const float* b_in; const float* g_q; const float* g_k;
    __device__ __forceinline__ void operator()(const acc_t& acc, const Unit& u, int wr, int wc, int fr, int fq) const {
        const int pn = u.pn;
        int mode, pitch, col0; size_t off;
        if (pn < 12) { const int seg = pn >> 1; mode = seg == 0 ? 1 : (seg == 1 ? 2 : 0); pitch = 512; col0 = 256 * (pn & 1); off = WS_Q + (size_t)seg * (32 * MiB); }
        else if (pn < 16) { mode = 3; pitch = 1024; col0 = 256 * (pn - 12); off = WS_SGA; }
        else { mode = 3; pitch = 1024; col0 = 256 * (pn - 16); off = WS_SGC; }
        bf16_t* base = (bf16_t*)(ws + off);
        const int lc0 = 64 * wc + 8 * fq;
        f32x4 bv[2][2], gv[2][2];
#pragma unroll
        for (int bj = 0; bj < 2; ++bj)
#pragma unroll
            for (int n = 0; n < 2; ++n) {
                bv[bj][n] = *(const f32x4*)(b_in + 256 * pn + lc0 + 32 * bj + 4 * n);
                const float* g = (mode == 2) ? g_k : g_q;
                gv[bj][n] = *(const f32x4*)(g + 8 * fq + 32 * bj + 4 * n);
            }
        const float qs = (mode == 1) ? C2 : 1.0f;
#pragma unroll
        for (int ai = 0; ai < 2; ++ai)
#pragma unroll
            for (int m = 0; m < 4; ++m) {
                const int row = u.pm * BM + ai * HALF + wr * 64 + m * 16 + fr;
                f32x4 v[2][2];
#pragma unroll
                for (int bj = 0; bj < 2; ++bj)
#pragma unroll
                    for (int n = 0; n < 2; ++n) v[bj][n] = acc[ai][bj][m][n] + bv[bj][n];
                if (mode == 1 || mode == 2) {
                    float ss = 0.f;
#pragma unroll
                    for (int bj = 0; bj < 2; ++bj)
#pragma unroll
                        for (int n = 0; n < 2; ++n) { const f32x4 x = v[bj][n]; ss += (x[0] * x[0] + x[1] * x[1]) + (x[2] * x[2] + x[3] * x[3]); }
                    ss += __shfl_xor(ss, 16); ss += __shfl_xor(ss, 32);
                    const float rstd = __frsqrt_rn(ss * (1.0f / 64.0f) + EPS) * qs;
#pragma unroll
                    for (int bj = 0; bj < 2; ++bj)
#pragma unroll
                        for (int n = 0; n < 2; ++n) v[bj][n] = v[bj][n] * rstd * gv[bj][n];
                } else if (mode == 3) {
#pragma unroll
                    for (int bj = 0; bj < 2; ++bj)
#pragma unroll
                        for (int n = 0; n < 2; ++n)
#pragma unroll
                            for (int j = 0; j < 4; ++j) v[bj][n][j] = sigmoidf_(v[bj][n][j]);
                }
                bf16_t* rowp = base + (size_t)row * pitch + col0 + lc0;
#pragma unroll
                for (int bj = 0; bj < 2; ++bj) {
                    u32x4 w; w.x = pg8::cvt_pk_bf16(v[bj][0][0], v[bj][0][1]); w.y = pg8::cvt_pk_bf16(v[bj][0][2], v[bj][0][3]); w.z = pg8::cvt_pk_bf16(v[bj][1][0], v[bj][1][1]); w.w = pg8::cvt_pk_bf16(v[bj][1][2], v[bj][1][3]);
                    *(u32x4*)(rowp + 32 * bj) = w;
                }
            }
    }
};

template <bool SECOND> struct EpiMerge {
    static constexpr bool PERM = true, AFTER_DRAIN = false; static constexpr int MID_T = 0;
    const bf16_t* gate; bf16_t* mout;
    __device__ __forceinline__ void operator()(const acc_t& acc, const Unit& u, int wr, int wc, int fr, int fq) const {
        const int col0 = u.pn * BM + wc * 32 + 8 * fq;
#pragma unroll
        for (int ai = 0; ai < 2; ++ai)
#pragma unroll
            for (int m = 0; m < 4; ++m) {
                const size_t ro = (size_t)(u.pm * BM + ai * HALF + wr * 64 + m * 16 + fr) * D + col0;
#pragma unroll
                for (int bj = 0; bj < 2; ++bj) {
                    const u32x4 c = *(const u32x4*)(gate + ro + bj * HALF);
                    const f32x4 v0 = acc[ai][bj][m][0], v1 = acc[ai][bj][m][1];
                    float r[8] = {v0[0] * bf_lo(c.x), v0[1] * bf_hi(c.x), v0[2] * bf_lo(c.y), v0[3] * bf_hi(c.y), v1[0] * bf_lo(c.z), v1[1] * bf_hi(c.z), v1[2] * bf_lo(c.w), v1[3] * bf_hi(c.w)};
                    if (SECOND) { const u32x4 p = *(const u32x4*)(mout + ro + bj * HALF);
                        r[0] += bf_lo(p.x); r[1] += bf_hi(p.x); r[2] += bf_lo(p.y); r[3] += bf_hi(p.y); r[4] += bf_lo(p.z); r[5] += bf_hi(p.z); r[6] += bf_lo(p.w); r[7] += bf_hi(p.w); }
                    u32x4 w; w.x = pg8::cvt_pk_bf16(r[0], r[1]); w.y = pg8::cvt_pk_bf16(r[2], r[3]); w.z = pg8::cvt_pk_bf16(r[4], r[5]); w.w = pg8::cvt_pk_bf16(r[6], r[7]);
                    *(u32x4*)(mout + ro + bj * HALF) = w;
                }
                asm volatile("" ::: "memory");
            }
    }
};

struct EpiResF32 {
    static constexpr bool PERM = false, AFTER_DRAIN = false; static constexpr int MID_T = 0;
    const float* x; float* out;
    __device__ __forceinline__ void operator()(const acc_t& acc, const Unit& u, int wr, int wc, int fr, int fq) const {
        const int col0 = u.pn * BM + wc * 32 + 4 * fq;
#pragma unroll
        for (int ai = 0; ai < 2; ++ai)
#pragma unroll
            for (int m = 0; m < 4; ++m) {
                const size_t ro = (size_t)(u.pm * BM + ai * HALF + wr * 64 + m * 16 + fr) * D + col0;
#pragma unroll
                for (int bj = 0; bj < 2; ++bj)
#pragma unroll
                    for (int n = 0; n < 2; ++n) { const f32x4 b = *(const f32x4*)(x + ro + bj * HALF + n * 16); *(f32x4*)(out + ro + bj * HALF + n * 16) = b + acc[ai][bj][m][n]; }
                if (m & 1) asm volatile("" ::: "memory");
            }
    }
};

struct EpiSwiglu {
    static constexpr bool PERM = true, AFTER_DRAIN = false; static constexpr int MID_T = 0;
    bf16_t* hdn;
    __device__ __forceinline__ void operator()(const acc_t& acc, const Unit& u, int wr, int wc, int fr, int fq) const {
        const int col0 = 128 * (u.pn & 3) + wc * 32 + 8 * fq;
#pragma unroll
        for (int ai = 0; ai < 2; ++ai)
#pragma unroll
            for (int m = 0; m < 4; ++m) {
                const size_t ro = (size_t)(u.pm * BM + ai * HALF + wr * 64 + m * 16 + fr) * DE + col0;
                float h[8];
#pragma unroll
                for (int n = 0; n < 2; ++n)
#pragma unroll
                    for (int j = 0; j < 4; ++j) { const float a = acc[ai][0][m][n][j], b = acc[ai][1][m][n][j]; h[4 * n + j] = a * sigmoidf_(a) * b; }
                u32x4 w; w.x = pg8::cvt_pk_bf16(h[0], h[1]); w.y = pg8::cvt_pk_bf16(h[2], h[3]); w.z = pg8::cvt_pk_bf16(h[4], h[5]); w.w = pg8::cvt_pk_bf16(h[6], h[7]);
                *(u32x4*)(hdn + ro) = w;
            }
    }
};

struct EpiDown {
    static constexpr bool PERM = true, AFTER_DRAIN = false; static constexpr int MID_T = 0;
    const int* row_slot; const float* row_w; bf16_t* contrib;
    __device__ __forceinline__ void operator()(const acc_t& acc, const Unit& u, int wr, int wc, int fr, int fq) const {
        const int col0 = 256 * (u.pn & 3) + wc * 32 + 8 * fq;
#pragma unroll
        for (int ai = 0; ai < 2; ++ai)
#pragma unroll
            for (int m = 0; m < 4; ++m) {
                const int row = u.pm * BM + ai * HALF + wr * 64 + m * 16 + fr;
                const int slot = row_slot[row]; const float w = row_w[row];
                if (slot >= 0) {
#pragma unroll
                    for (int bj = 0; bj < 2; ++bj) {
                        const f32x4 v0 = acc[ai][bj][m][0] * w, v1 = acc[ai][bj][m][1] * w;
                        u32x4 o; o.x = pg8::cvt_pk_bf16(v0[0], v0[1]); o.y = pg8::cvt_pk_bf16(v0[2], v0[3]); o.z = pg8::cvt_pk_bf16(v1[0], v1[1]); o.w = pg8::cvt_pk_bf16(v1[2], v1[3]);
                        *(u32x4*)(contrib + (size_t)slot * D + col0 + bj * HALF) = o;
                    }
                }
            }
    }
};

struct EpiPP {
    static constexpr bool PERM = false, AFTER_DRAIN = false; static constexpr int MID_T = 0;
    bf16_t* pp;
    __device__ __forceinline__ void operator()(const acc_t& acc, const Unit& u, int wr, int wc, int fr, int fq) const {
        const int col0 = u.pn * BM + wc * 32 + 4 * fq;
#pragma unroll
        for (int ai = 0; ai < 2; ++ai)
#pragma unroll
            for (int m = 0; m < 4; ++m) {
                const size_t ro = (size_t)(u.pm * BM + ai * HALF + wr * 64 + m * 16 + fr) * D + col0;
#pragma unroll
                for (int bj = 0; bj < 2; ++bj)
#pragma unroll
                    for (int n = 0; n < 2; ++n) { const f32x4 v = acc[ai][bj][m][n]; u32x2 w; w.x = pg8::cvt_pk_bf16(v[0], v[1]); w.y = pg8::cvt_pk_bf16(v[2], v[3]); *(u32x2*)(pp + ro + bj * HALF + n * 16) = w; }
            }
    }
};
struct EpiGate {
    static constexpr bool PERM = false, AFTER_DRAIN = false; static constexpr int MID_T = 0;
    const bf16_t* pp; const bf16_t* h2b; const float* rstd; const float* bpg; float* out;
    __device__ __forceinline__ void operator()(const acc_t& acc, const Unit& u, int wr, int wc, int fr, int fq) const {
        const int col0 = u.pn * BM + wc * 32 + 4 * fq;
#pragma unroll
        for (int ai = 0; ai < 2; ++ai)
#pragma unroll
            for (int m = 0; m < 4; ++m) {
                const int row = u.pm * BM + ai * HALF + wr * 64 + m * 16 + fr;
                const size_t ro = (size_t)row * D + col0; const float rs = rstd[row];
#pragma unroll
                for (int bj = 0; bj < 2; ++bj)
#pragma unroll
                    for (int n = 0; n < 2; ++n) {
                        const size_t o = ro + bj * HALF + n * 16;
                        const u32x2 hw = *(const u32x2*)(h2b + o); const u32x2 pw = *(const u32x2*)(pp + o);
                        const f32x4 a = acc[ai][bj][m][n] * rs + *(const f32x4*)(bpg + col0 + bj * HALF + n * 16);
                        f32x4 r;
                        r[0] = bf_lo(hw.x) + sigmoidf_(a[0]) * bf_lo(pw.x); r[1] = bf_hi(hw.x) + sigmoidf_(a[1]) * bf_hi(pw.x);
                        r[2] = bf_lo(hw.y) + sigmoidf_(a[2]) * bf_lo(pw.y); r[3] = bf_hi(hw.y) + sigmoidf_(a[3]) * bf_hi(pw.y);
                        *(f32x4*)(out + o) = r;
                    }
                asm volatile("" ::: "memory");
            }
    }
};

struct MoeOrder {
    const LAS int* pref;
    int nunits, G, c;
    __device__ __forceinline__ bool next(int i, Unit& u) const {
        const int L = i * G + c; if (L >= nunits) return false;
        const int rtg = L >> 2, pnl = L & 3; int e = 0;
#pragma unroll 4
        for (int k = 1; k < NE; ++k) e += (pref[k] <= rtg) ? 1 : 0;
        e = __builtin_amdgcn_readfirstlane(e);
        u.pm = rtg; u.pn = 4 * e + pnl; return true;
    }
    __device__ __forceinline__ void a_ready(const Unit&) const {}
    __device__ __forceinline__ void done(const Unit&) const {}
};

#define XB_TMO      128
#define XB_XCNT(j)  (256  + 64 * (j))
#define XB_XSUB(j)  (1280 + 64 * (j))
#define XB_XGEN(j)  (2304 + 64 * (j))
#define XB_TOP      3328
#define XB_TOPGEN   3392
#define XCD_BAR_WORDS 3456
#define XB_SPIN_CAP (1u << 18)

__device__ __forceinline__ unsigned xb_ld(unsigned* p)              { return __hip_atomic_load(p, __ATOMIC_RELAXED, __HIP_MEMORY_SCOPE_AGENT); }
__device__ __forceinline__ unsigned xb_add(unsigned* p, unsigned v) { return __hip_atomic_fetch_add(p, v, __ATOMIC_RELAXED, __HIP_MEMORY_SCOPE_AGENT); }
__device__ __forceinline__ unsigned xb_xcc_id() { return (unsigned)__builtin_amdgcn_s_getreg((3 << 11) | 20) & 0xFu; }
#define XB_SPIN(cond, bar) do { unsigned _sp = 0; while (cond) { __builtin_amdgcn_s_sleep(1); \
    if ((++_sp & 255u) == 0u) { if (xb_ld(&(bar)[XB_TMO])) break; if (_sp > XB_SPIN_CAP) { atomicAdd(&(bar)[XB_TMO], 1u); break; } } } } while (0)

struct XcdBarrier {
    unsigned* bar; unsigned x;
    volatile LAS unsigned* st;
};

__device__ __forceinline__ XcdBarrier xcd_barrier_post(unsigned* bar, volatile LAS unsigned* st) {
    XcdBarrier b; b.bar = bar; b.x = xb_xcc_id(); b.st = st;
    if (threadIdx.x == 0) (void)xb_add(&bar[XB_XCNT(b.x)], 1u);
    return b;
}
__device__ __forceinline__ void xcd_barrier_complete(unsigned* bar, unsigned x, unsigned& nloc, unsigned& nx) {
    const unsigned G = gridDim.x * gridDim.y * gridDim.z;
    unsigned sum, cnt, mine, sp = 0u;
    for (;;) {
        sum = 0u; cnt = 0u; mine = 0u;
#pragma unroll
        for (unsigned j = 0; j < 16; ++j) { const unsigned c = xb_ld(&bar[XB_XCNT(j)]); sum += c; cnt += (c > 0u) ? 1u : 0u; mine = (j == x) ? c : mine; }
        if (sum == G) break;
        __builtin_amdgcn_s_sleep(1);
        if ((++sp & 255u) == 0u) { if (xb_ld(&bar[XB_TMO])) break; if (sp > XB_SPIN_CAP) { atomicAdd(&bar[XB_TMO], 1u); break; } }
    }
    nloc = mine > 0u ? mine : 1u; nx = cnt > 0u ? cnt : 1u;
}

__device__ __forceinline__ void xcd_barrier(const XcdBarrier& b, int tid) {
    asm volatile("s_waitcnt vmcnt(0)" ::: "memory");
    __syncthreads();
    if (tid == 0) {
        unsigned* bar = b.bar;
        __builtin_amdgcn_s_waitcnt(0);
        unsigned nloc = b.st[0], nx = b.st[1];
        if (nloc == 0u) { xcd_barrier_complete(bar, b.x, nloc, nx); b.st[0] = nloc; b.st[1] = nx; }
        const unsigned old = xb_add(&bar[XB_XSUB(b.x)], 1u);
        const unsigned gen = old / nloc;
        if (old + 1u == (gen + 1u) * nloc) {
            __builtin_amdgcn_fence(__ATOMIC_RELEASE, "agent");
            asm volatile("s_waitcnt vmcnt(0)" ::: "memory");
            const unsigned og = xb_add(&bar[XB_TOP], 1u);
            const unsigned tg = og / nx;
            if (og + 1u == (tg + 1u) * nx) xb_add(&bar[XB_TOPGEN], 1u);
            else XB_SPIN(xb_ld(&bar[XB_TOPGEN]) == tg, bar);
            __builtin_amdgcn_fence(__ATOMIC_ACQUIRE, "agent");
            xb_add(&bar[XB_XGEN(b.x)], 1u);
            asm volatile("s_waitcnt vmcnt(0)" ::: "memory");
        } else {
            XB_SPIN(xb_ld(&bar[XB_XGEN(b.x)]) == gen, bar);
            __builtin_amdgcn_fence(__ATOMIC_ACQUIRE, "agent");
            asm volatile("s_waitcnt vmcnt(0)" ::: "memory");
        }
    }
    __syncthreads();
}

#include <hip/hip_bf16.h>
#include <cmath>
namespace attn_body {
using bf16=__hip_bfloat16;
using bf16x8=__attribute__((ext_vector_type(8)))short;
using s16x4=__attribute__((ext_vector_type(4)))short;
using f32x16=__attribute__((ext_vector_type(16)))float;
using u32x4=__attribute__((ext_vector_type(4)))unsigned;
constexpr int BATCH=8,NHEAD=8,SEQ=4096,D=64,DM=NHEAD*D,OPITCH=1024;
constexpr int NW=8,QBLK=32,QB=QBLK*NW,KVBLK=64,NQB=SEQ/QB;
constexpr int ATTN_PITCH=DM, ATTN_UNIT_ROWS=QB;
constexpr int BT_COPY=384, BT_BYTES=4*BT_COPY*4;
__device__ __forceinline__ int crow(int r,int hi){return (r&3)+8*(r>>2)+4*hi;}
#define SBAR() __builtin_amdgcn_sched_barrier(0)
constexpr int NSLOT=3, SLOTB=8192;
constexpr int LDS_K=0, LDS_V=NSLOT*SLOTB, LDS_WS=2*NSLOT*SLOTB, LDS_OST=LDS_WS+NW*64*4, LDS_BT=LDS_OST+NW*4096, LDS_BYTES=LDS_BT+BT_BYTES;
__device__ __forceinline__ void glds16(const void*gsrc,unsigned lds_dst){unsigned keep;
  asm volatile("s_mov_b32 %0, m0\n\ts_mov_b32 m0, %2\n\ts_nop 0\n\tglobal_load_lds_dwordx4 %1, off\n\ts_mov_b32 m0, %0":"=&s"(keep):"v"(gsrc),"s"(lds_dst):"memory");}
__device__ __forceinline__ float max3f(float a,float b,float c){float r;asm("v_max3_f32 %0, %1, %2, %3":"=v"(r):"v"(a),"v"(b),"v"(c));return r;}
__device__ __forceinline__ float max2f(float a,float b){float r;asm("v_max_f32_e32 %0, %1, %2":"=v"(r):"v"(a),"v"(b));return r;}
__device__ __forceinline__ float fadd_s(float a,float b){float r;asm("v_add_f32_e32 %0, %1, %2":"=v"(r):"v"(a),"v"(b));return r;}
__device__ __forceinline__ float fsub_s(float a,float b){float r;asm("v_sub_f32_e32 %0, %1, %2":"=v"(r):"v"(a),"v"(b));return r;}
typedef float f32x2_t __attribute__((ext_vector_type(2))); typedef float f32x4_t __attribute__((ext_vector_type(4))); typedef __bf16 bf16x2_t __attribute__((ext_vector_type(2)));
__device__ __forceinline__ unsigned cvtpk_s(float lo,float hi){f32x2_t v={lo,hi};bf16x2_t b=__builtin_convertvector(v,bf16x2_t);return __builtin_bit_cast(unsigned,b);}
#define WAIT_BAR(N) asm volatile("s_waitcnt vmcnt(" #N ") lgkmcnt(0)\n\ts_barrier":::"memory")

__device__ __forceinline__ void qkt(f32x16&p0,f32x16&p1,const char*Kslot,const bf16x8*qr,const f32x16&negm,int r32,int hi){
  const char*kb=Kslot+hi*1024+r32*16;
  #pragma unroll
  for(int d0=0;d0<4;++d0){
    const bf16x8 b0=*reinterpret_cast<const bf16x8*>(kb+d0*2048);
    const bf16x8 b1=*reinterpret_cast<const bf16x8*>(kb+d0*2048+512);
    if(d0==0){p0=__builtin_amdgcn_mfma_f32_32x32x16_bf16(b0,qr[0],negm,0,0,0);p1=__builtin_amdgcn_mfma_f32_32x32x16_bf16(b1,qr[0],negm,0,0,0);}
    else{p0=__builtin_amdgcn_mfma_f32_32x32x16_bf16(b0,qr[d0],p0,0,0,0);p1=__builtin_amdgcn_mfma_f32_32x32x16_bf16(b1,qr[d0],p1,0,0,0);}}
}
typedef __attribute__((address_space(3))) const char* lds_cptr;
typedef short v4i16_t __attribute__((ext_vector_type(4)));
__device__ __forceinline__ void kload8(bf16x8*kf,lds_cptr kp){
  kf[0]=*(const __attribute__((address_space(3))) bf16x8*)(kp);      kf[1]=*(const __attribute__((address_space(3))) bf16x8*)(kp+512);
  kf[2]=*(const __attribute__((address_space(3))) bf16x8*)(kp+2048); kf[3]=*(const __attribute__((address_space(3))) bf16x8*)(kp+2560);
  kf[4]=*(const __attribute__((address_space(3))) bf16x8*)(kp+4096); kf[5]=*(const __attribute__((address_space(3))) bf16x8*)(kp+4608);
  kf[6]=*(const __attribute__((address_space(3))) bf16x8*)(kp+6144); kf[7]=*(const __attribute__((address_space(3))) bf16x8*)(kp+6656);
}
__device__ __forceinline__ void kload2(bf16x8*kf,lds_cptr kp,int j){ kf[2*j]=*(const __attribute__((address_space(3))) bf16x8*)(kp+j*2048); kf[2*j+1]=*(const __attribute__((address_space(3))) bf16x8*)(kp+j*2048+512); }
__device__ __forceinline__ s16x4 vtr(lds_cptr p){ return __builtin_bit_cast(s16x4,__builtin_amdgcn_ds_read_tr16_b64_v4i16((__attribute__((address_space(3))) v4i16_t*)p)); }
__device__ __forceinline__ float rowmax(const f32x16&p0,const f32x16&p1){
  float a=max3f(p0[0],p0[1],p1[0]),b=max3f(p0[2],p0[3],p1[1]);a=max3f(a,p1[2],p1[3]);
  #pragma unroll
  for(int r=4;r<16;r+=4){a=max3f(a,p0[r],p0[r+1]);b=max3f(b,p0[r+2],p0[r+3]);a=max3f(a,p1[r],p1[r+1]);b=max3f(b,p1[r+2],p1[r+3]);}
  const float m=max2f(a,b);
  auto rr=__builtin_amdgcn_permlane32_swap(__float_as_uint(m),__float_as_uint(m),false,false);
  return max2f(__uint_as_float(rr[0]),__uint_as_float(rr[1]));
}
__device__ __forceinline__ void pv(f32x16*o,int vb,bf16x8 pa0,bf16x8 pa1,bf16x8 pa2,bf16x8 pa3){
  #pragma unroll
  for(int d0=0;d0<2;++d0){s16x4 lo[4],hi[4];
    #pragma unroll
    for(int ks=0;ks<4;++ks){
      asm volatile("ds_read_b64_tr_b16 %0,%1 offset:%c2":"=&v"(lo[ks]):"v"(vb),"i"(d0*4096+ks*1024):"memory");
      asm volatile("ds_read_b64_tr_b16 %0,%1 offset:%c2":"=&v"(hi[ks]):"v"(vb),"i"(d0*4096+ks*1024+512):"memory");}
    asm volatile("s_waitcnt lgkmcnt(0)":::"memory");SBAR();
    #define PK(k) (bf16x8){lo[k][0],lo[k][1],lo[k][2],lo[k][3],hi[k][0],hi[k][1],hi[k][2],hi[k][3]}
    o[d0]=__builtin_amdgcn_mfma_f32_32x32x16_bf16(pa0,PK(0),o[d0],0,0,0);
    o[d0]=__builtin_amdgcn_mfma_f32_32x32x16_bf16(pa1,PK(1),o[d0],0,0,0);
    o[d0]=__builtin_amdgcn_mfma_f32_32x32x16_bf16(pa2,PK(2),o[d0],0,0,0);
    o[d0]=__builtin_amdgcn_mfma_f32_32x32x16_bf16(pa3,PK(3),o[d0],0,0,0);
    #undef PK
  }
}

#ifndef ATTN_STORE16
#define ATTN_STORE16(p,v) (*(u32x4*)(p)=(v))
#endif
__device__ __forceinline__ void attn_unit(int b,int h,int qb,const bf16*Q,const bf16*K,const bf16*V,bf16*O,char*shm,float cinit,int tid){
  asm volatile("":"+v"(tid));
  const int lane=tid&63,r32=lane&31,hi=lane>>5; const int wid=__builtin_amdgcn_readfirstlane(tid>>6);
  const long rowbase=(long)b*SEQ; const int q0=qb*QB;
  const bf16*Qw=Q+(rowbase+q0+wid*QBLK)*DM+h*D;
  const int t0=(4*qb-8)>0?(4*qb-8):0;
  const bf16*Kh=K+(rowbase+(long)t0*KVBLK)*DM+h*D,*Vh=V+(rowbase+(long)t0*KVBLK)*DM+h*D;
  const int tb=t0-4*qb-(wid>>1)+8;
  const unsigned lds0=(unsigned)(uintptr_t)shm;
  float*wsf=(float*)(shm+LDS_WS)+wid*64;
  const bf16*ksrc=Kh+(long)lane*DM+wid*8;
  const bf16*vsrc=Vh+(long)(16*(wid&3)+(lane>>2))*DM+(wid>>2)*32+(lane&3)*8;
  const unsigned kdst=lds0+LDS_K+wid*1024, vdst=lds0+LDS_V+wid*1024;
  #define DMA_K(t,slot) glds16(ksrc+(long)(t)*KVBLK*DM,(unsigned)__builtin_amdgcn_readfirstlane(kdst+(slot)))
  #define DMA_V(t,slot) glds16(vsrc+(long)(t)*KVBLK*DM,(unsigned)__builtin_amdgcn_readfirstlane(vdst+(slot)))
  const int vb0=(int)(lds0+LDS_V)+((lane>>4)&1)*32+(lane&3)*8+(4*hi+((lane&15)>>2))*64;
  const char*Kbase=shm+LDS_K; bf16x8 kf[8];
  const lds_cptr shm3=(lds_cptr)shm; const lds_cptr kp0=shm3+LDS_K+hi*1024+r32*16; const lds_cptr vp0=shm3+LDS_V+((lane>>4)&1)*32+(lane&3)*8+(4*hi+((lane&15)>>2))*64;
  const int NT=4*qb+4-t0;
  const lds_cptr btl=shm3+LDS_BT+((3-r32)&3)*(BT_COPY*4)+4*(-193-32*(wid&1)-r32-((3-r32)&3)+4*hi);
  DMA_K(0,0);DMA_V(0,0);DMA_K(1,SLOTB);
  bf16x8 qr[4];
  #pragma unroll
  for(int d0=0;d0<4;++d0)qr[d0]=*reinterpret_cast<const bf16x8*>(&Qw[(long)r32*DM+d0*16+hi*8]);
  float l_reg=0.f;f32x16 o[2];o[0]=f32x16{};o[1]=f32x16{};f32x16 negm;
  asm volatile("":"+s"(cinit));
  _Pragma("unroll") for(int r=0;r<16;++r)negm[r]=cinit; asm volatile("":"+v"(negm));
  #define BIASMASK(P0,P1,t) do{ const int tau_=(t)+tb; \
    if(tau_<0||tau_>8){ _Pragma("unroll") for(int r=0;r<16;++r){P0[r]=-INFINITY;P1[r]=-INFINITY;} } \
    else if(tau_>=4){ const lds_cptr bp_=btl+256*tau_; \
      _Pragma("unroll") for(int g=0;g<4;++g){ const f32x4_t d0_=*(const __attribute__((address_space(3))) f32x4_t*)(bp_+32*g), d1_=*(const __attribute__((address_space(3))) f32x4_t*)(bp_+32*g+128); \
        _Pragma("unroll") for(int j=0;j<4;++j){P0[4*g+j]+=d0_[j];P1[4*g+j]+=d1_[j];} } } }while(0)
  #define START(P0,P1) do{ _Pragma("unroll") for(int r=0;r<16;++r)P0[r]=__builtin_amdgcn_exp2f(P0[r]); }while(0)
  #define RESC() do{}while(0)
  f32x16 pA0,pA1,pB0,pB1;
  int sl_prev=0,sl_cur=0,sl_next=SLOTB;
  #define ROT() do{sl_prev=sl_cur;sl_cur=sl_next;sl_next=(sl_next==(NSLOT-1)*SLOTB)?0:sl_next+SLOTB;}while(0)
  DMA_K(2,2*SLOTB);
  WAIT_BAR(3);
  qkt(pA0,pA1,Kbase,qr,negm,r32,hi);asm volatile("s_nop 15\n\ts_nop 7":"+v"(pA0),"+v"(pA1));BIASMASK(pA0,pA1,0);
  START(pA0,pA1);
  _Pragma("unroll") for(int r=0;r<16;++r)pA1[r]=__builtin_amdgcn_exp2f(pA1[r]);
  WAIT_BAR(0);
  DMA_K(3,0);DMA_V(1,SLOTB);
  ROT();
  kload8(kf,kp0+sl_cur);
  WAIT_BAR(2);
  s16x4 vlo[8],vhi[8]; u32x4 pw0,pw1,pw2,pw3;
  #define PKW(P,B) cvtpk_s(P[B],P[B+1])
  #define PAF(k) __builtin_bit_cast(bf16x8,pw##k)
  #define VFR(i) (bf16x8){vlo[i][0],vlo[i][1],vlo[i][2],vlo[i][3],vhi[i][0],vhi[i][1],vhi[i][2],vhi[i][3]}
  #define PIN(x) asm volatile("":"+v"(x))
  #define MX3(a,b,c) __builtin_fmaxf(__builtin_fmaxf((a),(b)),(c))
  #define GAPA(MF,A0,A1,A2,A3,W0,W1,PW) do{ MF; sacc+=A0; sacc+=A1; sacc+=A2; sacc+=A3; PIN(sacc); W0; W1; PIN(PW); SBAR(); }while(0)
  #define EX(v) __builtin_amdgcn_exp2f(v)
  #define GAPB(MF,X,B) do{ MF; X[B]=EX(X[B]); X[B+1]=EX(X[B+1]); X[B+2]=EX(X[B+2]); X[B+3]=EX(X[B+3]); PIN(X); SBAR(); }while(0)
  #define VRD(i) do{ vlo[i]=vtr(vp_+(((i)>>2)*4096+((i)&3)*1024)); vhi[i]=vtr(vp_+(((i)>>2)*4096+((i)&3)*1024+512)); }while(0)
  #define KRD(G,j) do{ if(G){ kload2(kf,kp0+sl_next,j); SBAR(); } }while(0)
  #define STEP(C0,C1,P0,P1,t,GK,GV,GL) do{ SBAR(); \
    const lds_cptr vp_=vp0+sl_prev; \
    VRD(0); SBAR(); float sacc=(P0[0]+P0[1]); \
    GAPA(C0=__builtin_amdgcn_mfma_f32_32x32x16_bf16(kf[0],qr[0],negm,0,0,0), P0[2],P0[3],P0[4],P0[5],     pw0[0]=PKW(P0,0), pw0[1]=PKW(P0,2), pw0); \
    VRD(4); SBAR(); GAPA(C1=__builtin_amdgcn_mfma_f32_32x32x16_bf16(kf[1],qr[0],negm,0,0,0), P0[6],P0[7],P0[8],P0[9],     pw0[2]=PKW(P0,4), pw0[3]=PKW(P0,6), pw0); \
    VRD(1); SBAR(); GAPA(C0=__builtin_amdgcn_mfma_f32_32x32x16_bf16(kf[2],qr[1],C0,0,0,0),   P0[10],P0[11],P0[12],P0[13], pw1[0]=PKW(P0,8), pw1[1]=PKW(P0,10), pw1); \
    VRD(5); SBAR(); GAPA(C1=__builtin_amdgcn_mfma_f32_32x32x16_bf16(kf[3],qr[1],C1,0,0,0),   P0[14],P0[15],P1[0],P1[1],   pw1[2]=PKW(P0,12),pw1[3]=PKW(P0,14), pw1); \
    VRD(2); SBAR(); GAPA(C0=__builtin_amdgcn_mfma_f32_32x32x16_bf16(kf[4],qr[2],C0,0,0,0),   P1[2],P1[3],P1[4],P1[5],     pw2[0]=PKW(P1,0), pw2[1]=PKW(P1,2), pw2); \
    VRD(6); SBAR(); GAPA(C1=__builtin_amdgcn_mfma_f32_32x32x16_bf16(kf[5],qr[2],C1,0,0,0),   P1[6],P1[7],P1[8],P1[9],     pw2[2]=PKW(P1,4), pw2[3]=PKW(P1,6), pw2); \
    VRD(3); SBAR(); GAPA(C0=__builtin_amdgcn_mfma_f32_32x32x16_bf16(kf[6],qr[3],C0,0,0,0),   P1[10],P1[11],P1[12],P1[13], pw3[0]=PKW(P1,8), pw3[1]=PKW(P1,10), pw3); \
    VRD(7); SBAR(); GAPA(C1=__builtin_amdgcn_mfma_f32_32x32x16_bf16(kf[7],qr[3],C1,0,0,0),   P1[14],P1[15],0.f,0.f,       pw3[2]=PKW(P1,12),pw3[3]=PKW(P1,14), pw3); \
    l_reg+=sacc; \
    if(GK){DMA_K((t)+3,sl_cur);} if(GV){DMA_V((t)+1,sl_next);} \
    BIASMASK(C0,C1,t); \
    SBAR(); \
    GAPB(o[0]=__builtin_amdgcn_mfma_f32_32x32x16_bf16(PAF(0),VFR(0),o[0],0,0,0), C0,0); \
    GAPB(o[1]=__builtin_amdgcn_mfma_f32_32x32x16_bf16(PAF(0),VFR(4),o[1],0,0,0), C0,4); \
    KRD(GL,0); GAPB(o[0]=__builtin_amdgcn_mfma_f32_32x32x16_bf16(PAF(1),VFR(1),o[0],0,0,0), C0,8); \
    KRD(GL,1); GAPB(o[1]=__builtin_amdgcn_mfma_f32_32x32x16_bf16(PAF(1),VFR(5),o[1],0,0,0), C0,12); \
    KRD(GL,2); GAPB(o[0]=__builtin_amdgcn_mfma_f32_32x32x16_bf16(PAF(2),VFR(2),o[0],0,0,0), C1,0); \
    KRD(GL,3); GAPB(o[1]=__builtin_amdgcn_mfma_f32_32x32x16_bf16(PAF(2),VFR(6),o[1],0,0,0), C1,4); \
    GAPB(o[0]=__builtin_amdgcn_mfma_f32_32x32x16_bf16(PAF(3),VFR(3),o[0],0,0,0), C1,8); \
    GAPB(o[1]=__builtin_amdgcn_mfma_f32_32x32x16_bf16(PAF(3),VFR(7),o[1],0,0,0), C1,12); \
    }while(0)
  int t=1;
  for(;t+5<NT;t+=2){
    STEP(pB0,pB1,pA0,pA1,t,true,true,true);     WAIT_BAR(2); RESC(); ROT();
    STEP(pA0,pA1,pB0,pB1,t+1,true,true,true);   WAIT_BAR(2); RESC(); ROT();
  }
  #define ENDW(tt) do{ if((tt)+3<NT){WAIT_BAR(2);} else if((tt)+2<NT){WAIT_BAR(1);} else {WAIT_BAR(0);} }while(0)
  for(;t+1<NT;t+=2){
    STEP(pB0,pB1,pA0,pA1,t,(t+3<NT),(t+1<NT),(t+1<NT));       ENDW(t);   RESC(); ROT();
    STEP(pA0,pA1,pB0,pB1,t+1,(t+4<NT),(t+2<NT),(t+2<NT));     ENDW(t+1); RESC(); ROT();
  }
  STEP(pB0,pB1,pA0,pA1,NT-1,false,false,false); RESC();
  { float sacc=pB0[0]+pB0[1]; _Pragma("unroll") for(int r=2;r<16;++r)sacc+=pB0[r]; _Pragma("unroll") for(int r=0;r<16;++r)sacc+=pB1[r]; l_reg+=sacc;
    pw0=(u32x4){PKW(pB0,0),PKW(pB0,2),PKW(pB0,4),PKW(pB0,6)};pw1=(u32x4){PKW(pB0,8),PKW(pB0,10),PKW(pB0,12),PKW(pB0,14)};pw2=(u32x4){PKW(pB1,0),PKW(pB1,2),PKW(pB1,4),PKW(pB1,6)};pw3=(u32x4){PKW(pB1,8),PKW(pB1,10),PKW(pB1,12),PKW(pB1,14)};
    SBAR(); pv(o,vb0+sl_cur,PAF(0),PAF(1),PAF(2),PAF(3)); }
  #undef PKW
  #undef PAF
  #undef VFR
  #undef PIN
  #undef MX3
  #undef GAPA
  #undef GAPB
  #undef EX
  #undef VRD
  #undef KRD
  #undef STEP
  #undef ENDW
  {auto rr=__builtin_amdgcn_permlane32_swap(__float_as_uint(l_reg),__float_as_uint(l_reg),false,false);l_reg=__uint_as_float(rr[0])+__uint_as_float(rr[1]);}
  if(hi==0)wsf[32+r32]=l_reg;asm volatile("s_waitcnt lgkmcnt(0)":::"memory");
  float rli[16];
  #pragma unroll
  for(int r=0;r<16;++r)rli[r]=__builtin_amdgcn_rcpf(wsf[32+crow(r,hi)]);
  bf16*Ow=O+(rowbase+q0+wid*QBLK)*OPITCH+h*D;
  { bf16*stg=(bf16*)(shm+LDS_OST)+wid*2048;
    #pragma unroll
    for(int r=0;r<16;++r){const int orow=crow(r,hi);
      #pragma unroll
      for(int d0=0;d0<2;++d0)stg[orow*64+d0*32+r32]=__float2bfloat16(o[d0][r]*rli[r]);}
    asm volatile("s_waitcnt lgkmcnt(0)":::"memory");
    #pragma unroll
    for(int i=0;i<4;++i){const int row=i*8+(lane>>3),ch=lane&7; const u32x4 v=*(const u32x4*)(stg+row*64+ch*8); ATTN_STORE16(Ow+(long)row*OPITCH+ch*8,v);} }
  asm volatile("s_waitcnt lgkmcnt(0)\n\ts_barrier":::"memory");
  #undef DMA_K
  #undef DMA_V
  #undef BIASMASK
  #undef START
  #undef RESC
  #undef ROT
}
constexpr int ATTN_LDS_BYTES=LDS_BYTES;
struct AttnUnit { int bh; int qb; };
__device__ __forceinline__ void attn_phase(char*lds,const bf16*Q,const bf16*K,const bf16*V,bf16*O,const float*gtab,const float*gcinit,int grid,int block,int tid){
  const int vcu=(block%8)*(grid/8)+block/8, s_=vcu&3, bh=vcu>>2, h=bh&7, b=bh>>3;
  { const f32x4_t* src=(const f32x4_t*)(gtab+(size_t)h*(4*BT_COPY)); __attribute__((address_space(3))) f32x4_t* dst=(__attribute__((address_space(3))) f32x4_t*)((lds_cptr)lds+LDS_BT);
    if(tid<BT_BYTES/16)dst[tid]=src[tid]; }
  const float cinit=__builtin_bit_cast(float,__builtin_amdgcn_readfirstlane(__builtin_bit_cast(int,gcinit[h])));
  asm volatile("s_waitcnt vmcnt(0) lgkmcnt(0)\n\ts_barrier":::"memory");
  for(int i=0;i<4;++i){ const int qb=(i==0)?s_:(i==1)?7-s_:(i==2)?8+s_:15-s_; attn_unit(b,h,qb,Q,K,V,O,lds,cinit,tid); }
}
#undef SBAR
#undef WAIT_BAR
}

struct Args {
    const float *x, *p, *g_mix, *w_in, *b_in, *g_q, *g_k, *rel_bias, *conv_w, *conv_b, *w_pa, *w_pc, *w_o, *g_ffn, *w_group, *b_group, *w_router, *b_router, *w1, *w3, *w2, *g_ple, *w_pg, *b_pg, *w_pp;
    float* out; unsigned char* ws;
};
constexpr int NWAVES = 8, NTHREADS = 512;
constexpr int RING_BYTES = 131072, MISC_OFF = RING_BYTES;
constexpr int LDS_BYTES = 147456;

__device__ __forceinline__ void transpose_item(const float* src, int ldw, bf16_t* dst, int ldT, LAS float* scr, int lane, const float* gain = nullptr) {
    float v[32];
#pragma unroll
    for (int i = 0; i < 32; ++i) { const int kk = 2 * i + (lane >> 5); v[i] = src[(size_t)kk * ldw + (lane & 31)]; }
    if (gain) {
#pragma unroll
        for (int i = 0; i < 32; ++i) v[i] *= gain[2 * i + (lane >> 5)];
    }
#pragma unroll
    for (int i = 0; i < 32; ++i) { const int kk = 2 * i + (lane >> 5); scr[kk * 33 + (lane & 31)] = v[i]; }
    LDS_WAIT(); asm volatile("" ::: "memory");
    const int c = lane & 7;
#pragma unroll
    for (int j = 0; j < 4; ++j) { const int n = (lane >> 3) + 8 * j; const LAS float* s = scr + (8 * c) * 33 + n;
        u32x4 o; o.x = pk2(s[0 * 33], s[1 * 33]); o.y = pk2(s[2 * 33], s[3 * 33]); o.z = pk2(s[4 * 33], s[5 * 33]); o.w = pk2(s[6 * 33], s[7 * 33]);
        *(u32x4*)(dst + (size_t)n * ldT + 8 * c) = o; }
    LDS_WAIT(); asm volatile("" ::: "memory");
}
__device__ __forceinline__ int win_phys_row(int n) { const int l = n & 255; return (n & ~255) | (((l >> 5) & 1) << 7) | (((l >> 6) & 3) << 5) | (l & 31); }

__device__ __forceinline__ void rms_row2_to_bf16(const float* xrow, const float* g, bf16_t* orow, int lane) {
    const f32x4* xr = (const f32x4*)xrow + lane; const f32x4* gr = (const f32x4*)g + lane;
    f32x4 v[2][4]; float s0 = 0.f, s1 = 0.f;
#pragma unroll
    for (int j = 0; j < 4; ++j) { v[0][j] = xr[64 * j]; v[1][j] = xr[256 + 64 * j]; }
#pragma unroll
    for (int j = 0; j < 4; ++j) { s0 += (v[0][j].x * v[0][j].x + v[0][j].y * v[0][j].y) + (v[0][j].z * v[0][j].z + v[0][j].w * v[0][j].w); s1 += (v[1][j].x * v[1][j].x + v[1][j].y * v[1][j].y) + (v[1][j].z * v[1][j].z + v[1][j].w * v[1][j].w); }
    const float r0 = rsqrtf(wave_sum(s0) * (1.f / D) + EPS), r1 = rsqrtf(wave_sum(s1) * (1.f / D) + EPS);
    unsigned long long* o8 = (unsigned long long*)orow + lane;
#pragma unroll
    for (int j = 0; j < 4; ++j) { const f32x4 gg = gr[64 * j];
        o8[64 * j] = (unsigned long long)pk2(v[0][j].x * r0 * gg.x, v[0][j].y * r0 * gg.y) | ((unsigned long long)pk2(v[0][j].z * r0 * gg.z, v[0][j].w * r0 * gg.w) << 32);
        o8[256 + 64 * j] = (unsigned long long)pk2(v[1][j].x * r1 * gg.x, v[1][j].y * r1 * gg.y) | ((unsigned long long)pk2(v[1][j].z * r1 * gg.z, v[1][j].w * r1 * gg.w) << 32); }
}

#ifndef FAST_G1
#define FAST_G1 1
#endif
#ifndef FAST_ATTN
#define FAST_ATTN 1
#endif
#ifndef FAST_G2
#define FAST_G2 1
#endif
#ifndef FAST_G3
#define FAST_G3 1
#endif
#ifndef FAST_G4
#define FAST_G4 1
#endif
#ifndef FAST_G5
#define FAST_G5 1
#endif
#ifndef FAST_G6
#define FAST_G6 1
#endif

template <class BRow>
__device__ __forceinline__ void naive_tile(const bf16_t* A, int lda, int K, BRow brow, LAS float* tile, bool accumulate) {
    const int tid = threadIdx.x, tr = tid >> 4, tc = tid & 15;
    float acc[2][4] = {{0.f, 0.f, 0.f, 0.f}, {0.f, 0.f, 0.f, 0.f}};
    const bf16_t* a0 = A + (size_t)(2 * tr) * lda; const bf16_t* a1 = a0 + lda;
    const bf16_t* b[4];
#pragma unroll
    for (int j = 0; j < 4; ++j) b[j] = brow(4 * tc + j);
    for (int k = 0; k < K; k += 8) {
        const u32x4 av0 = *(const u32x4*)(a0 + k), av1 = *(const u32x4*)(a1 + k);
#pragma unroll
        for (int j = 0; j < 4; ++j) {
            const u32x4 bv = *(const u32x4*)(b[j] + k);
#pragma unroll
            for (int e = 0; e < 4; ++e) {
                const float bl = bf_lo(bv[e]), bh = bf_hi(bv[e]);
                acc[0][j] += bf_lo(av0[e]) * bl + bf_hi(av0[e]) * bh;
                acc[1][j] += bf_lo(av1[e]) * bl + bf_hi(av1[e]) * bh;
            }
        }
    }
#pragma unroll
    for (int r = 0; r < 2; ++r)
#pragma unroll
        for (int j = 0; j < 4; ++j) { LAS float* t = tile + (2 * tr + r) * 65 + 4 * tc + j; *t = accumulate ? (*t + acc[r][j]) : acc[r][j]; }
}


typedef __attribute__((address_space(4))) const Args* KArgPtr;
__device__ __forceinline__ KArgPtr kargs() { KArgPtr p = (KArgPtr)__builtin_amdgcn_kernarg_segment_ptr(); asm volatile("" : "+s"(p)); return p; }
#define ctl ((unsigned*)(ws + WS_CTL))
#define wrt ((float*)(ws + WS_TAB))
#define rt_e ((int*)(ws + WS_ROUTE))
#define rt_pos (rt_e + 2 * T)
#define rt_w ((float*)(rt_pos + 2 * T))
#define row_slot ((int*)(ws + WS_ROWMETA))
#define row_w ((float*)(row_slot + XS_ROWS))
#define Win_t ((bf16_t*)(ws + WS_WIN))
#define Wm_t ((bf16_t*)(ws + WS_WM))
#define Wo_t ((bf16_t*)(ws + WS_WO))
#define Wpg_t ((bf16_t*)(ws + WS_WPG))
#define Wpp_t ((bf16_t*)(ws + WS_WPP))
#define pb ((bf16_t*)(ws + WS_PB))
#define nbuf ((bf16_t*)(ws + WS_NBUF))
#define qb ((bf16_t*)(ws + WS_Q))
#define kb ((bf16_t*)(ws + WS_K))
#define vb ((bf16_t*)(ws + WS_V))
#define ub ((bf16_t*)(ws + WS_U))
#define bgb ((bf16_t*)(ws + WS_BG))
#define cgb ((bf16_t*)(ws + WS_CG))
#define sga ((bf16_t*)(ws + WS_SGA))
#define sgc ((bf16_t*)(ws + WS_SGC))
#define yac ((bf16_t*)(ws + WS_YAC))
#define mbuf ((bf16_t*)(ws + WS_M))
#define W13_t ((bf16_t*)(ws + WS_W13))
#define W2_t ((bf16_t*)(ws + WS_W2))
#define xs ((bf16_t*)(ws + WS_XS))
#define hdn ((bf16_t*)(ws + WS_HDN))
#define contrib ((bf16_t*)(ws + WS_CONTRIB))
#define ppb ((bf16_t*)(ws + WS_PP))
#define tile0 ((LAS float*)lds)
#define tile1 (tile0 + 64 * 65)
#define pref ((LAS int*)(lds + MISC_OFF))
#define cnts (pref + 64)
__global__ void __launch_bounds__(NTHREADS, 2) fwd_kernel(Args a) {
    extern __shared__ __attribute__((aligned(16))) unsigned char lds_raw[];
    cg::grid_group grid = cg::this_grid();
    LAS unsigned char* lds = (LAS unsigned char*)lds_raw;
    const int G = gridDim.x, bx = blockIdx.x;
    const int wave_s = __builtin_amdgcn_readfirstlane((int)threadIdx.x >> 6);
    volatile LAS unsigned* bst = (volatile LAS unsigned*)(lds + MISC_OFF + 512);
    if (threadIdx.x < 2) bst[threadIdx.x] = 0u;
    __syncthreads();
    const XcdBarrier bar = xcd_barrier_post((unsigned*)(a.ws + WS_CTL) + CW_BAR, bst);
#define XBAR() do { int t_ = (wave_s << 6) | lane_id_fresh(); xcd_barrier(bar, t_); } while (0)
#define PHASE_VARS() const KArgPtr ap = kargs(); unsigned char* const ws = ap->ws; (void)ws; int tid = (wave_s << 6) | lane_id_fresh(); asm volatile("" : "+v"(tid)); const int lane = tid & 63, wave = __builtin_amdgcn_readfirstlane(tid >> 6); \
    const int gw = bx * NWAVES + wave, NGW = G * NWAVES; const size_t gtid = (size_t)bx * NTHREADS + tid, GT = (size_t)G * NTHREADS; (void)lane; (void)gw; (void)NGW; (void)gtid; (void)GT
    {
        PHASE_VARS();
        LAS float* scr = (LAS float*)(lds + wave * 16384);
        constexpr int I_IN = 16 * 160, I_PA = 8 * 32, I_PC = 8 * 32, I_O = 16 * 32, I_PG = 16 * 32, I_PP = 4 * 32;
        constexpr int NIT = I_IN + I_PA + I_PC + I_O + I_PG + I_PP;
        for (int it = gw; it < NIT; it += NGW) {
            int r = it;
            if (r < I_IN) { const int kb_ = r / 160, nb = r % 160; transpose_item(ap->w_in + (size_t)(kb_ * 64) * NIN + nb * 32, NIN, Win_t + (size_t)win_phys_row(nb * 32) * D + kb_ * 64, D, scr, lane); continue; } r -= I_IN;
            if (r < I_PA) { const int kb_ = r / 32, nb = r % 32; transpose_item(ap->w_pa + (size_t)(kb_ * 64) * D + nb * 32, D, Wm_t + (size_t)(nb * 32) * D + kb_ * 64, D, scr, lane); continue; } r -= I_PA;
            if (r < I_PC) { const int kb_ = r / 32, nb = r % 32; transpose_item(ap->w_pc + (size_t)(kb_ * 64) * D + nb * 32, D, Wm_t + (size_t)(nb * 32) * D + 512 + kb_ * 64, D, scr, lane); continue; } r -= I_PC;
            if (r < I_O) { const int kb_ = r / 32, nb = r % 32; transpose_item(ap->w_o + (size_t)(kb_ * 64) * D + nb * 32, D, Wo_t + (size_t)(nb * 32) * D + kb_ * 64, D, scr, lane); continue; } r -= I_O;
            if (r < I_PG) { const int kb_ = r / 32, nb = r % 32; transpose_item(ap->w_pg + (size_t)(kb_ * 64) * D + nb * 32, D, Wpg_t + (size_t)(nb * 32) * D + kb_ * 64, D, scr, lane, ap->g_ple + kb_ * 64); continue; } r -= I_PG;
            { const int kb_ = r / 32, nb = r % 32; transpose_item(ap->w_pp + (size_t)(kb_ * 64) * D + nb * 32, D, Wpp_t + (size_t)(nb * 32) * PLE + kb_ * 64, PLE, scr, lane); }
        }
        for (size_t i = gtid; i < (size_t)3 * 64 * 64 * 4; i += GT) { const int j = (int)(i & 3), ln = (int)((i >> 2) & 63), s_ = (int)((i >> 8) & 63), nt = (int)(i >> 14);
            const int k = 16 * s_ + 4 * (ln >> 4) + j, col = 16 * nt + (ln & 15);
            wrt[i] = col < 4 ? ap->w_group[k * 4 + col] : (col < 36 ? ap->w_router[k * 32 + (col - 4)] : 0.f); }
        { float* gtab = (float*)(ws + WS_GTAB); float* gcinit = (float*)(ws + WS_GCINIT);
          for (size_t i = gtid; i < (size_t)NH * 4 * 384; i += GT) { const int h = (int)(i / 1536), s_ = (int)((i / 384) & 3), y = (int)(i % 384), x = y + s_;
              int dd = 319 - x; dd = dd < -63 ? -63 : (dd > 256 ? 256 : dd);
              gtab[i] = x <= 382 ? (ap->rel_bias[h * NREL + dd + 63] - ap->rel_bias[h * NREL + 319]) * LOG2E : 0.f; }
          if (gtid < NH) { const int h = (int)gtid; float gq = 0.f, gk = 0.f, mb = -3.0e38f;
              for (int d = 0; d < HD; ++d) { gq = fmaxf(gq, fabsf(ap->g_q[d])); gk = fmaxf(gk, fabsf(ap->g_k[d])); }
              for (int d = 0; d < NREL; ++d) mb = fmaxf(mb, ap->rel_bias[h * NREL + d]);
              gcinit[h] = ap->rel_bias[h * NREL + 319] * LOG2E - (64.f * C2 * gq * gk + mb * LOG2E); } }
        for (int m = 2 * gw; m < T; m += 2 * NGW) rms_row2_to_bf16(ap->x + (size_t)m * D, ap->g_mix, nbuf + (size_t)m * D, lane);
        for (size_t i = gtid; i < (size_t)T * PLE / 8; i += GT) { const f32x4 v0 = ((const f32x4*)ap->p)[2 * i], v1 = ((const f32x4*)ap->p)[2 * i + 1];
            u32x4 o; o.x = pk2(v0.x, v0.y); o.y = pk2(v0.z, v0.w); o.z = pk2(v1.x, v1.y); o.w = pk2(v1.z, v1.w); ((u32x4*)pb)[i] = o; }
    }
    grid.sync();

#if FAST_G1
    { PHASE_VARS(); pg8::Gemm g{nbuf, Win_t, T, NIN, D, D}; pg8::StaticOrder S; S.init(T, NIN, G, bx); EpiInproj E{ws, ap->b_in, ap->g_q, ap->g_k};
      pg8::gemm_phase<EpiInproj, pg8::StaticOrder, true, true>(lds, g, S, E, tid); }
#else
    { PHASE_VARS();
    for (int tl = bx; tl < 512 * 80; tl += G) {
        const int rt = tl / 80, ct = tl % 80;
        naive_tile(nbuf + (size_t)rt * 64 * D, D, D, [=](int i) { return (const bf16_t*)(Win_t + (size_t)win_phys_row(64 * ct + i) * D); }, tile0, false);
        __syncthreads();
        const int row = tid >> 3, c8 = (tid & 7) * 8; float v[8]; float ss = 0.f;
#pragma unroll
        for (int j = 0; j < 8; ++j) { v[j] = tile0[row * 65 + c8 + j] + ap->b_in[64 * ct + c8 + j]; ss += v[j] * v[j]; }
        ss += __shfl_xor(ss, 1); ss += __shfl_xor(ss, 2); ss += __shfl_xor(ss, 4);
        bf16_t* dst;
        if (ct < 48) { const int seg = ct >> 3; dst = (bf16_t*)(ws + WS_Q + (size_t)seg * (32 * MiB)) + (size_t)(rt * 64 + row) * 512 + 64 * (ct & 7) + c8;
            if (seg < 2) { const float rstd = rsqrtf(ss * (1.f / 64.f) + EPS) * (seg == 0 ? C2 : 1.f); const float* g = seg == 0 ? ap->g_q : ap->g_k;
#pragma unroll
                for (int j = 0; j < 8; ++j) v[j] = v[j] * rstd * g[c8 + j]; } }
        else { dst = (ct < 64 ? sga : sgc) + (size_t)(rt * 64 + row) * D + 64 * ((ct - 48) & 15) + c8;
#pragma unroll
            for (int j = 0; j < 8; ++j) v[j] = sigmoidf_(v[j]); }
        u32x4 o; o.x = pk2(v[0], v[1]); o.y = pk2(v[2], v[3]); o.z = pk2(v[4], v[5]); o.w = pk2(v[6], v[7]); *(u32x4*)dst = o;
        __syncthreads();
    } }
#endif
    XBAR();

    {
        PHASE_VARS();
        for (size_t i = gtid; i < (size_t)T * (CW / 8); i += GT) {
            const int t = (int)(i >> 6), c8 = (int)(i & 63) * 8, s = t & (SEQ - 1);
            const size_t o = (size_t)t * CW + c8;
            const u32x4 u0 = *(const u32x4*)(ub + o), g0 = *(const u32x4*)(cgb + o), b0 = *(const u32x4*)(bgb + o);
            u32x4 u1 = {0u, 0u, 0u, 0u}, g1 = u1, u2 = u1, g2 = u1;
            if (s >= 1) { u1 = *(const u32x4*)(ub + o - CW); g1 = *(const u32x4*)(cgb + o - CW); }
            if (s >= 2) { u2 = *(const u32x4*)(ub + o - 2 * CW); g2 = *(const u32x4*)(cgb + o - 2 * CW); }
            float y[8];
#pragma unroll
            for (int e = 0; e < 4; ++e) {
#pragma unroll
                for (int hh = 0; hh < 2; ++hh) {
                    const int c = c8 + 2 * e + hh;
                    const float cu0 = hh ? bf_hi(u0[e]) * bf_hi(g0[e]) : bf_lo(u0[e]) * bf_lo(g0[e]);
                    const float cu1 = hh ? bf_hi(u1[e]) * bf_hi(g1[e]) : bf_lo(u1[e]) * bf_lo(g1[e]);
                    const float cu2 = hh ? bf_hi(u2[e]) * bf_hi(g2[e]) : bf_lo(u2[e]) * bf_lo(g2[e]);
                    const float bgv = hh ? bf_hi(b0[e]) : bf_lo(b0[e]);
                    y[2 * e + hh] = bgv * (ap->conv_b[c] + ap->conv_w[c] * cu2 + ap->conv_w[CW + c] * cu1 + ap->conv_w[2 * CW + c] * cu0);
                }
            }
            u32x4 w; w.x = pk2(y[0], y[1]); w.y = pk2(y[2], y[3]); w.z = pk2(y[4], y[5]); w.w = pk2(y[6], y[7]);
            *(u32x4*)(yac + (size_t)t * D + 512 + c8) = w;
        }
#if FAST_ATTN
        __syncthreads();
        attn_body::attn_phase((char*)lds_raw, (const attn_body::bf16*)qb, (const attn_body::bf16*)kb, (const attn_body::bf16*)vb, (attn_body::bf16*)yac, (const float*)(ws + WS_GTAB), (const float*)(ws + WS_GCINIT), G, bx, tid);
#else
        for (size_t i = gtid; i < (size_t)T * NH; i += GT) {
            const int h = (int)(i / T), t = (int)(i % T), s = t & (SEQ - 1), tb = t - s, c = s >> 6;
            float q[64], o[64];
#pragma unroll
            for (int d8 = 0; d8 < 8; ++d8) { const u32x4 w = *(const u32x4*)(qb + (size_t)t * AW + h * 64 + d8 * 8);
#pragma unroll
                for (int e = 0; e < 4; ++e) { q[d8 * 8 + 2 * e] = bf_lo(w[e]); q[d8 * 8 + 2 * e + 1] = bf_hi(w[e]); } }
#pragma unroll
            for (int d = 0; d < 64; ++d) o[d] = 0.f;
            float mrun = -1e30f, l = 0.f;
            int k0 = (c - 8) * 64; if (k0 < 0) k0 = 0;
            const int k1 = c * 64 + 63;
            for (int kp = k0; kp <= k1; ++kp) {
                const bf16_t* kr = kb + (size_t)(tb + kp) * AW + h * 64; float sc = 0.f;
#pragma unroll
                for (int d8 = 0; d8 < 8; ++d8) { const u32x4 w = *(const u32x4*)(kr + d8 * 8);
#pragma unroll
                    for (int e = 0; e < 4; ++e) sc += q[d8 * 8 + 2 * e] * bf_lo(w[e]) + q[d8 * 8 + 2 * e + 1] * bf_hi(w[e]); }
                int dd = s - kp; dd = dd < -63 ? -63 : (dd > 256 ? 256 : dd);
                sc += ap->rel_bias[h * NREL + dd + 63] * LOG2E;
                if (sc > mrun) { const float f = exp2f(mrun - sc); l *= f;
#pragma unroll
                    for (int d = 0; d < 64; ++d) o[d] *= f;
                    mrun = sc; }
                const float pr = exp2f(sc - mrun); l += pr;
                const bf16_t* vr = vb + (size_t)(tb + kp) * AW + h * 64;
#pragma unroll
                for (int d8 = 0; d8 < 8; ++d8) { const u32x4 w = *(const u32x4*)(vr + d8 * 8);
#pragma unroll
                    for (int e = 0; e < 4; ++e) { o[d8 * 8 + 2 * e] += pr * bf_lo(w[e]); o[d8 * 8 + 2 * e + 1] += pr * bf_hi(w[e]); } }
            }
            const float il = 1.f / l;
#pragma unroll
            for (int d8 = 0; d8 < 8; ++d8) { u32x4 w;
#pragma unroll
                for (int e = 0; e < 4; ++e) w[e] = pk2(o[d8 * 8 + 2 * e] * il, o[d8 * 8 + 2 * e + 1] * il);
                *(u32x4*)(yac + (size_t)t * D + h * 64 + d8 * 8) = w; }
        }
#endif
    }
    XBAR();

#if FAST_G2
    { PHASE_VARS(); pg8::StaticOrder S; S.init(T, D, G, bx);
      { pg8::Gemm g{yac, Wm_t, T, D, 512, D}; EpiMerge<false> E{sga, mbuf}; pg8::gemm_phase<EpiMerge<false>, pg8::StaticOrder, true, true>(lds, g, S, E, tid); }
      { pg8::Gemm g{yac + 512, Wm_t + 512, T, D, 512, D}; EpiMerge<true> E{sgc, mbuf}; pg8::gemm_phase<EpiMerge<true>, pg8::StaticOrder, true, true>(lds, g, S, E, tid); } }
#else
    { PHASE_VARS();
    for (int tl = bx; tl < 512 * 16; tl += G) {
        const int rt = tl / 16, ct = tl % 16;
        naive_tile(yac + (size_t)rt * 64 * D, D, 512, [=](int i) { return (const bf16_t*)(Wm_t + (size_t)(64 * ct + i) * D); }, tile0, false);
        naive_tile(yac + (size_t)rt * 64 * D + 512, D, 512, [=](int i) { return (const bf16_t*)(Wm_t + (size_t)(64 * ct + i) * D + 512); }, tile1, false);
        __syncthreads();
        const int row = tid >> 3, c8 = (tid & 7) * 8; const size_t o = (size_t)(rt * 64 + row) * D + 64 * ct + c8; float v[8];
#pragma unroll
        for (int j = 0; j < 8; ++j) v[j] = bf2f(sga[o + j]) * tile0[row * 65 + c8 + j] + bf2f(sgc[o + j]) * tile1[row * 65 + c8 + j];
        u32x4 w; w.x = pk2(v[0], v[1]); w.y = pk2(v[2], v[3]); w.z = pk2(v[4], v[5]); w.w = pk2(v[6], v[7]); *(u32x4*)(mbuf + o) = w;
        __syncthreads();
    } }
#endif
    XBAR();

#if FAST_G3
    { PHASE_VARS(); pg8::Gemm g{mbuf, Wo_t, T, D, D, D}; pg8::StaticOrder S; S.init(T, D, G, bx); EpiResF32 E{ap->x, ap->out};
      pg8::gemm_phase<EpiResF32, pg8::StaticOrder, true, true>(lds, g, S, E, tid); }
#else
    { PHASE_VARS();
    for (int tl = bx; tl < 512 * 16; tl += G) {
        const int rt = tl / 16, ct = tl % 16;
        naive_tile(mbuf + (size_t)rt * 64 * D, D, D, [=](int i) { return (const bf16_t*)(Wo_t + (size_t)(64 * ct + i) * D); }, tile0, false);
        __syncthreads();
        const int row = tid >> 3, c8 = (tid & 7) * 8; const size_t o = (size_t)(rt * 64 + row) * D + 64 * ct + c8;
#pragma unroll
        for (int j = 0; j < 8; ++j) ap->out[o + j] = ap->x[o + j] + tile0[row * 65 + c8 + j];
        __syncthreads();
    } }
#endif
    XBAR();

    {
        PHASE_VARS();
        {
            LAS float* lsc = (LAS float*)(lds + wave * 4096);
            const int r = lane & 15, q = lane >> 4;
            for (int task = gw; task < T / 16; task += NGW) {
                const int row0 = task * 16;
                const GAS float* arow = (const GAS float*)ap->out + (size_t)(row0 + r) * D + 4 * q;
                const GAS float* gp = (const GAS float*)ap->g_ffn + 4 * q;
                const GAS f32x4* bp = (const GAS f32x4*)wrt + lane;
                f32x4 acc0 = {0.f, 0.f, 0.f, 0.f}, acc1 = acc0, acc2 = acc0; float ss = 0.f;
#pragma unroll 4
                for (int s_ = 0; s_ < 64; ++s_) {
                    f32x4 av = *(const GAS f32x4*)(arow + 16 * s_); const f32x4 gv = *(const GAS f32x4*)(gp + 16 * s_);
                    const f32x4 b0 = bp[(0 * 64 + s_) * 64], b1 = bp[(1 * 64 + s_) * 64], b2 = bp[(2 * 64 + s_) * 64];
                    ss += (av.x * av.x + av.y * av.y) + (av.z * av.z + av.w * av.w);
                    av = av * gv;
#pragma unroll
                    for (int j = 0; j < 4; ++j) {
                        acc0 = __builtin_amdgcn_mfma_f32_16x16x4f32(av[j], b0[j], acc0, 0, 0, 0);
                        acc1 = __builtin_amdgcn_mfma_f32_16x16x4f32(av[j], b1[j], acc1, 0, 0, 0);
                        acc2 = __builtin_amdgcn_mfma_f32_16x16x4f32(av[j], b2[j], acc2, 0, 0, 0);
                    }
                }
                ss += __shfl_xor(ss, 16); ss += __shfl_xor(ss, 32);
                const float rstd = rsqrtf(ss * (1.f / D) + EPS);
#pragma unroll
                for (int g_ = 0; g_ < 4; ++g_) { const float rs = __shfl(rstd, 4 * q + g_);
                    lsc[(4 * q + g_) * 48 + r] = acc0[g_] * rs; lsc[(4 * q + g_) * 48 + 16 + r] = acc1[g_] * rs; lsc[(4 * q + g_) * 48 + 32 + r] = acc2[g_] * rs; }
                LDS_WAIT(); asm volatile("" ::: "memory");
                if (lane < 16) {
                    const int m = row0 + lane; float lg[36];
#pragma unroll
                    for (int c = 0; c < 36; ++c) lg[c] = lsc[lane * 48 + c];
                    float gl[4];
#pragma unroll
                    for (int c = 0; c < 4; ++c) gl[c] = lg[c] + ap->b_group[c];
                    int grp = 0; float gmax = gl[0];
#pragma unroll
                    for (int c = 1; c < 4; ++c) if (gl[c] > gmax) { gmax = gl[c]; grp = c; }
                    float gs = 0.f;
#pragma unroll
                    for (int c = 0; c < 4; ++c) gs += __expf(gl[c] - gmax);
                    const float pgrp = 1.f / gs;
                    float el[8];
#pragma unroll
                    for (int c = 0; c < 8; ++c) { const float x0 = lg[4 + c], x1 = lg[12 + c], x2 = lg[20 + c], x3 = lg[28 + c]; el[c] = (grp == 0 ? x0 : grp == 1 ? x1 : grp == 2 ? x2 : x3) + ap->b_router[grp * 8 + c]; }
                    int i0 = 0; float l0 = el[0];
#pragma unroll
                    for (int c = 1; c < 8; ++c) if (el[c] > l0) { l0 = el[c]; i0 = c; }
                    int i1 = -1; float l1 = -3.0e38f;
#pragma unroll
                    for (int c = 0; c < 8; ++c) if (c != i0 && el[c] > l1) { l1 = el[c]; i1 = c; }
                    const float e1 = __expf(l1 - l0), w0 = pgrp / (1.f + e1), w1 = pgrp * e1 / (1.f + e1);
                    const int ea = grp * 8 + i0, eb = grp * 8 + i1;
                    const int pa = (int)atomicAdd(&ctl[ea], 1u), pb_ = (int)atomicAdd(&ctl[eb], 1u);
                    rt_e[2 * m] = ea; rt_e[2 * m + 1] = eb; rt_pos[2 * m] = pa; rt_pos[2 * m + 1] = pb_; rt_w[2 * m] = w0; rt_w[2 * m + 1] = w1;
                    ((float*)(ws + WS_RSTD))[m] = rstd;
                }
                LDS_WAIT(); asm volatile("" ::: "memory");
            }
        }
        __syncthreads();
        LAS float* scr = (LAS float*)(lds + wave * 16384);
        constexpr int I_13 = 16 * 16, I_2 = 8 * 32, PER_E = 2 * I_13 + I_2;
        for (int it = gw; it < NE * PER_E; it += NGW) {
            const int e = it / PER_E; int r = it % PER_E;
            if (r < 2 * I_13) { const int which = r / I_13; r %= I_13; const int kb_ = r / 16, nb = r % 16, j0 = nb * 32;
                const float* src = (which ? ap->w3 : ap->w1) + (size_t)e * D * DE + (size_t)(kb_ * 64) * DE + j0;
                transpose_item(src, DE, W13_t + (size_t)(e * 1024 + (j0 >> 7) * 256 + which * 128 + (j0 & 127)) * D + kb_ * 64, D, scr, lane); }
            else { r -= 2 * I_13; const int kb_ = r / 32, nb = r % 32;
                transpose_item(ap->w2 + (size_t)e * DE * D + (size_t)(kb_ * 64) * D + nb * 32, D, W2_t + (size_t)(e * 1024 + nb * 32) * DE + kb_ * 64, DE, scr, lane); }
        }
    }
    XBAR();

    {
        PHASE_VARS();
        if (tid < NE) cnts[tid] = (int)__hip_atomic_load(&ctl[tid], __ATOMIC_RELAXED, __HIP_MEMORY_SCOPE_AGENT);
        __syncthreads();
        if (tid == 0) { int acc_ = 0; for (int e = 0; e < NE; ++e) { pref[e] = acc_; acc_ += (cnts[e] + 255) >> 8; } pref[NE] = acc_; }
        __syncthreads();
        for (size_t i = gtid; i < (size_t)NE * 256; i += GT) { const int e = (int)(i >> 8), r = (int)(i & 255); const int c = cnts[e];
            if (c + r < (((c + 255) >> 8) << 8)) row_slot[pref[e] * 256 + c + r] = -1; }
        for (int tk = gw; tk < T; tk += NGW) {
            const float rs = ((const float*)(ws + WS_RSTD))[tk];
            const int e0 = rt_e[2 * tk], e1 = rt_e[2 * tk + 1], r0 = pref[e0] * 256 + rt_pos[2 * tk], r1 = pref[e1] * 256 + rt_pos[2 * tk + 1];
            const f32x4* src = (const f32x4*)(ap->out + (size_t)tk * D) + 2 * lane; const f32x4* gs = (const f32x4*)ap->g_ffn + 2 * lane;
            u32x4* d0 = (u32x4*)(xs + (size_t)r0 * D) + lane; u32x4* d1 = (u32x4*)(xs + (size_t)r1 * D) + lane;
#pragma unroll
            for (int j = 0; j < 2; ++j) { const f32x4 a0 = src[128 * j], a1 = src[128 * j + 1], g0 = gs[128 * j], g1 = gs[128 * j + 1];
                u32x4 o; o.x = pk2(a0.x * rs * g0.x, a0.y * rs * g0.y); o.y = pk2(a0.z * rs * g0.z, a0.w * rs * g0.w); o.z = pk2(a1.x * rs * g1.x, a1.y * rs * g1.y); o.w = pk2(a1.z * rs * g1.z, a1.w * rs * g1.w);
                d0[64 * j] = o; d1[64 * j] = o; }
            if (lane == 0) { row_slot[r0] = 2 * tk; row_w[r0] = rt_w[2 * tk]; row_slot[r1] = 2 * tk + 1; row_w[r1] = rt_w[2 * tk + 1]; }
        }
    }
    XBAR();
    const int ntiles = __builtin_amdgcn_readfirstlane(pref[NE]);

#if FAST_G4
    { PHASE_VARS(); pg8::Gemm g{xs, W13_t, XS_ROWS, NE * 1024, D, D}; MoeOrder S{pref, ntiles * 4, G, bx}; EpiSwiglu E{hdn};
      pg8::gemm_phase<EpiSwiglu, MoeOrder, true, true>(lds, g, S, E, tid); }
#else
    { PHASE_VARS();
    for (int tl = bx; tl < ntiles * 4 * 8; tl += G) {
        const int rt = tl >> 3, ct = tl & 7, rtg = rt >> 2; int e = 0; for (int k = 1; k < NE; ++k) e += (pref[k] <= rtg) ? 1 : 0;
        naive_tile(xs + (size_t)rt * 64 * D, D, D, [=](int i) { const int j = 64 * ct + i; return (const bf16_t*)(W13_t + (size_t)(e * 1024 + (j >> 7) * 256 + (j & 127)) * D); }, tile0, false);
        naive_tile(xs + (size_t)rt * 64 * D, D, D, [=](int i) { const int j = 64 * ct + i; return (const bf16_t*)(W13_t + (size_t)(e * 1024 + (j >> 7) * 256 + 128 + (j & 127)) * D); }, tile1, false);
        __syncthreads();
        const int row = tid >> 3, c8 = (tid & 7) * 8; float v[8];
#pragma unroll
        for (int j = 0; j < 8; ++j) { const float x1 = tile0[row * 65 + c8 + j], x3 = tile1[row * 65 + c8 + j]; v[j] = x1 * sigmoidf_(x1) * x3; }
        u32x4 w; w.x = pk2(v[0], v[1]); w.y = pk2(v[2], v[3]); w.z = pk2(v[4], v[5]); w.w = pk2(v[6], v[7]); *(u32x4*)(hdn + (size_t)(rt * 64 + row) * DE + 64 * ct + c8) = w;
        __syncthreads();
    } }
#endif
    XBAR();

#if FAST_G5
    { PHASE_VARS(); pg8::Gemm g{hdn, W2_t, XS_ROWS, NE * 1024, DE, DE}; MoeOrder S{pref, ntiles * 4, G, bx}; EpiDown E{row_slot, row_w, contrib};
      pg8::gemm_phase<EpiDown, MoeOrder, true, true>(lds, g, S, E, tid); }
#else
    { PHASE_VARS();
    for (int tl = bx; tl < ntiles * 4 * 16; tl += G) {
        const int rt = tl >> 4, ct = tl & 15, rtg = rt >> 2; int e = 0; for (int k = 1; k < NE; ++k) e += (pref[k] <= rtg) ? 1 : 0;
        naive_tile(hdn + (size_t)rt * 64 * DE, DE, DE, [=](int i) { return (const bf16_t*)(W2_t + (size_t)(e * 1024 + 64 * ct + i) * DE); }, tile0, false);
        __syncthreads();
        const int row = tid >> 3, c8 = (tid & 7) * 8; const int grow = rt * 64 + row; const int slot = row_slot[grow];
        if (slot >= 0) { const float w_ = row_w[grow]; float v[8];
#pragma unroll
            for (int j = 0; j < 8; ++j) v[j] = tile0[row * 65 + c8 + j] * w_;
            u32x4 w; w.x = pk2(v[0], v[1]); w.y = pk2(v[2], v[3]); w.z = pk2(v[4], v[5]); w.w = pk2(v[6], v[7]); *(u32x4*)(contrib + (size_t)slot * D + 64 * ct + c8) = w; }
        __syncthreads();
    } }
#endif
    XBAR();

    { PHASE_VARS();
    for (int m0 = 2 * gw; m0 < T; m0 += 2 * NGW) {
        f32x4 v[2][4]; u32x2 p0[2][4], p1[2][4];
#pragma unroll
        for (int rr = 0; rr < 2; ++rr) { const int m = m0 + rr;
            const f32x4* xr = (const f32x4*)(ap->out + (size_t)m * D) + lane;
            const u32x2* c0 = (const u32x2*)(contrib + (size_t)(2 * m) * D) + lane; const u32x2* c1 = (const u32x2*)(contrib + (size_t)(2 * m + 1) * D) + lane;
#pragma unroll
            for (int j = 0; j < 4; ++j) { v[rr][j] = xr[64 * j]; p0[rr][j] = c0[64 * j]; p1[rr][j] = c1[64 * j]; } }
#pragma unroll
        for (int rr = 0; rr < 2; ++rr) { const int m = m0 + rr; float s = 0.f;
            unsigned long long* o8 = (unsigned long long*)(nbuf + (size_t)m * D) + lane;
#pragma unroll
            for (int j = 0; j < 4; ++j) { f32x4 h = v[rr][j];
                h.x += bf_lo(p0[rr][j].x) + bf_lo(p1[rr][j].x); h.y += bf_hi(p0[rr][j].x) + bf_hi(p1[rr][j].x); h.z += bf_lo(p0[rr][j].y) + bf_lo(p1[rr][j].y); h.w += bf_hi(p0[rr][j].y) + bf_hi(p1[rr][j].y);
                s += (h.x * h.x + h.y * h.y) + (h.z * h.z + h.w * h.w);
                o8[64 * j] = (unsigned long long)pk2(h.x, h.y) | ((unsigned long long)pk2(h.z, h.w) << 32); }
            s = wave_sum(s);
            if (lane == 0) ((float*)(ws + WS_RSTD))[m] = rsqrtf(s * (1.f / D) + EPS); }
    } }
    XBAR();

#if FAST_G6
    { PHASE_VARS(); pg8::StaticOrder S; S.init(T, D, G, bx);
      { pg8::Gemm g{pb, Wpp_t, T, D, PLE, PLE}; EpiPP E{ppb}; pg8::gemm_phase<EpiPP, pg8::StaticOrder, true, true>(lds, g, S, E, tid); }
      { pg8::Gemm g{nbuf, Wpg_t, T, D, D, D}; EpiGate E{ppb, nbuf, (const float*)(ws + WS_RSTD), ap->b_pg, ap->out}; pg8::gemm_phase<EpiGate, pg8::StaticOrder, true, true>(lds, g, S, E, tid); } }
#else
    { PHASE_VARS();
    for (int tl = bx; tl < 512 * 16; tl += G) {
        const int rt = tl / 16, ct = tl % 16;
        naive_tile(nbuf + (size_t)rt * 64 * D, D, D, [=](int i) { return (const bf16_t*)(Wpg_t + (size_t)(64 * ct + i) * D); }, tile0, false);
        naive_tile(pb + (size_t)rt * 64 * PLE, PLE, PLE, [=](int i) { return (const bf16_t*)(Wpp_t + (size_t)(64 * ct + i) * PLE); }, tile1, false);
        __syncthreads();
        const int row = tid >> 3, c8 = (tid & 7) * 8; const size_t o = (size_t)(rt * 64 + row) * D + 64 * ct + c8;
        { const float rs = ((const float*)(ws + WS_RSTD))[rt * 64 + row];
#pragma unroll
        for (int j = 0; j < 8; ++j) ap->out[o + j] = bf2f(nbuf[o + j]) + sigmoidf_(tile0[row * 65 + c8 + j] * rs + ap->b_pg[64 * ct + c8 + j]) * tile1[row * 65 + c8 + j]; }
        __syncthreads();
    } }
#endif
}

extern "C" void kernel_launch(void* const* d_in, const int* in_sizes, int n_in, void* d_out, int out_size, void* d_ws, size_t ws_size, hipStream_t stream) {
    static int grid = 0;
    if (grid == 0) {
        if (n_in != 25 || out_size != T * D || ws_size < WS_END) { fprintf(stderr, "kernel_launch: unexpected shapes (n_in %d out %d ws %zu); nothing launched\n", n_in, out_size, ws_size); grid = -1; return; }
        int dev = 0, cus = 0, per_cu = 0;
        if (hipGetDevice(&dev) != hipSuccess || hipDeviceGetAttribute(&cus, hipDeviceAttributeMultiprocessorCount, dev) != hipSuccess) { grid = -1; return; }
        if (hipFuncSetAttribute((const void*)fwd_kernel, hipFuncAttributeMaxDynamicSharedMemorySize, LDS_BYTES) != hipSuccess) { fprintf(stderr, "kernel_launch: hipFuncSetAttribute failed\n"); grid = -1; return; }
        if (hipOccupancyMaxActiveBlocksPerMultiprocessor(&per_cu, (const void*)fwd_kernel, NTHREADS, LDS_BYTES) != hipSuccess || per_cu < 1) { fprintf(stderr, "kernel_launch: occupancy query says %d\n", per_cu); (void)hipGetLastError(); grid = -1; return; }
        grid = cus;
    }
    if (grid < 0) return;
    if (hipMemsetAsync((char*)d_ws + WS_CTL, 0, CTL_ZERO_BYTES, stream) != hipSuccess) { fprintf(stderr, "kernel_launch: memset failed\n"); return; }
    Args a{};
    const float** f = (const float**)&a;
    for (int i = 0; i < 25; ++i) f[i] = (const float*)d_in[i];
    a.out = (float*)d_out; a.ws = (unsigned char*)d_ws;
    void* args[] = {&a};
    hipError_t e = hipLaunchCooperativeKernel((const void*)fwd_kernel, dim3(grid), dim3(NTHREADS), args, LDS_BYTES, stream);
    if (e != hipSuccess) fprintf(stderr, "kernel_launch: cooperative launch failed: %s (grid %d)\n", hipGetErrorString(e), grid);
}
```

```cpp
#include <hip/hip_runtime.h>
#include <hip/hip_cooperative_groups.h>
#include <cstdio>
#include <cstdint>
namespace cg = cooperative_groups;

#define GAS __attribute__((address_space(1)))
#define LAS __attribute__((address_space(3)))
typedef unsigned short bf16_t;
typedef short bf16x8 __attribute__((ext_vector_type(8)));
typedef float f32x4 __attribute__((ext_vector_type(4)));
typedef float f32x2 __attribute__((ext_vector_type(2)));
typedef unsigned u32x4 __attribute__((ext_vector_type(4)));
typedef unsigned u32x2 __attribute__((ext_vector_type(2)));
typedef int i32x4 __attribute__((ext_vector_type(4)));
typedef int i32x8 __attribute__((ext_vector_type(8)));
typedef GAS unsigned gu32;
#define RLX_AGENT __ATOMIC_RELAXED, __HIP_MEMORY_SCOPE_AGENT

constexpr int T = 32768, D = 1024, SEQ = 4096, NBATCH = 8;
constexpr int NIN = 5120, NH = 8, HD = 64, AW = 512, CW = 512;
constexpr int NE = 32, DE = 512, PLE = 256, NREL = 320;
constexpr int XS_ROWS = 65536 + NE * 256;
constexpr float EPS = 1e-6f;
constexpr float LOG2E = 1.4426950408889634f;
constexpr float C2 = 0.125f * LOG2E;

#ifndef F8_MOE
#define F8_MOE 1
#endif
#ifndef F8_GATES
#define F8_GATES 1
#endif
#ifndef F8_DOWN
#define F8_DOWN 1
#endif
constexpr float F8W = 32.0f;
constexpr size_t MiB = 1u << 20;
constexpr size_t WS_CTL = 0, CTL_ZERO_BYTES = 64 * 1024;
constexpr int CW_BAR = 4096, CNT_STRIDE = 64;
constexpr size_t WS_TAB = 1 * MiB;
constexpr size_t WS_GTAB = WS_TAB + 192 * 1024;
constexpr size_t WS_GCINIT = WS_GTAB + 8 * 4 * 384 * 4;
constexpr size_t WS_ROUTE = 2 * MiB;
constexpr size_t WS_CMAXF = 3 * MiB + 512 * 1024;
constexpr size_t WS_RSTD = 3 * MiB;
constexpr size_t WS_ROWMETA = 4 * MiB;
constexpr size_t WS_WIN = 6 * MiB;
constexpr size_t WS_WM = 16 * MiB;
constexpr size_t WS_WO = 18 * MiB;
constexpr size_t WS_WGP = 20 * MiB;
constexpr int HPB = 1536, HPE = HPB / 2;
constexpr size_t WS_HP = 24 * MiB;
constexpr size_t WS_H2B = 232 * MiB;
constexpr int CW_CMAXP = 14336;
constexpr int META_LO = 147456, META_HI = 147456 + 4 * 2048;
constexpr size_t WS_ESLOT = 72 * MiB, WS_EW = 76 * MiB;
constexpr size_t WS_XQ = 24 * MiB;
constexpr size_t WS_XB = 104 * MiB;
constexpr size_t WS_A1 = 168 * MiB;
constexpr size_t WS_B1 = 232 * MiB;
constexpr size_t WS_C1 = 296 * MiB;
constexpr size_t WS_SGA = 360 * MiB, WS_SGC = 424 * MiB;
constexpr size_t WS_M = WS_B1;
constexpr size_t WS_H1F8 = WS_A1;
constexpr size_t WS_H1B = WS_SGC;
constexpr size_t WS_W13 = WS_SGA;
constexpr size_t WS_W2 = 320 * MiB;
constexpr size_t WS_XS = 104 * MiB;
constexpr size_t WS_HDN = 248 * MiB;
constexpr size_t WS_CONTRIB = 104 * MiB;
constexpr size_t WS_END = 488 * MiB;

__device__ __forceinline__ unsigned f2bf(float f) { unsigned u = __builtin_bit_cast(unsigned, f); return (u + 0x7fffu + ((u >> 16) & 1u)) >> 16; }
__device__ __forceinline__ unsigned pk2(float lo, float hi) { return f2bf(lo) | (f2bf(hi) << 16); }
__device__ __forceinline__ float bf_lo(unsigned w) { return __builtin_bit_cast(float, w << 16); }
__device__ __forceinline__ float bf_hi(unsigned w) { return __builtin_bit_cast(float, w & 0xffff0000u); }
__device__ __forceinline__ float bf2f(bf16_t h) { return __builtin_bit_cast(float, (unsigned)h << 16); }
__device__ __forceinline__ float sigmoidf_(float x) { return __builtin_amdgcn_rcpf(1.0f + __builtin_amdgcn_exp2f(-LOG2E * x)); }
__device__ __forceinline__ float wave_sum(float v) {
#pragma unroll
    for (int o = 1; o < 64; o <<= 1) v += __shfl_xor(v, o);
    return v;
}
__device__ __forceinline__ int lane_id_fresh() { int l; asm volatile("v_mbcnt_lo_u32_b32 %0, -1, 0\n\tv_mbcnt_hi_u32_b32 %0, -1, %0" : "=v"(l)); return l; }
__device__ __forceinline__ unsigned pk4_fp8(float a, float b, float c, float d) { unsigned w = (unsigned)__builtin_amdgcn_cvt_pk_fp8_f32(a, b, 0, false); return (unsigned)__builtin_amdgcn_cvt_pk_fp8_f32(c, d, (int)w, true); }
#define LDS_WAIT() asm volatile("s_waitcnt lgkmcnt(0)" ::: "memory")
#define VM_WAIT() asm volatile("s_waitcnt vmcnt(0)" ::: "memory")

namespace pg8 {
#define PG8_LAS __attribute__((address_space(3)))
constexpr int BM = 256, BK = 64, HALF = 128, HTB = HALF * BK * 2  , STAGE_BYTES = 8 * HTB, NXCD = 8, WGM = 8;

__host__ __device__ __forceinline__ int lds_byte(int r, int c) { const int st = (r >> 4) * 2 + (c >> 5), rr = r & 15, cc = c & 31, ob = rr * 64 + cc * 2; return st * 1024 + (ob ^ (((ob >> 9) & 1) << 5)); }
__host__ __device__ __forceinline__ void stage_rc(int b, int& R, int& C) { const int st = b / 1024, sb = b % 1024, swz = sb ^ (((sb >> 9) & 1) << 5); R = (st >> 1) * 16 + swz / 64; C = (st & 1) * 32 + (swz % 64) / 2; }
__host__ __device__ __forceinline__ int perm32(int rho) { const int n = rho >> 4, i = rho & 15; return 8 * (i >> 2) + 4 * n + (i & 3); }

struct Unit { int pm, pn, part; };
struct Gemm { const bf16_t* A; const bf16_t* Bt; int M, N, K, ld; };

struct StaticOrder {
    int nM, nN, nwg, G, c;
    __host__ __device__ void init(int M, int N, int G_, int c_) { nM = M / BM; nN = N / BM; nwg = nM * nN; G = G_; c = c_; }
    __host__ __device__ bool next(int i, Unit& u) const {
        const long L = (long)i * G + c; if (L >= nwg) return false;
        int wgid = (int)L; { const int q = nwg / NXCD, r = nwg % NXCD, xcd = wgid % NXCD, off = wgid / NXCD; wgid = (xcd < r ? xcd * (q + 1) : r * (q + 1) + (xcd - r) * q) + off; }
        const int nig = WGM * nN, gid = wgid / nig, fm = gid * WGM, gsz = (nM - fm) < WGM ? (nM - fm) : WGM;
        u.pm = fm + ((wgid % nig) % gsz); u.pn = (wgid % nig) / gsz; u.part = 0; return true;
    }
    static constexpr bool GATHER = false;
    __device__ __forceinline__ int row_of(const Unit&, int) const { return 0; }
    __device__ __forceinline__ void a_ready(const Unit&) const {}
    __device__ __forceinline__ void done(const Unit&) const {}
};
struct PairOrder : StaticOrder {
    __host__ __device__ bool next(int i, Unit& u) const { if (!StaticOrder::next(i >> 1, u)) return false; u.part = i & 1; return true; }
};
__device__ __forceinline__ unsigned cvt_pk_bf16(float lo, float hi) { unsigned r; asm volatile("v_cvt_pk_bf16_f32 %0, %1, %2" : "=v"(r) : "v"(lo), "v"(hi)); return r; }

template <class Epi> __device__ __forceinline__ size_t koff_of(const Epi& E, const Unit& u) { if constexpr (Epi::MULTI) return (size_t)E.kt0(u.part) * (size_t)(BK * 2); else return (size_t)0; }
template <class Epi, class Sched, bool ALIGN_EPI = false, bool SP2 = false, int DUAL_T = 0, int I8MODE = 0>
__device__ __forceinline__ void gemm_phase(PG8_LAS unsigned char* lds, const Gemm g, const Sched& S, const Epi& E, int tid_) {
    asm volatile("" : "+v"(tid_));
    const int tid = tid_, wid = __builtin_amdgcn_readfirstlane(tid >> 6), lane = tid & 63, wr = wid >> 2, wc = wid & 3, fr = lane & 15, fq = lane >> 4;
    int K = g.K; asm volatile("" : "+s"(K));
    int nt = K / BK; const int LD = g.ld;
#define PG8_KOFF(u) koff_of(E, u)
    constexpr bool GATHER = Sched::GATHER; static_assert(!GATHER || SP2, "GATHER is written for the SP2 loop");
    unsigned voffA[2], voffA1[2], voffB[2]; int gR[2], gC[2];
#pragma unroll
    for (int i = 0; i < 2; ++i) { int R, C; stage_rc(tid * 16 + i * 8192, R, C); const int Rb = Epi::PERM ? ((R & ~31) + perm32(R & 31)) : R; gR[i] = R; gC[i] = C;
        voffA[i] = (unsigned)(R * LD + C) * 2u; voffA1[i] = 0u; voffB[i] = (unsigned)(Rb * LD + C) * 2u; }
#define PG8_GOFF(slot, i) ((unsigned)((((slot) < 0 ? 0 : (slot)) >> 1) * LD + gC[i]) * 2u)
    const size_t kstep = (size_t)(BK * 2);
    const size_t hstep = (size_t)HALF * LD * 2;
    const size_t tstep = 2 * hstep;
    const size_t hstepB = DUAL_T ? 0 : hstep, tstepB = DUAL_T ? hstep : tstep;
    const unsigned ldsw = (unsigned)wid * 1024u;
    const int aoff = lds_byte(wr * 64 + fr, fq * 8), boff = lds_byte(wc * 32 + fr, fq * 8);
#define PG8_SA(b, h) (((b) * 2 + (h)) * HTB)
#define PG8_SB(b, h) ((4 + (b) * 2 + (h)) * HTB)
#define PG8_STAGE(bufoff, gbase, voff) do { _Pragma("unroll") for (int _i = 0; _i < 2; ++_i) \
        __builtin_amdgcn_global_load_lds((const unsigned*)((const char*)(gbase) + (voff)[_i]), (PG8_LAS unsigned*)(lds + (bufoff) + ldsw + _i * 8192), 16, 0, 0); } while (0)
#define PG8_LD32(p_) __builtin_shufflevector(*(const PG8_LAS i32x4*)(p_), *(const PG8_LAS i32x4*)((p_) + 1024), 0, 1, 2, 3, 4, 5, 6, 7)
#define PG8_LDA(dst, b, h) do { if constexpr (I8MODE == 3) { _Pragma("unroll") for (int m = 0; m < 4; ++m) dst##8[m] = PG8_LD32(lds + PG8_SA(b, h) + aoff + m * 2048); } else { \
        _Pragma("unroll") for (int m = 0; m < 4; ++m) _Pragma("unroll") for (int k = 0; k < 2; ++k) dst[m][k] = *(const PG8_LAS bf16x8*)(lds + PG8_SA(b, h) + aoff + m * 2048 + k * 1024); } } while (0)
#define PG8_LDB(dst, b, h) do { if constexpr (I8MODE == 3) { _Pragma("unroll") for (int n = 0; n < 2; ++n) dst##8[n] = PG8_LD32(lds + PG8_SB(b, h) + boff + n * 2048); } else { \
        _Pragma("unroll") for (int n = 0; n < 2; ++n) _Pragma("unroll") for (int k = 0; k < 2; ++k) dst[n][k] = *(const PG8_LAS bf16x8*)(lds + PG8_SB(b, h) + boff + n * 2048 + k * 1024); } } while (0)
#define PG8_MMA(ai, bj, At, Bt) do { __builtin_amdgcn_s_setprio(1); _Pragma("unroll") for (int m = 0; m < 4; ++m) _Pragma("unroll") for (int n = 0; n < 2; ++n) _Pragma("unroll") for (int k = 0; k < 2; ++k) \
        acc[ai][bj][m][n] = __builtin_amdgcn_mfma_f32_16x16x32_bf16(Bt[n][k], At[m][k], acc[ai][bj][m][n], 0, 0, 0); __builtin_amdgcn_s_setprio(0); } while (0)
#define PG8_MMA_I8(ai, bj, At, Bt) do { __builtin_amdgcn_s_setprio(1); _Pragma("unroll") for (int m = 0; m < 4; ++m) _Pragma("unroll") for (int n = 0; n < 2; ++n) _Pragma("unroll") for (int k = 0; k < 2; ++k) \
        acc[ai][bj][m][n] = __builtin_bit_cast(f32x4, __builtin_amdgcn_mfma_i32_16x16x64_i8(__builtin_bit_cast(i32x4, Bt[n][k]), __builtin_bit_cast(i32x4, At[m][k]), __builtin_bit_cast(i32x4, acc[ai][bj][m][n]), 0, 0, 0)); __builtin_amdgcn_s_setprio(0); } while (0)
#define PG8_MMA_F8(ai, bj, At, Bt) do { __builtin_amdgcn_s_setprio(1); _Pragma("unroll") for (int m = 0; m < 4; ++m) _Pragma("unroll") for (int n = 0; n < 2; ++n) \
        acc[ai][bj][m][n] = __builtin_amdgcn_mfma_scale_f32_16x16x128_f8f6f4(Bt##8[n], At##8[m], acc[ai][bj][m][n], 0, 0, 0, 0x7f7f7f7f, 0, 0x7f7f7f7f); __builtin_amdgcn_s_setprio(0); } while (0)
#define PG8_MMA2(ai) do { if constexpr (I8MODE == 3) { PG8_MMA_F8(ai, 0, At, B0); PG8_MMA_F8(ai, 1, At, B1); } else if constexpr (DUAL_T > 0) { if (t < DUAL_T) { if constexpr (I8MODE != 0) { PG8_MMA_I8(ai, 0, At, B0); } else { PG8_MMA(ai, 0, At, B0); } } else { if constexpr (I8MODE == 1) { PG8_MMA_I8(ai, 1, At, B0); } else { PG8_MMA(ai, 1, At, B0); } } } \
        else { if constexpr (I8MODE == 1) { PG8_MMA_I8(ai, 0, At, B0); PG8_MMA_I8(ai, 1, At, B1); } else { PG8_MMA(ai, 0, At, B0); PG8_MMA(ai, 1, At, B1); } } } while (0)
#define PG8_STAGE_B1(buf, base) do { if constexpr (!DUAL_T) { PG8_STAGE(buf, base, voffB); } } while (0)
#define PG8_WAIT_VD(n, nd) do { if constexpr (DUAL_T > 0) { asm volatile("s_waitcnt vmcnt(" #nd ")" ::: "memory"); } else { asm volatile("s_waitcnt vmcnt(" #n ")" ::: "memory"); } } while (0)
#define PG8_WAIT_V(n) asm volatile("s_waitcnt vmcnt(" #n ")" ::: "memory")
#define PG8_WAIT_L(n) asm volatile("s_waitcnt lgkmcnt(" #n ")" ::: "memory")
#define PG8_BAR __builtin_amdgcn_s_barrier()
#define PG8_SCHED __builtin_amdgcn_sched_barrier(0)
    Unit cur, nxt; int ui = 0;
    if (!S.next(0, cur)) return;
    f32x4 acc[2][2][4][2];
#pragma unroll
    for (int a = 0; a < 2; ++a)
#pragma unroll
        for (int b = 0; b < 2; ++b)
#pragma unroll
            for (int m = 0; m < 4; ++m)
#pragma unroll
                for (int n = 0; n < 2; ++n) acc[a][b][m][n] = (f32x4){0.f, 0.f, 0.f, 0.f};
    bf16x8 At[4][2], B0[2][2], B1[2][2]; i32x8 At8[4], B08[2], B18[2];
    const char* cA = (const char*)g.A + (GATHER ? (size_t)0 : (size_t)cur.pm * tstep) + PG8_KOFF(cur); const char* cB = (const char*)g.Bt + (size_t)cur.pn * tstepB + PG8_KOFF(cur);
    if constexpr (Epi::MULTI) { nt = E.nkt(cur.part); asm volatile("" : "+s"(nt)); }
    S.a_ready(cur);
    int ns[4] = {0, 0, 0, 0};
    if constexpr (GATHER) {
#pragma unroll
        for (int i = 0; i < 2; ++i) { voffA[i] = PG8_GOFF(S.row_of(cur, gR[i]), i); voffA1[i] = PG8_GOFF(S.row_of(cur, HALF + gR[i]), i); } }
#define PG8_STAGE_A1(buf, base) do { if constexpr (GATHER) { PG8_STAGE(buf, base, voffA1); } else { PG8_STAGE(buf, (base) + hstep, voffA); } } while (0)
    if constexpr (SP2) {
        PG8_STAGE(PG8_SB(0, 0), cB, voffB); PG8_STAGE_B1(PG8_SB(0, 1), cB + hstepB); PG8_STAGE(PG8_SA(0, 0), cA, voffA); PG8_STAGE_A1(PG8_SA(0, 1), cA);
        if (wr == 1) PG8_BAR;
        PG8_WAIT_V(2); PG8_BAR;
        PG8_STAGE(PG8_SB(1, 0), cB + kstep, voffB); PG8_STAGE(PG8_SA(1, 0), cA + kstep, voffA); PG8_STAGE_B1(PG8_SB(1, 1), cB + hstepB + kstep);
        PG8_WAIT_VD(6, 4); PG8_BAR;
    } else {
        PG8_STAGE(PG8_SB(0, 0), cB, voffB); PG8_STAGE(PG8_SA(0, 0), cA, voffA); PG8_STAGE(PG8_SB(0, 1), cB + hstepB, voffB); PG8_STAGE(PG8_SA(0, 1), cA + hstep, voffA);
        if (wr == 1) PG8_BAR;
        PG8_WAIT_V(4); PG8_BAR;
        PG8_STAGE(PG8_SB(1, 0), cB + kstep, voffB); PG8_STAGE(PG8_SA(1, 0), cA + kstep, voffA); PG8_STAGE(PG8_SB(1, 1), cB + hstepB + kstep, voffB);
        PG8_WAIT_V(6); PG8_BAR;
    }
    for (;;) {
        const bool has_next = S.next(ui + 1, nxt);
        if constexpr (GATHER) { if (has_next) {
#pragma unroll
            for (int i = 0; i < 2; ++i) { ns[i] = S.row_of(nxt, gR[i]); ns[2 + i] = S.row_of(nxt, HALF + gR[i]); } } }
        const char* nA = (has_next && !GATHER) ? (const char*)g.A + (size_t)nxt.pm * tstep + PG8_KOFF(nxt) : cA; const char* nB = has_next ? (const char*)g.Bt + (size_t)nxt.pn * tstepB + PG8_KOFF(nxt) : cB;
        for (int t = 0; t < nt; t += 2) {
            const bool last = (t == nt - 2);
            if constexpr (Epi::MID_T > 0) { if (t == Epi::MID_T) E.mid(acc, cur, wr, wc, fr, fq); }
            const char* a1 = cA + (size_t)(t + 1) * kstep;
            const char* a2 = last ? nA : cA + (size_t)(t + 2) * kstep; const char* b2 = last ? nB : cB + (size_t)(t + 2) * kstep;
            const char* a3 = a2 + kstep; const char* b3 = b2 + kstep;
            if (last && has_next) S.a_ready(nxt);
            if constexpr (SP2) {
            PG8_LDB(B0, 0, 0); if constexpr (!DUAL_T) PG8_LDB(B1, 0, 1); PG8_SCHED; PG8_LDA(At, 0, 0); PG8_STAGE_A1(PG8_SA(1, 1), a1);
            if constexpr (GATHER) { if (last && has_next) {
#pragma unroll
                for (int i = 0; i < 2; ++i) { voffA[i] = PG8_GOFF(ns[i], i); voffA1[i] = PG8_GOFF(ns[2 + i], i); } } }
            PG8_WAIT_VD(8, 6); PG8_WAIT_L(0); PG8_BAR; PG8_MMA2(0); PG8_BAR; PG8_SCHED;
            PG8_LDA(At, 0, 1); PG8_STAGE(PG8_SB(0, 0), b2, voffB); PG8_STAGE_B1(PG8_SB(0, 1), b2 + hstepB); PG8_STAGE(PG8_SA(0, 0), a2, voffA);
            PG8_WAIT_VD(8, 6); PG8_WAIT_L(0); PG8_BAR; PG8_MMA2(1); PG8_BAR; PG8_SCHED;
            PG8_LDB(B0, 1, 0); if constexpr (!DUAL_T) PG8_LDB(B1, 1, 1); PG8_SCHED; PG8_LDA(At, 1, 0); PG8_STAGE_A1(PG8_SA(0, 1), a2);
            PG8_WAIT_VD(8, 6); PG8_WAIT_L(0); PG8_BAR; PG8_MMA2(0); PG8_BAR; PG8_SCHED;
            PG8_LDA(At, 1, 1); PG8_STAGE(PG8_SB(1, 0), b3, voffB); PG8_STAGE_B1(PG8_SB(1, 1), b3 + hstepB); PG8_STAGE(PG8_SA(1, 0), a3, voffA);
            PG8_WAIT_VD(8, 6); PG8_WAIT_L(0); PG8_BAR; PG8_MMA2(1); PG8_BAR; PG8_SCHED;
            } else {
            PG8_LDB(B0, 0, 0); PG8_SCHED; PG8_LDA(At, 0, 0); PG8_STAGE(PG8_SA(1, 1), a1 + hstep, voffA);
            PG8_WAIT_L(8); PG8_BAR; PG8_WAIT_L(0); PG8_MMA(0, 0, At, B0); PG8_BAR; PG8_SCHED;
            PG8_LDB(B1, 0, 1); PG8_STAGE(PG8_SB(0, 0), b2, voffB);
            PG8_BAR; PG8_WAIT_L(0); PG8_MMA(0, 1, At, B1); PG8_BAR;
            PG8_LDA(At, 0, 1); PG8_STAGE(PG8_SA(0, 0), a2, voffA);
            PG8_BAR; PG8_WAIT_L(0); PG8_MMA(1, 0, At, B0); PG8_BAR; PG8_SCHED;
            PG8_STAGE(PG8_SB(0, 1), b2 + hstepB, voffB);
            PG8_WAIT_V(6); PG8_BAR; PG8_MMA(1, 1, At, B1); PG8_BAR;
            PG8_LDB(B0, 1, 0); PG8_SCHED; PG8_LDA(At, 1, 0); PG8_STAGE(PG8_SA(0, 1), a2 + hstep, voffA);
            PG8_WAIT_L(8); PG8_BAR; PG8_WAIT_L(0); PG8_MMA(0, 0, At, B0); PG8_BAR; PG8_SCHED;
            PG8_LDB(B1, 1, 1); PG8_STAGE(PG8_SB(1, 0), b3, voffB);
            PG8_BAR; PG8_WAIT_L(0); PG8_MMA(0, 1, At, B1); PG8_BAR;
            PG8_LDA(At, 1, 1); PG8_STAGE(PG8_SA(1, 0), a3, voffA);
            PG8_BAR; PG8_WAIT_L(0); PG8_MMA(1, 0, At, B0); PG8_BAR; PG8_SCHED;
            PG8_STAGE(PG8_SB(1, 1), b3 + hstepB, voffB);
            PG8_WAIT_V(6); PG8_BAR; PG8_MMA(1, 1, At, B1); PG8_BAR;
            }
        }
        if constexpr (ALIGN_EPI) { if (wr == 0) PG8_BAR; }
        if constexpr (!Epi::AFTER_DRAIN) { E(acc, cur, wr, wc, fr, fq); S.done(cur); }
        if (!has_next) break;
        bool zero_acc = true; if constexpr (Epi::MULTI) zero_acc = E.reset(cur.part);
        if (zero_acc) {
#pragma unroll
        for (int a = 0; a < 2; ++a)
#pragma unroll
            for (int b = 0; b < 2; ++b)
#pragma unroll
                for (int m = 0; m < 4; ++m)
#pragma unroll
                    for (int n = 0; n < 2; ++n) acc[a][b][m][n] = (f32x4){0.f, 0.f, 0.f, 0.f};
        }
        cur = nxt; cA = nA; cB = nB; ++ui;
        if constexpr (Epi::MULTI) { nt = E.nkt(cur.part); asm volatile("" : "+s"(nt)); }
        if constexpr (ALIGN_EPI) { if (wr == 1) PG8_BAR; }
    }
    PG8_WAIT_V(0);
    if constexpr (!ALIGN_EPI) { if (wr == 0) PG8_BAR; }
    PG8_BAR;
#undef PG8_SA
#undef PG8_SB
#undef PG8_STAGE
#undef PG8_LDA
#undef PG8_LD32
#undef PG8_LDB
#undef PG8_MMA
#undef PG8_MMA2
#undef PG8_MMA_I8
#undef PG8_MMA_F8
#undef PG8_KOFF
#undef PG8_STAGE_B1
#undef PG8_WAIT_VD
#undef PG8_STAGE_A1
#undef PG8_GOFF
#undef PG8_WAIT_V
#undef PG8_WAIT_L
#undef PG8_BAR
#undef PG8_SCHED
}
}

typedef f32x4 acc_t[2][2][4][2];
using pg8::Unit; using pg8::HALF; using pg8::BM;

struct EpiInproj {
    static constexpr bool PERM = true, AFTER_DRAIN = false; static constexpr bool MULTI = false; static constexpr int MID_T = 0;
    unsigned char* ws; const float* b_in; const float* g_q; const float* g_k; const float* rstdx;
    __device__ __forceinline__ void operator()(const acc_t& acc, const Unit& u, int wr, int wc, int fr, int fq) const {
        const int pn = u.pn;
        int mode, col0; size_t off;
        if (pn < 12) { const int seg = pn >> 1; mode = seg == 0 ? 1 : (seg == 1 ? 2 : 0); col0 = 256 * (pn & 1) + ((seg == 2 || seg == 4 || seg == 5) ? 512 : 0);
            off = (seg == 0 || seg == 4) ? WS_A1 : ((seg == 1 || seg == 2) ? WS_B1 : WS_C1); }
        else if (pn < 16) { mode = 3; col0 = 256 * (pn - 12); off = WS_SGA; }
        else { mode = 3; col0 = 256 * (pn - 16); off = WS_SGC; }
        constexpr int pitch = 1024;
        bf16_t* base = (bf16_t*)(ws + off);
        const int lc0 = 64 * wc + 8 * fq;
        f32x4 bv[2][2], gv[2][2];
#pragma unroll
        for (int bj = 0; bj < 2; ++bj)
#pragma unroll
            for (int n = 0; n < 2; ++n) {
                bv[bj][n] = *(const f32x4*)(b_in + 256 * pn + lc0 + 32 * bj + 4 * n);
                const float* g = (mode == 2) ? g_k : g_q;
                gv[bj][n] = *(const f32x4*)(g + 8 * fq + 32 * bj + 4 * n);
            }
        const float qs = (mode == 1) ? C2 : 1.0f;
        float rsxv[2][4];
#pragma unroll
        for (int ai = 0; ai < 2; ++ai)
#pragma unroll
            for (int m = 0; m < 4; ++m) rsxv[ai][m] = rstdx[u.pm * BM + ai * HALF + wr * 64 + m * 16 + fr];
#pragma unroll
        for (int ai = 0; ai < 2; ++ai)
#pragma unroll
            for (int m = 0; m < 4; ++m) {
                const int row = u.pm * BM + ai * HALF + wr * 64 + m * 16 + fr; const float rsx = rsxv[ai][m];
                f32x4 v[2][2];
#pragma unroll
                for (int bj = 0; bj < 2; ++bj)
#pragma unroll
                    for (int n = 0; n < 2; ++n) v[bj][n] = acc[ai][bj][m][n] * rsx + bv[bj][n];
                if (mode == 1 || mode == 2) {
                    float ss = 0.f;
#pragma unroll
                    for (int bj = 0; bj < 2; ++bj)
#pragma unroll
                        for (int n = 0; n < 2; ++n) { const f32x4 x = v[bj][n]; ss += (x[0] * x[0] + x[1] * x[1]) + (x[2] * x[2] + x[3] * x[3]); }
                    ss += __shfl_xor(ss, 16); ss += __shfl_xor(ss, 32);
                    const float rstd = __frsqrt_rn(ss * (1.0f / 64.0f) + EPS) * qs;
#pragma unroll
                    for (int bj = 0; bj < 2; ++bj)
#pragma unroll
                        for (int n = 0; n < 2; ++n) v[bj][n] = v[bj][n] * rstd * gv[bj][n];
                } else if (mode == 3) {
#pragma unroll
                    for (int bj = 0; bj < 2; ++bj)
#pragma unroll
                        for (int n = 0; n < 2; ++n)
#pragma unroll
                            for (int j = 0; j < 4; ++j) v[bj][n][j] = sigmoidf_(v[bj][n][j]);
                }
                if (mode == 3) {
                    unsigned char* rp8 = (unsigned char*)base + (size_t)row * pitch + col0 + lc0; const float lo = (pn >= 16) ? 1.0f : 0.0f;
#pragma unroll
                    for (int bj = 0; bj < 2; ++bj) { unsigned w2[2];
#pragma unroll
                        for (int n = 0; n < 2; ++n) { unsigned b4 = 0;
#pragma unroll
                            for (int j = 0; j < 4; ++j) b4 |= (unsigned)__float2int_rn(fmaxf(v[bj][n][j] * 255.0f, lo)) << (8 * j);
                            w2[n] = b4; }
                        *(u32x2*)(rp8 + 32 * bj) = (u32x2){w2[0], w2[1]}; }
                    continue;
                }
                bf16_t* rowp = base + (size_t)row * pitch + col0 + lc0;
#pragma unroll
                for (int bj = 0; bj < 2; ++bj) {
                    u32x4 w; w.x = pg8::cvt_pk_bf16(v[bj][0][0], v[bj][0][1]); w.y = pg8::cvt_pk_bf16(v[bj][0][2], v[bj][0][3]); w.z = pg8::cvt_pk_bf16(v[bj][1][0], v[bj][1][1]); w.w = pg8::cvt_pk_bf16(v[bj][1][2], v[bj][1][3]);
                    *(u32x4*)(rowp + 32 * bj) = w;
                }
            }
    }
};

struct EpiGateF8 {
    static constexpr bool PERM = true, AFTER_DRAIN = false; static constexpr bool MULTI = false; static constexpr int MID_T = 0;
    unsigned char* sga8; unsigned char* sgc8; const float* bias; const float* rstdx;
    __device__ __forceinline__ void operator()(const acc_t& acc, const Unit& u, int wr, int wc, int fr, int fq) const {
        const int pn = u.pn; unsigned char* base = (pn < 4 ? sga8 : sgc8) + 256 * (pn & 3) + wc * 32 + 8 * fq; const float lo = (pn >= 4) ? 1.0f : 0.0f;
        f32x4 bv[2][2]; float rsxv[2][4];
#pragma unroll
        for (int bj = 0; bj < 2; ++bj)
#pragma unroll
            for (int n = 0; n < 2; ++n) bv[bj][n] = *(const f32x4*)(bias + 256 * pn + wc * 32 + 8 * fq + bj * HALF + 4 * n);
#pragma unroll
        for (int ai = 0; ai < 2; ++ai)
#pragma unroll
            for (int m = 0; m < 4; ++m) rsxv[ai][m] = rstdx[u.pm * BM + ai * HALF + wr * 64 + m * 16 + fr] * (1.0f / F8W);
#pragma unroll
        for (int ai = 0; ai < 2; ++ai)
#pragma unroll
            for (int m = 0; m < 4; ++m) {
                const int row = u.pm * BM + ai * HALF + wr * 64 + m * 16 + fr; const float rs = rsxv[ai][m];
#pragma unroll
                for (int bj = 0; bj < 2; ++bj) { unsigned w2[2];
#pragma unroll
                    for (int n = 0; n < 2; ++n) { unsigned b4 = 0;
#pragma unroll
                        for (int j = 0; j < 4; ++j) b4 |= (unsigned)__float2int_rn(fmaxf(sigmoidf_(acc[ai][bj][m][n][j] * rs + bv[bj][n][j]) * 255.0f, lo)) << (8 * j);
                        w2[n] = b4; }
                    *(u32x2*)(base + (size_t)row * 1024 + bj * HALF) = (u32x2){w2[0], w2[1]}; }
            }
    }
};

struct EpiMergeDual {
    static constexpr bool PERM = true, AFTER_DRAIN = false; static constexpr bool MULTI = false; static constexpr int MID_T = 0;
    const bf16_t* sga; const bf16_t* sgc; bf16_t* mout;
    __device__ __forceinline__ void operator()(const acc_t& acc, const Unit& u, int wr, int wc, int fr, int fq) const {
        const int col0 = u.pn * HALF + wc * 32 + 8 * fq;
#pragma unroll
        for (int ai = 0; ai < 2; ++ai)
#pragma unroll
            for (int m = 0; m < 4; ++m) {
                const size_t ro = (size_t)(u.pm * BM + ai * HALF + wr * 64 + m * 16 + fr) * D + col0;
                const u32x4 a = *(const u32x4*)(sga + ro), c = *(const u32x4*)(sgc + ro);
                const f32x4 x0 = acc[ai][0][m][0], x1 = acc[ai][0][m][1], y0 = acc[ai][1][m][0], y1 = acc[ai][1][m][1];
                u32x4 w;
                w.x = pg8::cvt_pk_bf16(x0[0] * bf_lo(a.x) + y0[0] * bf_lo(c.x), x0[1] * bf_hi(a.x) + y0[1] * bf_hi(c.x));
                w.y = pg8::cvt_pk_bf16(x0[2] * bf_lo(a.y) + y0[2] * bf_lo(c.y), x0[3] * bf_hi(a.y) + y0[3] * bf_hi(c.y));
                w.z = pg8::cvt_pk_bf16(x1[0] * bf_lo(a.z) + y1[0] * bf_lo(c.z), x1[1] * bf_hi(a.z) + y1[1] * bf_hi(c.z));
                w.w = pg8::cvt_pk_bf16(x1[2] * bf_lo(a.w) + y1[2] * bf_lo(c.w), x1[3] * bf_hi(a.w) + y1[3] * bf_hi(c.w));
                *(u32x4*)(mout + ro) = w;
            }
    }
};

struct EpiResBf16 {
    static constexpr bool PERM = true, AFTER_DRAIN = false; static constexpr bool MULTI = false; static constexpr int MID_T = 0;
    const bf16_t* xb; bf16_t* h1b; unsigned char* h1f8;
    __device__ __forceinline__ void operator()(const acc_t& acc, const Unit& u, int wr, int wc, int fr, int fq) const {
        const int col0 = u.pn * BM + wc * 32 + 8 * fq;
        u32x4 xv[2][4][2];
#pragma unroll
        for (int ai = 0; ai < 2; ++ai)
#pragma unroll
            for (int m = 0; m < 4; ++m)
#pragma unroll
                for (int bj = 0; bj < 2; ++bj) xv[ai][m][bj] = *(const u32x4*)(xb + (size_t)(u.pm * BM + ai * HALF + wr * 64 + m * 16 + fr) * D + col0 + bj * HALF);
#pragma unroll
        for (int ai = 0; ai < 2; ++ai)
#pragma unroll
            for (int m = 0; m < 4; ++m) {
                const size_t ro = (size_t)(u.pm * BM + ai * HALF + wr * 64 + m * 16 + fr) * D + col0;
#pragma unroll
                for (int bj = 0; bj < 2; ++bj) {
                    const u32x4 x = xv[ai][m][bj]; const f32x4 v0 = acc[ai][bj][m][0], v1 = acc[ai][bj][m][1];
                    u32x4 w; w.x = pg8::cvt_pk_bf16(v0[0] + bf_lo(x.x), v0[1] + bf_hi(x.x)); w.y = pg8::cvt_pk_bf16(v0[2] + bf_lo(x.y), v0[3] + bf_hi(x.y));
                    w.z = pg8::cvt_pk_bf16(v1[0] + bf_lo(x.z), v1[1] + bf_hi(x.z)); w.w = pg8::cvt_pk_bf16(v1[2] + bf_lo(x.w), v1[3] + bf_hi(x.w));
                    *(u32x4*)(h1b + ro + bj * HALF) = w;
                    if (h1f8) { u32x2 q; q.x = pk4_fp8(v0[0] + bf_lo(x.x), v0[1] + bf_hi(x.x), v0[2] + bf_lo(x.y), v0[3] + bf_hi(x.y)); q.y = pk4_fp8(v1[0] + bf_lo(x.z), v1[1] + bf_hi(x.z), v1[2] + bf_lo(x.w), v1[3] + bf_hi(x.w)); *(u32x2*)(h1f8 + ro + bj * HALF) = q; }
                }
            }
    }
};

__device__ __forceinline__ int moe_local(const LAS int* pref, int e, int rtg, int r) { const int l = (rtg - pref[e]) * pg8::BM + r; return l < pref[64 + e] ? ((e << 15) | l) : -1; }
__device__ __forceinline__ LAS u32x2* moe_meta(LAS unsigned char* lds, int i) { return (LAS u32x2*)(lds + (i < 4 ? META_LO + i * 2048 : META_HI)); }
__device__ __forceinline__ void moe_meta_preload(LAS unsigned char* lds, const LAS int* pref, int nunits, int G, int c, const int* eslot, const float* ftab, bool by_token, int tid) {
    for (int j = tid; j < 5 * 256; j += 512) { const int i = j >> 8, r = j & 255, L = i * G + c;
        int slot = -1; float f = 0.f;
        if (L < nunits) { const int rtg = L >> 2; int e = 0;
#pragma unroll 4
            for (int k = 1; k < NE; ++k) e += (pref[k] <= rtg) ? 1 : 0;
            const int idx = moe_local(pref, e, rtg, r);
            if (idx >= 0) { slot = eslot[idx]; f = by_token ? ftab[slot >> 1] : ftab[idx]; } }
        moe_meta(lds, i)[r] = (u32x2){(unsigned)slot, __builtin_bit_cast(unsigned, f)}; }
    __syncthreads();
}
template <int F8> struct EpiSwigluT {
    static constexpr bool PERM = true, AFTER_DRAIN = false; static constexpr bool MULTI = false; static constexpr int MID_T = 0;
    bf16_t* hdn; LAS unsigned char* lds; static constexpr float wsc = F8 ? 1.0f / F8W : 1.0f; static constexpr int f8out = F8 && F8_DOWN;
    __device__ __forceinline__ void operator()(const acc_t& acc, const Unit& u, int wr, int wc, int fr, int fq) const {
        const int col0 = 128 * (u.pn & 3) + wc * 32 + 8 * fq;
        float rsv[2][4]; const LAS float* mp = (const LAS float*)moe_meta(lds, u.part) + 1;
#pragma unroll
        for (int ai = 0; ai < 2; ++ai)
#pragma unroll
            for (int m = 0; m < 4; ++m) rsv[ai][m] = mp[2 * (ai * HALF + wr * 64 + m * 16 + fr)] * wsc;
#pragma unroll
        for (int ai = 0; ai < 2; ++ai)
#pragma unroll
            for (int m = 0; m < 4; ++m) {
                const int row = u.pm * BM + ai * HALF + wr * 64 + m * 16 + fr; const float rs = rsv[ai][m];
                const size_t ro = (size_t)row * DE + col0;
                float h[8];
#pragma unroll
                for (int n = 0; n < 2; ++n)
#pragma unroll
                    for (int j = 0; j < 4; ++j) { const float a = acc[ai][0][m][n][j] * rs, b = acc[ai][1][m][n][j] * rs; h[4 * n + j] = a * sigmoidf_(a) * b; }
                if (f8out) { u32x2 q; q.x = pk4_fp8(h[0], h[1], h[2], h[3]); q.y = pk4_fp8(h[4], h[5], h[6], h[7]); *(u32x2*)((unsigned char*)hdn + ro) = q; }
                else { u32x4 w; w.x = pg8::cvt_pk_bf16(h[0], h[1]); w.y = pg8::cvt_pk_bf16(h[2], h[3]); w.z = pg8::cvt_pk_bf16(h[4], h[5]); w.w = pg8::cvt_pk_bf16(h[6], h[7]);
                *(u32x4*)(hdn + ro) = w; }
            }
    }
};

template <int F8> struct EpiDownT {
    static constexpr bool PERM = true, AFTER_DRAIN = false; static constexpr bool MULTI = false; static constexpr int MID_T = 0;
    bf16_t* contrib; LAS unsigned char* lds; static constexpr float wsc = F8 ? 1.0f / F8W : 1.0f;
    __device__ __forceinline__ void operator()(const acc_t& acc, const Unit& u, int wr, int wc, int fr, int fq) const {
        const int col0 = 256 * (u.pn & 3) + wc * 32 + 8 * fq;
#pragma unroll
        for (int ai = 0; ai < 2; ++ai) {
            int sl[4]; float wv[4];
#pragma unroll
            for (int m = 0; m < 4; ++m) { const LAS unsigned* mq = (const LAS unsigned*)moe_meta(lds, u.part) + 2 * (ai * HALF + wr * 64 + m * 16 + fr); sl[m] = (int)mq[0]; wv[m] = __builtin_bit_cast(float, mq[1]) * wsc; }
#pragma unroll
            for (int m = 0; m < 4; ++m) {
                const int slot = sl[m]; const float w = wv[m];
                if (slot >= 0) {
#pragma unroll
                    for (int bj = 0; bj < 2; ++bj) {
                        const f32x4 v0 = acc[ai][bj][m][0] * w, v1 = acc[ai][bj][m][1] * w;
                        u32x4 o; o.x = pg8::cvt_pk_bf16(v0[0], v0[1]); o.y = pg8::cvt_pk_bf16(v0[2], v0[3]); o.z = pg8::cvt_pk_bf16(v1[0], v1[1]); o.w = pg8::cvt_pk_bf16(v1[2], v1[3]);
                        *(u32x4*)(contrib + (size_t)slot * D + col0 + bj * HALF) = o;
                    }
                }
                asm volatile("" ::: "memory");
            }
        }
    }
};

struct EpiGateDual {
    static constexpr bool PERM = false, AFTER_DRAIN = false; static constexpr bool MULTI = false; static constexpr int MID_T = 0;
    const bf16_t* h2b; const float* rsc; const float* cmax; const float* bpg; float* out;
    __device__ __forceinline__ void operator()(const acc_t& acc, const Unit& u, int wr, int wc, int fr, int fq) const {
        const int col0 = u.pn * HALF + wc * 32 + 4 * fq;
        f32x4 cs[2], bv[2]; float rsv[2][4]; u32x2 hv[2][4][2];
#pragma unroll
        for (int n = 0; n < 2; ++n) { cs[n] = *(const f32x4*)(cmax + col0 + n * 16) * (1.0f / 127.0f); bv[n] = *(const f32x4*)(bpg + col0 + n * 16); }
#pragma unroll
        for (int ai = 0; ai < 2; ++ai)
#pragma unroll
            for (int m = 0; m < 4; ++m) { const int row = u.pm * BM + ai * HALF + wr * 64 + m * 16 + fr; rsv[ai][m] = rsc[row];
#pragma unroll
                for (int n = 0; n < 2; ++n) hv[ai][m][n] = *(const u32x2*)(h2b + (size_t)row * D + col0 + n * 16); }
#pragma unroll
        for (int ai = 0; ai < 2; ++ai)
#pragma unroll
            for (int m = 0; m < 4; ++m) {
                const int row = u.pm * BM + ai * HALF + wr * 64 + m * 16 + fr; const float rs = rsv[ai][m];
#pragma unroll
                for (int n = 0; n < 2; ++n) {
                    const int c = col0 + n * 16;
                    const u32x2 hw = hv[ai][m][n];
                    const i32x4 ia = __builtin_bit_cast(i32x4, acc[ai][0][m][n]); const f32x4 pv = acc[ai][1][m][n];
                    f32x4 a; a[0] = (float)ia[0] * rs * cs[n][0] + bv[n][0]; a[1] = (float)ia[1] * rs * cs[n][1] + bv[n][1]; a[2] = (float)ia[2] * rs * cs[n][2] + bv[n][2]; a[3] = (float)ia[3] * rs * cs[n][3] + bv[n][3];
                    f32x4 r;
                    r[0] = bf_lo(hw.x) + sigmoidf_(a[0]) * pv[0]; r[1] = bf_hi(hw.x) + sigmoidf_(a[1]) * pv[1];
                    r[2] = bf_lo(hw.y) + sigmoidf_(a[2]) * pv[2]; r[3] = bf_hi(hw.y) + sigmoidf_(a[3]) * pv[3];
                    *(f32x4*)(out + (size_t)row * D + c) = r;
                }
            }
    }
};

struct EpiMerge2 {
    static constexpr bool PERM = true, AFTER_DRAIN = false; static constexpr bool MULTI = true; static constexpr int MID_T = 0;
    const unsigned char* sga; const unsigned char* sgc; bf16_t* mout;
    __device__ __forceinline__ int kt0(int part) const { return 8 * part; }
    __device__ __forceinline__ int nkt(int) const { return 8; }
    __device__ __forceinline__ bool reset(int part) const { return part == 1; }
    static __device__ __forceinline__ float u8(unsigned w, int j) { return (float)((w >> (8 * j)) & 0xffu); }
    __device__ __forceinline__ void operator()(acc_t& acc, const Unit& u, int wr, int wc, int fr, int fq) const {
        const int col0 = u.pn * BM + wc * 32 + 8 * fq;
        if (u.part == 0) {
            u32x2 av[2][4][2], cv[2][4][2];
#pragma unroll
            for (int ai = 0; ai < 2; ++ai)
#pragma unroll
                for (int m = 0; m < 4; ++m)
#pragma unroll
                    for (int bj = 0; bj < 2; ++bj) { const size_t o = (size_t)(u.pm * BM + ai * HALF + wr * 64 + m * 16 + fr) * D + col0 + bj * HALF; av[ai][m][bj] = *(const u32x2*)(sga + o); cv[ai][m][bj] = *(const u32x2*)(sgc + o); }
#pragma unroll
            for (int ai = 0; ai < 2; ++ai)
#pragma unroll
                for (int m = 0; m < 4; ++m)
#pragma unroll
                    for (int bj = 0; bj < 2; ++bj) {
                        const u32x2 a = av[ai][m][bj], c = cv[ai][m][bj];
#pragma unroll
                        for (int j = 0; j < 4; ++j) { acc[ai][bj][m][0][j] *= u8(a.x, j) * __builtin_amdgcn_rcpf(u8(c.x, j)); acc[ai][bj][m][1][j] *= u8(a.y, j) * __builtin_amdgcn_rcpf(u8(c.y, j)); }
                    }
        } else {
            u32x2 cv[2][4][2];
#pragma unroll
            for (int ai = 0; ai < 2; ++ai)
#pragma unroll
                for (int m = 0; m < 4; ++m)
#pragma unroll
                    for (int bj = 0; bj < 2; ++bj) cv[ai][m][bj] = *(const u32x2*)(sgc + (size_t)(u.pm * BM + ai * HALF + wr * 64 + m * 16 + fr) * D + col0 + bj * HALF);
#pragma unroll
            for (int ai = 0; ai < 2; ++ai)
#pragma unroll
                for (int m = 0; m < 4; ++m) {
                    const size_t ro = (size_t)(u.pm * BM + ai * HALF + wr * 64 + m * 16 + fr) * D + col0;
#pragma unroll
                    for (int bj = 0; bj < 2; ++bj) {
                        const u32x2 c = cv[ai][m][bj]; const f32x4 v0 = acc[ai][bj][m][0], v1 = acc[ai][bj][m][1]; constexpr float k = 1.0f / 255.0f;
                        u32x4 w; w.x = pg8::cvt_pk_bf16(v0[0] * u8(c.x, 0) * k, v0[1] * u8(c.x, 1) * k); w.y = pg8::cvt_pk_bf16(v0[2] * u8(c.x, 2) * k, v0[3] * u8(c.x, 3) * k);
                        w.z = pg8::cvt_pk_bf16(v1[0] * u8(c.y, 0) * k, v1[1] * u8(c.y, 1) * k); w.w = pg8::cvt_pk_bf16(v1[2] * u8(c.y, 2) * k, v1[3] * u8(c.y, 3) * k);
                        *(u32x4*)(mout + ro + bj * HALF) = w;
                    }
                }
        }
    }
};

template <bool GATHER_> struct MoeOrderT {
    static constexpr bool GATHER = GATHER_;
    const LAS int* pref;
    int nunits, G, c; LAS unsigned char* lds;
    __device__ __forceinline__ int row_of(const Unit& u, int r) const { return ((const LAS int*)moe_meta(lds, u.part))[2 * r]; }
    __device__ __forceinline__ bool next(int i, Unit& u) const {
        const int L = i * G + c; if (L >= nunits) return false;
        const int rtg = L >> 2, pnl = L & 3; int e = 0;
#pragma unroll 4
        for (int k = 1; k < NE; ++k) e += (pref[k] <= rtg) ? 1 : 0;
        e = __builtin_amdgcn_readfirstlane(e);
        u.pm = rtg; u.pn = 4 * e + pnl; u.part = i; return true;
    }
    __device__ __forceinline__ void a_ready(const Unit&) const {}
    __device__ __forceinline__ void done(const Unit&) const {}
};
struct StaticOrderId : pg8::StaticOrder {
    static constexpr bool GATHER = true;
    __device__ __forceinline__ int row_of(const Unit& u, int r) const { return 2 * (u.pm * pg8::BM + r); }
};
struct MoeOrderId : MoeOrderT<true> {
    __device__ __forceinline__ int row_of(const Unit& u, int r) const { return 2 * (u.pm * pg8::BM + r); }
};

#define XB_TMO      128
#define XB_XCNT(j)  (256  + 64 * (j))
#define XB_XSUB(j)  (1280 + 64 * (j))
#define XB_XGEN(j)  (2304 + 64 * (j))
#define XB_TOP      3328
#define XB_TOPGEN   3392
#define XCD_BAR_WORDS 3456
#define XB_SPIN_CAP (1u << 18)

__device__ __forceinline__ unsigned xb_ld(unsigned* p)              { return __hip_atomic_load(p, __ATOMIC_RELAXED, __HIP_MEMORY_SCOPE_AGENT); }
__device__ __forceinline__ unsigned xb_add(unsigned* p, unsigned v) { return __hip_atomic_fetch_add(p, v, __ATOMIC_RELAXED, __HIP_MEMORY_SCOPE_AGENT); }
__device__ __forceinline__ unsigned xb_xcc_id() { return (unsigned)__builtin_amdgcn_s_getreg((3 << 11) | 20) & 0xFu; }
#define XB_SPIN(cond, bar) do { unsigned _sp = 0; while (cond) { __builtin_amdgcn_s_sleep(1); \
    if ((++_sp & 255u) == 0u) { if (xb_ld(&(bar)[XB_TMO])) break; if (_sp > XB_SPIN_CAP) { atomicAdd(&(bar)[XB_TMO], 1u); break; } } } } while (0)

struct XcdBarrier {
    unsigned* bar; unsigned x;
    volatile LAS unsigned* st;
};

__device__ __forceinline__ XcdBarrier xcd_barrier_post(unsigned* bar, volatile LAS unsigned* st) {
    XcdBarrier b; b.bar = bar; b.x = xb_xcc_id(); b.st = st;
    if (threadIdx.x == 0) (void)xb_add(&bar[XB_XCNT(b.x)], 1u);
    return b;
}
__device__ __forceinline__ void xcd_barrier_complete(unsigned* bar, unsigned x, unsigned& nloc, unsigned& nx) {
    const unsigned G = gridDim.x * gridDim.y * gridDim.z;
    unsigned sum, cnt, mine, sp = 0u;
    for (;;) {
        sum = 0u; cnt = 0u; mine = 0u;
#pragma unroll
        for (unsigned j = 0; j < 16; ++j) { const unsigned c = xb_ld(&bar[XB_XCNT(j)]); sum += c; cnt += (c > 0u) ? 1u : 0u; mine = (j == x) ? c : mine; }
        if (sum == G) break;
        __builtin_amdgcn_s_sleep(1);
        if ((++sp & 255u) == 0u) { if (xb_ld(&bar[XB_TMO])) break; if (sp > XB_SPIN_CAP) { atomicAdd(&bar[XB_TMO], 1u); break; } }
    }
    nloc = mine > 0u ? mine : 1u; nx = cnt > 0u ? cnt : 1u;
}

__device__ __forceinline__ void xcd_barrier(const XcdBarrier& b, int tid) {
    asm volatile("s_waitcnt vmcnt(0)" ::: "memory");
    __syncthreads();
    if (tid == 0) {
        unsigned* bar = b.bar;
        __builtin_amdgcn_s_waitcnt(0);
        unsigned nloc = b.st[0], nx = b.st[1];
        if (nloc == 0u) { xcd_barrier_complete(bar, b.x, nloc, nx); b.st[0] = nloc; b.st[1] = nx; }
        const unsigned old = xb_add(&bar[XB_XSUB(b.x)], 1u);
        const unsigned gen = old / nloc;
        if (old + 1u == (gen + 1u) * nloc) {
            __builtin_amdgcn_fence(__ATOMIC_RELEASE, "agent");
            asm volatile("s_waitcnt vmcnt(0)" ::: "memory");
            const unsigned og = xb_add(&bar[XB_TOP], 1u);
            const unsigned tg = og / nx;
            if (og + 1u == (tg + 1u) * nx) xb_add(&bar[XB_TOPGEN], 1u);
            else XB_SPIN(xb_ld(&bar[XB_TOPGEN]) == tg, bar);
            __builtin_amdgcn_fence(__ATOMIC_ACQUIRE, "agent");
            xb_add(&bar[XB_XGEN(b.x)], 1u);
            asm volatile("s_waitcnt vmcnt(0)" ::: "memory");
        } else {
            XB_SPIN(xb_ld(&bar[XB_XGEN(b.x)]) == gen, bar);
            __builtin_amdgcn_fence(__ATOMIC_ACQUIRE, "agent");
            asm volatile("s_waitcnt vmcnt(0)" ::: "memory");
        }
    }
    __syncthreads();
}

#include <hip/hip_bf16.h>
#include <cmath>
namespace attn_body {
using bf16=__hip_bfloat16;
using bf16x8=__attribute__((ext_vector_type(8)))short;
using s16x4=__attribute__((ext_vector_type(4)))short;
using f32x16=__attribute__((ext_vector_type(16)))float;
using u32x4=__attribute__((ext_vector_type(4)))unsigned;
constexpr int BATCH=8,NHEAD=8,SEQ=4096,D=64,DM=1024,OPITCH=1024;
constexpr int NW=8,QBLK=32,QB=QBLK*NW,KVBLK=64,NQB=SEQ/QB;
constexpr int ATTN_PITCH=DM, ATTN_UNIT_ROWS=QB;
constexpr int BT_COPY=384, BT_BYTES=4*BT_COPY*4;
__device__ __forceinline__ int crow(int r,int hi){return (r&3)+8*(r>>2)+4*hi;}
#define SBAR() __builtin_amdgcn_sched_barrier(0)
constexpr int NSLOT=3, SLOTB=8192;
constexpr int LDS_K=0, LDS_V=NSLOT*SLOTB, LDS_WS=2*NSLOT*SLOTB, LDS_OST=LDS_WS+NW*64*4, LDS_BT=LDS_OST+NW*4096, LDS_BYTES=LDS_BT+BT_BYTES;
__device__ __forceinline__ void glds16(const void*gsrc,unsigned lds_dst){unsigned keep;
  asm volatile("s_mov_b32 %0, m0\n\ts_mov_b32 m0, %2\n\ts_nop 0\n\tglobal_load_lds_dwordx4 %1, off\n\ts_mov_b32 m0, %0":"=&s"(keep):"v"(gsrc),"s"(lds_dst):"memory");}
__device__ __forceinline__ float max3f(float a,float b,float c){float r;asm("v_max3_f32 %0, %1, %2, %3":"=v"(r):"v"(a),"v"(b),"v"(c));return r;}
__device__ __forceinline__ float max2f(float a,float b){float r;asm("v_max_f32_e32 %0, %1, %2":"=v"(r):"v"(a),"v"(b));return r;}
__device__ __forceinline__ float fadd_s(float a,float b){float r;asm("v_add_f32_e32 %0, %1, %2":"=v"(r):"v"(a),"v"(b));return r;}
__device__ __forceinline__ float fsub_s(float a,float b){float r;asm("v_sub_f32_e32 %0, %1, %2":"=v"(r):"v"(a),"v"(b));return r;}
typedef float f32x2_t __attribute__((ext_vector_type(2))); typedef float f32x4_t __attribute__((ext_vector_type(4))); typedef __bf16 bf16x2_t __attribute__((ext_vector_type(2)));
__device__ __forceinline__ unsigned cvtpk_s(float lo,float hi){f32x2_t v={lo,hi};bf16x2_t b=__builtin_convertvector(v,bf16x2_t);return __builtin_bit_cast(unsigned,b);}
#define WAIT_BAR(N) asm volatile("s_waitcnt vmcnt(" #N ") lgkmcnt(0)\n\ts_barrier":::"memory")

__device__ __forceinline__ void qkt(f32x16&p0,f32x16&p1,const char*Kslot,const bf16x8*qr,const f32x16&negm,int r32,int hi){
  const char*kb=Kslot+hi*1024+r32*16;
  #pragma unroll
  for(int d0=0;d0<4;++d0){
    const bf16x8 b0=*reinterpret_cast<const bf16x8*>(kb+d0*2048);
    const bf16x8 b1=*reinterpret_cast<const bf16x8*>(kb+d0*2048+512);
    if(d0==0){p0=__builtin_amdgcn_mfma_f32_32x32x16_bf16(b0,qr[0],negm,0,0,0);p1=__builtin_amdgcn_mfma_f32_32x32x16_bf16(b1,qr[0],negm,0,0,0);}
    else{p0=__builtin_amdgcn_mfma_f32_32x32x16_bf16(b0,qr[d0],p0,0,0,0);p1=__builtin_amdgcn_mfma_f32_32x32x16_bf16(b1,qr[d0],p1,0,0,0);}}
}
typedef __attribute__((address_space(3))) const char* lds_cptr;
typedef short v4i16_t __attribute__((ext_vector_type(4)));
__device__ __forceinline__ void kload8(bf16x8*kf,lds_cptr kp){
  kf[0]=*(const __attribute__((address_space(3))) bf16x8*)(kp);      kf[1]=*(const __attribute__((address_space(3))) bf16x8*)(kp+512);
  kf[2]=*(const __attribute__((address_space(3))) bf16x8*)(kp+2048); kf[3]=*(const __attribute__((address_space(3))) bf16x8*)(kp+2560);
  kf[4]=*(const __attribute__((address_space(3))) bf16x8*)(kp+4096); kf[5]=*(const __attribute__((address_space(3))) bf16x8*)(kp+4608);
  kf[6]=*(const __attribute__((address_space(3))) bf16x8*)(kp+6144); kf[7]=*(const __attribute__((address_space(3))) bf16x8*)(kp+6656);
}
__device__ __forceinline__ void kload2(bf16x8*kf,lds_cptr kp,int j){ kf[2*j]=*(const __attribute__((address_space(3))) bf16x8*)(kp+j*2048); kf[2*j+1]=*(const __attribute__((address_space(3))) bf16x8*)(kp+j*2048+512); }
__device__ __forceinline__ s16x4 vtr(lds_cptr p){ return __builtin_bit_cast(s16x4,__builtin_amdgcn_ds_read_tr16_b64_v4i16((__attribute__((address_space(3))) v4i16_t*)p)); }
__device__ __forceinline__ float rowmax(const f32x16&p0,const f32x16&p1){
  float a=max3f(p0[0],p0[1],p1[0]),b=max3f(p0[2],p0[3],p1[1]);a=max3f(a,p1[2],p1[3]);
  #pragma unroll
  for(int r=4;r<16;r+=4){a=max3f(a,p0[r],p0[r+1]);b=max3f(b,p0[r+2],p0[r+3]);a=max3f(a,p1[r],p1[r+1]);b=max3f(b,p1[r+2],p1[r+3]);}
  const float m=max2f(a,b);
  auto rr=__builtin_amdgcn_permlane32_swap(__float_as_uint(m),__float_as_uint(m),false,false);
  return max2f(__uint_as_float(rr[0]),__uint_as_float(rr[1]));
}
__device__ __forceinline__ void pv(f32x16*o,int vb,bf16x8 pa0,bf16x8 pa1,bf16x8 pa2,bf16x8 pa3){
  #pragma unroll
  for(int d0=0;d0<2;++d0){s16x4 lo[4],hi[4];
    #pragma unroll
    for(int ks=0;ks<4;++ks){
      asm volatile("ds_read_b64_tr_b16 %0,%1 offset:%c2":"=&v"(lo[ks]):"v"(vb),"i"(d0*4096+ks*1024):"memory");
      asm volatile("ds_read_b64_tr_b16 %0,%1 offset:%c2":"=&v"(hi[ks]):"v"(vb),"i"(d0*4096+ks*1024+512):"memory");}
    asm volatile("s_waitcnt lgkmcnt(0)":::"memory");SBAR();
    #define PK(k) (bf16x8){lo[k][0],lo[k][1],lo[k][2],lo[k][3],hi[k][0],hi[k][1],hi[k][2],hi[k][3]}
    o[d0]=__builtin_amdgcn_mfma_f32_32x32x16_bf16(pa0,PK(0),o[d0],0,0,0);
    o[d0]=__builtin_amdgcn_mfma_f32_32x32x16_bf16(pa1,PK(1),o[d0],0,0,0);
    o[d0]=__builtin_amdgcn_mfma_f32_32x32x16_bf16(pa2,PK(2),o[d0],0,0,0);
    o[d0]=__builtin_amdgcn_mfma_f32_32x32x16_bf16(pa3,PK(3),o[d0],0,0,0);
    #undef PK
  }
}

#ifndef ATTN_STORE16
#define ATTN_STORE16(p,v) (*(u32x4*)(p)=(v))
#endif
__device__ __forceinline__ void attn_unit(int b,int h,int qb,const bf16*Q,const bf16*K,const bf16*V,bf16*O,char*shm,float cinit,int tid){
  asm volatile("":"+v"(tid));
  const int lane=tid&63,r32=lane&31,hi=lane>>5; const int wid=__builtin_amdgcn_readfirstlane(tid>>6);
  const long rowbase=(long)b*SEQ; const int q0=qb*QB;
  const bf16*Qw=Q+(rowbase+q0+wid*QBLK)*DM+h*D;
  const int t0=(4*qb-8)>0?(4*qb-8):0;
  const bf16*Kh=K+(rowbase+(long)t0*KVBLK)*DM+h*D,*Vh=V+(rowbase+(long)t0*KVBLK)*DM+h*D;
  const int tb=t0-4*qb-(wid>>1)+8;
  const unsigned lds0=(unsigned)(uintptr_t)shm;
  float*wsf=(float*)(shm+LDS_WS)+wid*64;
  const bf16*ksrc=Kh+(long)lane*DM+wid*8;
  const bf16*vsrc=Vh+(long)(16*(wid&3)+(lane>>2))*DM+(wid>>2)*32+(lane&3)*8;
  const unsigned kdst=lds0+LDS_K+wid*1024, vdst=lds0+LDS_V+wid*1024;
  #define DMA_K(t,slot) glds16(ksrc+(long)(t)*KVBLK*DM,(unsigned)__builtin_amdgcn_readfirstlane(kdst+(slot)))
  #define DMA_V(t,slot) glds16(vsrc+(long)(t)*KVBLK*DM,(unsigned)__builtin_amdgcn_readfirstlane(vdst+(slot)))
  const int vb0=(int)(lds0+LDS_V)+((lane>>4)&1)*32+(lane&3)*8+(4*hi+((lane&15)>>2))*64;
  const char*Kbase=shm+LDS_K; bf16x8 kf[8];
  const lds_cptr shm3=(lds_cptr)shm; const lds_cptr kp0=shm3+LDS_K+hi*1024+r32*16; const lds_cptr vp0=shm3+LDS_V+((lane>>4)&1)*32+(lane&3)*8+(4*hi+((lane&15)>>2))*64;
  const int NT=4*qb+4-t0;
  const lds_cptr btl=shm3+LDS_BT+((3-r32)&3)*(BT_COPY*4)+4*(-193-32*(wid&1)-r32-((3-r32)&3)+4*hi);
  DMA_K(0,0);DMA_V(0,0);DMA_K(1,SLOTB);
  bf16x8 qr[4];
  #pragma unroll
  for(int d0=0;d0<4;++d0)qr[d0]=*reinterpret_cast<const bf16x8*>(&Qw[(long)r32*DM+d0*16+hi*8]);
  float l_reg=0.f;f32x16 o[2];o[0]=f32x16{};o[1]=f32x16{};f32x16 negm;
  asm volatile("":"+s"(cinit));
  _Pragma("unroll") for(int r=0;r<16;++r)negm[r]=cinit; asm volatile("":"+v"(negm));
  #define BIASMASK(P0,P1,t) do{ const int tau_=(t)+tb; \
    if(tau_<0||tau_>8){ _Pragma("unroll") for(int r=0;r<16;++r){P0[r]=-INFINITY;P1[r]=-INFINITY;} } \
    else if(tau_>=4){ const lds_cptr bp_=btl+256*tau_; \
      _Pragma("unroll") for(int g=0;g<4;++g){ const f32x4_t d0_=*(const __attribute__((address_space(3))) f32x4_t*)(bp_+32*g), d1_=*(const __attribute__((address_space(3))) f32x4_t*)(bp_+32*g+128); \
        _Pragma("unroll") for(int j=0;j<4;++j){P0[4*g+j]+=d0_[j];P1[4*g+j]+=d1_[j];} } } }while(0)
  #define START(P0,P1) do{ _Pragma("unroll") for(int r=0;r<16;++r)P0[r]=__builtin_amdgcn_exp2f(P0[r]); }while(0)
  #define RESC() do{}while(0)
  f32x16 pA0,pA1,pB0,pB1;
  int sl_prev=0,sl_cur=0,sl_next=SLOTB;
  #define ROT() do{sl_prev=sl_cur;sl_cur=sl_next;sl_next=(sl_next==(NSLOT-1)*SLOTB)?0:sl_next+SLOTB;}while(0)
  DMA_K(2,2*SLOTB);
  WAIT_BAR(3);
  qkt(pA0,pA1,Kbase,qr,negm,r32,hi);asm volatile("s_nop 15\n\ts_nop 7":"+v"(pA0),"+v"(pA1));BIASMASK(pA0,pA1,0);
  START(pA0,pA1);
  _Pragma("unroll") for(int r=0;r<16;++r)pA1[r]=__builtin_amdgcn_exp2f(pA1[r]);
  WAIT_BAR(0);
  DMA_K(3,0);DMA_V(1,SLOTB);
  ROT();
  kload8(kf,kp0+sl_cur);
  WAIT_BAR(2);
  s16x4 vlo[8],vhi[8]; u32x4 pw0,pw1,pw2,pw3;
  #define PKW(P,B) cvtpk_s(P[B],P[B+1])
  #define PAF(k) __builtin_bit_cast(bf16x8,pw##k)
  #define VFR(i) (bf16x8){vlo[i][0],vlo[i][1],vlo[i][2],vlo[i][3],vhi[i][0],vhi[i][1],vhi[i][2],vhi[i][3]}
  #define PIN(x) asm volatile("":"+v"(x))
  #define MX3(a,b,c) __builtin_fmaxf(__builtin_fmaxf((a),(b)),(c))
  #define GAPA(MF,A0,A1,A2,A3,W0,W1,PW) do{ MF; sacc+=A0; sacc+=A1; sacc+=A2; sacc+=A3; PIN(sacc); W0; W1; PIN(PW); SBAR(); }while(0)
  #define EX(v) __builtin_amdgcn_exp2f(v)
  #define GAPB(MF,X,B) do{ MF; X[B]=EX(X[B]); X[B+1]=EX(X[B+1]); X[B+2]=EX(X[B+2]); X[B+3]=EX(X[B+3]); PIN(X); SBAR(); }while(0)
  #define VRD(i) do{ vlo[i]=vtr(vp_+(((i)>>2)*4096+((i)&3)*1024)); vhi[i]=vtr(vp_+(((i)>>2)*4096+((i)&3)*1024+512)); }while(0)
  #define KRD(G,j) do{ if(G){ kload2(kf,kp0+sl_next,j); SBAR(); } }while(0)
  #define STEP(C0,C1,P0,P1,t,GK,GV,GL) do{ SBAR(); \
    const lds_cptr vp_=vp0+sl_prev; \
    VRD(0); SBAR(); float sacc=(P0[0]+P0[1]); \
    GAPA(C0=__builtin_amdgcn_mfma_f32_32x32x16_bf16(kf[0],qr[0],negm,0,0,0), P0[2],P0[3],P0[4],P0[5],     pw0[0]=PKW(P0,0), pw0[1]=PKW(P0,2), pw0); \
    VRD(4); SBAR(); GAPA(C1=__builtin_amdgcn_mfma_f32_32x32x16_bf16(kf[1],qr[0],negm,0,0,0), P0[6],P0[7],P0[8],P0[9],     pw0[2]=PKW(P0,4), pw0[3]=PKW(P0,6), pw0); \
    VRD(1); SBAR(); GAPA(C0=__builtin_amdgcn_mfma_f32_32x32x16_bf16(kf[2],qr[1],C0,0,0,0),   P0[10],P0[11],P0[12],P0[13], pw1[0]=PKW(P0,8), pw1[1]=PKW(P0,10), pw1); \
    VRD(5); SBAR(); GAPA(C1=__builtin_amdgcn_mfma_f32_32x32x16_bf16(kf[3],qr[1],C1,0,0,0),   P0[14],P0[15],P1[0],P1[1],   pw1[2]=PKW(P0,12),pw1[3]=PKW(P0,14), pw1); \
    VRD(2); SBAR(); GAPA(C0=__builtin_amdgcn_mfma_f32_32x32x16_bf16(kf[4],qr[2],C0,0,0,0),   P1[2],P1[3],P1[4],P1[5],     pw2[0]=PKW(P1,0), pw2[1]=PKW(P1,2), pw2); \
    VRD(6); SBAR(); GAPA(C1=__builtin_amdgcn_mfma_f32_32x32x16_bf16(kf[5],qr[2],C1,0,0,0),   P1[6],P1[7],P1[8],P1[9],     pw2[2]=PKW(P1,4), pw2[3]=PKW(P1,6), pw2); \
    VRD(3); SBAR(); GAPA(C0=__builtin_amdgcn_mfma_f32_32x32x16_bf16(kf[6],qr[3],C0,0,0,0),   P1[10],P1[11],P1[12],P1[13], pw3[0]=PKW(P1,8), pw3[1]=PKW(P1,10), pw3); \
    VRD(7); SBAR(); GAPA(C1=__builtin_amdgcn_mfma_f32_32x32x16_bf16(kf[7],qr[3],C1,0,0,0),   P1[14],P1[15],0.f,0.f,       pw3[2]=PKW(P1,12),pw3[3]=PKW(P1,14), pw3); \
    l_reg+=sacc; \
    if(GK){DMA_K((t)+3,sl_cur);} if(GV){DMA_V((t)+1,sl_next);} \
    BIASMASK(C0,C1,t); \
    SBAR(); \
    GAPB(o[0]=__builtin_amdgcn_mfma_f32_32x32x16_bf16(PAF(0),VFR(0),o[0],0,0,0), C0,0); \
    GAPB(o[1]=__builtin_amdgcn_mfma_f32_32x32x16_bf16(PAF(0),VFR(4),o[1],0,0,0), C0,4); \
    KRD(GL,0); GAPB(o[0]=__builtin_amdgcn_mfma_f32_32x32x16_bf16(PAF(1),VFR(1),o[0],0,0,0), C0,8); \
    KRD(GL,1); GAPB(o[1]=__builtin_amdgcn_mfma_f32_32x32x16_bf16(PAF(1),VFR(5),o[1],0,0,0), C0,12); \
    KRD(GL,2); GAPB(o[0]=__builtin_amdgcn_mfma_f32_32x32x16_bf16(PAF(2),VFR(2),o[0],0,0,0), C1,0); \
    KRD(GL,3); GAPB(o[1]=__builtin_amdgcn_mfma_f32_32x32x16_bf16(PAF(2),VFR(6),o[1],0,0,0), C1,4); \
    GAPB(o[0]=__builtin_amdgcn_mfma_f32_32x32x16_bf16(PAF(3),VFR(3),o[0],0,0,0), C1,8); \
    GAPB(o[1]=__builtin_amdgcn_mfma_f32_32x32x16_bf16(PAF(3),VFR(7),o[1],0,0,0), C1,12); \
    }while(0)
  int t=1;
  for(;t+5<NT;t+=2){
    STEP(pB0,pB1,pA0,pA1,t,true,true,true);     WAIT_BAR(2); RESC(); ROT();
    STEP(pA0,pA1,pB0,pB1,t+1,true,true,true);   WAIT_BAR(2); RESC(); ROT();
  }
  #define ENDW(tt) do{ if((tt)+3<NT){WAIT_BAR(2);} else if((tt)+2<NT){WAIT_BAR(1);} else {WAIT_BAR(0);} }while(0)
  for(;t+1<NT;t+=2){
    STEP(pB0,pB1,pA0,pA1,t,(t+3<NT),(t+1<NT),(t+1<NT));       ENDW(t);   RESC(); ROT();
    STEP(pA0,pA1,pB0,pB1,t+1,(t+4<NT),(t+2<NT),(t+2<NT));     ENDW(t+1); RESC(); ROT();
  }
  STEP(pB0,pB1,pA0,pA1,NT-1,false,false,false); RESC();
  { float sacc=pB0[0]+pB0[1]; _Pragma("unroll") for(int r=2;r<16;++r)sacc+=pB0[r]; _Pragma("unroll") for(int r=0;r<16;++r)sacc+=pB1[r]; l_reg+=sacc;
    pw0=(u32x4){PKW(pB0,0),PKW(pB0,2),PKW(pB0,4),PKW(pB0,6)};pw1=(u32x4){PKW(pB0,8),PKW(pB0,10),PKW(pB0,12),PKW(pB0,14)};pw2=(u32x4){PKW(pB1,0),PKW(pB1,2),PKW(pB1,4),PKW(pB1,6)};pw3=(u32x4){PKW(pB1,8),PKW(pB1,10),PKW(pB1,12),PKW(pB1,14)};
    SBAR(); pv(o,vb0+sl_cur,PAF(0),PAF(1),PAF(2),PAF(3)); }
  #undef PKW
  #undef PAF
  #undef VFR
  #undef PIN
  #undef MX3
  #undef GAPA
  #undef GAPB
  #undef EX
  #undef VRD
  #undef KRD
  #undef STEP
  #undef ENDW
  {auto rr=__builtin_amdgcn_permlane32_swap(__float_as_uint(l_reg),__float_as_uint(l_reg),false,false);l_reg=__uint_as_float(rr[0])+__uint_as_float(rr[1]);}
  if(hi==0)wsf[32+r32]=l_reg;asm volatile("s_waitcnt lgkmcnt(0)":::"memory");
  float rli[16];
  #pragma unroll
  for(int r=0;r<16;++r)rli[r]=__builtin_amdgcn_rcpf(wsf[32+crow(r,hi)]);
  bf16*Ow=O+(rowbase+q0+wid*QBLK)*OPITCH+h*D;
  { bf16*stg=(bf16*)(shm+LDS_OST)+wid*2048;
    #pragma unroll
    for(int r=0;r<16;++r){const int orow=crow(r,hi);
      #pragma unroll
      for(int d0=0;d0<2;++d0)stg[orow*64+d0*32+r32]=__float2bfloat16(o[d0][r]*rli[r]);}
    asm volatile("s_waitcnt lgkmcnt(0)":::"memory");
    #pragma unroll
    for(int i=0;i<4;++i){const int row=i*8+(lane>>3),ch=lane&7; const u32x4 v=*(const u32x4*)(stg+row*64+ch*8); ATTN_STORE16(Ow+(long)row*OPITCH+ch*8,v);} }
  asm volatile("s_waitcnt lgkmcnt(0)\n\ts_barrier":::"memory");
  #undef DMA_K
  #undef DMA_V
  #undef BIASMASK
  #undef START
  #undef RESC
  #undef ROT
}
constexpr int ATTN_LDS_BYTES=LDS_BYTES;
struct AttnUnit { int bh; int qb; };
__device__ __forceinline__ void attn_phase(char*lds,const bf16*Q,const bf16*K,const bf16*V,bf16*O,const float*gtab,const float*gcinit,int grid,int block,int tid){
  const int vcu=(block%8)*(grid/8)+block/8, s_=vcu&3, bh=vcu>>2, h=bh&7, b=bh>>3;
  { const f32x4_t* src=(const f32x4_t*)(gtab+(size_t)h*(4*BT_COPY)); __attribute__((address_space(3))) f32x4_t* dst=(__attribute__((address_space(3))) f32x4_t*)((lds_cptr)lds+LDS_BT);
    if(tid<BT_BYTES/16)dst[tid]=src[tid]; }
  const float cinit=__builtin_bit_cast(float,__builtin_amdgcn_readfirstlane(__builtin_bit_cast(int,gcinit[h])));
  asm volatile("s_waitcnt vmcnt(0) lgkmcnt(0)\n\ts_barrier":::"memory");
  for(int i=0;i<4;++i){ const int qb=(i==0)?s_:(i==1)?7-s_:(i==2)?8+s_:15-s_; attn_unit(b,h,qb,Q,K,V,O,lds,cinit,tid); }
}
#undef SBAR
#undef WAIT_BAR
}

struct Args {
    const float *x, *p, *g_mix, *w_in, *b_in, *g_q, *g_k, *rel_bias, *conv_w, *conv_b, *w_pa, *w_pc, *w_o, *g_ffn, *w_group, *b_group, *w_router, *b_router, *w1, *w3, *w2, *g_ple, *w_pg, *b_pg, *w_pp;
    float* out; unsigned char* ws;
};
constexpr int NWAVES = 8, NTHREADS = 512;
constexpr int RING_BYTES = 131072, MISC_OFF = 139264, WSCR = 16640;
constexpr int LDS_BYTES = 163840; static_assert(META_HI + 2048 <= LDS_BYTES, "MoE metadata area");

__device__ __forceinline__ void transpose_item(const float* src, int ldw, bf16_t* dst, int ldT, LAS float* scr, int lane, const float* gain = nullptr, int hi_off = 0) {
    float v[64];
#pragma unroll
    for (int i = 0; i < 64; ++i) v[i] = src[(size_t)i * ldw + lane];
    if (gain) {
#pragma unroll
        for (int i = 0; i < 64; ++i) v[i] *= gain[i];
    }
#pragma unroll
    for (int i = 0; i < 64; ++i) scr[i * 65 + lane] = v[i];
    LDS_WAIT(); asm volatile("" ::: "memory");
    const int c = lane & 7;
#pragma unroll
    for (int j = 0; j < 8; ++j) { const int n = (lane >> 3) + 8 * j; const LAS float* s = scr + (8 * c) * 65 + n;
        u32x4 o; o.x = pk2(s[0 * 65], s[1 * 65]); o.y = pk2(s[2 * 65], s[3 * 65]); o.z = pk2(s[4 * 65], s[5 * 65]); o.w = pk2(s[6 * 65], s[7 * 65]);
        *(u32x4*)(dst + (size_t)(n + (n >= 32 ? hi_off : 0)) * ldT + 8 * c) = o; }
    LDS_WAIT(); asm volatile("" ::: "memory");
}
__device__ __forceinline__ void transpose_item_f8(const float* src, int ldw, unsigned char* dst, int ldTb, LAS float* scr, int lane, const float* gain, float sc) {
    float v[64];
#pragma unroll
    for (int i = 0; i < 64; ++i) v[i] = src[(size_t)i * ldw + lane];
#pragma unroll
    for (int i = 0; i < 64; ++i) scr[i * 65 + lane] = v[i] * (gain ? gain[i] : 1.0f) * sc;
    LDS_WAIT(); asm volatile("" ::: "memory");
    const int c = lane & 3;
#pragma unroll
    for (int j = 0; j < 4; ++j) { const int n = (lane >> 2) + 16 * j; const LAS float* s = scr + (16 * c) * 65 + n; unsigned w[4];
#pragma unroll
        for (int e = 0; e < 4; ++e) w[e] = pk4_fp8(s[(4 * e) * 65], s[(4 * e + 1) * 65], s[(4 * e + 2) * 65], s[(4 * e + 3) * 65]);
        *(u32x4*)(dst + (size_t)n * ldTb + 16 * c) = (u32x4){w[0], w[1], w[2], w[3]}; }
    LDS_WAIT(); asm volatile("" ::: "memory");
}
__device__ __forceinline__ void transpose_item_q8(const float* src, int ldw, signed char* dst, int ldTb, LAS float* scr, int lane, const float* gain, const float* cmax) {
    float v[64];
#pragma unroll
    for (int i = 0; i < 64; ++i) v[i] = src[(size_t)i * ldw + lane];
    const float sc = 127.0f / fmaxf(__builtin_bit_cast(float, __hip_atomic_load((const unsigned*)cmax + lane, __ATOMIC_RELAXED, __HIP_MEMORY_SCOPE_AGENT)), 1e-30f);
#pragma unroll
    for (int i = 0; i < 64; ++i) scr[i * 65 + lane] = v[i] * gain[i] * sc;
    LDS_WAIT(); asm volatile("" ::: "memory");
    const int c = lane & 3;
#pragma unroll
    for (int j = 0; j < 4; ++j) { const int n = (lane >> 2) + 16 * j; const LAS float* s = scr + (16 * c) * 65 + n; unsigned w[4];
#pragma unroll
        for (int e = 0; e < 4; ++e) { const int q0 = __float2int_rn(s[(4 * e) * 65]), q1 = __float2int_rn(s[(4 * e + 1) * 65]), q2 = __float2int_rn(s[(4 * e + 2) * 65]), q3 = __float2int_rn(s[(4 * e + 3) * 65]);
            w[e] = (unsigned)(q0 & 0xff) | ((unsigned)(q1 & 0xff) << 8) | ((unsigned)(q2 & 0xff) << 16) | ((unsigned)(q3 & 0xff) << 24); }
        *(u32x4*)(dst + (size_t)n * ldTb + 16 * c) = (u32x4){w[0], w[1], w[2], w[3]}; }
    LDS_WAIT(); asm volatile("" ::: "memory");
}
__device__ __forceinline__ void colmax_item(const float* src, int ldw, int lane, const float* gain, unsigned* cmax) {
    float v[64]; float m = 0.f;
#pragma unroll
    for (int i = 0; i < 64; ++i) v[i] = src[(size_t)i * ldw + lane];
#pragma unroll
    for (int i = 0; i < 64; ++i) m = fmaxf(m, fabsf(v[i] * gain[i]));
    atomicMax(cmax + lane, __builtin_bit_cast(unsigned, m));
}
__device__ __forceinline__ int win_phys_row(int n) { const int l = n & 255; return (n & ~255) | (((l >> 5) & 1) << 7) | (((l >> 6) & 3) << 5) | (l & 31); }

__device__ __forceinline__ void row2_to_bf16_rstd(const float* xrow, bf16_t* orow, float* rstd2, int lane, unsigned char* qrow = nullptr) {
    const f32x4* xr = (const f32x4*)xrow + lane;
    f32x4 v[2][4]; float s0 = 0.f, s1 = 0.f;
#pragma unroll
    for (int j = 0; j < 4; ++j) { v[0][j] = xr[64 * j]; v[1][j] = xr[256 + 64 * j]; }
    unsigned long long* o8 = (unsigned long long*)orow + lane;
#pragma unroll
    for (int j = 0; j < 4; ++j) { s0 += (v[0][j].x * v[0][j].x + v[0][j].y * v[0][j].y) + (v[0][j].z * v[0][j].z + v[0][j].w * v[0][j].w); s1 += (v[1][j].x * v[1][j].x + v[1][j].y * v[1][j].y) + (v[1][j].z * v[1][j].z + v[1][j].w * v[1][j].w);
        o8[64 * j] = (unsigned long long)pk2(v[0][j].x, v[0][j].y) | ((unsigned long long)pk2(v[0][j].z, v[0][j].w) << 32);
        o8[256 + 64 * j] = (unsigned long long)pk2(v[1][j].x, v[1][j].y) | ((unsigned long long)pk2(v[1][j].z, v[1][j].w) << 32);
        if (qrow) { ((unsigned*)qrow)[64 * j + lane] = pk4_fp8(v[0][j].x, v[0][j].y, v[0][j].z, v[0][j].w); ((unsigned*)qrow)[256 + 64 * j + lane] = pk4_fp8(v[1][j].x, v[1][j].y, v[1][j].z, v[1][j].w); } }
    s0 = wave_sum(s0); s1 = wave_sum(s1);
    if (lane == 0) { rstd2[0] = rsqrtf(s0 * (1.f / D) + EPS); rstd2[1] = rsqrtf(s1 * (1.f / D) + EPS); }
}


typedef __attribute__((address_space(4))) const Args* KArgPtr;
__device__ __forceinline__ KArgPtr kargs() { KArgPtr p = (KArgPtr)__builtin_amdgcn_kernarg_segment_ptr(); asm volatile("" : "+s"(p)); return p; }
#define ctl ((unsigned*)(ws + WS_CTL))
#define wrt ((float*)(ws + WS_TAB))
#define eslot ((int*)(ws + WS_ESLOT))
#define ew ((float*)(ws + WS_EW))
#define Win_t ((bf16_t*)(ws + WS_WIN))
#define Wm_t ((bf16_t*)(ws + WS_WM))
#define Wo_t ((bf16_t*)(ws + WS_WO))
#define Wgp8 ((unsigned char*)(ws + WS_WGP))
#define hp8 ((unsigned char*)(ws + WS_HP))
#define h2b ((bf16_t*)(ws + WS_H2B))
#define xb ((bf16_t*)(ws + WS_XB))
#define A1 ((bf16_t*)(ws + WS_A1))
#define B1 ((bf16_t*)(ws + WS_B1))
#define C1 ((bf16_t*)(ws + WS_C1))
#define sga ((bf16_t*)(ws + WS_SGA))
#define sgc ((bf16_t*)(ws + WS_SGC))
#define mbuf ((bf16_t*)(ws + WS_M))
#define h1b ((bf16_t*)(ws + WS_H1B))
#define rstdv ((float*)(ws + WS_RSTD))
#define W13_t ((bf16_t*)(ws + WS_W13))
#define W2_t ((bf16_t*)(ws + WS_W2))
#define xs ((bf16_t*)(ws + WS_XS))
#define hdn ((bf16_t*)(ws + WS_HDN))
#define contrib ((bf16_t*)(ws + WS_CONTRIB))
#define tile0 ((LAS float*)lds)
#define tile1 (tile0 + 64 * 65)
#define pref ((LAS int*)(lds + MISC_OFF))
#define cnts (pref + 64)
__global__ void __launch_bounds__(NTHREADS, 2) fwd_kernel(Args a) {
    extern __shared__ __attribute__((aligned(16))) unsigned char lds_raw[];
    cg::grid_group grid = cg::this_grid();
    LAS unsigned char* lds = (LAS unsigned char*)lds_raw;
    const int G = gridDim.x, bx = blockIdx.x;
    const int wave_s = __builtin_amdgcn_readfirstlane((int)threadIdx.x >> 6);
    volatile LAS unsigned* bst = (volatile LAS unsigned*)(lds + MISC_OFF + 512);
    if (threadIdx.x < 2) bst[threadIdx.x] = 0u;
    __syncthreads();
    const XcdBarrier bar = xcd_barrier_post((unsigned*)(a.ws + WS_CTL) + CW_BAR, bst);
#ifndef PROBE_A
#define PROBE_A -1
#endif
#ifndef PROBE_B
#define PROBE_B -1
#endif
#define STAMP(i) do { if (PROBE_A >= 0 && bx == 0) { int t_ = lane_id_fresh(); if (wave_s == 0 && t_ == 0) ((volatile LAS unsigned long long*)(lds + MISC_OFF + 1024))[i] = __builtin_amdgcn_s_memrealtime(); } } while (0)
#define XBAR() do { int t_ = (wave_s << 6) | lane_id_fresh(); xcd_barrier(bar, t_); } while (0)
    STAMP(0);
#define PHASE_VARS() const KArgPtr ap = kargs(); unsigned char* const ws = ap->ws; (void)ws; int tid = (wave_s << 6) | lane_id_fresh(); asm volatile("" : "+v"(tid)); const int lane = tid & 63, wave = __builtin_amdgcn_readfirstlane(tid >> 6); \
    const int gw = bx * NWAVES + wave, NGW = G * NWAVES; const size_t gtid = (size_t)bx * NTHREADS + tid, GT = (size_t)G * NTHREADS; (void)lane; (void)gw; (void)NGW; (void)gtid; (void)GT
    {
        PHASE_VARS();
        LAS float* scr = (LAS float*)(lds + wave * WSCR);
        constexpr int I_IN = 16 * 80, I_PA = 8 * 16, I_PC = 8 * 16, I_O = 16 * 16, I_PG = 16 * 16, I_PP = 4 * 16;
        constexpr int NIT = I_IN + I_PA + I_PC + I_O + I_PG + I_PP;
        for (int it = gw; it < NIT; it += NGW) {
            int r = it;
            if (r < I_IN) { const int kb_ = r / 80, nb = r % 80;
#if F8_GATES
                if (nb >= 48) { transpose_item_f8(ap->w_in + (size_t)(kb_ * 64) * NIN + nb * 64, NIN, (unsigned char*)(Win_t + (size_t)3072 * D) + (size_t)((nb - 48) * 64) * D + kb_ * 64, D, scr, lane, ap->g_mix + kb_ * 64, F8W); continue; }
#endif
                transpose_item(ap->w_in + (size_t)(kb_ * 64) * NIN + nb * 64, NIN, Win_t + (size_t)win_phys_row(nb * 64) * D + kb_ * 64, D, scr, lane, ap->g_mix + kb_ * 64, 96); continue; } r -= I_IN;
            if (r < I_PA) { const int kb_ = r / 16, nb = r % 16; transpose_item(ap->w_pa + (size_t)(kb_ * 64) * D + nb * 64, D, Wm_t + (size_t)(nb * 64) * D + kb_ * 64, D, scr, lane); continue; } r -= I_PA;
            if (r < I_PC) { const int kb_ = r / 16, nb = r % 16; transpose_item(ap->w_pc + (size_t)(kb_ * 64) * D + nb * 64, D, Wm_t + (size_t)(nb * 64) * D + 512 + kb_ * 64, D, scr, lane); continue; } r -= I_PC;
            if (r < I_O) { const int kb_ = r / 16, nb = r % 16; transpose_item(ap->w_o + (size_t)(kb_ * 64) * D + nb * 64, D, Wo_t + (size_t)(nb * 64) * D + kb_ * 64, D, scr, lane); continue; } r -= I_O;
            if (r < I_PG) { const int kb_ = r / 16, nb = r % 16; colmax_item(ap->w_pg + (size_t)(kb_ * 64) * D + nb * 64, D, lane, ap->g_ple + kb_ * 64, ctl + CW_CMAXP + nb * 64); continue; } r -= I_PG;
            { const int kb_ = r / 16, nb = r % 16; transpose_item(ap->w_pp + (size_t)(kb_ * 64) * D + nb * 64, D, (bf16_t*)Wgp8 + (size_t)(nb * 64) * HPE + 512 + kb_ * 64, HPE, scr, lane); }
        }
        const size_t rtid = (size_t)(G - 1 - bx) * NTHREADS + tid; const int rgw = (G - 1 - bx) * NWAVES + wave;
        for (size_t i = rtid; i < (size_t)3 * 32 * 64 * 8; i += GT) { const int j = (int)(i & 7), ln = (int)((i >> 3) & 63), s_ = (int)((i >> 9) & 31), nt = (int)(i >> 14);
            const int k = 32 * s_ + 8 * (ln >> 4) + j, col = 16 * nt + (ln & 15);
            wrt[i] = col < 4 ? ap->w_group[k * 4 + col] : (col < 36 ? ap->w_router[k * 32 + (col - 4)] : 0.f); }
        { float* gtab = (float*)(ws + WS_GTAB); float* gcinit = (float*)(ws + WS_GCINIT);
          for (size_t i = rtid; i < (size_t)NH * 4 * 384; i += GT) { const int h = (int)(i / 1536), s_ = (int)((i / 384) & 3), y = (int)(i % 384), x = y + s_;
              int dd = 319 - x; dd = dd < -63 ? -63 : (dd > 256 ? 256 : dd);
              gtab[i] = x <= 382 ? (ap->rel_bias[h * NREL + dd + 63] - ap->rel_bias[h * NREL + 319]) * LOG2E : 0.f; }
          if (rgw < NH) { const int h = rgw;
              float gq = fabsf(ap->g_q[lane]), gk = fabsf(ap->g_k[lane]), mb = -3.0e38f;
#pragma unroll
              for (int j = 0; j < 5; ++j) mb = fmaxf(mb, ap->rel_bias[h * NREL + lane + 64 * j]);
#pragma unroll
              for (int o = 1; o < 64; o <<= 1) { gq = fmaxf(gq, __shfl_xor(gq, o)); gk = fmaxf(gk, __shfl_xor(gk, o)); mb = fmaxf(mb, __shfl_xor(mb, o)); }
              if (lane == 0) gcinit[h] = ap->rel_bias[h * NREL + 319] * LOG2E - (64.f * C2 * gq * gk + mb * LOG2E); } }
        STAMP(12);
        for (int m = 2 * gw; m < T; m += 2 * NGW) row2_to_bf16_rstd(ap->x + (size_t)m * D, xb + (size_t)m * D, rstdv + m, lane, F8_GATES ? ws + WS_XQ + (size_t)m * D : nullptr);
    }
    if (G == 0x7fffff) grid.sync();
    XBAR();
    STAMP(1);

#if F8_GATES
    { PHASE_VARS(); pg8::Gemm g{xb, Win_t, T, 3072, D, D}; pg8::StaticOrder S; S.init(T, 3072, G, bx); EpiInproj E{ws, ap->b_in, ap->g_q, ap->g_k, rstdv};
      pg8::gemm_phase<EpiInproj, pg8::StaticOrder, true, true>(lds, g, S, E, tid); }
    { PHASE_VARS(); pg8::Gemm g{(const bf16_t*)(ws + WS_XQ), Win_t + (size_t)3072 * D, T, 2048, D / 2, D / 2}; StaticOrderId S; S.init(T, 2048, G, bx);
      EpiGateF8 E{(unsigned char*)sga, (unsigned char*)sgc, ap->b_in + 3072, rstdv};
      pg8::gemm_phase<EpiGateF8, StaticOrderId, true, true, 0, 3>(lds, g, S, E, tid); }
#else
    { PHASE_VARS(); pg8::Gemm g{xb, Win_t, T, NIN, D, D}; pg8::StaticOrder S; S.init(T, NIN, G, bx); EpiInproj E{ws, ap->b_in, ap->g_q, ap->g_k, rstdv};
      pg8::gemm_phase<EpiInproj, pg8::StaticOrder, true, true>(lds, g, S, E, tid); }
#endif
    XBAR();
    STAMP(2);

    {
        PHASE_VARS();
        for (size_t i = gtid; i < (size_t)T * (CW / 8); i += GT) {
            const int t = (int)(i >> 6), c8 = (int)(i & 63) * 8, s = t & (SEQ - 1);
            const size_t o = (size_t)t * D + c8;
            const u32x4 u0 = *(const u32x4*)(C1 + o), g0 = *(const u32x4*)(C1 + o + 512), b0 = *(const u32x4*)(A1 + o + 512);
            u32x4 u1 = {0u, 0u, 0u, 0u}, g1 = u1, u2 = u1, g2 = u1;
            if (s >= 1) { u1 = *(const u32x4*)(C1 + o - D); g1 = *(const u32x4*)(C1 + o + 512 - D); }
            if (s >= 2) { u2 = *(const u32x4*)(C1 + o - 2 * D); g2 = *(const u32x4*)(C1 + o + 512 - 2 * D); }
            float y[8];
#pragma unroll
            for (int e = 0; e < 4; ++e) {
#pragma unroll
                for (int hh = 0; hh < 2; ++hh) {
                    const int c = c8 + 2 * e + hh;
                    const float cu0 = hh ? bf_hi(u0[e]) * bf_hi(g0[e]) : bf_lo(u0[e]) * bf_lo(g0[e]);
                    const float cu1 = hh ? bf_hi(u1[e]) * bf_hi(g1[e]) : bf_lo(u1[e]) * bf_lo(g1[e]);
                    const float cu2 = hh ? bf_hi(u2[e]) * bf_hi(g2[e]) : bf_lo(u2[e]) * bf_lo(g2[e]);
                    const float bgv = hh ? bf_hi(b0[e]) : bf_lo(b0[e]);
                    y[2 * e + hh] = bgv * (ap->conv_b[c] + ap->conv_w[c] * cu2 + ap->conv_w[CW + c] * cu1 + ap->conv_w[2 * CW + c] * cu0);
                }
            }
            u32x4 w; w.x = pk2(y[0], y[1]); w.y = pk2(y[2], y[3]); w.z = pk2(y[4], y[5]); w.w = pk2(y[6], y[7]);
            *(u32x4*)(A1 + o + 512) = w;
        }
        __syncthreads();
        attn_body::attn_phase((char*)lds_raw, (const attn_body::bf16*)A1, (const attn_body::bf16*)B1, (const attn_body::bf16*)(B1 + 512), (attn_body::bf16*)A1, (const float*)(ws + WS_GTAB), (const float*)(ws + WS_GCINIT), G, bx, tid);
    }
    XBAR();
    STAMP(3);

    { PHASE_VARS(); pg8::Gemm g{A1, Wm_t, T, D, D, D}; pg8::PairOrder S; S.init(T, D, G, bx); EpiMerge2 E{(const unsigned char*)sga, (const unsigned char*)sgc, mbuf};
      pg8::gemm_phase<EpiMerge2, pg8::PairOrder, true, true>(lds, g, S, E, tid); }
    XBAR();
    STAMP(4);

    { PHASE_VARS(); pg8::Gemm g{mbuf, Wo_t, T, D, D, D}; pg8::StaticOrder S; S.init(T, D, G, bx); EpiResBf16 E{xb, h1b, F8_MOE ? (unsigned char*)(ws + WS_H1F8) : (unsigned char*)nullptr};
      pg8::gemm_phase<EpiResBf16, pg8::StaticOrder, true, true>(lds, g, S, E, tid); }
    XBAR();
    STAMP(5);

    {
        PHASE_VARS();
        {
            LAS int* lcnt = (LAS int*)(lds + MISC_OFF + 2048); LAS int* lbase = lcnt + 32;
            if (tid < 32) lcnt[tid] = 0;
            __syncthreads();
            int ea = 0, eb = 0, ra = 0, rb = 0; float wa = 0.f, wb = 0.f;
            LAS float* lsc = (LAS float*)(lds + wave * WSCR);
            const int r = lane & 15, q = lane >> 4;
            for (int task = gw; task < T / 16; task += NGW) {
                const int row0 = task * 16;
                const GAS bf16_t* arow = (const GAS bf16_t*)h1b + (size_t)(row0 + r) * D + 8 * q;
                const GAS float* gp = (const GAS float*)ap->g_ffn + 8 * q;
                const GAS f32x4* bp = (const GAS f32x4*)wrt + 2 * lane;
                f32x4 acc0 = {0.f, 0.f, 0.f, 0.f}, acc1 = acc0, acc2 = acc0; float ss = 0.f;
                u32x4 acur[8], anxt[8]; f32x4 bc[2][3][2], bn[2][3][2];
#pragma unroll
                for (int i = 0; i < 8; ++i) acur[i] = *(const GAS u32x4*)(arow + 32 * i);
#pragma unroll
                for (int st = 0; st < 2; ++st)
#pragma unroll
                    for (int nt = 0; nt < 3; ++nt) { bc[st][nt][0] = bp[(nt * 32 + st) * 128]; bc[st][nt][1] = bp[(nt * 32 + st) * 128 + 1]; }
#pragma unroll 1
                for (int ch = 0; ch < 4; ++ch) {
                    const int chn = ch < 3 ? ch + 1 : 3;
#pragma unroll
                    for (int i = 0; i < 8; ++i) anxt[i] = *(const GAS u32x4*)(arow + 32 * (8 * chn + i));
#pragma unroll
                    for (int gq = 0; gq < 4; ++gq) {
                        const int s0 = 8 * ch + 2 * gq, sn = (s0 + 2 < 32) ? s0 + 2 : 30;
#pragma unroll
                        for (int st = 0; st < 2; ++st)
#pragma unroll
                            for (int nt = 0; nt < 3; ++nt) { bn[st][nt][0] = bp[(nt * 32 + sn + st) * 128]; bn[st][nt][1] = bp[(nt * 32 + sn + st) * 128 + 1]; }
#pragma unroll
                        for (int st = 0; st < 2; ++st) {
                            const int s_ = s0 + st;
                            const u32x4 aw = acur[2 * gq + st]; const f32x4 g0 = *(const GAS f32x4*)(gp + 32 * s_), g1 = *(const GAS f32x4*)(gp + 32 * s_ + 4);
                            float av[8] = {bf_lo(aw.x), bf_hi(aw.x), bf_lo(aw.y), bf_hi(aw.y), bf_lo(aw.z), bf_hi(aw.z), bf_lo(aw.w), bf_hi(aw.w)};
#pragma unroll
                            for (int j = 0; j < 8; ++j) { ss += av[j] * av[j]; av[j] *= (j < 4 ? g0[j & 3] : g1[j & 3]); }
#pragma unroll
                            for (int j = 0; j < 8; ++j) {
                                acc0 = __builtin_amdgcn_mfma_f32_16x16x4f32(av[j], bc[st][0][j >> 2][j & 3], acc0, 0, 0, 0);
                                acc1 = __builtin_amdgcn_mfma_f32_16x16x4f32(av[j], bc[st][1][j >> 2][j & 3], acc1, 0, 0, 0);
                                acc2 = __builtin_amdgcn_mfma_f32_16x16x4f32(av[j], bc[st][2][j >> 2][j & 3], acc2, 0, 0, 0);
                            }
                        }
#pragma unroll
                        for (int st = 0; st < 2; ++st)
#pragma unroll
                            for (int nt = 0; nt < 3; ++nt) { bc[st][nt][0] = bn[st][nt][0]; bc[st][nt][1] = bn[st][nt][1]; }
                        asm volatile("" ::: "memory");
                    }
#pragma unroll
                    for (int i = 0; i < 8; ++i) acur[i] = anxt[i];
                }
                ss += __shfl_xor(ss, 16); ss += __shfl_xor(ss, 32);
                const float rstd = rsqrtf(ss * (1.f / D) + EPS);
#pragma unroll
                for (int g_ = 0; g_ < 4; ++g_) { const float rs = __shfl(rstd, 4 * q + g_);
                    lsc[(4 * q + g_) * 48 + r] = acc0[g_] * rs; lsc[(4 * q + g_) * 48 + 16 + r] = acc1[g_] * rs; lsc[(4 * q + g_) * 48 + 32 + r] = acc2[g_] * rs; }
                LDS_WAIT(); asm volatile("" ::: "memory");
                if (lane < 16) {
                    const int m = row0 + lane; float lg[36];
#pragma unroll
                    for (int c = 0; c < 36; ++c) lg[c] = lsc[lane * 48 + c];
                    float gl[4];
#pragma unroll
                    for (int c = 0; c < 4; ++c) gl[c] = lg[c] + ap->b_group[c];
                    int grp = 0; float gmax = gl[0];
#pragma unroll
                    for (int c = 1; c < 4; ++c) if (gl[c] > gmax) { gmax = gl[c]; grp = c; }
                    float gs = 0.f;
#pragma unroll
                    for (int c = 0; c < 4; ++c) gs += __expf(gl[c] - gmax);
                    const float pgrp = 1.f / gs;
                    float el[8];
#pragma unroll
                    for (int c = 0; c < 8; ++c) { const float x0 = lg[4 + c], x1 = lg[12 + c], x2 = lg[20 + c], x3 = lg[28 + c]; el[c] = (grp == 0 ? x0 : grp == 1 ? x1 : grp == 2 ? x2 : x3) + ap->b_router[grp * 8 + c]; }
                    int i0 = 0; float l0 = el[0];
#pragma unroll
                    for (int c = 1; c < 8; ++c) if (el[c] > l0) { l0 = el[c]; i0 = c; }
                    int i1 = -1; float l1 = -3.0e38f;
#pragma unroll
                    for (int c = 0; c < 8; ++c) if (c != i0 && el[c] > l1) { l1 = el[c]; i1 = c; }
                    if (i1 < 0) i1 = i0 ? 0 : 1;
                    const float e1 = __expf(l1 - l0), w0 = pgrp / (1.f + e1), w1 = pgrp * e1 / (1.f + e1);
                    ea = grp * 8 + i0; eb = grp * 8 + i1;
                    ra = (int)__hip_atomic_fetch_add(&lcnt[ea], 1, __ATOMIC_RELAXED, __HIP_MEMORY_SCOPE_WORKGROUP); rb = (int)__hip_atomic_fetch_add(&lcnt[eb], 1, __ATOMIC_RELAXED, __HIP_MEMORY_SCOPE_WORKGROUP);
                    wa = w0; wb = w1;
                    rstdv[m] = rstd;
                }
                LDS_WAIT(); asm volatile("" ::: "memory");
            }
            __syncthreads();
            if (tid < 32) lbase[tid] = (int)atomicAdd(&ctl[tid * CNT_STRIDE], (unsigned)lcnt[tid]);
            __syncthreads();
            if (lane < 16) { const int m = gw * 16 + lane; const int ia = (ea << 15) | (lbase[ea] + ra), ib = (eb << 15) | (lbase[eb] + rb);
                eslot[ia] = 2 * m; ew[ia] = wa; eslot[ib] = 2 * m + 1; ew[ib] = wb; }
        }
        STAMP(11);
        LAS float* scr = (LAS float*)(lds + wave * WSCR);
        constexpr int I_13 = 16 * 8, PER_E = 2 * I_13;
        for (int it = gw; it < NE * PER_E; it += NGW) {
            const int e = it / PER_E; int r = it % PER_E;
            const int which = r / I_13; r %= I_13; const int kb_ = r / 8, nb = r % 8, j0 = nb * 64;
            const float* src = (which ? ap->w3 : ap->w1) + (size_t)e * D * DE + (size_t)(kb_ * 64) * DE + j0;
#if F8_MOE
            transpose_item_f8(src, DE, (unsigned char*)W13_t + (size_t)(e * 1024 + (j0 >> 7) * 256 + which * 128 + (j0 & 127)) * D + kb_ * 64, D, scr, lane, ap->g_ffn + kb_ * 64, F8W);
#else
            transpose_item(src, DE, W13_t + (size_t)(e * 1024 + (j0 >> 7) * 256 + which * 128 + (j0 & 127)) * D + kb_ * 64, D, scr, lane, ap->g_ffn + kb_ * 64);
#endif
        }
    }
    XBAR();
    STAMP(6);

    {
        PHASE_VARS();
        if (tid < NE) cnts[tid] = (int)__hip_atomic_load(&ctl[tid * CNT_STRIDE], __ATOMIC_RELAXED, __HIP_MEMORY_SCOPE_AGENT);
        __syncthreads();
        if (tid == 0) { int acc_ = 0; for (int e = 0; e < NE; ++e) { pref[e] = acc_; acc_ += (cnts[e] + 255) >> 8; } pref[NE] = acc_; }
        __syncthreads();
    }
    STAMP(7);
    const int ntiles = __builtin_amdgcn_readfirstlane(pref[NE]);

#if F8_MOE
    { PHASE_VARS(); pg8::Gemm g{(const bf16_t*)(ws + WS_H1F8), W13_t, XS_ROWS, NE * 1024, D / 2, D / 2}; moe_meta_preload(lds, pref, ntiles * 4, G, bx, eslot, rstdv, true, tid); MoeOrderT<true> S{pref, ntiles * 4, G, bx, lds}; EpiSwigluT<1> E{hdn, lds};
      pg8::gemm_phase<EpiSwigluT<1>, MoeOrderT<true>, true, true, 0, 3>(lds, g, S, E, tid); }
#else
    { PHASE_VARS(); pg8::Gemm g{h1b, W13_t, XS_ROWS, NE * 1024, D, D}; moe_meta_preload(lds, pref, ntiles * 4, G, bx, eslot, rstdv, true, tid); MoeOrderT<true> S{pref, ntiles * 4, G, bx, lds}; EpiSwigluT<0> E{hdn, lds};
      pg8::gemm_phase<EpiSwigluT<0>, MoeOrderT<true>, true, true>(lds, g, S, E, tid); }
#endif
    { PHASE_VARS();
      { const int nun = ntiles * 4, rem = nun % G, nf = rem ? G - rem : G, fb = rem ? bx - rem : bx;
        if (fb >= 0) {
            LAS float* scr = (LAS float*)(lds + wave * WSCR);
            for (int it = fb * NWAVES + wave; it < NE * 128; it += nf * NWAVES) { const int e = it >> 7, r = it & 127, kb_ = r / 16, nb = r % 16;
#if F8_MOE && F8_DOWN
                transpose_item_f8(ap->w2 + (size_t)e * DE * D + (size_t)(kb_ * 64) * D + nb * 64, D, (unsigned char*)W2_t + (size_t)(e * 1024 + nb * 64) * DE + kb_ * 64, DE, scr, lane, nullptr, F8W); }
#else
                transpose_item(ap->w2 + (size_t)e * DE * D + (size_t)(kb_ * 64) * D + nb * 64, D, W2_t + (size_t)(e * 1024 + nb * 64) * DE + kb_ * 64, DE, scr, lane); }
#endif
            for (size_t i = (size_t)fb * NTHREADS + tid; i < 1024; i += (size_t)nf * NTHREADS) ((float*)(ws + WS_CMAXF))[i] = __builtin_bit_cast(float, __hip_atomic_load(ctl + CW_CMAXP + i, __ATOMIC_RELAXED, __HIP_MEMORY_SCOPE_AGENT));
            for (int it = fb * NWAVES + wave; it < 16 * 16; it += nf * NWAVES) { const int kb_ = it / 16, nb = it % 16;
                transpose_item_q8(ap->w_pg + (size_t)(kb_ * 64) * D + nb * 64, D, (signed char*)Wgp8 + (size_t)(nb * 64) * HPB + kb_ * 64, HPB, scr, lane, ap->g_ple + kb_ * 64, (const float*)(ctl + CW_CMAXP) + nb * 64); }
            for (size_t i = (size_t)fb * NTHREADS + tid; i < (size_t)T * PLE / 8; i += (size_t)nf * NTHREADS) { const f32x4 v0 = ((const f32x4*)ap->p)[2 * i], v1 = ((const f32x4*)ap->p)[2 * i + 1];
                u32x4 o; o.x = pk2(v0.x, v0.y); o.y = pk2(v0.z, v0.w); o.z = pk2(v1.x, v1.y); o.w = pk2(v1.z, v1.w); *(u32x4*)(hp8 + (i >> 5) * HPB + 1024 + (i & 31) * 16) = o; }
        } } }
    XBAR();
    STAMP(8);

#if F8_MOE && F8_DOWN
    { PHASE_VARS(); pg8::Gemm g{hdn, W2_t, XS_ROWS, NE * 1024, DE / 2, DE / 2}; moe_meta_preload(lds, pref, ntiles * 4, G, bx, eslot, ew, false, tid); MoeOrderId S{{pref, ntiles * 4, G, bx, lds}}; EpiDownT<1> E{contrib, lds};
      pg8::gemm_phase<EpiDownT<1>, MoeOrderId, true, true, 0, 3>(lds, g, S, E, tid); }
#else
    { PHASE_VARS(); pg8::Gemm g{hdn, W2_t, XS_ROWS, NE * 1024, DE, DE}; moe_meta_preload(lds, pref, ntiles * 4, G, bx, eslot, ew, false, tid); MoeOrderT<false> S{pref, ntiles * 4, G, bx, lds}; EpiDownT<0> E{contrib, lds};
      pg8::gemm_phase<EpiDownT<0>, MoeOrderT<false>, true, true>(lds, g, S, E, tid); }
#endif
    XBAR();
    STAMP(9);

    { PHASE_VARS();
    for (int m0 = 2 * gw; m0 < T; m0 += 2 * NGW) {
        u32x2 hv[2][4], p0[2][4], p1[2][4];
#pragma unroll
        for (int rr = 0; rr < 2; ++rr) { const int m = m0 + rr;
            const u32x2* xr = (const u32x2*)(h1b + (size_t)m * D) + lane;
            const u32x2* c0 = (const u32x2*)(contrib + (size_t)(2 * m) * D) + lane; const u32x2* c1 = (const u32x2*)(contrib + (size_t)(2 * m + 1) * D) + lane;
#pragma unroll
            for (int j = 0; j < 4; ++j) { hv[rr][j] = xr[64 * j]; p0[rr][j] = c0[64 * j]; p1[rr][j] = c1[64 * j]; } }
#pragma unroll
        for (int rr = 0; rr < 2; ++rr) { const int m = m0 + rr; float s = 0.f, am = 0.f; f32x4 h[4];
            unsigned long long* o8 = (unsigned long long*)(h2b + (size_t)m * D) + lane;
#pragma unroll
            for (int j = 0; j < 4; ++j) {
                h[j].x = bf_lo(hv[rr][j].x) + bf_lo(p0[rr][j].x) + bf_lo(p1[rr][j].x); h[j].y = bf_hi(hv[rr][j].x) + bf_hi(p0[rr][j].x) + bf_hi(p1[rr][j].x);
                h[j].z = bf_lo(hv[rr][j].y) + bf_lo(p0[rr][j].y) + bf_lo(p1[rr][j].y); h[j].w = bf_hi(hv[rr][j].y) + bf_hi(p0[rr][j].y) + bf_hi(p1[rr][j].y);
                s += (h[j].x * h[j].x + h[j].y * h[j].y) + (h[j].z * h[j].z + h[j].w * h[j].w);
                am = fmaxf(fmaxf(am, fmaxf(fabsf(h[j].x), fabsf(h[j].y))), fmaxf(fabsf(h[j].z), fabsf(h[j].w)));
                o8[64 * j] = (unsigned long long)pk2(h[j].x, h[j].y) | ((unsigned long long)pk2(h[j].z, h[j].w) << 32); }
            s = wave_sum(s);
#pragma unroll
            for (int o = 1; o < 64; o <<= 1) am = fmaxf(am, __shfl_xor(am, o));
            const float qs = 127.0f / fmaxf(am, 1e-30f);
            unsigned* q4 = (unsigned*)(hp8 + (size_t)m * HPB) + lane;
#pragma unroll
            for (int j = 0; j < 4; ++j) { const int q0 = __float2int_rn(h[j].x * qs), q1 = __float2int_rn(h[j].y * qs), q2 = __float2int_rn(h[j].z * qs), q3 = __float2int_rn(h[j].w * qs);
                q4[64 * j] = (unsigned)(q0 & 0xff) | ((unsigned)(q1 & 0xff) << 8) | ((unsigned)(q2 & 0xff) << 16) | ((unsigned)(q3 & 0xff) << 24); }
            if (lane == 0) rstdv[m] = rsqrtf(s * (1.f / D) + EPS) * am * (1.0f / 127.0f); }
    } }
    XBAR();
    STAMP(10);

    { PHASE_VARS(); pg8::Gemm g{(const bf16_t*)hp8, (const bf16_t*)Wgp8, T, 2 * D, HPE, HPE}; pg8::StaticOrder S; S.init(T, 2 * D, G, bx);
      EpiGateDual E{h2b, rstdv, (const float*)(ws + WS_CMAXF), ap->b_pg, ap->out};
      pg8::gemm_phase<EpiGateDual, pg8::StaticOrder, true, true, 8, 2>(lds, g, S, E, tid); }
    STAMP(15);
    if (PROBE_A >= 0 && bx == 0) { int t_ = lane_id_fresh(); if (wave_s == 0 && t_ == 0) { volatile LAS unsigned long long* ts = (volatile LAS unsigned long long*)(lds + MISC_OFF + 1024);
        const unsigned long long d = 4ull * (ts[PROBE_B] - ts[PROBE_A]), t0 = __builtin_amdgcn_s_memrealtime(); while (__builtin_amdgcn_s_memrealtime() - t0 < d) __builtin_amdgcn_s_sleep(8); } }
}

extern "C" void kernel_launch(void* const* d_in, const int* in_sizes, int n_in, void* d_out, int out_size, void* d_ws, size_t ws_size, hipStream_t stream) {
    static int grid = 0;
    if (grid == 0) {
        if (n_in != 25 || out_size != T * D || ws_size < WS_END) { fprintf(stderr, "kernel_launch: unexpected shapes (n_in %d out %d ws %zu); nothing launched\n", n_in, out_size, ws_size); grid = -1; return; }
        int dev = 0, cus = 0, per_cu = 0;
        if (hipGetDevice(&dev) != hipSuccess || hipDeviceGetAttribute(&cus, hipDeviceAttributeMultiprocessorCount, dev) != hipSuccess) { grid = -1; return; }
        if (hipFuncSetAttribute((const void*)fwd_kernel, hipFuncAttributeMaxDynamicSharedMemorySize, LDS_BYTES) != hipSuccess) { fprintf(stderr, "kernel_launch: hipFuncSetAttribute failed\n"); grid = -1; return; }
        if (hipOccupancyMaxActiveBlocksPerMultiprocessor(&per_cu, (const void*)fwd_kernel, NTHREADS, LDS_BYTES) != hipSuccess || per_cu < 1) { fprintf(stderr, "kernel_launch: occupancy query says %d\n", per_cu); (void)hipGetLastError(); grid = -1; return; }
        if (cus != 256) { fprintf(stderr, "kernel_launch: built for a 256-CU device (got %d)\n", cus); grid = -1; return; }
        grid = cus;
    }
    if (grid < 0) return;
    if (hipMemsetAsync((char*)d_ws + WS_CTL, 0, CTL_ZERO_BYTES, stream) != hipSuccess) { fprintf(stderr, "kernel_launch: memset failed\n"); return; }
    Args a{};
    const float** f = (const float**)&a;
    for (int i = 0; i < 25; ++i) f[i] = (const float*)d_in[i];
    a.out = (float*)d_out; a.ws = (unsigned char*)d_ws;
    void* args[] = {&a};
    hipError_t e = hipLaunchCooperativeKernel((const void*)fwd_kernel, dim3(grid), dim3(NTHREADS), args, LDS_BYTES, stream);
    if (e != hipSuccess) fprintf(stderr, "kernel_launch: cooperative launch failed: %s (grid %d)\n", hipGetErrorString(e), grid);
}
```

```cpp
#include <hip/hip_runtime.h>
#include <hip/hip_cooperative_groups.h>
#include <cstdio>
#include <cstdint>
namespace cg = cooperative_groups;

#define GAS __attribute__((address_space(1)))
#define LAS __attribute__((address_space(3)))
typedef unsigned short bf16_t;
typedef short bf16x8 __attribute__((ext_vector_type(8)));
typedef float f32x4 __attribute__((ext_vector_type(4)));
typedef float f32x2 __attribute__((ext_vector_type(2)));
typedef unsigned u32x4 __attribute__((ext_vector_type(4)));
typedef unsigned u32x2 __attribute__((ext_vector_type(2)));
typedef int i32x4 __attribute__((ext_vector_type(4)));
typedef int i32x8 __attribute__((ext_vector_type(8)));
typedef GAS unsigned gu32;
#define RLX_AGENT __ATOMIC_RELAXED, __HIP_MEMORY_SCOPE_AGENT

constexpr int T = 32768, D = 1024, SEQ = 4096, NBATCH = 8;
constexpr int NIN = 5120, NH = 8, HD = 64, AW = 512, CW = 512;
constexpr int NE = 32, DE = 512, PLE = 256, NREL = 320;
constexpr int XS_ROWS = 65536 + NE * 256;
constexpr float EPS = 1e-6f;
constexpr float LOG2E = 1.4426950408889634f;
constexpr float C2 = 0.125f * LOG2E;

#ifndef F8_MOE
#define F8_MOE 1
#endif
#ifndef F8_GATES
#define F8_GATES 1
#endif
#ifndef F8_CONTRIB
#define F8_CONTRIB 1
#endif
constexpr float CSC = 16.0f;
#ifndef F8_DOWN
#define F8_DOWN 1
#endif
constexpr float F8W = 32.0f;
constexpr size_t MiB = 1u << 20;
constexpr size_t WS_CTL = 0, CTL_ZERO_BYTES = 64 * 1024;
constexpr int CW_BAR = 4096, CNT_STRIDE = 64;
constexpr size_t WS_TAB = 1 * MiB;
constexpr size_t WS_GTAB = WS_TAB + 192 * 1024;
constexpr size_t WS_GCINIT = WS_GTAB + 8 * 4 * 384 * 4;
constexpr size_t WS_ROUTE = 2 * MiB;
constexpr size_t WS_CMAXF = 3 * MiB + 512 * 1024;
constexpr size_t WS_RSTD = 3 * MiB;
constexpr size_t WS_ROWMETA = 4 * MiB;
constexpr size_t WS_WIN = 6 * MiB;
constexpr size_t WS_WM = 16 * MiB;
constexpr size_t WS_WO = 18 * MiB;
constexpr size_t WS_WGP = 20 * MiB;
constexpr int HPB = 1536, HPE = HPB / 2;
constexpr size_t WS_HP = 24 * MiB;
constexpr size_t WS_H2B = 232 * MiB;
constexpr int CW_CMAXP = 14336;
constexpr int META_LO = 147456, META_HI = 147456 + 4 * 2048;
constexpr size_t WS_ESLOT = 72 * MiB, WS_EW = 76 * MiB;
constexpr size_t WS_XQ = 24 * MiB;
constexpr size_t WS_XB = 104 * MiB;
constexpr size_t WS_A1 = 168 * MiB;
constexpr size_t WS_B1 = 232 * MiB;
constexpr size_t WS_C1 = 296 * MiB;
constexpr size_t WS_SGA = 360 * MiB, WS_SGC = 424 * MiB;
constexpr size_t WS_M = WS_B1;
constexpr size_t WS_H1F8 = WS_A1;
constexpr size_t WS_H1B = WS_SGC;
constexpr size_t WS_W13 = WS_SGA;
constexpr size_t WS_W2 = 320 * MiB;
constexpr size_t WS_XS = 104 * MiB;
constexpr size_t WS_HDN = 248 * MiB;
constexpr size_t WS_CONTRIB = 104 * MiB;
constexpr size_t WS_END = 488 * MiB;

__device__ __forceinline__ unsigned f2bf(float f) { unsigned u = __builtin_bit_cast(unsigned, f); return (u + 0x7fffu + ((u >> 16) & 1u)) >> 16; }
__device__ __forceinline__ unsigned pk2(float lo, float hi) { return f2bf(lo) | (f2bf(hi) << 16); }
__device__ __forceinline__ float bf_lo(unsigned w) { return __builtin_bit_cast(float, w << 16); }
__device__ __forceinline__ float bf_hi(unsigned w) { return __builtin_bit_cast(float, w & 0xffff0000u); }
__device__ __forceinline__ float bf2f(bf16_t h) { return __builtin_bit_cast(float, (unsigned)h << 16); }
__device__ __forceinline__ float sigmoidf_(float x) { return __builtin_amdgcn_rcpf(1.0f + __builtin_amdgcn_exp2f(-LOG2E * x)); }
__device__ __forceinline__ float wave_sum(float v) {
#pragma unroll
    for (int o = 1; o < 64; o <<= 1) v += __shfl_xor(v, o);
    return v;
}
__device__ __forceinline__ int lane_id_fresh() { int l; asm volatile("v_mbcnt_lo_u32_b32 %0, -1, 0\n\tv_mbcnt_hi_u32_b32 %0, -1, %0" : "=v"(l)); return l; }
__device__ __forceinline__ unsigned pk4_fp8(float a, float b, float c, float d) { unsigned w = (unsigned)__builtin_amdgcn_cvt_pk_fp8_f32(a, b, 0, false); return (unsigned)__builtin_amdgcn_cvt_pk_fp8_f32(c, d, (int)w, true); }
#define LDS_WAIT() asm volatile("s_waitcnt lgkmcnt(0)" ::: "memory")
#define VM_WAIT() asm volatile("s_waitcnt vmcnt(0)" ::: "memory")

namespace pg8 {
#define PG8_LAS __attribute__((address_space(3)))
constexpr int BM = 256, BK = 64, HALF = 128, HTB = HALF * BK * 2  , STAGE_BYTES = 8 * HTB, NXCD = 8, WGM = 8;

__host__ __device__ __forceinline__ int lds_byte(int r, int c) { const int st = (r >> 4) * 2 + (c >> 5), rr = r & 15, cc = c & 31, ob = rr * 64 + cc * 2; return st * 1024 + (ob ^ (((ob >> 9) & 1) << 5)); }
__host__ __device__ __forceinline__ void stage_rc(int b, int& R, int& C) { const int st = b / 1024, sb = b % 1024, swz = sb ^ (((sb >> 9) & 1) << 5); R = (st >> 1) * 16 + swz / 64; C = (st & 1) * 32 + (swz % 64) / 2; }
__host__ __device__ __forceinline__ int perm32(int rho) { const int n = rho >> 4, i = rho & 15; return 8 * (i >> 2) + 4 * n + (i & 3); }

struct Unit { int pm, pn, part; };
struct Gemm { const bf16_t* A; const bf16_t* Bt; int M, N, K, ld; };

struct StaticOrder {
    int nM, nN, nwg, G, c;
    __host__ __device__ void init(int M, int N, int G_, int c_) { nM = M / BM; nN = N / BM; nwg = nM * nN; G = G_; c = c_; }
    __host__ __device__ bool next(int i, Unit& u) const {
        const long L = (long)i * G + c; if (L >= nwg) return false;
        int wgid = (int)L; { const int q = nwg / NXCD, r = nwg % NXCD, xcd = wgid % NXCD, off = wgid / NXCD; wgid = (xcd < r ? xcd * (q + 1) : r * (q + 1) + (xcd - r) * q) + off; }
        const int nig = WGM * nN, gid = wgid / nig, fm = gid * WGM, gsz = (nM - fm) < WGM ? (nM - fm) : WGM;
        u.pm = fm + ((wgid % nig) % gsz); u.pn = (wgid % nig) / gsz; u.part = 0; return true;
    }
    static constexpr bool GATHER = false;
    __device__ __forceinline__ int row_of(const Unit&, int) const { return 0; }
    __device__ __forceinline__ void a_ready(const Unit&) const {}
    __device__ __forceinline__ void done(const Unit&) const {}
};
struct PairOrder : StaticOrder {
    __host__ __device__ bool next(int i, Unit& u) const { if (!StaticOrder::next(i >> 1, u)) return false; u.part = i & 1; return true; }
};
__device__ __forceinline__ unsigned cvt_pk_bf16(float lo, float hi) { unsigned r; asm volatile("v_cvt_pk_bf16_f32 %0, %1, %2" : "=v"(r) : "v"(lo), "v"(hi)); return r; }

template <class Epi> __device__ __forceinline__ size_t koff_of(const Epi& E, const Unit& u) { if constexpr (Epi::MULTI) return (size_t)E.kt0(u.part) * (size_t)(BK * 2); else return (size_t)0; }
template <class Epi, class Sched, bool ALIGN_EPI = false, bool SP2 = false, int DUAL_T = 0, int I8MODE = 0>
__device__ __forceinline__ void gemm_phase(PG8_LAS unsigned char* lds, const Gemm g, const Sched& S, const Epi& E, int tid_) {
    asm volatile("" : "+v"(tid_));
    const int tid = tid_, wid = __builtin_amdgcn_readfirstlane(tid >> 6), lane = tid & 63, wr = wid >> 2, wc = wid & 3, fr = lane & 15, fq = lane >> 4;
    int K = g.K; asm volatile("" : "+s"(K));
    int nt = K / BK; const int LD = g.ld;
#define PG8_KOFF(u) koff_of(E, u)
    constexpr bool GATHER = Sched::GATHER; static_assert(!GATHER || SP2, "GATHER is written for the SP2 loop");
    unsigned voffA[2], voffA1[2], voffB[2]; int gR[2], gC[2];
#pragma unroll
    for (int i = 0; i < 2; ++i) { int R, C; stage_rc(tid * 16 + i * 8192, R, C); const int Rb = Epi::PERM ? ((R & ~31) + perm32(R & 31)) : R; gR[i] = R; gC[i] = C;
        voffA[i] = (unsigned)(R * LD + C) * 2u; voffA1[i] = 0u; voffB[i] = (unsigned)(Rb * LD + C) * 2u; }
#define PG8_GOFF(slot, i) ((unsigned)((((slot) < 0 ? 0 : (slot)) >> 1) * LD + gC[i]) * 2u)
    const size_t kstep = (size_t)(BK * 2);
    const size_t hstep = (size_t)HALF * LD * 2;
    const size_t tstep = 2 * hstep;
    const size_t hstepB = DUAL_T ? 0 : hstep, tstepB = DUAL_T ? hstep : tstep;
    const unsigned ldsw = (unsigned)wid * 1024u;
    const int aoff = lds_byte(wr * 64 + fr, fq * 8), boff = lds_byte(wc * 32 + fr, fq * 8);
#define PG8_SA(b, h) (((b) * 2 + (h)) * HTB)
#define PG8_SB(b, h) ((4 + (b) * 2 + (h)) * HTB)
#define PG8_STAGE(bufoff, gbase, voff) do { _Pragma("unroll") for (int _i = 0; _i < 2; ++_i) \
        __builtin_amdgcn_global_load_lds((const unsigned*)((const char*)(gbase) + (voff)[_i]), (PG8_LAS unsigned*)(lds + (bufoff) + ldsw + _i * 8192), 16, 0, 0); } while (0)
#define PG8_LD32(p_) __builtin_shufflevector(*(const PG8_LAS i32x4*)(p_), *(const PG8_LAS i32x4*)((p_) + 1024), 0, 1, 2, 3, 4, 5, 6, 7)
#define PG8_LDA(dst, b, h) do { if constexpr (I8MODE == 3) { _Pragma("unroll") for (int m = 0; m < 4; ++m) dst##8[m] = PG8_LD32(lds + PG8_SA(b, h) + aoff + m * 2048); } else { \
        _Pragma("unroll") for (int m = 0; m < 4; ++m) _Pragma("unroll") for (int k = 0; k < 2; ++k) dst[m][k] = *(const PG8_LAS bf16x8*)(lds + PG8_SA(b, h) + aoff + m * 2048 + k * 1024); } } while (0)
#define PG8_LDB(dst, b, h) do { if constexpr (I8MODE == 3) { _Pragma("unroll") for (int n = 0; n < 2; ++n) dst##8[n] = PG8_LD32(lds + PG8_SB(b, h) + boff + n * 2048); } else { \
        _Pragma("unroll") for (int n = 0; n < 2; ++n) _Pragma("unroll") for (int k = 0; k < 2; ++k) dst[n][k] = *(const PG8_LAS bf16x8*)(lds + PG8_SB(b, h) + boff + n * 2048 + k * 1024); } } while (0)
#define PG8_MMA(ai, bj, At, Bt) do { __builtin_amdgcn_s_setprio(1); _Pragma("unroll") for (int m = 0; m < 4; ++m) _Pragma("unroll") for (int n = 0; n < 2; ++n) _Pragma("unroll") for (int k = 0; k < 2; ++k) \
        acc[ai][bj][m][n] = __builtin_amdgcn_mfma_f32_16x16x32_bf16(Bt[n][k], At[m][k], acc[ai][bj][m][n], 0, 0, 0); __builtin_amdgcn_s_setprio(0); } while (0)
#define PG8_MMA_I8(ai, bj, At, Bt) do { __builtin_amdgcn_s_setprio(1); _Pragma("unroll") for (int m = 0; m < 4; ++m) _Pragma("unroll") for (int n = 0; n < 2; ++n) _Pragma("unroll") for (int k = 0; k < 2; ++k) \
        acc[ai][bj][m][n] = __builtin_bit_cast(f32x4, __builtin_amdgcn_mfma_i32_16x16x64_i8(__builtin_bit_cast(i32x4, Bt[n][k]), __builtin_bit_cast(i32x4, At[m][k]), __builtin_bit_cast(i32x4, acc[ai][bj][m][n]), 0, 0, 0)); __builtin_amdgcn_s_setprio(0); } while (0)
#define PG8_MMA_F8(ai, bj, At, Bt) do { __builtin_amdgcn_s_setprio(1); _Pragma("unroll") for (int m = 0; m < 4; ++m) _Pragma("unroll") for (int n = 0; n < 2; ++n) \
        acc[ai][bj][m][n] = __builtin_amdgcn_mfma_scale_f32_16x16x128_f8f6f4(Bt##8[n], At##8[m], acc[ai][bj][m][n], 0, 0, 0, 0x7f7f7f7f, 0, 0x7f7f7f7f); __builtin_amdgcn_s_setprio(0); } while (0)
#define PG8_MMA2(ai) do { if constexpr (I8MODE == 3) { PG8_MMA_F8(ai, 0, At, B0); PG8_MMA_F8(ai, 1, At, B1); } else if constexpr (DUAL_T > 0) { if (t < DUAL_T) { if constexpr (I8MODE != 0) { PG8_MMA_I8(ai, 0, At, B0); } else { PG8_MMA(ai, 0, At, B0); } } else { if constexpr (I8MODE == 1) { PG8_MMA_I8(ai, 1, At, B0); } else { PG8_MMA(ai, 1, At, B0); } } } \
        else { if constexpr (I8MODE == 1) { PG8_MMA_I8(ai, 0, At, B0); PG8_MMA_I8(ai, 1, At, B1); } else { PG8_MMA(ai, 0, At, B0); PG8_MMA(ai, 1, At, B1); } } } while (0)
#define PG8_STAGE_B1(buf, base) do { if constexpr (!DUAL_T) { PG8_STAGE(buf, base, voffB); } } while (0)
#define PG8_WAIT_VD(n, nd) do { if constexpr (DUAL_T > 0) { asm volatile("s_waitcnt vmcnt(" #nd ")" ::: "memory"); } else { asm volatile("s_waitcnt vmcnt(" #n ")" ::: "memory"); } } while (0)
#define PG8_WAIT_V(n) asm volatile("s_waitcnt vmcnt(" #n ")" ::: "memory")
#define PG8_WAIT_L(n) asm volatile("s_waitcnt lgkmcnt(" #n ")" ::: "memory")
#define PG8_BAR __builtin_amdgcn_s_barrier()
#define PG8_SCHED __builtin_amdgcn_sched_barrier(0)
    Unit cur, nxt; int ui = 0;
    if (!S.next(0, cur)) return;
    f32x4 acc[2][2][4][2];
#pragma unroll
    for (int a = 0; a < 2; ++a)
#pragma unroll
        for (int b = 0; b < 2; ++b)
#pragma unroll
            for (int m = 0; m < 4; ++m)
#pragma unroll
                for (int n = 0; n < 2; ++n) acc[a][b][m][n] = (f32x4){0.f, 0.f, 0.f, 0.f};
    bf16x8 At[4][2], B0[2][2], B1[2][2]; i32x8 At8[4], B08[2], B18[2];
    const char* cA = (const char*)g.A + (GATHER ? (size_t)0 : (size_t)cur.pm * tstep) + PG8_KOFF(cur); const char* cB = (const char*)g.Bt + (size_t)cur.pn * tstepB + PG8_KOFF(cur);
    if constexpr (Epi::MULTI) { nt = E.nkt(cur.part); asm volatile("" : "+s"(nt)); }
    S.a_ready(cur);
    int ns[4] = {0, 0, 0, 0};
    if constexpr (GATHER) {
#pragma unroll
        for (int i = 0; i < 2; ++i) { voffA[i] = PG8_GOFF(S.row_of(cur, gR[i]), i); voffA1[i] = PG8_GOFF(S.row_of(cur, HALF + gR[i]), i); } }
#define PG8_STAGE_A1(buf, base) do { if constexpr (GATHER) { PG8_STAGE(buf, base, voffA1); } else { PG8_STAGE(buf, (base) + hstep, voffA); } } while (0)
    if constexpr (SP2) {
        PG8_STAGE(PG8_SB(0, 0), cB, voffB); PG8_STAGE_B1(PG8_SB(0, 1), cB + hstepB); PG8_STAGE(PG8_SA(0, 0), cA, voffA); PG8_STAGE_A1(PG8_SA(0, 1), cA);
        if (wr == 1) PG8_BAR;
        PG8_WAIT_V(2); PG8_BAR;
        PG8_STAGE(PG8_SB(1, 0), cB + kstep, voffB); PG8_STAGE(PG8_SA(1, 0), cA + kstep, voffA); PG8_STAGE_B1(PG8_SB(1, 1), cB + hstepB + kstep);
        PG8_WAIT_VD(6, 4); PG8_BAR;
    } else {
        PG8_STAGE(PG8_SB(0, 0), cB, voffB); PG8_STAGE(PG8_SA(0, 0), cA, voffA); PG8_STAGE(PG8_SB(0, 1), cB + hstepB, voffB); PG8_STAGE(PG8_SA(0, 1), cA + hstep, voffA);
        if (wr == 1) PG8_BAR;
        PG8_WAIT_V(4); PG8_BAR;
        PG8_STAGE(PG8_SB(1, 0), cB + kstep, voffB); PG8_STAGE(PG8_SA(1, 0), cA + kstep, voffA); PG8_STAGE(PG8_SB(1, 1), cB + hstepB + kstep, voffB);
        PG8_WAIT_V(6); PG8_BAR;
    }
    for (;;) {
        const bool has_next = S.next(ui + 1, nxt);
        if constexpr (GATHER) { if (has_next) {
#pragma unroll
            for (int i = 0; i < 2; ++i) { ns[i] = S.row_of(nxt, gR[i]); ns[2 + i] = S.row_of(nxt, HALF + gR[i]); } } }
        const char* nA = (has_next && !GATHER) ? (const char*)g.A + (size_t)nxt.pm * tstep + PG8_KOFF(nxt) : cA; const char* nB = has_next ? (const char*)g.Bt + (size_t)nxt.pn * tstepB + PG8_KOFF(nxt) : cB;
        for (int t = 0; t < nt; t += 2) {
            const bool last = (t == nt - 2);
            if constexpr (Epi::MID_T > 0) { if (t == Epi::MID_T) E.mid(acc, cur, wr, wc, fr, fq); }
            const char* a1 = cA + (size_t)(t + 1) * kstep;
            const char* a2 = last ? nA : cA + (size_t)(t + 2) * kstep; const char* b2 = last ? nB : cB + (size_t)(t + 2) * kstep;
            const char* a3 = a2 + kstep; const char* b3 = b2 + kstep;
            if (last && has_next) S.a_ready(nxt);
            if constexpr (SP2) {
            PG8_LDB(B0, 0, 0); if constexpr (!DUAL_T) PG8_LDB(B1, 0, 1); PG8_SCHED; PG8_LDA(At, 0, 0); PG8_STAGE_A1(PG8_SA(1, 1), a1);
            if constexpr (GATHER) { if (last && has_next) {
#pragma unroll
                for (int i = 0; i < 2; ++i) { voffA[i] = PG8_GOFF(ns[i], i); voffA1[i] = PG8_GOFF(ns[2 + i], i); } } }
            PG8_WAIT_VD(8, 6); PG8_WAIT_L(0); PG8_BAR; PG8_MMA2(0); PG8_BAR; PG8_SCHED;
            PG8_LDA(At, 0, 1); PG8_STAGE(PG8_SB(0, 0), b2, voffB); PG8_STAGE_B1(PG8_SB(0, 1), b2 + hstepB); PG8_STAGE(PG8_SA(0, 0), a2, voffA);
            PG8_WAIT_VD(8, 6); PG8_WAIT_L(0); PG8_BAR; PG8_MMA2(1); PG8_BAR; PG8_SCHED;
            PG8_LDB(B0, 1, 0); if constexpr (!DUAL_T) PG8_LDB(B1, 1, 1); PG8_SCHED; PG8_LDA(At, 1, 0); PG8_STAGE_A1(PG8_SA(0, 1), a2);
            PG8_WAIT_VD(8, 6); PG8_WAIT_L(0); PG8_BAR; PG8_MMA2(0); PG8_BAR; PG8_SCHED;
            PG8_LDA(At, 1, 1); PG8_STAGE(PG8_SB(1, 0), b3, voffB); PG8_STAGE_B1(PG8_SB(1, 1), b3 + hstepB); PG8_STAGE(PG8_SA(1, 0), a3, voffA);
            PG8_WAIT_VD(8, 6); PG8_WAIT_L(0); PG8_BAR; PG8_MMA2(1); PG8_BAR; PG8_SCHED;
            } else {
            PG8_LDB(B0, 0, 0); PG8_SCHED; PG8_LDA(At, 0, 0); PG8_STAGE(PG8_SA(1, 1), a1 + hstep, voffA);
            PG8_WAIT_L(8); PG8_BAR; PG8_WAIT_L(0); PG8_MMA(0, 0, At, B0); PG8_BAR; PG8_SCHED;
            PG8_LDB(B1, 0, 1); PG8_STAGE(PG8_SB(0, 0), b2, voffB);
            PG8_BAR; PG8_WAIT_L(0); PG8_MMA(0, 1, At, B1); PG8_BAR;
            PG8_LDA(At, 0, 1); PG8_STAGE(PG8_SA(0, 0), a2, voffA);
            PG8_BAR; PG8_WAIT_L(0); PG8_MMA(1, 0, At, B0); PG8_BAR; PG8_SCHED;
            PG8_STAGE(PG8_SB(0, 1), b2 + hstepB, voffB);
            PG8_WAIT_V(6); PG8_BAR; PG8_MMA(1, 1, At, B1); PG8_BAR;
            PG8_LDB(B0, 1, 0); PG8_SCHED; PG8_LDA(At, 1, 0); PG8_STAGE(PG8_SA(0, 1), a2 + hstep, voffA);
            PG8_WAIT_L(8); PG8_BAR; PG8_WAIT_L(0); PG8_MMA(0, 0, At, B0); PG8_BAR; PG8_SCHED;
            PG8_LDB(B1, 1, 1); PG8_STAGE(PG8_SB(1, 0), b3, voffB);
            PG8_BAR; PG8_WAIT_L(0); PG8_MMA(0, 1, At, B1); PG8_BAR;
            PG8_LDA(At, 1, 1); PG8_STAGE(PG8_SA(1, 0), a3, voffA);
            PG8_BAR; PG8_WAIT_L(0); PG8_MMA(1, 0, At, B0); PG8_BAR; PG8_SCHED;
            PG8_STAGE(PG8_SB(1, 1), b3 + hstepB, voffB);
            PG8_WAIT_V(6); PG8_BAR; PG8_MMA(1, 1, At, B1); PG8_BAR;
            }
        }
        if constexpr (ALIGN_EPI) { if (wr == 0) PG8_BAR; }
        if constexpr (!Epi::AFTER_DRAIN) { E(acc, cur, wr, wc, fr, fq); S.done(cur); }
        if (!has_next) break;
        bool zero_acc = true; if constexpr (Epi::MULTI) zero_acc = E.reset(cur.part);
        if (zero_acc) {
#pragma unroll
        for (int a = 0; a < 2; ++a)
#pragma unroll
            for (int b = 0; b < 2; ++b)
#pragma unroll
                for (int m = 0; m < 4; ++m)
#pragma unroll
                    for (int n = 0; n < 2; ++n) acc[a][b][m][n] = (f32x4){0.f, 0.f, 0.f, 0.f};
        }
        cur = nxt; cA = nA; cB = nB; ++ui;
        if constexpr (Epi::MULTI) { nt = E.nkt(cur.part); asm volatile("" : "+s"(nt)); }
        if constexpr (ALIGN_EPI) { if (wr == 1) PG8_BAR; }
    }
    PG8_WAIT_V(0);
    if constexpr (!ALIGN_EPI) { if (wr == 0) PG8_BAR; }
    PG8_BAR;
#undef PG8_SA
#undef PG8_SB
#undef PG8_STAGE
#undef PG8_LDA
#undef PG8_LD32
#undef PG8_LDB
#undef PG8_MMA
#undef PG8_MMA2
#undef PG8_MMA_I8
#undef PG8_MMA_F8
#undef PG8_KOFF
#undef PG8_STAGE_B1
#undef PG8_WAIT_VD
#undef PG8_STAGE_A1
#undef PG8_GOFF
#undef PG8_WAIT_V
#undef PG8_WAIT_L
#undef PG8_BAR
#undef PG8_SCHED
}
}

typedef f32x4 acc_t[2][2][4][2];
using pg8::Unit; using pg8::HALF; using pg8::BM;

struct EpiInproj {
    static constexpr bool PERM = true, AFTER_DRAIN = false; static constexpr bool MULTI = false; static constexpr int MID_T = 0;
    unsigned char* ws; const float* b_in; const float* g_q; const float* g_k; const float* rstdx;
    __device__ __forceinline__ void operator()(const acc_t& acc, const Unit& u, int wr, int wc, int fr, int fq) const {
        const int pn = u.pn;
        int mode, col0; size_t off;
        if (pn < 12) { const int seg = pn >> 1; mode = seg == 0 ? 1 : (seg == 1 ? 2 : 0); col0 = 256 * (pn & 1) + ((seg == 2 || seg == 4 || seg == 5) ? 512 : 0);
            off = (seg == 0 || seg == 4) ? WS_A1 : ((seg == 1 || seg == 2) ? WS_B1 : WS_C1); }
        else if (pn < 16) { mode = 3; col0 = 256 * (pn - 12); off = WS_SGA; }
        else { mode = 3; col0 = 256 * (pn - 16); off = WS_SGC; }
        constexpr int pitch = 1024;
        bf16_t* base = (bf16_t*)(ws + off);
        const int lc0 = 64 * wc + 8 * fq;
        f32x4 bv[2][2], gv[2][2];
#pragma unroll
        for (int bj = 0; bj < 2; ++bj)
#pragma unroll
            for (int n = 0; n < 2; ++n) {
                bv[bj][n] = *(const f32x4*)(b_in + 256 * pn + lc0 + 32 * bj + 4 * n);
                const float* g = (mode == 2) ? g_k : g_q;
                gv[bj][n] = *(const f32x4*)(g + 8 * fq + 32 * bj + 4 * n);
            }
        const float qs = (mode == 1) ? C2 : 1.0f;
        float rsxv[2][4];
#pragma unroll
        for (int ai = 0; ai < 2; ++ai)
#pragma unroll
            for (int m = 0; m < 4; ++m) rsxv[ai][m] = rstdx[u.pm * BM + ai * HALF + wr * 64 + m * 16 + fr];
#pragma unroll
        for (int ai = 0; ai < 2; ++ai)
#pragma unroll
            for (int m = 0; m < 4; ++m) {
                const int row = u.pm * BM + ai * HALF + wr * 64 + m * 16 + fr; const float rsx = rsxv[ai][m];
                f32x4 v[2][2];
#pragma unroll
                for (int bj = 0; bj < 2; ++bj)
#pragma unroll
                    for (int n = 0; n < 2; ++n) v[bj][n] = acc[ai][bj][m][n] * rsx + bv[bj][n];
                if (mode == 1 || mode == 2) {
                    float ss = 0.f;
#pragma unroll
                    for (int bj = 0; bj < 2; ++bj)
#pragma unroll
                        for (int n = 0; n < 2; ++n) { const f32x4 x = v[bj][n]; ss += (x[0] * x[0] + x[1] * x[1]) + (x[2] * x[2] + x[3] * x[3]); }
                    ss += __shfl_xor(ss, 16); ss += __shfl_xor(ss, 32);
                    const float rstd = __frsqrt_rn(ss * (1.0f / 64.0f) + EPS) * qs;
#pragma unroll
                    for (int bj = 0; bj < 2; ++bj)
#pragma unroll
                        for (int n = 0; n < 2; ++n) v[bj][n] = v[bj][n] * rstd * gv[bj][n];
                } else if (mode == 3) {
#pragma unroll
                    for (int bj = 0; bj < 2; ++bj)
#pragma unroll
                        for (int n = 0; n < 2; ++n)
#pragma unroll
                            for (int j = 0; j < 4; ++j) v[bj][n][j] = sigmoidf_(v[bj][n][j]);
                }
                if (mode == 3) {
                    unsigned char* rp8 = (unsigned char*)base + (size_t)row * pitch + col0 + lc0; const float lo = (pn >= 16) ? 1.0f : 0.0f;
#pragma unroll
                    for (int bj = 0; bj < 2; ++bj) { unsigned w2[2];
#pragma unroll
                        for (int n = 0; n < 2; ++n) { unsigned b4 = 0;
#pragma unroll
                            for (int j = 0; j < 4; ++j) b4 |= (unsigned)__float2int_rn(fmaxf(v[bj][n][j] * 255.0f, lo)) << (8 * j);
                            w2[n] = b4; }
                        *(u32x2*)(rp8 + 32 * bj) = (u32x2){w2[0], w2[1]}; }
                    continue;
                }
                bf16_t* rowp = base + (size_t)row * pitch + col0 + lc0;
#pragma unroll
                for (int bj = 0; bj < 2; ++bj) {
                    u32x4 w; w.x = pg8::cvt_pk_bf16(v[bj][0][0], v[bj][0][1]); w.y = pg8::cvt_pk_bf16(v[bj][0][2], v[bj][0][3]); w.z = pg8::cvt_pk_bf16(v[bj][1][0], v[bj][1][1]); w.w = pg8::cvt_pk_bf16(v[bj][1][2], v[bj][1][3]);
                    *(u32x4*)(rowp + 32 * bj) = w;
                }
            }
    }
};

struct EpiGateF8 {
    static constexpr bool PERM = true, AFTER_DRAIN = false; static constexpr bool MULTI = false; static constexpr int MID_T = 0;
    unsigned char* sga8; unsigned char* sgc8; const float* bias; const float* rstdx;
    __device__ __forceinline__ void operator()(const acc_t& acc, const Unit& u, int wr, int wc, int fr, int fq) const {
        const int pn = u.pn; unsigned char* base = (pn < 4 ? sga8 : sgc8) + 256 * (pn & 3) + wc * 32 + 8 * fq; const float lo = (pn >= 4) ? 1.0f : 0.0f;
        f32x4 bv[2][2]; float rsxv[2][4];
#pragma unroll
        for (int bj = 0; bj < 2; ++bj)
#pragma unroll
            for (int n = 0; n < 2; ++n) bv[bj][n] = *(const f32x4*)(bias + 256 * pn + wc * 32 + 8 * fq + bj * HALF + 4 * n);
#pragma unroll
        for (int ai = 0; ai < 2; ++ai)
#pragma unroll
            for (int m = 0; m < 4; ++m) rsxv[ai][m] = rstdx[u.pm * BM + ai * HALF + wr * 64 + m * 16 + fr] * (1.0f / F8W);
#pragma unroll
        for (int ai = 0; ai < 2; ++ai)
#pragma unroll
            for (int m = 0; m < 4; ++m) {
                const int row = u.pm * BM + ai * HALF + wr * 64 + m * 16 + fr; const float rs = rsxv[ai][m];
#pragma unroll
                for (int bj = 0; bj < 2; ++bj) { unsigned w2[2];
#pragma unroll
                    for (int n = 0; n < 2; ++n) { unsigned b4 = 0;
#pragma unroll
                        for (int j = 0; j < 4; ++j) b4 |= (unsigned)__float2int_rn(fmaxf(sigmoidf_(acc[ai][bj][m][n][j] * rs + bv[bj][n][j]) * 255.0f, lo)) << (8 * j);
                        w2[n] = b4; }
                    *(u32x2*)(base + (size_t)row * 1024 + bj * HALF) = (u32x2){w2[0], w2[1]}; }
            }
    }
};

struct EpiMergeDual {
    static constexpr bool PERM = true, AFTER_DRAIN = false; static constexpr bool MULTI = false; static constexpr int MID_T = 0;
    const bf16_t* sga; const bf16_t* sgc; bf16_t* mout;
    __device__ __forceinline__ void operator()(const acc_t& acc, const Unit& u, int wr, int wc, int fr, int fq) const {
        const int col0 = u.pn * HALF + wc * 32 + 8 * fq;
#pragma unroll
        for (int ai = 0; ai < 2; ++ai)
#pragma unroll
            for (int m = 0; m < 4; ++m) {
                const size_t ro = (size_t)(u.pm * BM + ai * HALF + wr * 64 + m * 16 + fr) * D + col0;
                const u32x4 a = *(const u32x4*)(sga + ro), c = *(const u32x4*)(sgc + ro);
                const f32x4 x0 = acc[ai][0][m][0], x1 = acc[ai][0][m][1], y0 = acc[ai][1][m][0], y1 = acc[ai][1][m][1];
                u32x4 w;
                w.x = pg8::cvt_pk_bf16(x0[0] * bf_lo(a.x) + y0[0] * bf_lo(c.x), x0[1] * bf_hi(a.x) + y0[1] * bf_hi(c.x));
                w.y = pg8::cvt_pk_bf16(x0[2] * bf_lo(a.y) + y0[2] * bf_lo(c.y), x0[3] * bf_hi(a.y) + y0[3] * bf_hi(c.y));
                w.z = pg8::cvt_pk_bf16(x1[0] * bf_lo(a.z) + y1[0] * bf_lo(c.z), x1[1] * bf_hi(a.z) + y1[1] * bf_hi(c.z));
                w.w = pg8::cvt_pk_bf16(x1[2] * bf_lo(a.w) + y1[2] * bf_lo(c.w), x1[3] * bf_hi(a.w) + y1[3] * bf_hi(c.w));
                *(u32x4*)(mout + ro) = w;
            }
    }
};

struct EpiResBf16 {
    static constexpr bool PERM = true, AFTER_DRAIN = false; static constexpr bool MULTI = false; static constexpr int MID_T = 0;
    const bf16_t* xb; bf16_t* h1b; unsigned char* h1f8;
    __device__ __forceinline__ void operator()(const acc_t& acc, const Unit& u, int wr, int wc, int fr, int fq) const {
        const int col0 = u.pn * BM + wc * 32 + 8 * fq;
        u32x4 xv[2][4][2];
#pragma unroll
        for (int ai = 0; ai < 2; ++ai)
#pragma unroll
            for (int m = 0; m < 4; ++m)
#pragma unroll
                for (int bj = 0; bj < 2; ++bj) xv[ai][m][bj] = *(const u32x4*)(xb + (size_t)(u.pm * BM + ai * HALF + wr * 64 + m * 16 + fr) * D + col0 + bj * HALF);
#pragma unroll
        for (int ai = 0; ai < 2; ++ai)
#pragma unroll
            for (int m = 0; m < 4; ++m) {
                const size_t ro = (size_t)(u.pm * BM + ai * HALF + wr * 64 + m * 16 + fr) * D + col0;
#pragma unroll
                for (int bj = 0; bj < 2; ++bj) {
                    const u32x4 x = xv[ai][m][bj]; const f32x4 v0 = acc[ai][bj][m][0], v1 = acc[ai][bj][m][1];
                    u32x4 w; w.x = pg8::cvt_pk_bf16(v0[0] + bf_lo(x.x), v0[1] + bf_hi(x.x)); w.y = pg8::cvt_pk_bf16(v0[2] + bf_lo(x.y), v0[3] + bf_hi(x.y));
                    w.z = pg8::cvt_pk_bf16(v1[0] + bf_lo(x.z), v1[1] + bf_hi(x.z)); w.w = pg8::cvt_pk_bf16(v1[2] + bf_lo(x.w), v1[3] + bf_hi(x.w));
                    *(u32x4*)(h1b + ro + bj * HALF) = w;
                    if (h1f8) { u32x2 q; q.x = pk4_fp8(v0[0] + bf_lo(x.x), v0[1] + bf_hi(x.x), v0[2] + bf_lo(x.y), v0[3] + bf_hi(x.y)); q.y = pk4_fp8(v1[0] + bf_lo(x.z), v1[1] + bf_hi(x.z), v1[2] + bf_lo(x.w), v1[3] + bf_hi(x.w)); *(u32x2*)(h1f8 + ro + bj * HALF) = q; }
                }
            }
    }
};

__device__ __forceinline__ int moe_local(const LAS int* pref, int e, int rtg, int r) { const int l = (rtg - pref[e]) * pg8::BM + r; return l < pref[64 + e] ? ((e << 15) | l) : -1; }
__device__ __forceinline__ LAS u32x2* moe_meta(LAS unsigned char* lds, int i) { return (LAS u32x2*)(lds + (i < 4 ? META_LO + i * 2048 : META_HI)); }
__device__ __forceinline__ void moe_meta_preload(LAS unsigned char* lds, const LAS int* pref, int nunits, int G, int c, const int* eslot, const float* ftab, bool by_token, int tid) {
    for (int j = tid; j < 5 * 256; j += 512) { const int i = j >> 8, r = j & 255, L = i * G + c;
        int slot = -1; float f = 0.f;
        if (L < nunits) { const int rtg = L >> 2; int e = 0;
#pragma unroll 4
            for (int k = 1; k < NE; ++k) e += (pref[k] <= rtg) ? 1 : 0;
            const int idx = moe_local(pref, e, rtg, r);
            if (idx >= 0) { slot = eslot[idx]; f = by_token ? ftab[slot >> 1] : ftab[idx]; } }
        moe_meta(lds, i)[r] = (u32x2){(unsigned)slot, __builtin_bit_cast(unsigned, f)}; }
    __syncthreads();
}
template <int F8> struct EpiSwigluT {
    static constexpr bool PERM = true, AFTER_DRAIN = false; static constexpr bool MULTI = false; static constexpr int MID_T = 0;
    bf16_t* hdn; LAS unsigned char* lds; static constexpr float wsc = F8 ? 1.0f / F8W : 1.0f; static constexpr int f8out = F8 && F8_DOWN;
    __device__ __forceinline__ void operator()(const acc_t& acc, const Unit& u, int wr, int wc, int fr, int fq) const {
        const int col0 = 128 * (u.pn & 3) + wc * 32 + 8 * fq;
        float rsv[2][4]; const LAS float* mp = (const LAS float*)moe_meta(lds, u.part) + 1;
#pragma unroll
        for (int ai = 0; ai < 2; ++ai)
#pragma unroll
            for (int m = 0; m < 4; ++m) rsv[ai][m] = mp[2 * (ai * HALF + wr * 64 + m * 16 + fr)] * wsc;
#pragma unroll
        for (int ai = 0; ai < 2; ++ai)
#pragma unroll
            for (int m = 0; m < 4; ++m) {
                const int row = u.pm * BM + ai * HALF + wr * 64 + m * 16 + fr; const float rs = rsv[ai][m];
                const size_t ro = (size_t)row * DE + col0;
                float h[8];
#pragma unroll
                for (int n = 0; n < 2; ++n)
#pragma unroll
                    for (int j = 0; j < 4; ++j) { const float a = acc[ai][0][m][n][j] * rs, b = acc[ai][1][m][n][j] * rs; h[4 * n + j] = a * sigmoidf_(a) * b; }
                if (f8out) { u32x2 q; q.x = pk4_fp8(h[0], h[1], h[2], h[3]); q.y = pk4_fp8(h[4], h[5], h[6], h[7]); *(u32x2*)((unsigned char*)hdn + ro) = q; }
                else { u32x4 w; w.x = pg8::cvt_pk_bf16(h[0], h[1]); w.y = pg8::cvt_pk_bf16(h[2], h[3]); w.z = pg8::cvt_pk_bf16(h[4], h[5]); w.w = pg8::cvt_pk_bf16(h[6], h[7]);
                *(u32x4*)(hdn + ro) = w; }
            }
    }
};

template <int F8> struct EpiDownT {
    static constexpr bool PERM = true, AFTER_DRAIN = false; static constexpr bool MULTI = false; static constexpr int MID_T = 0;
    bf16_t* contrib; LAS unsigned char* lds; static constexpr float wsc = (F8 ? 1.0f / F8W : 1.0f) * (F8_CONTRIB ? CSC : 1.0f);
    __device__ __forceinline__ void operator()(const acc_t& acc, const Unit& u, int wr, int wc, int fr, int fq) const {
        const int col0 = 256 * (u.pn & 3) + wc * 32 + 8 * fq;
#pragma unroll
        for (int ai = 0; ai < 2; ++ai) {
            int sl[4]; float wv[4];
#pragma unroll
            for (int m = 0; m < 4; ++m) { const LAS unsigned* mq = (const LAS unsigned*)moe_meta(lds, u.part) + 2 * (ai * HALF + wr * 64 + m * 16 + fr); sl[m] = (int)mq[0]; wv[m] = __builtin_bit_cast(float, mq[1]) * wsc; }
#pragma unroll
            for (int m = 0; m < 4; ++m) {
                const int slot = sl[m]; const float w = wv[m];
                if (slot >= 0) {
#pragma unroll
                    for (int bj = 0; bj < 2; ++bj) {
                        const f32x4 v0 = acc[ai][bj][m][0] * w, v1 = acc[ai][bj][m][1] * w;
#if F8_CONTRIB
                        *(u32x2*)((unsigned char*)contrib + (size_t)slot * D + col0 + bj * HALF) = (u32x2){pk4_fp8(v0[0], v0[1], v0[2], v0[3]), pk4_fp8(v1[0], v1[1], v1[2], v1[3])};
#else
                        u32x4 o; o.x = pg8::cvt_pk_bf16(v0[0], v0[1]); o.y = pg8::cvt_pk_bf16(v0[2], v0[3]); o.z = pg8::cvt_pk_bf16(v1[0], v1[1]); o.w = pg8::cvt_pk_bf16(v1[2], v1[3]);
                        *(u32x4*)(contrib + (size_t)slot * D + col0 + bj * HALF) = o;
#endif
                    }
                }
                asm volatile("" ::: "memory");
            }
        }
    }
};

struct EpiGateDual {
    static constexpr bool PERM = false, AFTER_DRAIN = false; static constexpr bool MULTI = false; static constexpr int MID_T = 0;
    const bf16_t* h2b; const float* rsc; const float* cmax; const float* bpg; float* out;
    __device__ __forceinline__ void operator()(const acc_t& acc, const Unit& u, int wr, int wc, int fr, int fq) const {
        const int col0 = u.pn * HALF + wc * 32 + 4 * fq;
        f32x4 cs[2], bv[2]; float rsv[2][4]; u32x2 hv[2][4][2];
#pragma unroll
        for (int n = 0; n < 2; ++n) { cs[n] = *(const f32x4*)(cmax + col0 + n * 16) * (1.0f / 127.0f); bv[n] = *(const f32x4*)(bpg + col0 + n * 16); }
#pragma unroll
        for (int ai = 0; ai < 2; ++ai)
#pragma unroll
            for (int m = 0; m < 4; ++m) { const int row = u.pm * BM + ai * HALF + wr * 64 + m * 16 + fr; rsv[ai][m] = rsc[row];
#pragma unroll
                for (int n = 0; n < 2; ++n) hv[ai][m][n] = *(const u32x2*)(h2b + (size_t)row * D + col0 + n * 16); }
#pragma unroll
        for (int ai = 0; ai < 2; ++ai)
#pragma unroll
            for (int m = 0; m < 4; ++m) {
                const int row = u.pm * BM + ai * HALF + wr * 64 + m * 16 + fr; const float rs = rsv[ai][m];
#pragma unroll
                for (int n = 0; n < 2; ++n) {
                    const int c = col0 + n * 16;
                    const u32x2 hw = hv[ai][m][n];
                    const i32x4 ia = __builtin_bit_cast(i32x4, acc[ai][0][m][n]); const f32x4 pv = acc[ai][1][m][n];
                    f32x4 a; a[0] = (float)ia[0] * rs * cs[n][0] + bv[n][0]; a[1] = (float)ia[1] * rs * cs[n][1] + bv[n][1]; a[2] = (float)ia[2] * rs * cs[n][2] + bv[n][2]; a[3] = (float)ia[3] * rs * cs[n][3] + bv[n][3];
                    f32x4 r;
                    r[0] = bf_lo(hw.x) + sigmoidf_(a[0]) * pv[0]; r[1] = bf_hi(hw.x) + sigmoidf_(a[1]) * pv[1];
                    r[2] = bf_lo(hw.y) + sigmoidf_(a[2]) * pv[2]; r[3] = bf_hi(hw.y) + sigmoidf_(a[3]) * pv[3];
                    *(f32x4*)(out + (size_t)row * D + c) = r;
                }
            }
    }
};

struct EpiMerge2 {
    static constexpr bool PERM = true, AFTER_DRAIN = false; static constexpr bool MULTI = true; static constexpr int MID_T = 0;
    const unsigned char* sga; const unsigned char* sgc; bf16_t* mout;
    __device__ __forceinline__ int kt0(int part) const { return 8 * part; }
    __device__ __forceinline__ int nkt(int) const { return 8; }
    __device__ __forceinline__ bool reset(int part) const { return part == 1; }
    static __device__ __forceinline__ float u8(unsigned w, int j) { return (float)((w >> (8 * j)) & 0xffu); }
    __device__ __forceinline__ void operator()(acc_t& acc, const Unit& u, int wr, int wc, int fr, int fq) const {
        const int col0 = u.pn * BM + wc * 32 + 8 * fq;
        if (u.part == 0) {
            u32x2 av[2][4][2], cv[2][4][2];
#pragma unroll
            for (int ai = 0; ai < 2; ++ai)
#pragma unroll
                for (int m = 0; m < 4; ++m)
#pragma unroll
                    for (int bj = 0; bj < 2; ++bj) { const size_t o = (size_t)(u.pm * BM + ai * HALF + wr * 64 + m * 16 + fr) * D + col0 + bj * HALF; av[ai][m][bj] = *(const u32x2*)(sga + o); cv[ai][m][bj] = *(const u32x2*)(sgc + o); }
#pragma unroll
            for (int ai = 0; ai < 2; ++ai)
#pragma unroll
                for (int m = 0; m < 4; ++m)
#pragma unroll
                    for (int bj = 0; bj < 2; ++bj) {
                        const u32x2 a = av[ai][m][bj], c = cv[ai][m][bj];
#pragma unroll
                        for (int j = 0; j < 4; ++j) { acc[ai][bj][m][0][j] *= u8(a.x, j) * __builtin_amdgcn_rcpf(u8(c.x, j)); acc[ai][bj][m][1][j] *= u8(a.y, j) * __builtin_amdgcn_rcpf(u8(c.y, j)); }
                    }
        } else {
            u32x2 cv[2][4][2];
#pragma unroll
            for (int ai = 0; ai < 2; ++ai)
#pragma unroll
                for (int m = 0; m < 4; ++m)
#pragma unroll
                    for (int bj = 0; bj < 2; ++bj) cv[ai][m][bj] = *(const u32x2*)(sgc + (size_t)(u.pm * BM + ai * HALF + wr * 64 + m * 16 + fr) * D + col0 + bj * HALF);
#pragma unroll
            for (int ai = 0; ai < 2; ++ai)
#pragma unroll
                for (int m = 0; m < 4; ++m) {
                    const size_t ro = (size_t)(u.pm * BM + ai * HALF + wr * 64 + m * 16 + fr) * D + col0;
#pragma unroll
                    for (int bj = 0; bj < 2; ++bj) {
                        const u32x2 c = cv[ai][m][bj]; const f32x4 v0 = acc[ai][bj][m][0], v1 = acc[ai][bj][m][1]; constexpr float k = 1.0f / 255.0f;
                        u32x4 w; w.x = pg8::cvt_pk_bf16(v0[0] * u8(c.x, 0) * k, v0[1] * u8(c.x, 1) * k); w.y = pg8::cvt_pk_bf16(v0[2] * u8(c.x, 2) * k, v0[3] * u8(c.x, 3) * k);
                        w.z = pg8::cvt_pk_bf16(v1[0] * u8(c.y, 0) * k, v1[1] * u8(c.y, 1) * k); w.w = pg8::cvt_pk_bf16(v1[2] * u8(c.y, 2) * k, v1[3] * u8(c.y, 3) * k);
                        *(u32x4*)(mout + ro + bj * HALF) = w;
                    }
                }
        }
    }
};

template <bool GATHER_> struct MoeOrderT {
    static constexpr bool GATHER = GATHER_;
    const LAS int* pref;
    int nunits, G, c; LAS unsigned char* lds;
    __device__ __forceinline__ int row_of(const Unit& u, int r) const { return ((const LAS int*)moe_meta(lds, u.part))[2 * r]; }
    __device__ __forceinline__ bool next(int i, Unit& u) const {
        const int L = i * G + c; if (L >= nunits) return false;
        const int rtg = L >> 2, pnl = L & 3; int e = 0;
#pragma unroll 4
        for (int k = 1; k < NE; ++k) e += (pref[k] <= rtg) ? 1 : 0;
        e = __builtin_amdgcn_readfirstlane(e);
        u.pm = rtg; u.pn = 4 * e + pnl; u.part = i; return true;
    }
    __device__ __forceinline__ void a_ready(const Unit&) const {}
    __device__ __forceinline__ void done(const Unit&) const {}
};
struct StaticOrderId : pg8::StaticOrder {
    static constexpr bool GATHER = true;
    __device__ __forceinline__ int row_of(const Unit& u, int r) const { return 2 * (u.pm * pg8::BM + r); }
};
struct MoeOrderId : MoeOrderT<true> {
    __device__ __forceinline__ int row_of(const Unit& u, int r) const { return 2 * (u.pm * pg8::BM + r); }
};

#define XB_TMO      128
#define XB_XCNT(j)  (256  + 64 * (j))
#define XB_XSUB(j)  (1280 + 64 * (j))
#define XB_XGEN(j)  (2304 + 64 * (j))
#define XB_TOP      3328
#define XB_TOPGEN   3392
#define XCD_BAR_WORDS 3456
#define XB_SPIN_CAP (1u << 18)

__device__ __forceinline__ unsigned xb_ld(unsigned* p)              { return __hip_atomic_load(p, __ATOMIC_RELAXED, __HIP_MEMORY_SCOPE_AGENT); }
__device__ __forceinline__ unsigned xb_add(unsigned* p, unsigned v) { return __hip_atomic_fetch_add(p, v, __ATOMIC_RELAXED, __HIP_MEMORY_SCOPE_AGENT); }
__device__ __forceinline__ unsigned xb_xcc_id() { return (unsigned)__builtin_amdgcn_s_getreg((3 << 11) | 20) & 0xFu; }
#define XB_SPIN(cond, bar) do { unsigned _sp = 0; while (cond) { __builtin_amdgcn_s_sleep(1); \
    if ((++_sp & 255u) == 0u) { if (xb_ld(&(bar)[XB_TMO])) break; if (_sp > XB_SPIN_CAP) { atomicAdd(&(bar)[XB_TMO], 1u); break; } } } } while (0)

struct XcdBarrier {
    unsigned* bar; unsigned x;
    volatile LAS unsigned* st;
};

__device__ __forceinline__ XcdBarrier xcd_barrier_post(unsigned* bar, volatile LAS unsigned* st) {
    XcdBarrier b; b.bar = bar; b.x = xb_xcc_id(); b.st = st;
    if (threadIdx.x == 0) (void)xb_add(&bar[XB_XCNT(b.x)], 1u);
    return b;
}
__device__ __forceinline__ void xcd_barrier_complete(unsigned* bar, unsigned x, unsigned& nloc, unsigned& nx) {
    const unsigned G = gridDim.x * gridDim.y * gridDim.z;
    unsigned sum, cnt, mine, sp = 0u;
    for (;;) {
        sum = 0u; cnt = 0u; mine = 0u;
#pragma unroll
        for (unsigned j = 0; j < 16; ++j) { const unsigned c = xb_ld(&bar[XB_XCNT(j)]); sum += c; cnt += (c > 0u) ? 1u : 0u; mine = (j == x) ? c : mine; }
        if (sum == G) break;
        __builtin_amdgcn_s_sleep(1);
        if ((++sp & 255u) == 0u) { if (xb_ld(&bar[XB_TMO])) break; if (sp > XB_SPIN_CAP) { atomicAdd(&bar[XB_TMO], 1u); break; } }
    }
    nloc = mine > 0u ? mine : 1u; nx = cnt > 0u ? cnt : 1u;
}

__device__ __forceinline__ void xcd_barrier(const XcdBarrier& b, int tid) {
    asm volatile("s_waitcnt vmcnt(0)" ::: "memory");
    __syncthreads();
    if (tid == 0) {
        unsigned* bar = b.bar;
        __builtin_amdgcn_s_waitcnt(0);
        unsigned nloc = b.st[0], nx = b.st[1];
        if (nloc == 0u) { xcd_barrier_complete(bar, b.x, nloc, nx); b.st[0] = nloc; b.st[1] = nx; }
        const unsigned old = xb_add(&bar[XB_XSUB(b.x)], 1u);
        const unsigned gen = old / nloc;
        if (old + 1u == (gen + 1u) * nloc) {
            __builtin_amdgcn_fence(__ATOMIC_RELEASE, "agent");
            asm volatile("s_waitcnt vmcnt(0)" ::: "memory");
            const unsigned og = xb_add(&bar[XB_TOP], 1u);
            const unsigned tg = og / nx;
            if (og + 1u == (tg + 1u) * nx) xb_add(&bar[XB_TOPGEN], 1u);
            else XB_SPIN(xb_ld(&bar[XB_TOPGEN]) == tg, bar);
            __builtin_amdgcn_fence(__ATOMIC_ACQUIRE, "agent");
            xb_add(&bar[XB_XGEN(b.x)], 1u);
            asm volatile("s_waitcnt vmcnt(0)" ::: "memory");
        } else {
            XB_SPIN(xb_ld(&bar[XB_XGEN(b.x)]) == gen, bar);
            __builtin_amdgcn_fence(__ATOMIC_ACQUIRE, "agent");
            asm volatile("s_waitcnt vmcnt(0)" ::: "memory");
        }
    }
    __syncthreads();
}

#include <hip/hip_bf16.h>
#include <cmath>
namespace attn_body {
using bf16=__hip_bfloat16;
using bf16x8=__attribute__((ext_vector_type(8)))short;
using s16x4=__attribute__((ext_vector_type(4)))short;
using f32x16=__attribute__((ext_vector_type(16)))float;
using u32x4=__attribute__((ext_vector_type(4)))unsigned;
constexpr int BATCH=8,NHEAD=8,SEQ=4096,D=64,DM=1024,OPITCH=1024;
constexpr int NW=8,QBLK=32,QB=QBLK*NW,KVBLK=64,NQB=SEQ/QB;
constexpr int ATTN_PITCH=DM, ATTN_UNIT_ROWS=QB;
constexpr int BT_COPY=384, BT_BYTES=4*BT_COPY*4;
__device__ __forceinline__ int crow(int r,int hi){return (r&3)+8*(r>>2)+4*hi;}
#define SBAR() __builtin_amdgcn_sched_barrier(0)
constexpr int NSLOT=3, SLOTB=8192;
constexpr int LDS_K=0, LDS_V=NSLOT*SLOTB, LDS_WS=2*NSLOT*SLOTB, LDS_OST=LDS_WS+NW*64*4, LDS_BT=LDS_OST+NW*4096, LDS_BYTES=LDS_BT+BT_BYTES;
__device__ __forceinline__ void glds16(const void*gsrc,unsigned lds_dst){unsigned keep;
  asm volatile("s_mov_b32 %0, m0\n\ts_mov_b32 m0, %2\n\ts_nop 0\n\tglobal_load_lds_dwordx4 %1, off\n\ts_mov_b32 m0, %0":"=&s"(keep):"v"(gsrc),"s"(lds_dst):"memory");}
__device__ __forceinline__ float max3f(float a,float b,float c){float r;asm("v_max3_f32 %0, %1, %2, %3":"=v"(r):"v"(a),"v"(b),"v"(c));return r;}
__device__ __forceinline__ float max2f(float a,float b){float r;asm("v_max_f32_e32 %0, %1, %2":"=v"(r):"v"(a),"v"(b));return r;}
__device__ __forceinline__ float fadd_s(float a,float b){float r;asm("v_add_f32_e32 %0, %1, %2":"=v"(r):"v"(a),"v"(b));return r;}
__device__ __forceinline__ float fsub_s(float a,float b){float r;asm("v_sub_f32_e32 %0, %1, %2":"=v"(r):"v"(a),"v"(b));return r;}
typedef float f32x2_t __attribute__((ext_vector_type(2))); typedef float f32x4_t __attribute__((ext_vector_type(4))); typedef __bf16 bf16x2_t __attribute__((ext_vector_type(2)));
__device__ __forceinline__ unsigned cvtpk_s(float lo,float hi){f32x2_t v={lo,hi};bf16x2_t b=__builtin_convertvector(v,bf16x2_t);return __builtin_bit_cast(unsigned,b);}
#define WAIT_BAR(N) asm volatile("s_waitcnt vmcnt(" #N ") lgkmcnt(0)\n\ts_barrier":::"memory")

__device__ __forceinline__ void qkt(f32x16&p0,f32x16&p1,const char*Kslot,const bf16x8*qr,const f32x16&negm,int r32,int hi){
  const char*kb=Kslot+hi*1024+r32*16;
  #pragma unroll
  for(int d0=0;d0<4;++d0){
    const bf16x8 b0=*reinterpret_cast<const bf16x8*>(kb+d0*2048);
    const bf16x8 b1=*reinterpret_cast<const bf16x8*>(kb+d0*2048+512);
    if(d0==0){p0=__builtin_amdgcn_mfma_f32_32x32x16_bf16(b0,qr[0],negm,0,0,0);p1=__builtin_amdgcn_mfma_f32_32x32x16_bf16(b1,qr[0],negm,0,0,0);}
    else{p0=__builtin_amdgcn_mfma_f32_32x32x16_bf16(b0,qr[d0],p0,0,0,0);p1=__builtin_amdgcn_mfma_f32_32x32x16_bf16(b1,qr[d0],p1,0,0,0);}}
}
typedef __attribute__((address_space(3))) const char* lds_cptr;
typedef short v4i16_t __attribute__((ext_vector_type(4)));
__device__ __forceinline__ void kload8(bf16x8*kf,lds_cptr kp){
  kf[0]=*(const __attribute__((address_space(3))) bf16x8*)(kp);      kf[1]=*(const __attribute__((address_space(3))) bf16x8*)(kp+512);
  kf[2]=*(const __attribute__((address_space(3))) bf16x8*)(kp+2048); kf[3]=*(const __attribute__((address_space(3))) bf16x8*)(kp+2560);
  kf[4]=*(const __attribute__((address_space(3))) bf16x8*)(kp+4096); kf[5]=*(const __attribute__((address_space(3))) bf16x8*)(kp+4608);
  kf[6]=*(const __attribute__((address_space(3))) bf16x8*)(kp+6144); kf[7]=*(const __attribute__((address_space(3))) bf16x8*)(kp+6656);
}
__device__ __forceinline__ void kload2(bf16x8*kf,lds_cptr kp,int j){ kf[2*j]=*(const __attribute__((address_space(3))) bf16x8*)(kp+j*2048); kf[2*j+1]=*(const __attribute__((address_space(3))) bf16x8*)(kp+j*2048+512); }
__device__ __forceinline__ s16x4 vtr(lds_cptr p){ return __builtin_bit_cast(s16x4,__builtin_amdgcn_ds_read_tr16_b64_v4i16((__attribute__((address_space(3))) v4i16_t*)p)); }
__device__ __forceinline__ float rowmax(const f32x16&p0,const f32x16&p1){
  float a=max3f(p0[0],p0[1],p1[0]),b=max3f(p0[2],p0[3],p1[1]);a=max3f(a,p1[2],p1[3]);
  #pragma unroll
  for(int r=4;r<16;r+=4){a=max3f(a,p0[r],p0[r+1]);b=max3f(b,p0[r+2],p0[r+3]);a=max3f(a,p1[r],p1[r+1]);b=max3f(b,p1[r+2],p1[r+3]);}
  const float m=max2f(a,b);
  auto rr=__builtin_amdgcn_permlane32_swap(__float_as_uint(m),__float_as_uint(m),false,false);
  return max2f(__uint_as_float(rr[0]),__uint_as_float(rr[1]));
}
__device__ __forceinline__ void pv(f32x16*o,int vb,bf16x8 pa0,bf16x8 pa1,bf16x8 pa2,bf16x8 pa3){
  #pragma unroll
  for(int d0=0;d0<2;++d0){s16x4 lo[4],hi[4];
    #pragma unroll
    for(int ks=0;ks<4;++ks){
      asm volatile("ds_read_b64_tr_b16 %0,%1 offset:%c2":"=&v"(lo[ks]):"v"(vb),"i"(d0*4096+ks*1024):"memory");
      asm volatile("ds_read_b64_tr_b16 %0,%1 offset:%c2":"=&v"(hi[ks]):"v"(vb),"i"(d0*4096+ks*1024+512):"memory");}
    asm volatile("s_waitcnt lgkmcnt(0)":::"memory");SBAR();
    #define PK(k) (bf16x8){lo[k][0],lo[k][1],lo[k][2],lo[k][3],hi[k][0],hi[k][1],hi[k][2],hi[k][3]}
    o[d0]=__builtin_amdgcn_mfma_f32_32x32x16_bf16(pa0,PK(0),o[d0],0,0,0);
    o[d0]=__builtin_amdgcn_mfma_f32_32x32x16_bf16(pa1,PK(1),o[d0],0,0,0);
    o[d0]=__builtin_amdgcn_mfma_f32_32x32x16_bf16(pa2,PK(2),o[d0],0,0,0);
    o[d0]=__builtin_amdgcn_mfma_f32_32x32x16_bf16(pa3,PK(3),o[d0],0,0,0);
    #undef PK
  }
}

#ifndef ATTN_STORE16
#define ATTN_STORE16(p,v) (*(u32x4*)(p)=(v))
#endif
__device__ __forceinline__ void attn_unit(int b,int h,int qb,const bf16*Q,const bf16*K,const bf16*V,bf16*O,char*shm,float cinit,int tid){
  asm volatile("":"+v"(tid));
  const int lane=tid&63,r32=lane&31,hi=lane>>5; const int wid=__builtin_amdgcn_readfirstlane(tid>>6);
  const long rowbase=(long)b*SEQ; const int q0=qb*QB;
  const bf16*Qw=Q+(rowbase+q0+wid*QBLK)*DM+h*D;
  const int t0=(4*qb-8)>0?(4*qb-8):0;
  const bf16*Kh=K+(rowbase+(long)t0*KVBLK)*DM+h*D,*Vh=V+(rowbase+(long)t0*KVBLK)*DM+h*D;
  const int tb=t0-4*qb-(wid>>1)+8;
  const unsigned lds0=(unsigned)(uintptr_t)shm;
  float*wsf=(float*)(shm+LDS_WS)+wid*64;
  const bf16*ksrc=Kh+(long)lane*DM+wid*8;
  const bf16*vsrc=Vh+(long)(16*(wid&3)+(lane>>2))*DM+(wid>>2)*32+(lane&3)*8;
  const unsigned kdst=lds0+LDS_K+wid*1024, vdst=lds0+LDS_V+wid*1024;
  #define DMA_K(t,slot) glds16(ksrc+(long)(t)*KVBLK*DM,(unsigned)__builtin_amdgcn_readfirstlane(kdst+(slot)))
  #define DMA_V(t,slot) glds16(vsrc+(long)(t)*KVBLK*DM,(unsigned)__builtin_amdgcn_readfirstlane(vdst+(slot)))
  const int vb0=(int)(lds0+LDS_V)+((lane>>4)&1)*32+(lane&3)*8+(4*hi+((lane&15)>>2))*64;
  const char*Kbase=shm+LDS_K; bf16x8 kf[8];
  const lds_cptr shm3=(lds_cptr)shm; const lds_cptr kp0=shm3+LDS_K+hi*1024+r32*16; const lds_cptr vp0=shm3+LDS_V+((lane>>4)&1)*32+(lane&3)*8+(4*hi+((lane&15)>>2))*64;
  const int NT=4*qb+4-t0;
  const lds_cptr btl=shm3+LDS_BT+((3-r32)&3)*(BT_COPY*4)+4*(-193-32*(wid&1)-r32-((3-r32)&3)+4*hi);
  DMA_K(0,0);DMA_V(0,0);DMA_K(1,SLOTB);
  bf16x8 qr[4];
  #pragma unroll
  for(int d0=0;d0<4;++d0)qr[d0]=*reinterpret_cast<const bf16x8*>(&Qw[(long)r32*DM+d0*16+hi*8]);
  float l_reg=0.f;f32x16 o[2];o[0]=f32x16{};o[1]=f32x16{};f32x16 negm;
  asm volatile("":"+s"(cinit));
  _Pragma("unroll") for(int r=0;r<16;++r)negm[r]=cinit; asm volatile("":"+v"(negm));
  #define BIASMASK(P0,P1,t) do{ const int tau_=(t)+tb; \
    if(tau_<0||tau_>8){ _Pragma("unroll") for(int r=0;r<16;++r){P0[r]=-INFINITY;P1[r]=-INFINITY;} } \
    else if(tau_>=4){ const lds_cptr bp_=btl+256*tau_; \
      _Pragma("unroll") for(int g=0;g<4;++g){ const f32x4_t d0_=*(const __attribute__((address_space(3))) f32x4_t*)(bp_+32*g), d1_=*(const __attribute__((address_space(3))) f32x4_t*)(bp_+32*g+128); \
        _Pragma("unroll") for(int j=0;j<4;++j){P0[4*g+j]+=d0_[j];P1[4*g+j]+=d1_[j];} } } }while(0)
  #define START(P0,P1) do{ _Pragma("unroll") for(int r=0;r<16;++r)P0[r]=__builtin_amdgcn_exp2f(P0[r]); }while(0)
  #define RESC() do{}while(0)
  f32x16 pA0,pA1,pB0,pB1;
  int sl_prev=0,sl_cur=0,sl_next=SLOTB;
  #define ROT() do{sl_prev=sl_cur;sl_cur=sl_next;sl_next=(sl_next==(NSLOT-1)*SLOTB)?0:sl_next+SLOTB;}while(0)
  DMA_K(2,2*SLOTB);
  WAIT_BAR(3);
  qkt(pA0,pA1,Kbase,qr,negm,r32,hi);asm volatile("s_nop 15\n\ts_nop 7":"+v"(pA0),"+v"(pA1));BIASMASK(pA0,pA1,0);
  START(pA0,pA1);
  _Pragma("unroll") for(int r=0;r<16;++r)pA1[r]=__builtin_amdgcn_exp2f(pA1[r]);
  WAIT_BAR(0);
  DMA_K(3,0);DMA_V(1,SLOTB);
  ROT();
  kload8(kf,kp0+sl_cur);
  WAIT_BAR(2);
  s16x4 vlo[8],vhi[8]; u32x4 pw0,pw1,pw2,pw3;
  #define PKW(P,B) cvtpk_s(P[B],P[B+1])
  #define PAF(k) __builtin_bit_cast(bf16x8,pw##k)
  #define VFR(i) (bf16x8){vlo[i][0],vlo[i][1],vlo[i][2],vlo[i][3],vhi[i][0],vhi[i][1],vhi[i][2],vhi[i][3]}
  #define PIN(x) asm volatile("":"+v"(x))
  #define MX3(a,b,c) __builtin_fmaxf(__builtin_fmaxf((a),(b)),(c))
  #define GAPA(MF,A0,A1,A2,A3,W0,W1,PW) do{ MF; sacc+=A0; sacc+=A1; sacc+=A2; sacc+=A3; PIN(sacc); W0; W1; PIN(PW); SBAR(); }while(0)
  #define EX(v) __builtin_amdgcn_exp2f(v)
  #define GAPB(MF,X,B) do{ MF; X[B]=EX(X[B]); X[B+1]=EX(X[B+1]); X[B+2]=EX(X[B+2]); X[B+3]=EX(X[B+3]); PIN(X); SBAR(); }while(0)
  #define VRD(i) do{ vlo[i]=vtr(vp_+(((i)>>2)*4096+((i)&3)*1024)); vhi[i]=vtr(vp_+(((i)>>2)*4096+((i)&3)*1024+512)); }while(0)
  #define KRD(G,j) do{ if(G){ kload2(kf,kp0+sl_next,j); SBAR(); } }while(0)
  #define STEP(C0,C1,P0,P1,t,GK,GV,GL) do{ SBAR(); \
    const lds_cptr vp_=vp0+sl_prev; \
    VRD(0); SBAR(); float sacc=(P0[0]+P0[1]); \
    GAPA(C0=__builtin_amdgcn_mfma_f32_32x32x16_bf16(kf[0],qr[0],negm,0,0,0), P0[2],P0[3],P0[4],P0[5],     pw0[0]=PKW(P0,0), pw0[1]=PKW(P0,2), pw0); \
    VRD(4); SBAR(); GAPA(C1=__builtin_amdgcn_mfma_f32_32x32x16_bf16(kf[1],qr[0],negm,0,0,0), P0[6],P0[7],P0[8],P0[9],     pw0[2]=PKW(P0,4), pw0[3]=PKW(P0,6), pw0); \
    VRD(1); SBAR(); GAPA(C0=__builtin_amdgcn_mfma_f32_32x32x16_bf16(kf[2],qr[1],C0,0,0,0),   P0[10],P0[11],P0[12],P0[13], pw1[0]=PKW(P0,8), pw1[1]=PKW(P0,10), pw1); \
    VRD(5); SBAR(); GAPA(C1=__builtin_amdgcn_mfma_f32_32x32x16_bf16(kf[3],qr[1],C1,0,0,0),   P0[14],P0[15],P1[0],P1[1],   pw1[2]=PKW(P0,12),pw1[3]=PKW(P0,14), pw1); \
    VRD(2); SBAR(); GAPA(C0=__builtin_amdgcn_mfma_f32_32x32x16_bf16(kf[4],qr[2],C0,0,0,0),   P1[2],P1[3],P1[4],P1[5],     pw2[0]=PKW(P1,0), pw2[1]=PKW(P1,2), pw2); \
    VRD(6); SBAR(); GAPA(C1=__builtin_amdgcn_mfma_f32_32x32x16_bf16(kf[5],qr[2],C1,0,0,0),   P1[6],P1[7],P1[8],P1[9],     pw2[2]=PKW(P1,4), pw2[3]=PKW(P1,6), pw2); \
    VRD(3); SBAR(); GAPA(C0=__builtin_amdgcn_mfma_f32_32x32x16_bf16(kf[6],qr[3],C0,0,0,0),   P1[10],P1[11],P1[12],P1[13], pw3[0]=PKW(P1,8), pw3[1]=PKW(P1,10), pw3); \
    VRD(7); SBAR(); GAPA(C1=__builtin_amdgcn_mfma_f32_32x32x16_bf16(kf[7],qr[3],C1,0,0,0),   P1[14],P1[15],0.f,0.f,       pw3[2]=PKW(P1,12),pw3[3]=PKW(P1,14), pw3); \
    l_reg+=sacc; \
    if(GK){DMA_K((t)+3,sl_cur);} if(GV){DMA_V((t)+1,sl_next);} \
    BIASMASK(C0,C1,t); \
    SBAR(); \
    GAPB(o[0]=__builtin_amdgcn_mfma_f32_32x32x16_bf16(PAF(0),VFR(0),o[0],0,0,0), C0,0); \
    GAPB(o[1]=__builtin_amdgcn_mfma_f32_32x32x16_bf16(PAF(0),VFR(4),o[1],0,0,0), C0,4); \
    KRD(GL,0); GAPB(o[0]=__builtin_amdgcn_mfma_f32_32x32x16_bf16(PAF(1),VFR(1),o[0],0,0,0), C0,8); \
    KRD(GL,1); GAPB(o[1]=__builtin_amdgcn_mfma_f32_32x32x16_bf16(PAF(1),VFR(5),o[1],0,0,0), C0,12); \
    KRD(GL,2); GAPB(o[0]=__builtin_amdgcn_mfma_f32_32x32x16_bf16(PAF(2),VFR(2),o[0],0,0,0), C1,0); \
    KRD(GL,3); GAPB(o[1]=__builtin_amdgcn_mfma_f32_32x32x16_bf16(PAF(2),VFR(6),o[1],0,0,0), C1,4); \
    GAPB(o[0]=__builtin_amdgcn_mfma_f32_32x32x16_bf16(PAF(3),VFR(3),o[0],0,0,0), C1,8); \
    GAPB(o[1]=__builtin_amdgcn_mfma_f32_32x32x16_bf16(PAF(3),VFR(7),o[1],0,0,0), C1,12); \
    }while(0)
  int t=1;
  for(;t+5<NT;t+=2){
    STEP(pB0,pB1,pA0,pA1,t,true,true,true);     WAIT_BAR(2); RESC(); ROT();
    STEP(pA0,pA1,pB0,pB1,t+1,true,true,true);   WAIT_BAR(2); RESC(); ROT();
  }
  #define ENDW(tt) do{ if((tt)+3<NT){WAIT_BAR(2);} else if((tt)+2<NT){WAIT_BAR(1);} else {WAIT_BAR(0);} }while(0)
  for(;t+1<NT;t+=2){
    STEP(pB0,pB1,pA0,pA1,t,(t+3<NT),(t+1<NT),(t+1<NT));       ENDW(t);   RESC(); ROT();
    STEP(pA0,pA1,pB0,pB1,t+1,(t+4<NT),(t+2<NT),(t+2<NT));     ENDW(t+1); RESC(); ROT();
  }
  STEP(pB0,pB1,pA0,pA1,NT-1,false,false,false); RESC();
  { float sacc=pB0[0]+pB0[1]; _Pragma("unroll") for(int r=2;r<16;++r)sacc+=pB0[r]; _Pragma("unroll") for(int r=0;r<16;++r)sacc+=pB1[r]; l_reg+=sacc;
    pw0=(u32x4){PKW(pB0,0),PKW(pB0,2),PKW(pB0,4),PKW(pB0,6)};pw1=(u32x4){PKW(pB0,8),PKW(pB0,10),PKW(pB0,12),PKW(pB0,14)};pw2=(u32x4){PKW(pB1,0),PKW(pB1,2),PKW(pB1,4),PKW(pB1,6)};pw3=(u32x4){PKW(pB1,8),PKW(pB1,10),PKW(pB1,12),PKW(pB1,14)};
    SBAR(); pv(o,vb0+sl_cur,PAF(0),PAF(1),PAF(2),PAF(3)); }
  #undef PKW
  #undef PAF
  #undef VFR
  #undef PIN
  #undef MX3
  #undef GAPA
  #undef GAPB
  #undef EX
  #undef VRD
  #undef KRD
  #undef STEP
  #undef ENDW
  {auto rr=__builtin_amdgcn_permlane32_swap(__float_as_uint(l_reg),__float_as_uint(l_reg),false,false);l_reg=__uint_as_float(rr[0])+__uint_as_float(rr[1]);}
  if(hi==0)wsf[32+r32]=l_reg;asm volatile("s_waitcnt lgkmcnt(0)":::"memory");
  float rli[16];
  #pragma unroll
  for(int r=0;r<16;++r)rli[r]=__builtin_amdgcn_rcpf(wsf[32+crow(r,hi)]);
  bf16*Ow=O+(rowbase+q0+wid*QBLK)*OPITCH+h*D;
  { bf16*stg=(bf16*)(shm+LDS_OST)+wid*2048;
    #pragma unroll
    for(int r=0;r<16;++r){const int orow=crow(r,hi);
      #pragma unroll
      for(int d0=0;d0<2;++d0)stg[orow*64+d0*32+r32]=__float2bfloat16(o[d0][r]*rli[r]);}
    asm volatile("s_waitcnt lgkmcnt(0)":::"memory");
    #pragma unroll
    for(int i=0;i<4;++i){const int row=i*8+(lane>>3),ch=lane&7; const u32x4 v=*(const u32x4*)(stg+row*64+ch*8); ATTN_STORE16(Ow+(long)row*OPITCH+ch*8,v);} }
  asm volatile("s_waitcnt lgkmcnt(0)\n\ts_barrier":::"memory");
  #undef DMA_K
  #undef DMA_V
  #undef BIASMASK
  #undef START
  #undef RESC
  #undef ROT
}
constexpr int ATTN_LDS_BYTES=LDS_BYTES;
struct AttnUnit { int bh; int qb; };
__device__ __forceinline__ void attn_phase(char*lds,const bf16*Q,const bf16*K,const bf16*V,bf16*O,const float*gtab,const float*gcinit,int grid,int block,int tid){
  const int vcu=(block%8)*(grid/8)+block/8, s_=vcu&3, bh=vcu>>2, h=bh&7, b=bh>>3;
  { const f32x4_t* src=(const f32x4_t*)(gtab+(size_t)h*(4*BT_COPY)); __attribute__((address_space(3))) f32x4_t* dst=(__attribute__((address_space(3))) f32x4_t*)((lds_cptr)lds+LDS_BT);
    if(tid<BT_BYTES/16)dst[tid]=src[tid]; }
  const float cinit=__builtin_bit_cast(float,__builtin_amdgcn_readfirstlane(__builtin_bit_cast(int,gcinit[h])));
  asm volatile("s_waitcnt vmcnt(0) lgkmcnt(0)\n\ts_barrier":::"memory");
  for(int i=0;i<4;++i){ const int qb=(i==0)?s_:(i==1)?7-s_:(i==2)?8+s_:15-s_; attn_unit(b,h,qb,Q,K,V,O,lds,cinit,tid); }
}
#undef SBAR
#undef WAIT_BAR
}

struct Args {
    const float *x, *p, *g_mix, *w_in, *b_in, *g_q, *g_k, *rel_bias, *conv_w, *conv_b, *w_pa, *w_pc, *w_o, *g_ffn, *w_group, *b_group, *w_router, *b_router, *w1, *w3, *w2, *g_ple, *w_pg, *b_pg, *w_pp;
    float* out; unsigned char* ws;
};
constexpr int NWAVES = 8, NTHREADS = 512;
constexpr int RING_BYTES = 131072, MISC_OFF = 139264, WSCR = 16640;
constexpr int LDS_BYTES = 163840; static_assert(META_HI + 2048 <= LDS_BYTES, "MoE metadata area");

__device__ __forceinline__ void transpose_item(const float* src, int ldw, bf16_t* dst, int ldT, LAS float* scr, int lane, const float* gain = nullptr, int hi_off = 0) {
    float v[64];
#pragma unroll
    for (int i = 0; i < 64; ++i) v[i] = src[(size_t)i * ldw + lane];
    if (gain) {
#pragma unroll
        for (int i = 0; i < 64; ++i) v[i] *= gain[i];
    }
#pragma unroll
    for (int i = 0; i < 64; ++i) scr[i * 65 + lane] = v[i];
    LDS_WAIT(); asm volatile("" ::: "memory");
    const int c = lane & 7;
#pragma unroll
    for (int j = 0; j < 8; ++j) { const int n = (lane >> 3) + 8 * j; const LAS float* s = scr + (8 * c) * 65 + n;
        u32x4 o; o.x = pk2(s[0 * 65], s[1 * 65]); o.y = pk2(s[2 * 65], s[3 * 65]); o.z = pk2(s[4 * 65], s[5 * 65]); o.w = pk2(s[6 * 65], s[7 * 65]);
        *(u32x4*)(dst + (size_t)(n + (n >= 32 ? hi_off : 0)) * ldT + 8 * c) = o; }
    LDS_WAIT(); asm volatile("" ::: "memory");
}
__device__ __forceinline__ void transpose_item_f8(const float* src, int ldw, unsigned char* dst, int ldTb, LAS float* scr, int lane, const float* gain, float sc) {
    float v[64];
#pragma unroll
    for (int i = 0; i < 64; ++i) v[i] = src[(size_t)i * ldw + lane];
#pragma unroll
    for (int i = 0; i < 64; ++i) scr[i * 65 + lane] = v[i] * (gain ? gain[i] : 1.0f) * sc;
    LDS_WAIT(); asm volatile("" ::: "memory");
    const int c = lane & 3;
#pragma unroll
    for (int j = 0; j < 4; ++j) { const int n = (lane >> 2) + 16 * j; const LAS float* s = scr + (16 * c) * 65 + n; unsigned w[4];
#pragma unroll
        for (int e = 0; e < 4; ++e) w[e] = pk4_fp8(s[(4 * e) * 65], s[(4 * e + 1) * 65], s[(4 * e + 2) * 65], s[(4 * e + 3) * 65]);
        *(u32x4*)(dst + (size_t)n * ldTb + 16 * c) = (u32x4){w[0], w[1], w[2], w[3]}; }
    LDS_WAIT(); asm volatile("" ::: "memory");
}
__device__ __forceinline__ void transpose_item_q8(const float* src, int ldw, signed char* dst, int ldTb, LAS float* scr, int lane, const float* gain, const float* cmax) {
    float v[64];
#pragma unroll
    for (int i = 0; i < 64; ++i) v[i] = src[(size_t)i * ldw + lane];
    const float sc = 127.0f / fmaxf(__builtin_bit_cast(float, __hip_atomic_load((const unsigned*)cmax + lane, __ATOMIC_RELAXED, __HIP_MEMORY_SCOPE_AGENT)), 1e-30f);
#pragma unroll
    for (int i = 0; i < 64; ++i) scr[i * 65 + lane] = v[i] * gain[i] * sc;
    LDS_WAIT(); asm volatile("" ::: "memory");
    const int c = lane & 3;
#pragma unroll
    for (int j = 0; j < 4; ++j) { const int n = (lane >> 2) + 16 * j; const LAS float* s = scr + (16 * c) * 65 + n; unsigned w[4];
#pragma unroll
        for (int e = 0; e < 4; ++e) { const int q0 = __float2int_rn(s[(4 * e) * 65]), q1 = __float2int_rn(s[(4 * e + 1) * 65]), q2 = __float2int_rn(s[(4 * e + 2) * 65]), q3 = __float2int_rn(s[(4 * e + 3) * 65]);
            w[e] = (unsigned)(q0 & 0xff) | ((unsigned)(q1 & 0xff) << 8) | ((unsigned)(q2 & 0xff) << 16) | ((unsigned)(q3 & 0xff) << 24); }
        *(u32x4*)(dst + (size_t)n * ldTb + 16 * c) = (u32x4){w[0], w[1], w[2], w[3]}; }
    LDS_WAIT(); asm volatile("" ::: "memory");
}
__device__ __forceinline__ void colmax_item(const float* src, int ldw, int lane, const float* gain, unsigned* cmax) {
    float v[64]; float m = 0.f;
#pragma unroll
    for (int i = 0; i < 64; ++i) v[i] = src[(size_t)i * ldw + lane];
#pragma unroll
    for (int i = 0; i < 64; ++i) m = fmaxf(m, fabsf(v[i] * gain[i]));
    atomicMax(cmax + lane, __builtin_bit_cast(unsigned, m));
}
__device__ __forceinline__ int win_phys_row(int n) { const int l = n & 255; return (n & ~255) | (((l >> 5) & 1) << 7) | (((l >> 6) & 3) << 5) | (l & 31); }

__device__ __forceinline__ void row2_to_bf16_rstd(const float* xrow, bf16_t* orow, float* rstd2, int lane, unsigned char* qrow = nullptr) {
    const f32x4* xr = (const f32x4*)xrow + lane;
    f32x4 v[2][4]; float s0 = 0.f, s1 = 0.f;
#pragma unroll
    for (int j = 0; j < 4; ++j) { v[0][j] = xr[64 * j]; v[1][j] = xr[256 + 64 * j]; }
    unsigned long long* o8 = (unsigned long long*)orow + lane;
#pragma unroll
    for (int j = 0; j < 4; ++j) { s0 += (v[0][j].x * v[0][j].x + v[0][j].y * v[0][j].y) + (v[0][j].z * v[0][j].z + v[0][j].w * v[0][j].w); s1 += (v[1][j].x * v[1][j].x + v[1][j].y * v[1][j].y) + (v[1][j].z * v[1][j].z + v[1][j].w * v[1][j].w);
        o8[64 * j] = (unsigned long long)pk2(v[0][j].x, v[0][j].y) | ((unsigned long long)pk2(v[0][j].z, v[0][j].w) << 32);
        o8[256 + 64 * j] = (unsigned long long)pk2(v[1][j].x, v[1][j].y) | ((unsigned long long)pk2(v[1][j].z, v[1][j].w) << 32);
        if (qrow) { ((unsigned*)qrow)[64 * j + lane] = pk4_fp8(v[0][j].x, v[0][j].y, v[0][j].z, v[0][j].w); ((unsigned*)qrow)[256 + 64 * j + lane] = pk4_fp8(v[1][j].x, v[1][j].y, v[1][j].z, v[1][j].w); } }
    s0 = wave_sum(s0); s1 = wave_sum(s1);
    if (lane == 0) { rstd2[0] = rsqrtf(s0 * (1.f / D) + EPS); rstd2[1] = rsqrtf(s1 * (1.f / D) + EPS); }
}


typedef __attribute__((address_space(4))) const Args* KArgPtr;
__device__ __forceinline__ KArgPtr kargs() { KArgPtr p = (KArgPtr)__builtin_amdgcn_kernarg_segment_ptr(); asm volatile("" : "+s"(p)); return p; }
#define ctl ((unsigned*)(ws + WS_CTL))
#define wrt ((float*)(ws + WS_TAB))
#define eslot ((int*)(ws + WS_ESLOT))
#define ew ((float*)(ws + WS_EW))
#define Win_t ((bf16_t*)(ws + WS_WIN))
#define Wm_t ((bf16_t*)(ws + WS_WM))
#define Wo_t ((bf16_t*)(ws + WS_WO))
#define Wgp8 ((unsigned char*)(ws + WS_WGP))
#define hp8 ((unsigned char*)(ws + WS_HP))
#define h2b ((bf16_t*)(ws + WS_H2B))
#define xb ((bf16_t*)(ws + WS_XB))
#define A1 ((bf16_t*)(ws + WS_A1))
#define B1 ((bf16_t*)(ws + WS_B1))
#define C1 ((bf16_t*)(ws + WS_C1))
#define sga ((bf16_t*)(ws + WS_SGA))
#define sgc ((bf16_t*)(ws + WS_SGC))
#define mbuf ((bf16_t*)(ws + WS_M))
#define h1b ((bf16_t*)(ws + WS_H1B))
#define rstdv ((float*)(ws + WS_RSTD))
#define W13_t ((bf16_t*)(ws + WS_W13))
#define W2_t ((bf16_t*)(ws + WS_W2))
#define xs ((bf16_t*)(ws + WS_XS))
#define hdn ((bf16_t*)(ws + WS_HDN))
#define contrib ((bf16_t*)(ws + WS_CONTRIB))
#define tile0 ((LAS float*)lds)
#define tile1 (tile0 + 64 * 65)
#define pref ((LAS int*)(lds + MISC_OFF))
#define cnts (pref + 64)
__global__ void __launch_bounds__(NTHREADS, 2) fwd_kernel(Args a) {
    extern __shared__ __attribute__((aligned(16))) unsigned char lds_raw[];
    cg::grid_group grid = cg::this_grid();
    LAS unsigned char* lds = (LAS unsigned char*)lds_raw;
    const int G = gridDim.x, bx = blockIdx.x;
    const int wave_s = __builtin_amdgcn_readfirstlane((int)threadIdx.x >> 6);
    volatile LAS unsigned* bst = (volatile LAS unsigned*)(lds + MISC_OFF + 512);
    if (threadIdx.x < 2) bst[threadIdx.x] = 0u;
    __syncthreads();
    const XcdBarrier bar = xcd_barrier_post((unsigned*)(a.ws + WS_CTL) + CW_BAR, bst);
#ifndef PROBE_A
#define PROBE_A -1
#endif
#ifndef PROBE_B
#define PROBE_B -1
#endif
#define STAMP(i) do { if (PROBE_A >= 0 && bx == 0) { int t_ = lane_id_fresh(); if (wave_s == 0 && t_ == 0) ((volatile LAS unsigned long long*)(lds + MISC_OFF + 1024))[i] = __builtin_amdgcn_s_memrealtime(); } } while (0)
#define XBAR() do { int t_ = (wave_s << 6) | lane_id_fresh(); xcd_barrier(bar, t_); } while (0)
    STAMP(0);
#define PHASE_VARS() const KArgPtr ap = kargs(); unsigned char* const ws = ap->ws; (void)ws; int tid = (wave_s << 6) | lane_id_fresh(); asm volatile("" : "+v"(tid)); const int lane = tid & 63, wave = __builtin_amdgcn_readfirstlane(tid >> 6); \
    const int gw = bx * NWAVES + wave, NGW = G * NWAVES; const size_t gtid = (size_t)bx * NTHREADS + tid, GT = (size_t)G * NTHREADS; (void)lane; (void)gw; (void)NGW; (void)gtid; (void)GT
    {
        PHASE_VARS();
        LAS float* scr = (LAS float*)(lds + wave * WSCR);
        constexpr int I_IN = 16 * 80, I_PA = 8 * 16, I_PC = 8 * 16, I_O = 16 * 16, I_PG = 16 * 16, I_PP = 4 * 16;
        constexpr int NIT = I_IN + I_PA + I_PC + I_O + I_PG + I_PP;
        for (int it = gw; it < NIT; it += NGW) {
            int r = it;
            if (r < I_IN) { const int kb_ = r / 80, nb = r % 80;
#if F8_GATES
                if (nb >= 48) { transpose_item_f8(ap->w_in + (size_t)(kb_ * 64) * NIN + nb * 64, NIN, (unsigned char*)(Win_t + (size_t)3072 * D) + (size_t)((nb - 48) * 64) * D + kb_ * 64, D, scr, lane, ap->g_mix + kb_ * 64, F8W); continue; }
#endif
                transpose_item(ap->w_in + (size_t)(kb_ * 64) * NIN + nb * 64, NIN, Win_t + (size_t)win_phys_row(nb * 64) * D + kb_ * 64, D, scr, lane, ap->g_mix + kb_ * 64, 96); continue; } r -= I_IN;
            if (r < I_PA) { const int kb_ = r / 16, nb = r % 16; transpose_item(ap->w_pa + (size_t)(kb_ * 64) * D + nb * 64, D, Wm_t + (size_t)(nb * 64) * D + kb_ * 64, D, scr, lane); continue; } r -= I_PA;
            if (r < I_PC) { const int kb_ = r / 16, nb = r % 16; transpose_item(ap->w_pc + (size_t)(kb_ * 64) * D + nb * 64, D, Wm_t + (size_t)(nb * 64) * D + 512 + kb_ * 64, D, scr, lane); continue; } r -= I_PC;
            if (r < I_O) { const int kb_ = r / 16, nb = r % 16; transpose_item(ap->w_o + (size_t)(kb_ * 64) * D + nb * 64, D, Wo_t + (size_t)(nb * 64) * D + kb_ * 64, D, scr, lane); continue; } r -= I_O;
            if (r < I_PG) { const int kb_ = r / 16, nb = r % 16; colmax_item(ap->w_pg + (size_t)(kb_ * 64) * D + nb * 64, D, lane, ap->g_ple + kb_ * 64, ctl + CW_CMAXP + nb * 64); continue; } r -= I_PG;
            { const int kb_ = r / 16, nb = r % 16; transpose_item(ap->w_pp + (size_t)(kb_ * 64) * D + nb * 64, D, (bf16_t*)Wgp8 + (size_t)(nb * 64) * HPE + 512 + kb_ * 64, HPE, scr, lane); }
        }
        const size_t rtid = (size_t)(G - 1 - bx) * NTHREADS + tid; const int rgw = (G - 1 - bx) * NWAVES + wave;
        for (size_t i = rtid; i < (size_t)3 * 32 * 64 * 8; i += GT) { const int j = (int)(i & 7), ln = (int)((i >> 3) & 63), s_ = (int)((i >> 9) & 31), nt = (int)(i >> 14);
            const int k = 32 * s_ + 8 * (ln >> 4) + j, col = 16 * nt + (ln & 15);
            wrt[i] = col < 4 ? ap->w_group[k * 4 + col] : (col < 36 ? ap->w_router[k * 32 + (col - 4)] : 0.f); }
        { float* gtab = (float*)(ws + WS_GTAB); float* gcinit = (float*)(ws + WS_GCINIT);
          for (size_t i = rtid; i < (size_t)NH * 4 * 384; i += GT) { const int h = (int)(i / 1536), s_ = (int)((i / 384) & 3), y = (int)(i % 384), x = y + s_;
              int dd = 319 - x; dd = dd < -63 ? -63 : (dd > 256 ? 256 : dd);
              gtab[i] = x <= 382 ? (ap->rel_bias[h * NREL + dd + 63] - ap->rel_bias[h * NREL + 319]) * LOG2E : 0.f; }
          if (rgw < NH) { const int h = rgw;
              float gq = fabsf(ap->g_q[lane]), gk = fabsf(ap->g_k[lane]), mb = -3.0e38f;
#pragma unroll
              for (int j = 0; j < 5; ++j) mb = fmaxf(mb, ap->rel_bias[h * NREL + lane + 64 * j]);
#pragma unroll
              for (int o = 1; o < 64; o <<= 1) { gq = fmaxf(gq, __shfl_xor(gq, o)); gk = fmaxf(gk, __shfl_xor(gk, o)); mb = fmaxf(mb, __shfl_xor(mb, o)); }
              if (lane == 0) gcinit[h] = ap->rel_bias[h * NREL + 319] * LOG2E - (64.f * C2 * gq * gk + mb * LOG2E); } }
        STAMP(12);
        for (int m = 2 * gw; m < T; m += 2 * NGW) row2_to_bf16_rstd(ap->x + (size_t)m * D, xb + (size_t)m * D, rstdv + m, lane, F8_GATES ? ws + WS_XQ + (size_t)m * D : nullptr);
    }
    if (G == 0x7fffff) grid.sync();
    XBAR();
    STAMP(1);

#if F8_GATES
    { PHASE_VARS(); pg8::Gemm g{xb, Win_t, T, 3072, D, D}; pg8::StaticOrder S; S.init(T, 3072, G, bx); EpiInproj E{ws, ap->b_in, ap->g_q, ap->g_k, rstdv};
      pg8::gemm_phase<EpiInproj, pg8::StaticOrder, true, true>(lds, g, S, E, tid); }
    { PHASE_VARS(); pg8::Gemm g{(const bf16_t*)(ws + WS_XQ), Win_t + (size_t)3072 * D, T, 2048, D / 2, D / 2}; StaticOrderId S; S.init(T, 2048, G, bx);
      EpiGateF8 E{(unsigned char*)sga, (unsigned char*)sgc, ap->b_in + 3072, rstdv};
      pg8::gemm_phase<EpiGateF8, StaticOrderId, true, true, 0, 3>(lds, g, S, E, tid); }
#else
    { PHASE_VARS(); pg8::Gemm g{xb, Win_t, T, NIN, D, D}; pg8::StaticOrder S; S.init(T, NIN, G, bx); EpiInproj E{ws, ap->b_in, ap->g_q, ap->g_k, rstdv};
      pg8::gemm_phase<EpiInproj, pg8::StaticOrder, true, true>(lds, g, S, E, tid); }
#endif
    XBAR();
    STAMP(2);

    {
        PHASE_VARS();
        for (size_t i = gtid; i < (size_t)T * (CW / 8); i += GT) {
            const int t = (int)(i >> 6), c8 = (int)(i & 63) * 8, s = t & (SEQ - 1);
            const size_t o = (size_t)t * D + c8;
            const u32x4 u0 = *(const u32x4*)(C1 + o), g0 = *(const u32x4*)(C1 + o + 512), b0 = *(const u32x4*)(A1 + o + 512);
            u32x4 u1 = {0u, 0u, 0u, 0u}, g1 = u1, u2 = u1, g2 = u1;
            if (s >= 1) { u1 = *(const u32x4*)(C1 + o - D); g1 = *(const u32x4*)(C1 + o + 512 - D); }
            if (s >= 2) { u2 = *(const u32x4*)(C1 + o - 2 * D); g2 = *(const u32x4*)(C1 + o + 512 - 2 * D); }
            float y[8];
#pragma unroll
            for (int e = 0; e < 4; ++e) {
#pragma unroll
                for (int hh = 0; hh < 2; ++hh) {
                    const int c = c8 + 2 * e + hh;
                    const float cu0 = hh ? bf_hi(u0[e]) * bf_hi(g0[e]) : bf_lo(u0[e]) * bf_lo(g0[e]);
                    const float cu1 = hh ? bf_hi(u1[e]) * bf_hi(g1[e]) : bf_lo(u1[e]) * bf_lo(g1[e]);
                    const float cu2 = hh ? bf_hi(u2[e]) * bf_hi(g2[e]) : bf_lo(u2[e]) * bf_lo(g2[e]);
                    const float bgv = hh ? bf_hi(b0[e]) : bf_lo(b0[e]);
                    y[2 * e + hh] = bgv * (ap->conv_b[c] + ap->conv_w[c] * cu2 + ap->conv_w[CW + c] * cu1 + ap->conv_w[2 * CW + c] * cu0);
                }
            }
            u32x4 w; w.x = pk2(y[0], y[1]); w.y = pk2(y[2], y[3]); w.z = pk2(y[4], y[5]); w.w = pk2(y[6], y[7]);
            *(u32x4*)(A1 + o + 512) = w;
        }
        __syncthreads();
        attn_body::attn_phase((char*)lds_raw, (const attn_body::bf16*)A1, (const attn_body::bf16*)B1, (const attn_body::bf16*)(B1 + 512), (attn_body::bf16*)A1, (const float*)(ws + WS_GTAB), (const float*)(ws + WS_GCINIT), G, bx, tid);
    }
    XBAR();
    STAMP(3);

    { PHASE_VARS(); pg8::Gemm g{A1, Wm_t, T, D, D, D}; pg8::PairOrder S; S.init(T, D, G, bx); EpiMerge2 E{(const unsigned char*)sga, (const unsigned char*)sgc, mbuf};
      pg8::gemm_phase<EpiMerge2, pg8::PairOrder, true, true>(lds, g, S, E, tid); }
    XBAR();
    STAMP(4);

    { PHASE_VARS(); pg8::Gemm g{mbuf, Wo_t, T, D, D, D}; pg8::StaticOrder S; S.init(T, D, G, bx); EpiResBf16 E{xb, h1b, F8_MOE ? (unsigned char*)(ws + WS_H1F8) : (unsigned char*)nullptr};
      pg8::gemm_phase<EpiResBf16, pg8::StaticOrder, true, true>(lds, g, S, E, tid); }
    XBAR();
    STAMP(5);

    {
        PHASE_VARS();
        {
            LAS int* lcnt = (LAS int*)(lds + MISC_OFF + 2048); LAS int* lbase = lcnt + 32;
            if (tid < 32) lcnt[tid] = 0;
            __syncthreads();
            int ea = 0, eb = 0, ra = 0, rb = 0; float wa = 0.f, wb = 0.f;
            LAS float* lsc = (LAS float*)(lds + wave * WSCR);
            const int r = lane & 15, q = lane >> 4;
            for (int task = gw; task < T / 16; task += NGW) {
                const int row0 = task * 16;
                const GAS bf16_t* arow = (const GAS bf16_t*)h1b + (size_t)(row0 + r) * D + 8 * q;
                const GAS float* gp = (const GAS float*)ap->g_ffn + 8 * q;
                const GAS f32x4* bp = (const GAS f32x4*)wrt + 2 * lane;
                f32x4 acc0 = {0.f, 0.f, 0.f, 0.f}, acc1 = acc0, acc2 = acc0; float ss = 0.f;
                u32x4 acur[8], anxt[8]; f32x4 bc[2][3][2], bn[2][3][2];
#pragma unroll
                for (int i = 0; i < 8; ++i) acur[i] = *(const GAS u32x4*)(arow + 32 * i);
#pragma unroll
                for (int st = 0; st < 2; ++st)
#pragma unroll
                    for (int nt = 0; nt < 3; ++nt) { bc[st][nt][0] = bp[(nt * 32 + st) * 128]; bc[st][nt][1] = bp[(nt * 32 + st) * 128 + 1]; }
#pragma unroll 1
                for (int ch = 0; ch < 4; ++ch) {
                    const int chn = ch < 3 ? ch + 1 : 3;
#pragma unroll
                    for (int i = 0; i < 8; ++i) anxt[i] = *(const GAS u32x4*)(arow + 32 * (8 * chn + i));
#pragma unroll
                    for (int gq = 0; gq < 4; ++gq) {
                        const int s0 = 8 * ch + 2 * gq, sn = (s0 + 2 < 32) ? s0 + 2 : 30;
#pragma unroll
                        for (int st = 0; st < 2; ++st)
#pragma unroll
                            for (int nt = 0; nt < 3; ++nt) { bn[st][nt][0] = bp[(nt * 32 + sn + st) * 128]; bn[st][nt][1] = bp[(nt * 32 + sn + st) * 128 + 1]; }
#pragma unroll
                        for (int st = 0; st < 2; ++st) {
                            const int s_ = s0 + st;
                            const u32x4 aw = acur[2 * gq + st]; const f32x4 g0 = *(const GAS f32x4*)(gp + 32 * s_), g1 = *(const GAS f32x4*)(gp + 32 * s_ + 4);
                            float av[8] = {bf_lo(aw.x), bf_hi(aw.x), bf_lo(aw.y), bf_hi(aw.y), bf_lo(aw.z), bf_hi(aw.z), bf_lo(aw.w), bf_hi(aw.w)};
#pragma unroll
                            for (int j = 0; j < 8; ++j) { ss += av[j] * av[j]; av[j] *= (j < 4 ? g0[j & 3] : g1[j & 3]); }
#pragma unroll
                            for (int j = 0; j < 8; ++j) {
                                acc0 = __builtin_amdgcn_mfma_f32_16x16x4f32(av[j], bc[st][0][j >> 2][j & 3], acc0, 0, 0, 0);
                                acc1 = __builtin_amdgcn_mfma_f32_16x16x4f32(av[j], bc[st][1][j >> 2][j & 3], acc1, 0, 0, 0);
                                acc2 = __builtin_amdgcn_mfma_f32_16x16x4f32(av[j], bc[st][2][j >> 2][j & 3], acc2, 0, 0, 0);
                            }
                        }
#pragma unroll
                        for (int st = 0; st < 2; ++st)
#pragma unroll
                            for (int nt = 0; nt < 3; ++nt) { bc[st][nt][0] = bn[st][nt][0]; bc[st][nt][1] = bn[st][nt][1]; }
                        asm volatile("" ::: "memory");
                    }
#pragma unroll
                    for (int i = 0; i < 8; ++i) acur[i] = anxt[i];
                }
                ss += __shfl_xor(ss, 16); ss += __shfl_xor(ss, 32);
                const float rstd = rsqrtf(ss * (1.f / D) + EPS);
#pragma unroll
                for (int g_ = 0; g_ < 4; ++g_) { const float rs = __shfl(rstd, 4 * q + g_);
                    lsc[(4 * q + g_) * 48 + r] = acc0[g_] * rs; lsc[(4 * q + g_) * 48 + 16 + r] = acc1[g_] * rs; lsc[(4 * q + g_) * 48 + 32 + r] = acc2[g_] * rs; }
                LDS_WAIT(); asm volatile("" ::: "memory");
                if (lane < 16) {
                    const int m = row0 + lane; float lg[36];
#pragma unroll
                    for (int c = 0; c < 36; ++c) lg[c] = lsc[lane * 48 + c];
                    float gl[4];
#pragma unroll
                    for (int c = 0; c < 4; ++c) gl[c] = lg[c] + ap->b_group[c];
                    int grp = 0; float gmax = gl[0];
#pragma unroll
                    for (int c = 1; c < 4; ++c) if (gl[c] > gmax) { gmax = gl[c]; grp = c; }
                    float gs = 0.f;
#pragma unroll
                    for (int c = 0; c < 4; ++c) gs += __expf(gl[c] - gmax);
                    const float pgrp = 1.f / gs;
                    float el[8];
#pragma unroll
                    for (int c = 0; c < 8; ++c) { const float x0 = lg[4 + c], x1 = lg[12 + c], x2 = lg[20 + c], x3 = lg[28 + c]; el[c] = (grp == 0 ? x0 : grp == 1 ? x1 : grp == 2 ? x2 : x3) + ap->b_router[grp * 8 + c]; }
                    int i0 = 0; float l0 = el[0];
#pragma unroll
                    for (int c = 1; c < 8; ++c) if (el[c] > l0) { l0 = el[c]; i0 = c; }
                    int i1 = -1; float l1 = -3.0e38f;
#pragma unroll
                    for (int c = 0; c < 8; ++c) if (c != i0 && el[c] > l1) { l1 = el[c]; i1 = c; }
                    if (i1 < 0) i1 = i0 ? 0 : 1;
                    const float e1 = __expf(l1 - l0), w0 = pgrp / (1.f + e1), w1 = pgrp * e1 / (1.f + e1);
                    ea = grp * 8 + i0; eb = grp * 8 + i1;
                    ra = (int)__hip_atomic_fetch_add(&lcnt[ea], 1, __ATOMIC_RELAXED, __HIP_MEMORY_SCOPE_WORKGROUP); rb = (int)__hip_atomic_fetch_add(&lcnt[eb], 1, __ATOMIC_RELAXED, __HIP_MEMORY_SCOPE_WORKGROUP);
                    wa = w0; wb = w1;
                    rstdv[m] = rstd;
                }
                LDS_WAIT(); asm volatile("" ::: "memory");
            }
            __syncthreads();
            if (tid < 32) lbase[tid] = (int)atomicAdd(&ctl[tid * CNT_STRIDE], (unsigned)lcnt[tid]);
            __syncthreads();
            if (lane < 16) { const int m = gw * 16 + lane; const int ia = (ea << 15) | (lbase[ea] + ra), ib = (eb << 15) | (lbase[eb] + rb);
                eslot[ia] = 2 * m; ew[ia] = wa; eslot[ib] = 2 * m + 1; ew[ib] = wb; }
        }
        STAMP(11);
        LAS float* scr = (LAS float*)(lds + wave * WSCR);
        constexpr int I_13 = 16 * 8, PER_E = 2 * I_13;
        for (int it = gw; it < NE * PER_E; it += NGW) {
            const int e = it / PER_E; int r = it % PER_E;
            const int which = r / I_13; r %= I_13; const int kb_ = r / 8, nb = r % 8, j0 = nb * 64;
            const float* src = (which ? ap->w3 : ap->w1) + (size_t)e * D * DE + (size_t)(kb_ * 64) * DE + j0;
#if F8_MOE
            transpose_item_f8(src, DE, (unsigned char*)W13_t + (size_t)(e * 1024 + (j0 >> 7) * 256 + which * 128 + (j0 & 127)) * D + kb_ * 64, D, scr, lane, ap->g_ffn + kb_ * 64, F8W);
#else
            transpose_item(src, DE, W13_t + (size_t)(e * 1024 + (j0 >> 7) * 256 + which * 128 + (j0 & 127)) * D + kb_ * 64, D, scr, lane, ap->g_ffn + kb_ * 64);
#endif
        }
    }
    XBAR();
    STAMP(6);

    {
        PHASE_VARS();
        if (tid < NE) cnts[tid] = (int)__hip_atomic_load(&ctl[tid * CNT_STRIDE], __ATOMIC_RELAXED, __HIP_MEMORY_SCOPE_AGENT);
        __syncthreads();
        if (tid == 0) { int acc_ = 0; for (int e = 0; e < NE; ++e) { pref[e] = acc_; acc_ += (cnts[e] + 255) >> 8; } pref[NE] = acc_; }
        __syncthreads();
    }
    STAMP(7);
    const int ntiles = __builtin_amdgcn_readfirstlane(pref[NE]);

#if F8_MOE
    { PHASE_VARS(); pg8::Gemm g{(const bf16_t*)(ws + WS_H1F8), W13_t, XS_ROWS, NE * 1024, D / 2, D / 2}; moe_meta_preload(lds, pref, ntiles * 4, G, bx, eslot, rstdv, true, tid); MoeOrderT<true> S{pref, ntiles * 4, G, bx, lds}; EpiSwigluT<1> E{hdn, lds};
      pg8::gemm_phase<EpiSwigluT<1>, MoeOrderT<true>, true, true, 0, 3>(lds, g, S, E, tid); }
#else
    { PHASE_VARS(); pg8::Gemm g{h1b, W13_t, XS_ROWS, NE * 1024, D, D}; moe_meta_preload(lds, pref, ntiles * 4, G, bx, eslot, rstdv, true, tid); MoeOrderT<true> S{pref, ntiles * 4, G, bx, lds}; EpiSwigluT<0> E{hdn, lds};
      pg8::gemm_phase<EpiSwigluT<0>, MoeOrderT<true>, true, true>(lds, g, S, E, tid); }
#endif
    { PHASE_VARS();
      { const int nun = ntiles * 4, rem = nun % G, nf = rem ? G - rem : G, fb = rem ? bx - rem : bx;
        if (fb >= 0) {
            LAS float* scr = (LAS float*)(lds + wave * WSCR);
            for (int it = fb * NWAVES + wave; it < NE * 128; it += nf * NWAVES) { const int e = it >> 7, r = it & 127, kb_ = r / 16, nb = r % 16;
#if F8_MOE && F8_DOWN
                transpose_item_f8(ap->w2 + (size_t)e * DE * D + (size_t)(kb_ * 64) * D + nb * 64, D, (unsigned char*)W2_t + (size_t)(e * 1024 + nb * 64) * DE + kb_ * 64, DE, scr, lane, nullptr, F8W); }
#else
                transpose_item(ap->w2 + (size_t)e * DE * D + (size_t)(kb_ * 64) * D + nb * 64, D, W2_t + (size_t)(e * 1024 + nb * 64) * DE + kb_ * 64, DE, scr, lane); }
#endif
            for (size_t i = (size_t)fb * NTHREADS + tid; i < 1024; i += (size_t)nf * NTHREADS) ((float*)(ws + WS_CMAXF))[i] = __builtin_bit_cast(float, __hip_atomic_load(ctl + CW_CMAXP + i, __ATOMIC_RELAXED, __HIP_MEMORY_SCOPE_AGENT));
            for (int it = fb * NWAVES + wave; it < 16 * 16; it += nf * NWAVES) { const int kb_ = it / 16, nb = it % 16;
                transpose_item_q8(ap->w_pg + (size_t)(kb_ * 64) * D + nb * 64, D, (signed char*)Wgp8 + (size_t)(nb * 64) * HPB + kb_ * 64, HPB, scr, lane, ap->g_ple + kb_ * 64, (const float*)(ctl + CW_CMAXP) + nb * 64); }
            for (size_t i = (size_t)fb * NTHREADS + tid; i < (size_t)T * PLE / 8; i += (size_t)nf * NTHREADS) { const f32x4 v0 = ((const f32x4*)ap->p)[2 * i], v1 = ((const f32x4*)ap->p)[2 * i + 1];
                u32x4 o; o.x = pk2(v0.x, v0.y); o.y = pk2(v0.z, v0.w); o.z = pk2(v1.x, v1.y); o.w = pk2(v1.z, v1.w); *(u32x4*)(hp8 + (i >> 5) * HPB + 1024 + (i & 31) * 16) = o; }
        } } }
    XBAR();
    STAMP(8);

#if F8_MOE && F8_DOWN
    { PHASE_VARS(); pg8::Gemm g{hdn, W2_t, XS_ROWS, NE * 1024, DE / 2, DE / 2}; moe_meta_preload(lds, pref, ntiles * 4, G, bx, eslot, ew, false, tid); MoeOrderId S{{pref, ntiles * 4, G, bx, lds}}; EpiDownT<1> E{contrib, lds};
      pg8::gemm_phase<EpiDownT<1>, MoeOrderId, true, true, 0, 3>(lds, g, S, E, tid); }
#else
    { PHASE_VARS(); pg8::Gemm g{hdn, W2_t, XS_ROWS, NE * 1024, DE, DE}; moe_meta_preload(lds, pref, ntiles * 4, G, bx, eslot, ew, false, tid); MoeOrderT<false> S{pref, ntiles * 4, G, bx, lds}; EpiDownT<0> E{contrib, lds};
      pg8::gemm_phase<EpiDownT<0>, MoeOrderT<false>, true, true>(lds, g, S, E, tid); }
#endif
    XBAR();
    STAMP(9);

    { PHASE_VARS();
    for (int m0 = 2 * gw; m0 < T; m0 += 2 * NGW) {
#if F8_CONTRIB
        u32x2 hv[2][4]; unsigned p0[2][4], p1[2][4];
#pragma unroll
        for (int rr = 0; rr < 2; ++rr) { const int m = m0 + rr;
            const u32x2* xr = (const u32x2*)(h1b + (size_t)m * D) + lane;
            const unsigned* c0 = (const unsigned*)((const unsigned char*)contrib + (size_t)(2 * m) * D) + lane; const unsigned* c1 = (const unsigned*)((const unsigned char*)contrib + (size_t)(2 * m + 1) * D) + lane;
#pragma unroll
            for (int j = 0; j < 4; ++j) { hv[rr][j] = xr[64 * j]; p0[rr][j] = c0[64 * j]; p1[rr][j] = c1[64 * j]; } }
#else
        u32x2 hv[2][4], p0[2][4], p1[2][4];
#pragma unroll
        for (int rr = 0; rr < 2; ++rr) { const int m = m0 + rr;
            const u32x2* xr = (const u32x2*)(h1b + (size_t)m * D) + lane;
            const u32x2* c0 = (const u32x2*)(contrib + (size_t)(2 * m) * D) + lane; const u32x2* c1 = (const u32x2*)(contrib + (size_t)(2 * m + 1) * D) + lane;
#pragma unroll
            for (int j = 0; j < 4; ++j) { hv[rr][j] = xr[64 * j]; p0[rr][j] = c0[64 * j]; p1[rr][j] = c1[64 * j]; } }
#endif
#pragma unroll
        for (int rr = 0; rr < 2; ++rr) { const int m = m0 + rr; float s = 0.f, am = 0.f; f32x4 h[4];
            unsigned long long* o8 = (unsigned long long*)(h2b + (size_t)m * D) + lane;
#pragma unroll
            for (int j = 0; j < 4; ++j) {
#if F8_CONTRIB
                { const f32x2 a0 = __builtin_amdgcn_cvt_pk_f32_fp8((int)p0[rr][j], false), a1 = __builtin_amdgcn_cvt_pk_f32_fp8((int)p0[rr][j], true), b0 = __builtin_amdgcn_cvt_pk_f32_fp8((int)p1[rr][j], false), b1 = __builtin_amdgcn_cvt_pk_f32_fp8((int)p1[rr][j], true);
                  constexpr float k = 1.0f / CSC;
                  h[j].x = bf_lo(hv[rr][j].x) + (a0[0] + b0[0]) * k; h[j].y = bf_hi(hv[rr][j].x) + (a0[1] + b0[1]) * k; h[j].z = bf_lo(hv[rr][j].y) + (a1[0] + b1[0]) * k; h[j].w = bf_hi(hv[rr][j].y) + (a1[1] + b1[1]) * k; }
#else
                h[j].x = bf_lo(hv[rr][j].x) + bf_lo(p0[rr][j].x) + bf_lo(p1[rr][j].x); h[j].y = bf_hi(hv[rr][j].x) + bf_hi(p0[rr][j].x) + bf_hi(p1[rr][j].x);
                h[j].z = bf_lo(hv[rr][j].y) + bf_lo(p0[rr][j].y) + bf_lo(p1[rr][j].y); h[j].w = bf_hi(hv[rr][j].y) + bf_hi(p0[rr][j].y) + bf_hi(p1[rr][j].y);
#endif
                s += (h[j].x * h[j].x + h[j].y * h[j].y) + (h[j].z * h[j].z + h[j].w * h[j].w);
                am = fmaxf(fmaxf(am, fmaxf(fabsf(h[j].x), fabsf(h[j].y))), fmaxf(fabsf(h[j].z), fabsf(h[j].w)));
                o8[64 * j] = (unsigned long long)pk2(h[j].x, h[j].y) | ((unsigned long long)pk2(h[j].z, h[j].w) << 32); }
            s = wave_sum(s);
#pragma unroll
            for (int o = 1; o < 64; o <<= 1) am = fmaxf(am, __shfl_xor(am, o));
            const float qs = 127.0f / fmaxf(am, 1e-30f);
            unsigned* q4 = (unsigned*)(hp8 + (size_t)m * HPB) + lane;
#pragma unroll
            for (int j = 0; j < 4; ++j) { const int q0 = __float2int_rn(h[j].x * qs), q1 = __float2int_rn(h[j].y * qs), q2 = __float2int_rn(h[j].z * qs), q3 = __float2int_rn(h[j].w * qs);
                q4[64 * j] = (unsigned)(q0 & 0xff) | ((unsigned)(q1 & 0xff) << 8) | ((unsigned)(q2 & 0xff) << 16) | ((unsigned)(q3 & 0xff) << 24); }
            if (lane == 0) rstdv[m] = rsqrtf(s * (1.f / D) + EPS) * am * (1.0f / 127.0f); }
    } }
    XBAR();
    STAMP(10);

    { PHASE_VARS(); pg8::Gemm g{(const bf16_t*)hp8, (const bf16_t*)Wgp8, T, 2 * D, HPE, HPE}; pg8::StaticOrder S; S.init(T, 2 * D, G, bx);
      EpiGateDual E{h2b, rstdv, (const float*)(ws + WS_CMAXF), ap->b_pg, ap->out};
      pg8::gemm_phase<EpiGateDual, pg8::StaticOrder, true, true, 8, 2>(lds, g, S, E, tid); }
    STAMP(15);
    if (PROBE_A >= 0 && bx == 0) { int t_ = lane_id_fresh(); if (wave_s == 0 && t_ == 0) { volatile LAS unsigned long long* ts = (volatile LAS unsigned long long*)(lds + MISC_OFF + 1024);
        const unsigned long long d = 4ull * (ts[PROBE_B] - ts[PROBE_A]), t0 = __builtin_amdgcn_s_memrealtime(); while (__builtin_amdgcn_s_memrealtime() - t0 < d) __builtin_amdgcn_s_sleep(8); } }
}

extern "C" void kernel_launch(void* const* d_in, const int* in_sizes, int n_in, void* d_out, int out_size, void* d_ws, size_t ws_size, hipStream_t stream) {
    static int grid = 0;
    if (grid == 0) {
        if (n_in != 25 || out_size != T * D || ws_size < WS_END) { fprintf(stderr, "kernel_launch: unexpected shapes (n_in %d out %d ws %zu); nothing launched\n", n_in, out_size, ws_size); grid = -1; return; }
        int dev = 0, cus = 0, per_cu = 0;
        if (hipGetDevice(&dev) != hipSuccess || hipDeviceGetAttribute(&cus, hipDeviceAttributeMultiprocessorCount, dev) != hipSuccess) { grid = -1; return; }
        if (hipFuncSetAttribute((const void*)fwd_kernel, hipFuncAttributeMaxDynamicSharedMemorySize, LDS_BYTES) != hipSuccess) { fprintf(stderr, "kernel_launch: hipFuncSetAttribute failed\n"); grid = -1; return; }
        if (hipOccupancyMaxActiveBlocksPerMultiprocessor(&per_cu, (const void*)fwd_kernel, NTHREADS, LDS_BYTES) != hipSuccess || per_cu < 1) { fprintf(stderr, "kernel_launch: occupancy query says %d\n", per_cu); (void)hipGetLastError(); grid = -1; return; }
        if (cus != 256) { fprintf(stderr, "kernel_launch: built for a 256-CU device (got %d)\n", cus); grid = -1; return; }
        grid = cus;
    }
    if (grid < 0) return;
    if (hipMemsetAsync((char*)d_ws + WS_CTL, 0, CTL_ZERO_BYTES, stream) != hipSuccess) { fprintf(stderr, "kernel_launch: memset failed\n"); return; }
    Args a{};
    const float** f = (const float**)&a;
    for (int i = 0; i < 25; ++i) f[i] = (const float*)d_in[i];
    a.out = (float*)d_out; a.ws = (unsigned char*)d_ws;
    void* args[] = {&a};
    hipError_t e = hipLaunchCooperativeKernel((const void*)fwd_kernel, dim3(grid), dim3(NTHREADS), args, LDS_BYTES, stream);
    if (e != hipSuccess) fprintf(stderr, "kernel_launch: cooperative launch failed: %s (grid %d)\n", hipGetErrorString(e), grid);
}
```

```cpp
#include <hip/hip_runtime.h>
#include <hip/hip_cooperative_groups.h>
#include <cstdio>
#include <cstdint>
namespace cg = cooperative_groups;

#define GAS __attribute__((address_space(1)))
#define LAS __attribute__((address_space(3)))
typedef unsigned short bf16_t;
typedef short bf16x8 __attribute__((ext_vector_type(8)));
typedef float f32x4 __attribute__((ext_vector_type(4)));
typedef float f32x2 __attribute__((ext_vector_type(2)));
typedef unsigned u32x4 __attribute__((ext_vector_type(4)));
typedef unsigned u32x2 __attribute__((ext_vector_type(2)));
typedef int i32x4 __attribute__((ext_vector_type(4)));
typedef int i32x8 __attribute__((ext_vector_type(8)));
typedef GAS unsigned gu32;
#define RLX_AGENT __ATOMIC_RELAXED, __HIP_MEMORY_SCOPE_AGENT

constexpr int T = 32768, D = 1024, SEQ = 4096, NBATCH = 8;
constexpr int NIN = 5120, NH = 8, HD = 64, AW = 512, CW = 512;
constexpr int NE = 32, DE = 512, PLE = 256, NREL = 320;
constexpr int XS_ROWS = 65536 + NE * 256;
constexpr float EPS = 1e-6f;
constexpr float LOG2E = 1.4426950408889634f;
constexpr float C2 = 0.125f * LOG2E;

#ifndef F8_MOE
#define F8_MOE 1
#endif
#ifndef F8_GATES
#define F8_GATES 1
#endif
#ifndef CU_PAIR
#define CU_PAIR 1
#endif
#ifndef F8_CONTRIB
#define F8_CONTRIB 1
#endif
constexpr float CSC = 16.0f;
#ifndef F8_DOWN
#define F8_DOWN 1
#endif
constexpr float F8W = 32.0f;
constexpr size_t MiB = 1u << 20;
constexpr size_t WS_CTL = 0, CTL_ZERO_BYTES = 64 * 1024;
constexpr int CW_BAR = 4096, CNT_STRIDE = 64;
constexpr size_t WS_TAB = 1 * MiB;
constexpr size_t WS_GTAB = WS_TAB + 192 * 1024;
constexpr size_t WS_GCINIT = WS_GTAB + 8 * 4 * 384 * 4;
constexpr size_t WS_ROUTE = 2 * MiB;
constexpr size_t WS_CMAXF = 3 * MiB + 512 * 1024;
constexpr size_t WS_RSTD = 3 * MiB;
constexpr size_t WS_ROWMETA = 4 * MiB;
constexpr size_t WS_WIN = 6 * MiB;
constexpr size_t WS_WM = 16 * MiB;
constexpr size_t WS_WO = 18 * MiB;
constexpr size_t WS_WGP = 20 * MiB;
constexpr int HPB = 1536, HPE = HPB / 2;
constexpr size_t WS_HP = 24 * MiB;
constexpr size_t WS_H2B = 232 * MiB;
constexpr int CW_CMAXP = 14336;
constexpr int META_LO = 147456, META_HI = 147456 + 4 * 2048;
constexpr size_t WS_ESLOT = 72 * MiB, WS_EW = 76 * MiB;
constexpr size_t WS_XQ = 24 * MiB;
constexpr size_t WS_XB = 104 * MiB;
constexpr size_t WS_A1 = 168 * MiB;
constexpr size_t WS_B1 = 232 * MiB;
constexpr size_t WS_C1 = 296 * MiB;
constexpr size_t WS_SGA = 360 * MiB, WS_SGC = 424 * MiB;
constexpr size_t WS_M = WS_B1;
constexpr size_t WS_H1F8 = WS_A1;
constexpr size_t WS_H1B = WS_SGC;
constexpr size_t WS_W13 = WS_SGA;
constexpr size_t WS_W2 = 320 * MiB;
constexpr size_t WS_XS = 104 * MiB;
constexpr size_t WS_HDN = 248 * MiB;
constexpr size_t WS_CONTRIB = 104 * MiB;
constexpr size_t WS_END = 488 * MiB;

__device__ __forceinline__ unsigned f2bf(float f) { unsigned u = __builtin_bit_cast(unsigned, f); return (u + 0x7fffu + ((u >> 16) & 1u)) >> 16; }
__device__ __forceinline__ unsigned pk2(float lo, float hi) { return f2bf(lo) | (f2bf(hi) << 16); }
__device__ __forceinline__ float bf_lo(unsigned w) { return __builtin_bit_cast(float, w << 16); }
__device__ __forceinline__ float bf_hi(unsigned w) { return __builtin_bit_cast(float, w & 0xffff0000u); }
__device__ __forceinline__ float bf2f(bf16_t h) { return __builtin_bit_cast(float, (unsigned)h << 16); }
__device__ __forceinline__ float sigmoidf_(float x) { return __builtin_amdgcn_rcpf(1.0f + __builtin_amdgcn_exp2f(-LOG2E * x)); }
__device__ __forceinline__ float wave_sum(float v) {
#pragma unroll
    for (int o = 1; o < 64; o <<= 1) v += __shfl_xor(v, o);
    return v;
}
__device__ __forceinline__ int lane_id_fresh() { int l; asm volatile("v_mbcnt_lo_u32_b32 %0, -1, 0\n\tv_mbcnt_hi_u32_b32 %0, -1, %0" : "=v"(l)); return l; }
__device__ __forceinline__ unsigned pk4_fp8(float a, float b, float c, float d) { unsigned w = (unsigned)__builtin_amdgcn_cvt_pk_fp8_f32(a, b, 0, false); return (unsigned)__builtin_amdgcn_cvt_pk_fp8_f32(c, d, (int)w, true); }
#define LDS_WAIT() asm volatile("s_waitcnt lgkmcnt(0)" ::: "memory")
#define VM_WAIT() asm volatile("s_waitcnt vmcnt(0)" ::: "memory")

namespace pg8 {
#define PG8_LAS __attribute__((address_space(3)))
constexpr int BM = 256, BK = 64, HALF = 128, HTB = HALF * BK * 2  , STAGE_BYTES = 8 * HTB, NXCD = 8, WGM = 8;

__host__ __device__ __forceinline__ int lds_byte(int r, int c) { const int st = (r >> 4) * 2 + (c >> 5), rr = r & 15, cc = c & 31, ob = rr * 64 + cc * 2; return st * 1024 + (ob ^ (((ob >> 9) & 1) << 5)); }
__host__ __device__ __forceinline__ void stage_rc(int b, int& R, int& C) { const int st = b / 1024, sb = b % 1024, swz = sb ^ (((sb >> 9) & 1) << 5); R = (st >> 1) * 16 + swz / 64; C = (st & 1) * 32 + (swz % 64) / 2; }
__host__ __device__ __forceinline__ int perm32(int rho) { const int n = rho >> 4, i = rho & 15; return 8 * (i >> 2) + 4 * n + (i & 3); }

struct Unit { int pm, pn, part; };
struct Gemm { const bf16_t* A; const bf16_t* Bt; int M, N, K, ld; };

struct StaticOrder {
    int nM, nN, nwg, G, c;
    __host__ __device__ void init(int M, int N, int G_, int c_) { nM = M / BM; nN = N / BM; nwg = nM * nN; G = G_; c = c_; }
    __host__ __device__ bool next(int i, Unit& u) const {
        const long L = (long)i * G + c; if (L >= nwg) return false;
        int wgid = (int)L; { const int q = nwg / NXCD, r = nwg % NXCD, xcd = wgid % NXCD, off = wgid / NXCD; wgid = (xcd < r ? xcd * (q + 1) : r * (q + 1) + (xcd - r) * q) + off; }
        const int nig = WGM * nN, gid = wgid / nig, fm = gid * WGM, gsz = (nM - fm) < WGM ? (nM - fm) : WGM;
        u.pm = fm + ((wgid % nig) % gsz); u.pn = (wgid % nig) / gsz; u.part = 0; return true;
    }
    static constexpr bool GATHER = false;
    __device__ __forceinline__ int row_of(const Unit&, int) const { return 0; }
    __device__ __forceinline__ void a_ready(const Unit&) const {}
    __device__ __forceinline__ void done(const Unit&) const {}
};
struct PairOrder : StaticOrder {
    __host__ __device__ bool next(int i, Unit& u) const { if (!StaticOrder::next(i >> 1, u)) return false; u.part = i & 1; return true; }
};
__device__ __forceinline__ unsigned cvt_pk_bf16(float lo, float hi) { unsigned r; asm volatile("v_cvt_pk_bf16_f32 %0, %1, %2" : "=v"(r) : "v"(lo), "v"(hi)); return r; }

template <class Epi> __device__ __forceinline__ size_t koff_of(const Epi& E, const Unit& u) { if constexpr (Epi::MULTI) return (size_t)E.kt0(u.part) * (size_t)(BK * 2); else return (size_t)0; }
template <class Epi, class Sched, bool ALIGN_EPI = false, bool SP2 = false, int DUAL_T = 0, int I8MODE = 0>
__device__ __forceinline__ void gemm_phase(PG8_LAS unsigned char* lds, const Gemm g, const Sched& S, const Epi& E, int tid_) {
    asm volatile("" : "+v"(tid_));
    const int tid = tid_, wid = __builtin_amdgcn_readfirstlane(tid >> 6), lane = tid & 63, wr = wid >> 2, wc = wid & 3, fr = lane & 15, fq = lane >> 4;
    int K = g.K; asm volatile("" : "+s"(K));
    int nt = K / BK; const int LD = g.ld;
#define PG8_KOFF(u) koff_of(E, u)
    constexpr bool GATHER = Sched::GATHER; static_assert(!GATHER || SP2, "GATHER is written for the SP2 loop");
    unsigned voffA[2], voffA1[2], voffB[2]; int gR[2], gC[2];
#pragma unroll
    for (int i = 0; i < 2; ++i) { int R, C; stage_rc(tid * 16 + i * 8192, R, C); const int Rb = Epi::PERM ? ((R & ~31) + perm32(R & 31)) : R; gR[i] = R; gC[i] = C;
        voffA[i] = (unsigned)(R * LD + C) * 2u; voffA1[i] = 0u; voffB[i] = (unsigned)(Rb * LD + C) * 2u; }
#define PG8_GOFF(slot, i) ((unsigned)((((slot) < 0 ? 0 : (slot)) >> 1) * LD + gC[i]) * 2u)
    const size_t kstep = (size_t)(BK * 2);
    const size_t hstep = (size_t)HALF * LD * 2;
    const size_t tstep = 2 * hstep;
    const size_t hstepB = DUAL_T ? 0 : hstep, tstepB = DUAL_T ? hstep : tstep;
    const unsigned ldsw = (unsigned)wid * 1024u;
    const int aoff = lds_byte(wr * 64 + fr, fq * 8), boff = lds_byte(wc * 32 + fr, fq * 8);
#define PG8_SA(b, h) (((b) * 2 + (h)) * HTB)
#define PG8_SB(b, h) ((4 + (b) * 2 + (h)) * HTB)
#define PG8_STAGE(bufoff, gbase, voff) do { _Pragma("unroll") for (int _i = 0; _i < 2; ++_i) \
        __builtin_amdgcn_global_load_lds((const unsigned*)((const char*)(gbase) + (voff)[_i]), (PG8_LAS unsigned*)(lds + (bufoff) + ldsw + _i * 8192), 16, 0, 0); } while (0)
#define PG8_LD32(p_) __builtin_shufflevector(*(const PG8_LAS i32x4*)(p_), *(const PG8_LAS i32x4*)((p_) + 1024), 0, 1, 2, 3, 4, 5, 6, 7)
#define PG8_LDA(dst, b, h) do { if constexpr (I8MODE == 3) { _Pragma("unroll") for (int m = 0; m < 4; ++m) dst##8[m] = PG8_LD32(lds + PG8_SA(b, h) + aoff + m * 2048); } else { \
        _Pragma("unroll") for (int m = 0; m < 4; ++m) _Pragma("unroll") for (int k = 0; k < 2; ++k) dst[m][k] = *(const PG8_LAS bf16x8*)(lds + PG8_SA(b, h) + aoff + m * 2048 + k * 1024); } } while (0)
#define PG8_LDB(dst, b, h) do { if constexpr (I8MODE == 3) { _Pragma("unroll") for (int n = 0; n < 2; ++n) dst##8[n] = PG8_LD32(lds + PG8_SB(b, h) + boff + n * 2048); } else { \
        _Pragma("unroll") for (int n = 0; n < 2; ++n) _Pragma("unroll") for (int k = 0; k < 2; ++k) dst[n][k] = *(const PG8_LAS bf16x8*)(lds + PG8_SB(b, h) + boff + n * 2048 + k * 1024); } } while (0)
#define PG8_MMA(ai, bj, At, Bt) do { __builtin_amdgcn_s_setprio(1); _Pragma("unroll") for (int m = 0; m < 4; ++m) _Pragma("unroll") for (int n = 0; n < 2; ++n) _Pragma("unroll") for (int k = 0; k < 2; ++k) \
        acc[ai][bj][m][n] = __builtin_amdgcn_mfma_f32_16x16x32_bf16(Bt[n][k], At[m][k], acc[ai][bj][m][n], 0, 0, 0); __builtin_amdgcn_s_setprio(0); } while (0)
#define PG8_MMA_I8(ai, bj, At, Bt) do { __builtin_amdgcn_s_setprio(1); _Pragma("unroll") for (int m = 0; m < 4; ++m) _Pragma("unroll") for (int n = 0; n < 2; ++n) _Pragma("unroll") for (int k = 0; k < 2; ++k) \
        acc[ai][bj][m][n] = __builtin_bit_cast(f32x4, __builtin_amdgcn_mfma_i32_16x16x64_i8(__builtin_bit_cast(i32x4, Bt[n][k]), __builtin_bit_cast(i32x4, At[m][k]), __builtin_bit_cast(i32x4, acc[ai][bj][m][n]), 0, 0, 0)); __builtin_amdgcn_s_setprio(0); } while (0)
#define PG8_MMA_F8(ai, bj, At, Bt) do { __builtin_amdgcn_s_setprio(1); _Pragma("unroll") for (int m = 0; m < 4; ++m) _Pragma("unroll") for (int n = 0; n < 2; ++n) \
        acc[ai][bj][m][n] = __builtin_amdgcn_mfma_scale_f32_16x16x128_f8f6f4(Bt##8[n], At##8[m], acc[ai][bj][m][n], 0, 0, 0, 0x7f7f7f7f, 0, 0x7f7f7f7f); __builtin_amdgcn_s_setprio(0); } while (0)
#define PG8_MMA2(ai) do { if constexpr (I8MODE == 3) { PG8_MMA_F8(ai, 0, At, B0); PG8_MMA_F8(ai, 1, At, B1); } else if constexpr (DUAL_T > 0) { if (t < DUAL_T) { if constexpr (I8MODE != 0) { PG8_MMA_I8(ai, 0, At, B0); } else { PG8_MMA(ai, 0, At, B0); } } else { if constexpr (I8MODE == 1) { PG8_MMA_I8(ai, 1, At, B0); } else { PG8_MMA(ai, 1, At, B0); } } } \
        else { if constexpr (I8MODE == 1) { PG8_MMA_I8(ai, 0, At, B0); PG8_MMA_I8(ai, 1, At, B1); } else { PG8_MMA(ai, 0, At, B0); PG8_MMA(ai, 1, At, B1); } } } while (0)
#define PG8_STAGE_B1(buf, base) do { if constexpr (!DUAL_T) { PG8_STAGE(buf, base, voffB); } } while (0)
#define PG8_WAIT_VD(n, nd) do { if constexpr (DUAL_T > 0) { asm volatile("s_waitcnt vmcnt(" #nd ")" ::: "memory"); } else { asm volatile("s_waitcnt vmcnt(" #n ")" ::: "memory"); } } while (0)
#define PG8_WAIT_V(n) asm volatile("s_waitcnt vmcnt(" #n ")" ::: "memory")
#define PG8_WAIT_L(n) asm volatile("s_waitcnt lgkmcnt(" #n ")" ::: "memory")
#define PG8_BAR __builtin_amdgcn_s_barrier()
#define PG8_SCHED __builtin_amdgcn_sched_barrier(0)
    Unit cur, nxt; int ui = 0;
    if (!S.next(0, cur)) return;
    f32x4 acc[2][2][4][2];
#pragma unroll
    for (int a = 0; a < 2; ++a)
#pragma unroll
        for (int b = 0; b < 2; ++b)
#pragma unroll
            for (int m = 0; m < 4; ++m)
#pragma unroll
                for (int n = 0; n < 2; ++n) acc[a][b][m][n] = (f32x4){0.f, 0.f, 0.f, 0.f};
    bf16x8 At[4][2], B0[2][2], B1[2][2]; i32x8 At8[4], B08[2], B18[2];
    const char* cA = (const char*)g.A + (GATHER ? (size_t)0 : (size_t)cur.pm * tstep) + PG8_KOFF(cur); const char* cB = (const char*)g.Bt + (size_t)cur.pn * tstepB + PG8_KOFF(cur);
    if constexpr (Epi::MULTI) { nt = E.nkt(cur.part); asm volatile("" : "+s"(nt)); }
    S.a_ready(cur);
    int ns[4] = {0, 0, 0, 0};
    if constexpr (GATHER) {
#pragma unroll
        for (int i = 0; i < 2; ++i) { voffA[i] = PG8_GOFF(S.row_of(cur, gR[i]), i); voffA1[i] = PG8_GOFF(S.row_of(cur, HALF + gR[i]), i); } }
#define PG8_STAGE_A1(buf, base) do { if constexpr (GATHER) { PG8_STAGE(buf, base, voffA1); } else { PG8_STAGE(buf, (base) + hstep, voffA); } } while (0)
    if constexpr (SP2) {
        PG8_STAGE(PG8_SB(0, 0), cB, voffB); PG8_STAGE_B1(PG8_SB(0, 1), cB + hstepB); PG8_STAGE(PG8_SA(0, 0), cA, voffA); PG8_STAGE_A1(PG8_SA(0, 1), cA);
        if (wr == 1) PG8_BAR;
        PG8_WAIT_V(2); PG8_BAR;
        PG8_STAGE(PG8_SB(1, 0), cB + kstep, voffB); PG8_STAGE(PG8_SA(1, 0), cA + kstep, voffA); PG8_STAGE_B1(PG8_SB(1, 1), cB + hstepB + kstep);
        PG8_WAIT_VD(6, 4); PG8_BAR;
    } else {
        PG8_STAGE(PG8_SB(0, 0), cB, voffB); PG8_STAGE(PG8_SA(0, 0), cA, voffA); PG8_STAGE(PG8_SB(0, 1), cB + hstepB, voffB); PG8_STAGE(PG8_SA(0, 1), cA + hstep, voffA);
        if (wr == 1) PG8_BAR;
        PG8_WAIT_V(4); PG8_BAR;
        PG8_STAGE(PG8_SB(1, 0), cB + kstep, voffB); PG8_STAGE(PG8_SA(1, 0), cA + kstep, voffA); PG8_STAGE(PG8_SB(1, 1), cB + hstepB + kstep, voffB);
        PG8_WAIT_V(6); PG8_BAR;
    }
    for (;;) {
        const bool has_next = S.next(ui + 1, nxt);
        if constexpr (GATHER) { if (has_next) {
#pragma unroll
            for (int i = 0; i < 2; ++i) { ns[i] = S.row_of(nxt, gR[i]); ns[2 + i] = S.row_of(nxt, HALF + gR[i]); } } }
        const char* nA = (has_next && !GATHER) ? (const char*)g.A + (size_t)nxt.pm * tstep + PG8_KOFF(nxt) : cA; const char* nB = has_next ? (const char*)g.Bt + (size_t)nxt.pn * tstepB + PG8_KOFF(nxt) : cB;
        for (int t = 0; t < nt; t += 2) {
            const bool last = (t == nt - 2);
            if constexpr (Epi::MID_T > 0) { if (t == Epi::MID_T) E.mid(acc, cur, wr, wc, fr, fq); }
            const char* a1 = cA + (size_t)(t + 1) * kstep;
            const char* a2 = last ? nA : cA + (size_t)(t + 2) * kstep; const char* b2 = last ? nB : cB + (size_t)(t + 2) * kstep;
            const char* a3 = a2 + kstep; const char* b3 = b2 + kstep;
            if (last && has_next) S.a_ready(nxt);
            if constexpr (SP2) {
            PG8_LDB(B0, 0, 0); if constexpr (!DUAL_T) PG8_LDB(B1, 0, 1); PG8_SCHED; PG8_LDA(At, 0, 0); PG8_STAGE_A1(PG8_SA(1, 1), a1);
            if constexpr (GATHER) { if (last && has_next) {
#pragma unroll
                for (int i = 0; i < 2; ++i) { voffA[i] = PG8_GOFF(ns[i], i); voffA1[i] = PG8_GOFF(ns[2 + i], i); } } }
            PG8_WAIT_VD(8, 6); PG8_WAIT_L(0); PG8_BAR; PG8_MMA2(0); PG8_BAR; PG8_SCHED;
            PG8_LDA(At, 0, 1); PG8_STAGE(PG8_SB(0, 0), b2, voffB); PG8_STAGE_B1(PG8_SB(0, 1), b2 + hstepB); PG8_STAGE(PG8_SA(0, 0), a2, voffA);
            PG8_WAIT_VD(8, 6); PG8_WAIT_L(0); PG8_BAR; PG8_MMA2(1); PG8_BAR; PG8_SCHED;
            PG8_LDB(B0, 1, 0); if constexpr (!DUAL_T) PG8_LDB(B1, 1, 1); PG8_SCHED; PG8_LDA(At, 1, 0); PG8_STAGE_A1(PG8_SA(0, 1), a2);
            PG8_WAIT_VD(8, 6); PG8_WAIT_L(0); PG8_BAR; PG8_MMA2(0); PG8_BAR; PG8_SCHED;
            PG8_LDA(At, 1, 1); PG8_STAGE(PG8_SB(1, 0), b3, voffB); PG8_STAGE_B1(PG8_SB(1, 1), b3 + hstepB); PG8_STAGE(PG8_SA(1, 0), a3, voffA);
            PG8_WAIT_VD(8, 6); PG8_WAIT_L(0); PG8_BAR; PG8_MMA2(1); PG8_BAR; PG8_SCHED;
            } else {
            PG8_LDB(B0, 0, 0); PG8_SCHED; PG8_LDA(At, 0, 0); PG8_STAGE(PG8_SA(1, 1), a1 + hstep, voffA);
            PG8_WAIT_L(8); PG8_BAR; PG8_WAIT_L(0); PG8_MMA(0, 0, At, B0); PG8_BAR; PG8_SCHED;
            PG8_LDB(B1, 0, 1); PG8_STAGE(PG8_SB(0, 0), b2, voffB);
            PG8_BAR; PG8_WAIT_L(0); PG8_MMA(0, 1, At, B1); PG8_BAR;
            PG8_LDA(At, 0, 1); PG8_STAGE(PG8_SA(0, 0), a2, voffA);
            PG8_BAR; PG8_WAIT_L(0); PG8_MMA(1, 0, At, B0); PG8_BAR; PG8_SCHED;
            PG8_STAGE(PG8_SB(0, 1), b2 + hstepB, voffB);
            PG8_WAIT_V(6); PG8_BAR; PG8_MMA(1, 1, At, B1); PG8_BAR;
            PG8_LDB(B0, 1, 0); PG8_SCHED; PG8_LDA(At, 1, 0); PG8_STAGE(PG8_SA(0, 1), a2 + hstep, voffA);
            PG8_WAIT_L(8); PG8_BAR; PG8_WAIT_L(0); PG8_MMA(0, 0, At, B0); PG8_BAR; PG8_SCHED;
            PG8_LDB(B1, 1, 1); PG8_STAGE(PG8_SB(1, 0), b3, voffB);
            PG8_BAR; PG8_WAIT_L(0); PG8_MMA(0, 1, At, B1); PG8_BAR;
            PG8_LDA(At, 1, 1); PG8_STAGE(PG8_SA(1, 0), a3, voffA);
            PG8_BAR; PG8_WAIT_L(0); PG8_MMA(1, 0, At, B0); PG8_BAR; PG8_SCHED;
            PG8_STAGE(PG8_SB(1, 1), b3 + hstepB, voffB);
            PG8_WAIT_V(6); PG8_BAR; PG8_MMA(1, 1, At, B1); PG8_BAR;
            }
        }
        if constexpr (ALIGN_EPI) { if (wr == 0) PG8_BAR; }
        if constexpr (!Epi::AFTER_DRAIN) { E(acc, cur, wr, wc, fr, fq); S.done(cur); }
        if (!has_next) break;
        bool zero_acc = true; if constexpr (Epi::MULTI) zero_acc = E.reset(cur.part);
        if (zero_acc) {
#pragma unroll
        for (int a = 0; a < 2; ++a)
#pragma unroll
            for (int b = 0; b < 2; ++b)
#pragma unroll
                for (int m = 0; m < 4; ++m)
#pragma unroll
                    for (int n = 0; n < 2; ++n) acc[a][b][m][n] = (f32x4){0.f, 0.f, 0.f, 0.f};
        }
        cur = nxt; cA = nA; cB = nB; ++ui;
        if constexpr (Epi::MULTI) { nt = E.nkt(cur.part); asm volatile("" : "+s"(nt)); }
        if constexpr (ALIGN_EPI) { if (wr == 1) PG8_BAR; }
    }
    PG8_WAIT_V(0);
    if constexpr (!ALIGN_EPI) { if (wr == 0) PG8_BAR; }
    PG8_BAR;
#undef PG8_SA
#undef PG8_SB
#undef PG8_STAGE
#undef PG8_LDA
#undef PG8_LD32
#undef PG8_LDB
#undef PG8_MMA
#undef PG8_MMA2
#undef PG8_MMA_I8
#undef PG8_MMA_F8
#undef PG8_KOFF
#undef PG8_STAGE_B1
#undef PG8_WAIT_VD
#undef PG8_STAGE_A1
#undef PG8_GOFF
#undef PG8_WAIT_V
#undef PG8_WAIT_L
#undef PG8_BAR
#undef PG8_SCHED
}
}

typedef f32x4 acc_t[2][2][4][2];
using pg8::Unit; using pg8::HALF; using pg8::BM;

struct EpiInproj {
    static constexpr bool PERM = true, AFTER_DRAIN = false; static constexpr bool MULTI = false; static constexpr int MID_T = 0;
    unsigned char* ws; const float* b_in; const float* g_q; const float* g_k; const float* rstdx;
    __device__ __forceinline__ void operator()(const acc_t& acc, const Unit& u, int wr, int wc, int fr, int fq) const {
        const int pn = u.pn;
        int mode, col0; size_t off;
        if (pn < 12) { const int seg = pn >> 1; mode = seg == 0 ? 1 : (seg == 1 ? 2 : 0); col0 = 256 * (pn & 1) + ((seg == 2 || seg == 4 || seg == 5) ? 512 : 0);
            off = (seg == 0 || seg == 4) ? WS_A1 : ((seg == 1 || seg == 2) ? WS_B1 : WS_C1);
            if (CU_PAIR && (seg == 3 || seg == 5)) mode = 4; }
        else if (pn < 16) { mode = 3; col0 = 256 * (pn - 12); off = WS_SGA; }
        else { mode = 3; col0 = 256 * (pn - 16); off = WS_SGC; }
        constexpr int pitch = 1024;
        bf16_t* base = (bf16_t*)(ws + off);
        const int lc0 = 64 * wc + 8 * fq;
        f32x4 bv[2][2], gv[2][2];
#pragma unroll
        for (int bj = 0; bj < 2; ++bj)
#pragma unroll
            for (int n = 0; n < 2; ++n) {
                bv[bj][n] = (mode == 4) ? *(const f32x4*)(b_in + (bj ? 2560 : 1536) + 128 * (pn < 8 ? pn - 6 : pn - 8) + 32 * wc + 8 * fq + 4 * n) : *(const f32x4*)(b_in + 256 * pn + lc0 + 32 * bj + 4 * n);
                const float* g = (mode == 2) ? g_k : g_q;
                gv[bj][n] = *(const f32x4*)(g + 8 * fq + 32 * bj + 4 * n);
            }
        const float qs = (mode == 1) ? C2 : 1.0f;
        float rsxv[2][4];
#pragma unroll
        for (int ai = 0; ai < 2; ++ai)
#pragma unroll
            for (int m = 0; m < 4; ++m) rsxv[ai][m] = rstdx[u.pm * BM + ai * HALF + wr * 64 + m * 16 + fr];
#pragma unroll
        for (int ai = 0; ai < 2; ++ai)
#pragma unroll
            for (int m = 0; m < 4; ++m) {
                const int row = u.pm * BM + ai * HALF + wr * 64 + m * 16 + fr; const float rsx = rsxv[ai][m];
                f32x4 v[2][2];
#pragma unroll
                for (int bj = 0; bj < 2; ++bj)
#pragma unroll
                    for (int n = 0; n < 2; ++n) v[bj][n] = acc[ai][bj][m][n] * rsx + bv[bj][n];
                if (mode == 1 || mode == 2) {
                    float ss = 0.f;
#pragma unroll
                    for (int bj = 0; bj < 2; ++bj)
#pragma unroll
                        for (int n = 0; n < 2; ++n) { const f32x4 x = v[bj][n]; ss += (x[0] * x[0] + x[1] * x[1]) + (x[2] * x[2] + x[3] * x[3]); }
                    ss += __shfl_xor(ss, 16); ss += __shfl_xor(ss, 32);
                    const float rstd = __frsqrt_rn(ss * (1.0f / 64.0f) + EPS) * qs;
#pragma unroll
                    for (int bj = 0; bj < 2; ++bj)
#pragma unroll
                        for (int n = 0; n < 2; ++n) v[bj][n] = v[bj][n] * rstd * gv[bj][n];
                } else if (mode == 3) {
#pragma unroll
                    for (int bj = 0; bj < 2; ++bj)
#pragma unroll
                        for (int n = 0; n < 2; ++n)
#pragma unroll
                            for (int j = 0; j < 4; ++j) v[bj][n][j] = sigmoidf_(v[bj][n][j]);
                }
                if (mode == 4) {
                    const f32x4 c0 = v[0][0] * v[1][0], c1 = v[0][1] * v[1][1];
                    u32x4 w; w.x = pg8::cvt_pk_bf16(c0[0], c0[1]); w.y = pg8::cvt_pk_bf16(c0[2], c0[3]); w.z = pg8::cvt_pk_bf16(c1[0], c1[1]); w.w = pg8::cvt_pk_bf16(c1[2], c1[3]);
                    *(u32x4*)((bf16_t*)(ws + WS_C1) + (size_t)row * pitch + 128 * (pn < 8 ? pn - 6 : pn - 8) + 32 * wc + 8 * fq) = w;
                    continue;
                }
                if (mode == 3) {
                    unsigned char* rp8 = (unsigned char*)base + (size_t)row * pitch + col0 + lc0; const float lo = (pn >= 16) ? 1.0f : 0.0f;
#pragma unroll
                    for (int bj = 0; bj < 2; ++bj) { unsigned w2[2];
#pragma unroll
                        for (int n = 0; n < 2; ++n) { unsigned b4 = 0;
#pragma unroll
                            for (int j = 0; j < 4; ++j) b4 |= (unsigned)__float2int_rn(fmaxf(v[bj][n][j] * 255.0f, lo)) << (8 * j);
                            w2[n] = b4; }
                        *(u32x2*)(rp8 + 32 * bj) = (u32x2){w2[0], w2[1]}; }
                    continue;
                }
                bf16_t* rowp = base + (size_t)row * pitch + col0 + lc0;
#pragma unroll
                for (int bj = 0; bj < 2; ++bj) {
                    u32x4 w; w.x = pg8::cvt_pk_bf16(v[bj][0][0], v[bj][0][1]); w.y = pg8::cvt_pk_bf16(v[bj][0][2], v[bj][0][3]); w.z = pg8::cvt_pk_bf16(v[bj][1][0], v[bj][1][1]); w.w = pg8::cvt_pk_bf16(v[bj][1][2], v[bj][1][3]);
                    *(u32x4*)(rowp + 32 * bj) = w;
                }
            }
    }
};

struct EpiGateF8 {
    static constexpr bool PERM = true, AFTER_DRAIN = false; static constexpr bool MULTI = false; static constexpr int MID_T = 0;
    unsigned char* sga8; unsigned char* sgc8; const float* bias; const float* rstdx;
    __device__ __forceinline__ void operator()(const acc_t& acc, const Unit& u, int wr, int wc, int fr, int fq) const {
        const int pn = u.pn; unsigned char* base = (pn < 4 ? sga8 : sgc8) + 256 * (pn & 3) + wc * 32 + 8 * fq; const float lo = (pn >= 4) ? 1.0f : 0.0f;
        f32x4 bv[2][2]; float rsxv[2][4];
#pragma unroll
        for (int bj = 0; bj < 2; ++bj)
#pragma unroll
            for (int n = 0; n < 2; ++n) bv[bj][n] = *(const f32x4*)(bias + 256 * pn + wc * 32 + 8 * fq + bj * HALF + 4 * n);
#pragma unroll
        for (int ai = 0; ai < 2; ++ai)
#pragma unroll
            for (int m = 0; m < 4; ++m) rsxv[ai][m] = rstdx[u.pm * BM + ai * HALF + wr * 64 + m * 16 + fr] * (1.0f / F8W);
#pragma unroll
        for (int ai = 0; ai < 2; ++ai)
#pragma unroll
            for (int m = 0; m < 4; ++m) {
                const int row = u.pm * BM + ai * HALF + wr * 64 + m * 16 + fr; const float rs = rsxv[ai][m];
#pragma unroll
                for (int bj = 0; bj < 2; ++bj) { unsigned w2[2];
#pragma unroll
                    for (int n = 0; n < 2; ++n) { unsigned b4 = 0;
#pragma unroll
                        for (int j = 0; j < 4; ++j) b4 |= (unsigned)__float2int_rn(fmaxf(sigmoidf_(acc[ai][bj][m][n][j] * rs + bv[bj][n][j]) * 255.0f, lo)) << (8 * j);
                        w2[n] = b4; }
                    *(u32x2*)(base + (size_t)row * 1024 + bj * HALF) = (u32x2){w2[0], w2[1]}; }
            }
    }
};

struct EpiMergeDual {
    static constexpr bool PERM = true, AFTER_DRAIN = false; static constexpr bool MULTI = false; static constexpr int MID_T = 0;
    const bf16_t* sga; const bf16_t* sgc; bf16_t* mout;
    __device__ __forceinline__ void operator()(const acc_t& acc, const Unit& u, int wr, int wc, int fr, int fq) const {
        const int col0 = u.pn * HALF + wc * 32 + 8 * fq;
#pragma unroll
        for (int ai = 0; ai < 2; ++ai)
#pragma unroll
            for (int m = 0; m < 4; ++m) {
                const size_t ro = (size_t)(u.pm * BM + ai * HALF + wr * 64 + m * 16 + fr) * D + col0;
                const u32x4 a = *(const u32x4*)(sga + ro), c = *(const u32x4*)(sgc + ro);
                const f32x4 x0 = acc[ai][0][m][0], x1 = acc[ai][0][m][1], y0 = acc[ai][1][m][0], y1 = acc[ai][1][m][1];
                u32x4 w;
                w.x = pg8::cvt_pk_bf16(x0[0] * bf_lo(a.x) + y0[0] * bf_lo(c.x), x0[1] * bf_hi(a.x) + y0[1] * bf_hi(c.x));
                w.y = pg8::cvt_pk_bf16(x0[2] * bf_lo(a.y) + y0[2] * bf_lo(c.y), x0[3] * bf_hi(a.y) + y0[3] * bf_hi(c.y));
                w.z = pg8::cvt_pk_bf16(x1[0] * bf_lo(a.z) + y1[0] * bf_lo(c.z), x1[1] * bf_hi(a.z) + y1[1] * bf_hi(c.z));
                w.w = pg8::cvt_pk_bf16(x1[2] * bf_lo(a.w) + y1[2] * bf_lo(c.w), x1[3] * bf_hi(a.w) + y1[3] * bf_hi(c.w));
                *(u32x4*)(mout + ro) = w;
            }
    }
};

struct EpiResBf16 {
    static constexpr bool PERM = true, AFTER_DRAIN = false; static constexpr bool MULTI = false; static constexpr int MID_T = 0;
    const bf16_t* xb; bf16_t* h1b; unsigned char* h1f8;
    __device__ __forceinline__ void operator()(const acc_t& acc, const Unit& u, int wr, int wc, int fr, int fq) const {
        const int col0 = u.pn * BM + wc * 32 + 8 * fq;
        u32x4 xv[2][4][2];
#pragma unroll
        for (int ai = 0; ai < 2; ++ai)
#pragma unroll
            for (int m = 0; m < 4; ++m)
#pragma unroll
                for (int bj = 0; bj < 2; ++bj) xv[ai][m][bj] = *(const u32x4*)(xb + (size_t)(u.pm * BM + ai * HALF + wr * 64 + m * 16 + fr) * D + col0 + bj * HALF);
#pragma unroll
        for (int ai = 0; ai < 2; ++ai)
#pragma unroll
            for (int m = 0; m < 4; ++m) {
                const size_t ro = (size_t)(u.pm * BM + ai * HALF + wr * 64 + m * 16 + fr) * D + col0;
#pragma unroll
                for (int bj = 0; bj < 2; ++bj) {
                    const u32x4 x = xv[ai][m][bj]; const f32x4 v0 = acc[ai][bj][m][0], v1 = acc[ai][bj][m][1];
                    u32x4 w; w.x = pg8::cvt_pk_bf16(v0[0] + bf_lo(x.x), v0[1] + bf_hi(x.x)); w.y = pg8::cvt_pk_bf16(v0[2] + bf_lo(x.y), v0[3] + bf_hi(x.y));
                    w.z = pg8::cvt_pk_bf16(v1[0] + bf_lo(x.z), v1[1] + bf_hi(x.z)); w.w = pg8::cvt_pk_bf16(v1[2] + bf_lo(x.w), v1[3] + bf_hi(x.w));
                    *(u32x4*)(h1b + ro + bj * HALF) = w;
                    if (h1f8) { u32x2 q; q.x = pk4_fp8(v0[0] + bf_lo(x.x), v0[1] + bf_hi(x.x), v0[2] + bf_lo(x.y), v0[3] + bf_hi(x.y)); q.y = pk4_fp8(v1[0] + bf_lo(x.z), v1[1] + bf_hi(x.z), v1[2] + bf_lo(x.w), v1[3] + bf_hi(x.w)); *(u32x2*)(h1f8 + ro + bj * HALF) = q; }
                }
            }
    }
};

__device__ __forceinline__ int moe_local(const LAS int* pref, int e, int rtg, int r) { const int l = (rtg - pref[e]) * pg8::BM + r; return l < pref[64 + e] ? ((e << 15) | l) : -1; }
__device__ __forceinline__ LAS u32x2* moe_meta(LAS unsigned char* lds, int i) { return (LAS u32x2*)(lds + (i < 4 ? META_LO + i * 2048 : META_HI)); }
__device__ __forceinline__ void moe_meta_preload(LAS unsigned char* lds, const LAS int* pref, int nunits, int G, int c, const int* eslot, const float* ftab, bool by_token, int tid) {
    for (int j = tid; j < 5 * 256; j += 512) { const int i = j >> 8, r = j & 255, L = i * G + c;
        int slot = -1; float f = 0.f;
        if (L < nunits) { const int rtg = L >> 2; int e = 0;
#pragma unroll 4
            for (int k = 1; k < NE; ++k) e += (pref[k] <= rtg) ? 1 : 0;
            const int idx = moe_local(pref, e, rtg, r);
            if (idx >= 0) { slot = eslot[idx]; f = by_token ? ftab[slot >> 1] : ftab[idx]; } }
        moe_meta(lds, i)[r] = (u32x2){(unsigned)slot, __builtin_bit_cast(unsigned, f)}; }
    __syncthreads();
}
template <int F8> struct EpiSwigluT {
    static constexpr bool PERM = true, AFTER_DRAIN = false; static constexpr bool MULTI = false; static constexpr int MID_T = 0;
    bf16_t* hdn; LAS unsigned char* lds; static constexpr float wsc = F8 ? 1.0f / F8W : 1.0f; static constexpr int f8out = F8 && F8_DOWN;
    __device__ __forceinline__ void operator()(const acc_t& acc, const Unit& u, int wr, int wc, int fr, int fq) const {
        const int col0 = 128 * (u.pn & 3) + wc * 32 + 8 * fq;
        float rsv[2][4]; const LAS float* mp = (const LAS float*)moe_meta(lds, u.part) + 1;
#pragma unroll
        for (int ai = 0; ai < 2; ++ai)
#pragma unroll
            for (int m = 0; m < 4; ++m) rsv[ai][m] = mp[2 * (ai * HALF + wr * 64 + m * 16 + fr)] * wsc;
#pragma unroll
        for (int ai = 0; ai < 2; ++ai)
#pragma unroll
            for (int m = 0; m < 4; ++m) {
                const int row = u.pm * BM + ai * HALF + wr * 64 + m * 16 + fr; const float rs = rsv[ai][m];
                const size_t ro = (size_t)row * DE + col0;
                float h[8];
#pragma unroll
                for (int n = 0; n < 2; ++n)
#pragma unroll
                    for (int j = 0; j < 4; ++j) { const float a = acc[ai][0][m][n][j] * rs, b = acc[ai][1][m][n][j] * rs; h[4 * n + j] = a * sigmoidf_(a) * b; }
                if (f8out) { u32x2 q; q.x = pk4_fp8(h[0], h[1], h[2], h[3]); q.y = pk4_fp8(h[4], h[5], h[6], h[7]); *(u32x2*)((unsigned char*)hdn + ro) = q; }
                else { u32x4 w; w.x = pg8::cvt_pk_bf16(h[0], h[1]); w.y = pg8::cvt_pk_bf16(h[2], h[3]); w.z = pg8::cvt_pk_bf16(h[4], h[5]); w.w = pg8::cvt_pk_bf16(h[6], h[7]);
                *(u32x4*)(hdn + ro) = w; }
            }
    }
};

template <int F8> struct EpiDownT {
    static constexpr bool PERM = true, AFTER_DRAIN = false; static constexpr bool MULTI = false; static constexpr int MID_T = 0;
    bf16_t* contrib; LAS unsigned char* lds; static constexpr float wsc = (F8 ? 1.0f / F8W : 1.0f) * (F8_CONTRIB ? CSC : 1.0f);
    __device__ __forceinline__ void operator()(const acc_t& acc, const Unit& u, int wr, int wc, int fr, int fq) const {
        const int col0 = 256 * (u.pn & 3) + wc * 32 + 8 * fq;
#pragma unroll
        for (int ai = 0; ai < 2; ++ai) {
            int sl[4]; float wv[4];
#pragma unroll
            for (int m = 0; m < 4; ++m) { const LAS unsigned* mq = (const LAS unsigned*)moe_meta(lds, u.part) + 2 * (ai * HALF + wr * 64 + m * 16 + fr); sl[m] = (int)mq[0]; wv[m] = __builtin_bit_cast(float, mq[1]) * wsc; }
#pragma unroll
            for (int m = 0; m < 4; ++m) {
                const int slot = sl[m]; const float w = wv[m];
                if (slot >= 0) {
#pragma unroll
                    for (int bj = 0; bj < 2; ++bj) {
                        const f32x4 v0 = acc[ai][bj][m][0] * w, v1 = acc[ai][bj][m][1] * w;
#if F8_CONTRIB
                        *(u32x2*)((unsigned char*)contrib + (size_t)slot * D + col0 + bj * HALF) = (u32x2){pk4_fp8(v0[0], v0[1], v0[2], v0[3]), pk4_fp8(v1[0], v1[1], v1[2], v1[3])};
#else
                        u32x4 o; o.x = pg8::cvt_pk_bf16(v0[0], v0[1]); o.y = pg8::cvt_pk_bf16(v0[2], v0[3]); o.z = pg8::cvt_pk_bf16(v1[0], v1[1]); o.w = pg8::cvt_pk_bf16(v1[2], v1[3]);
                        *(u32x4*)(contrib + (size_t)slot * D + col0 + bj * HALF) = o;
#endif
                    }
                }
                asm volatile("" ::: "memory");
            }
        }
    }
};

struct EpiGateDual {
    static constexpr bool PERM = false, AFTER_DRAIN = false; static constexpr bool MULTI = false; static constexpr int MID_T = 0;
    const bf16_t* h2b; const float* rsc; const float* cmax; const float* bpg; float* out;
    __device__ __forceinline__ void operator()(const acc_t& acc, const Unit& u, int wr, int wc, int fr, int fq) const {
        const int col0 = u.pn * HALF + wc * 32 + 4 * fq;
        f32x4 cs[2], bv[2]; float rsv[2][4]; u32x2 hv[2][4][2];
#pragma unroll
        for (int n = 0; n < 2; ++n) { cs[n] = *(const f32x4*)(cmax + col0 + n * 16) * (1.0f / 127.0f); bv[n] = *(const f32x4*)(bpg + col0 + n * 16); }
#pragma unroll
        for (int ai = 0; ai < 2; ++ai)
#pragma unroll
            for (int m = 0; m < 4; ++m) { const int row = u.pm * BM + ai * HALF + wr * 64 + m * 16 + fr; rsv[ai][m] = rsc[row];
#pragma unroll
                for (int n = 0; n < 2; ++n) hv[ai][m][n] = *(const u32x2*)(h2b + (size_t)row * D + col0 + n * 16); }
#pragma unroll
        for (int ai = 0; ai < 2; ++ai)
#pragma unroll
            for (int m = 0; m < 4; ++m) {
                const int row = u.pm * BM + ai * HALF + wr * 64 + m * 16 + fr; const float rs = rsv[ai][m];
#pragma unroll
                for (int n = 0; n < 2; ++n) {
                    const int c = col0 + n * 16;
                    const u32x2 hw = hv[ai][m][n];
                    const i32x4 ia = __builtin_bit_cast(i32x4, acc[ai][0][m][n]); const f32x4 pv = acc[ai][1][m][n];
                    f32x4 a; a[0] = (float)ia[0] * rs * cs[n][0] + bv[n][0]; a[1] = (float)ia[1] * rs * cs[n][1] + bv[n][1]; a[2] = (float)ia[2] * rs * cs[n][2] + bv[n][2]; a[3] = (float)ia[3] * rs * cs[n][3] + bv[n][3];
                    f32x4 r;
                    r[0] = bf_lo(hw.x) + sigmoidf_(a[0]) * pv[0]; r[1] = bf_hi(hw.x) + sigmoidf_(a[1]) * pv[1];
                    r[2] = bf_lo(hw.y) + sigmoidf_(a[2]) * pv[2]; r[3] = bf_hi(hw.y) + sigmoidf_(a[3]) * pv[3];
                    *(f32x4*)(out + (size_t)row * D + c) = r;
                }
            }
    }
};

struct EpiMerge2 {
    static constexpr bool PERM = true, AFTER_DRAIN = false; static constexpr bool MULTI = true; static constexpr int MID_T = 0;
    const unsigned char* sga; const unsigned char* sgc; bf16_t* mout;
    __device__ __forceinline__ int kt0(int part) const { return 8 * part; }
    __device__ __forceinline__ int nkt(int) const { return 8; }
    __device__ __forceinline__ bool reset(int part) const { return part == 1; }
    static __device__ __forceinline__ float u8(unsigned w, int j) { return (float)((w >> (8 * j)) & 0xffu); }
    __device__ __forceinline__ void operator()(acc_t& acc, const Unit& u, int wr, int wc, int fr, int fq) const {
        const int col0 = u.pn * BM + wc * 32 + 8 * fq;
        if (u.part == 0) {
            u32x2 av[2][4][2], cv[2][4][2];
#pragma unroll
            for (int ai = 0; ai < 2; ++ai)
#pragma unroll
                for (int m = 0; m < 4; ++m)
#pragma unroll
                    for (int bj = 0; bj < 2; ++bj) { const size_t o = (size_t)(u.pm * BM + ai * HALF + wr * 64 + m * 16 + fr) * D + col0 + bj * HALF; av[ai][m][bj] = *(const u32x2*)(sga + o); cv[ai][m][bj] = *(const u32x2*)(sgc + o); }
#pragma unroll
            for (int ai = 0; ai < 2; ++ai)
#pragma unroll
                for (int m = 0; m < 4; ++m)
#pragma unroll
                    for (int bj = 0; bj < 2; ++bj) {
                        const u32x2 a = av[ai][m][bj], c = cv[ai][m][bj];
#pragma unroll
                        for (int j = 0; j < 4; ++j) { acc[ai][bj][m][0][j] *= u8(a.x, j) * __builtin_amdgcn_rcpf(u8(c.x, j)); acc[ai][bj][m][1][j] *= u8(a.y, j) * __builtin_amdgcn_rcpf(u8(c.y, j)); }
                    }
        } else {
            u32x2 cv[2][4][2];
#pragma unroll
            for (int ai = 0; ai < 2; ++ai)
#pragma unroll
                for (int m = 0; m < 4; ++m)
#pragma unroll
                    for (int bj = 0; bj < 2; ++bj) cv[ai][m][bj] = *(const u32x2*)(sgc + (size_t)(u.pm * BM + ai * HALF + wr * 64 + m * 16 + fr) * D + col0 + bj * HALF);
#pragma unroll
            for (int ai = 0; ai < 2; ++ai)
#pragma unroll
                for (int m = 0; m < 4; ++m) {
                    const size_t ro = (size_t)(u.pm * BM + ai * HALF + wr * 64 + m * 16 + fr) * D + col0;
#pragma unroll
                    for (int bj = 0; bj < 2; ++bj) {
                        const u32x2 c = cv[ai][m][bj]; const f32x4 v0 = acc[ai][bj][m][0], v1 = acc[ai][bj][m][1]; constexpr float k = 1.0f / 255.0f;
                        u32x4 w; w.x = pg8::cvt_pk_bf16(v0[0] * u8(c.x, 0) * k, v0[1] * u8(c.x, 1) * k); w.y = pg8::cvt_pk_bf16(v0[2] * u8(c.x, 2) * k, v0[3] * u8(c.x, 3) * k);
                        w.z = pg8::cvt_pk_bf16(v1[0] * u8(c.y, 0) * k, v1[1] * u8(c.y, 1) * k); w.w = pg8::cvt_pk_bf16(v1[2] * u8(c.y, 2) * k, v1[3] * u8(c.y, 3) * k);
                        *(u32x4*)(mout + ro + bj * HALF) = w;
                    }
                }
        }
    }
};

template <bool GATHER_> struct MoeOrderT {
    static constexpr bool GATHER = GATHER_;
    const LAS int* pref;
    int nunits, G, c; LAS unsigned char* lds;
    __device__ __forceinline__ int row_of(const Unit& u, int r) const { return ((const LAS int*)moe_meta(lds, u.part))[2 * r]; }
    __device__ __forceinline__ bool next(int i, Unit& u) const {
        const int L = i * G + c; if (L >= nunits) return false;
        const int rtg = L >> 2, pnl = L & 3; int e = 0;
#pragma unroll 4
        for (int k = 1; k < NE; ++k) e += (pref[k] <= rtg) ? 1 : 0;
        e = __builtin_amdgcn_readfirstlane(e);
        u.pm = rtg; u.pn = 4 * e + pnl; u.part = i; return true;
    }
    __device__ __forceinline__ void a_ready(const Unit&) const {}
    __device__ __forceinline__ void done(const Unit&) const {}
};
struct StaticOrderId : pg8::StaticOrder {
    static constexpr bool GATHER = true;
    __device__ __forceinline__ int row_of(const Unit& u, int r) const { return 2 * (u.pm * pg8::BM + r); }
};
struct MoeOrderId : MoeOrderT<true> {
    __device__ __forceinline__ int row_of(const Unit& u, int r) const { return 2 * (u.pm * pg8::BM + r); }
};

#define XB_TMO      128
#define XB_XCNT(j)  (256  + 64 * (j))
#define XB_XSUB(j)  (1280 + 64 * (j))
#define XB_XGEN(j)  (2304 + 64 * (j))
#define XB_TOP      3328
#define XB_TOPGEN   3392
#define XCD_BAR_WORDS 3456
#define XB_SPIN_CAP (1u << 18)

__device__ __forceinline__ unsigned xb_ld(unsigned* p)              { return __hip_atomic_load(p, __ATOMIC_RELAXED, __HIP_MEMORY_SCOPE_AGENT); }
__device__ __forceinline__ unsigned xb_add(unsigned* p, unsigned v) { return __hip_atomic_fetch_add(p, v, __ATOMIC_RELAXED, __HIP_MEMORY_SCOPE_AGENT); }
__device__ __forceinline__ unsigned xb_xcc_id() { return (unsigned)__builtin_amdgcn_s_getreg((3 << 11) | 20) & 0xFu; }
#define XB_SPIN(cond, bar) do { unsigned _sp = 0; while (cond) { __builtin_amdgcn_s_sleep(1); \
    if ((++_sp & 255u) == 0u) { if (xb_ld(&(bar)[XB_TMO])) break; if (_sp > XB_SPIN_CAP) { atomicAdd(&(bar)[XB_TMO], 1u); break; } } } } while (0)

struct XcdBarrier {
    unsigned* bar; unsigned x;
    volatile LAS unsigned* st;
};

__device__ __forceinline__ XcdBarrier xcd_barrier_post(unsigned* bar, volatile LAS unsigned* st) {
    XcdBarrier b; b.bar = bar; b.x = xb_xcc_id(); b.st = st;
    if (threadIdx.x == 0) (void)xb_add(&bar[XB_XCNT(b.x)], 1u);
    return b;
}
__device__ __forceinline__ void xcd_barrier_complete(unsigned* bar, unsigned x, unsigned& nloc, unsigned& nx) {
    const unsigned G = gridDim.x * gridDim.y * gridDim.z;
    unsigned sum, cnt, mine, sp = 0u;
    for (;;) {
        sum = 0u; cnt = 0u; mine = 0u;
#pragma unroll
        for (unsigned j = 0; j < 16; ++j) { const unsigned c = xb_ld(&bar[XB_XCNT(j)]); sum += c; cnt += (c > 0u) ? 1u : 0u; mine = (j == x) ? c : mine; }
        if (sum == G) break;
        __builtin_amdgcn_s_sleep(1);
        if ((++sp & 255u) == 0u) { if (xb_ld(&bar[XB_TMO])) break; if (sp > XB_SPIN_CAP) { atomicAdd(&bar[XB_TMO], 1u); break; } }
    }
    nloc = mine > 0u ? mine : 1u; nx = cnt > 0u ? cnt : 1u;
}

__device__ __forceinline__ void xcd_barrier(const XcdBarrier& b, int tid) {
    asm volatile("s_waitcnt vmcnt(0)" ::: "memory");
    __syncthreads();
    if (tid == 0) {
        unsigned* bar = b.bar;
        __builtin_amdgcn_s_waitcnt(0);
        unsigned nloc = b.st[0], nx = b.st[1];
        if (nloc == 0u) { xcd_barrier_complete(bar, b.x, nloc, nx); b.st[0] = nloc; b.st[1] = nx; }
        const unsigned old = xb_add(&bar[XB_XSUB(b.x)], 1u);
        const unsigned gen = old / nloc;
        if (old + 1u == (gen + 1u) * nloc) {
            __builtin_amdgcn_fence(__ATOMIC_RELEASE, "agent");
            asm volatile("s_waitcnt vmcnt(0)" ::: "memory");
            const unsigned og = xb_add(&bar[XB_TOP], 1u);
            const unsigned tg = og / nx;
            if (og + 1u == (tg + 1u) * nx) xb_add(&bar[XB_TOPGEN], 1u);
            else XB_SPIN(xb_ld(&bar[XB_TOPGEN]) == tg, bar);
            __builtin_amdgcn_fence(__ATOMIC_ACQUIRE, "agent");
            xb_add(&bar[XB_XGEN(b.x)], 1u);
            asm volatile("s_waitcnt vmcnt(0)" ::: "memory");
        } else {
            XB_SPIN(xb_ld(&bar[XB_XGEN(b.x)]) == gen, bar);
            __builtin_amdgcn_fence(__ATOMIC_ACQUIRE, "agent");
            asm volatile("s_waitcnt vmcnt(0)" ::: "memory");
        }
    }
    __syncthreads();
}

#include <hip/hip_bf16.h>
#include <cmath>
namespace attn_body {
using bf16=__hip_bfloat16;
using bf16x8=__attribute__((ext_vector_type(8)))short;
using s16x4=__attribute__((ext_vector_type(4)))short;
using f32x16=__attribute__((ext_vector_type(16)))float;
using u32x4=__attribute__((ext_vector_type(4)))unsigned;
constexpr int BATCH=8,NHEAD=8,SEQ=4096,D=64,DM=1024,OPITCH=1024;
constexpr int NW=8,QBLK=32,QB=QBLK*NW,KVBLK=64,NQB=SEQ/QB;
constexpr int ATTN_PITCH=DM, ATTN_UNIT_ROWS=QB;
constexpr int BT_COPY=384, BT_BYTES=4*BT_COPY*4;
__device__ __forceinline__ int crow(int r,int hi){return (r&3)+8*(r>>2)+4*hi;}
#define SBAR() __builtin_amdgcn_sched_barrier(0)
constexpr int NSLOT=3, SLOTB=8192;
constexpr int LDS_K=0, LDS_V=NSLOT*SLOTB, LDS_WS=2*NSLOT*SLOTB, LDS_OST=LDS_WS+NW*64*4, LDS_BT=LDS_OST+NW*4096, LDS_BYTES=LDS_BT+BT_BYTES;
__device__ __forceinline__ void glds16(const void*gsrc,unsigned lds_dst){unsigned keep;
  asm volatile("s_mov_b32 %0, m0\n\ts_mov_b32 m0, %2\n\ts_nop 0\n\tglobal_load_lds_dwordx4 %1, off\n\ts_mov_b32 m0, %0":"=&s"(keep):"v"(gsrc),"s"(lds_dst):"memory");}
__device__ __forceinline__ float max3f(float a,float b,float c){float r;asm("v_max3_f32 %0, %1, %2, %3":"=v"(r):"v"(a),"v"(b),"v"(c));return r;}
__device__ __forceinline__ float max2f(float a,float b){float r;asm("v_max_f32_e32 %0, %1, %2":"=v"(r):"v"(a),"v"(b));return r;}
__device__ __forceinline__ float fadd_s(float a,float b){float r;asm("v_add_f32_e32 %0, %1, %2":"=v"(r):"v"(a),"v"(b));return r;}
__device__ __forceinline__ float fsub_s(float a,float b){float r;asm("v_sub_f32_e32 %0, %1, %2":"=v"(r):"v"(a),"v"(b));return r;}
typedef float f32x2_t __attribute__((ext_vector_type(2))); typedef float f32x4_t __attribute__((ext_vector_type(4))); typedef __bf16 bf16x2_t __attribute__((ext_vector_type(2)));
__device__ __forceinline__ unsigned cvtpk_s(float lo,float hi){f32x2_t v={lo,hi};bf16x2_t b=__builtin_convertvector(v,bf16x2_t);return __builtin_bit_cast(unsigned,b);}
#define WAIT_BAR(N) asm volatile("s_waitcnt vmcnt(" #N ") lgkmcnt(0)\n\ts_barrier":::"memory")

__device__ __forceinline__ void qkt(f32x16&p0,f32x16&p1,const char*Kslot,const bf16x8*qr,const f32x16&negm,int r32,int hi){
  const char*kb=Kslot+hi*1024+r32*16;
  #pragma unroll
  for(int d0=0;d0<4;++d0){
    const bf16x8 b0=*reinterpret_cast<const bf16x8*>(kb+d0*2048);
    const bf16x8 b1=*reinterpret_cast<const bf16x8*>(kb+d0*2048+512);
    if(d0==0){p0=__builtin_amdgcn_mfma_f32_32x32x16_bf16(b0,qr[0],negm,0,0,0);p1=__builtin_amdgcn_mfma_f32_32x32x16_bf16(b1,qr[0],negm,0,0,0);}
    else{p0=__builtin_amdgcn_mfma_f32_32x32x16_bf16(b0,qr[d0],p0,0,0,0);p1=__builtin_amdgcn_mfma_f32_32x32x16_bf16(b1,qr[d0],p1,0,0,0);}}
}
typedef __attribute__((address_space(3))) const char* lds_cptr;
typedef short v4i16_t __attribute__((ext_vector_type(4)));
__device__ __forceinline__ void kload8(bf16x8*kf,lds_cptr kp){
  kf[0]=*(const __attribute__((address_space(3))) bf16x8*)(kp);      kf[1]=*(const __attribute__((address_space(3))) bf16x8*)(kp+512);
  kf[2]=*(const __attribute__((address_space(3))) bf16x8*)(kp+2048); kf[3]=*(const __attribute__((address_space(3))) bf16x8*)(kp+2560);
  kf[4]=*(const __attribute__((address_space(3))) bf16x8*)(kp+4096); kf[5]=*(const __attribute__((address_space(3))) bf16x8*)(kp+4608);
  kf[6]=*(const __attribute__((address_space(3))) bf16x8*)(kp+6144); kf[7]=*(const __attribute__((address_space(3))) bf16x8*)(kp+6656);
}
__device__ __forceinline__ void kload2(bf16x8*kf,lds_cptr kp,int j){ kf[2*j]=*(const __attribute__((address_space(3))) bf16x8*)(kp+j*2048); kf[2*j+1]=*(const __attribute__((address_space(3))) bf16x8*)(kp+j*2048+512); }
__device__ __forceinline__ s16x4 vtr(lds_cptr p){ return __builtin_bit_cast(s16x4,__builtin_amdgcn_ds_read_tr16_b64_v4i16((__attribute__((address_space(3))) v4i16_t*)p)); }
__device__ __forceinline__ float rowmax(const f32x16&p0,const f32x16&p1){
  float a=max3f(p0[0],p0[1],p1[0]),b=max3f(p0[2],p0[3],p1[1]);a=max3f(a,p1[2],p1[3]);
  #pragma unroll
  for(int r=4;r<16;r+=4){a=max3f(a,p0[r],p0[r+1]);b=max3f(b,p0[r+2],p0[r+3]);a=max3f(a,p1[r],p1[r+1]);b=max3f(b,p1[r+2],p1[r+3]);}
  const float m=max2f(a,b);
  auto rr=__builtin_amdgcn_permlane32_swap(__float_as_uint(m),__float_as_uint(m),false,false);
  return max2f(__uint_as_float(rr[0]),__uint_as_float(rr[1]));
}
__device__ __forceinline__ void pv(f32x16*o,int vb,bf16x8 pa0,bf16x8 pa1,bf16x8 pa2,bf16x8 pa3){
  #pragma unroll
  for(int d0=0;d0<2;++d0){s16x4 lo[4],hi[4];
    #pragma unroll
    for(int ks=0;ks<4;++ks){
      asm volatile("ds_read_b64_tr_b16 %0,%1 offset:%c2":"=&v"(lo[ks]):"v"(vb),"i"(d0*4096+ks*1024):"memory");
      asm volatile("ds_read_b64_tr_b16 %0,%1 offset:%c2":"=&v"(hi[ks]):"v"(vb),"i"(d0*4096+ks*1024+512):"memory");}
    asm volatile("s_waitcnt lgkmcnt(0)":::"memory");SBAR();
    #define PK(k) (bf16x8){lo[k][0],lo[k][1],lo[k][2],lo[k][3],hi[k][0],hi[k][1],hi[k][2],hi[k][3]}
    o[d0]=__builtin_amdgcn_mfma_f32_32x32x16_bf16(pa0,PK(0),o[d0],0,0,0);
    o[d0]=__builtin_amdgcn_mfma_f32_32x32x16_bf16(pa1,PK(1),o[d0],0,0,0);
    o[d0]=__builtin_amdgcn_mfma_f32_32x32x16_bf16(pa2,PK(2),o[d0],0,0,0);
    o[d0]=__builtin_amdgcn_mfma_f32_32x32x16_bf16(pa3,PK(3),o[d0],0,0,0);
    #undef PK
  }
}

#ifndef ATTN_STORE16
#define ATTN_STORE16(p,v) (*(u32x4*)(p)=(v))
#endif
__device__ __forceinline__ void attn_unit(int b,int h,int qb,const bf16*Q,const bf16*K,const bf16*V,bf16*O,char*shm,float cinit,int tid){
  asm volatile("":"+v"(tid));
  const int lane=tid&63,r32=lane&31,hi=lane>>5; const int wid=__builtin_amdgcn_readfirstlane(tid>>6);
  const long rowbase=(long)b*SEQ; const int q0=qb*QB;
  const bf16*Qw=Q+(rowbase+q0+wid*QBLK)*DM+h*D;
  const int t0=(4*qb-8)>0?(4*qb-8):0;
  const bf16*Kh=K+(rowbase+(long)t0*KVBLK)*DM+h*D,*Vh=V+(rowbase+(long)t0*KVBLK)*DM+h*D;
  const int tb=t0-4*qb-(wid>>1)+8;
  const unsigned lds0=(unsigned)(uintptr_t)shm;
  float*wsf=(float*)(shm+LDS_WS)+wid*64;
  const bf16*ksrc=Kh+(long)lane*DM+wid*8;
  const bf16*vsrc=Vh+(long)(16*(wid&3)+(lane>>2))*DM+(wid>>2)*32+(lane&3)*8;
  const unsigned kdst=lds0+LDS_K+wid*1024, vdst=lds0+LDS_V+wid*1024;
  #define DMA_K(t,slot) glds16(ksrc+(long)(t)*KVBLK*DM,(unsigned)__builtin_amdgcn_readfirstlane(kdst+(slot)))
  #define DMA_V(t,slot) glds16(vsrc+(long)(t)*KVBLK*DM,(unsigned)__builtin_amdgcn_readfirstlane(vdst+(slot)))
  const int vb0=(int)(lds0+LDS_V)+((lane>>4)&1)*32+(lane&3)*8+(4*hi+((lane&15)>>2))*64;
  const char*Kbase=shm+LDS_K; bf16x8 kf[8];
  const lds_cptr shm3=(lds_cptr)shm; const lds_cptr kp0=shm3+LDS_K+hi*1024+r32*16; const lds_cptr vp0=shm3+LDS_V+((lane>>4)&1)*32+(lane&3)*8+(4*hi+((lane&15)>>2))*64;
  const int NT=4*qb+4-t0;
  const lds_cptr btl=shm3+LDS_BT+((3-r32)&3)*(BT_COPY*4)+4*(-193-32*(wid&1)-r32-((3-r32)&3)+4*hi);
  DMA_K(0,0);DMA_V(0,0);DMA_K(1,SLOTB);
  bf16x8 qr[4];
  #pragma unroll
  for(int d0=0;d0<4;++d0)qr[d0]=*reinterpret_cast<const bf16x8*>(&Qw[(long)r32*DM+d0*16+hi*8]);
  float l_reg=0.f;f32x16 o[2];o[0]=f32x16{};o[1]=f32x16{};f32x16 negm;
  asm volatile("":"+s"(cinit));
  _Pragma("unroll") for(int r=0;r<16;++r)negm[r]=cinit; asm volatile("":"+v"(negm));
  #define BIASMASK(P0,P1,t) do{ const int tau_=(t)+tb; \
    if(tau_<0||tau_>8){ _Pragma("unroll") for(int r=0;r<16;++r){P0[r]=-INFINITY;P1[r]=-INFINITY;} } \
    else if(tau_>=4){ const lds_cptr bp_=btl+256*tau_; \
      _Pragma("unroll") for(int g=0;g<4;++g){ const f32x4_t d0_=*(const __attribute__((address_space(3))) f32x4_t*)(bp_+32*g), d1_=*(const __attribute__((address_space(3))) f32x4_t*)(bp_+32*g+128); \
        _Pragma("unroll") for(int j=0;j<4;++j){P0[4*g+j]+=d0_[j];P1[4*g+j]+=d1_[j];} } } }while(0)
  #define START(P0,P1) do{ _Pragma("unroll") for(int r=0;r<16;++r)P0[r]=__builtin_amdgcn_exp2f(P0[r]); }while(0)
  #define RESC() do{}while(0)
  f32x16 pA0,pA1,pB0,pB1;
  int sl_prev=0,sl_cur=0,sl_next=SLOTB;
  #define ROT() do{sl_prev=sl_cur;sl_cur=sl_next;sl_next=(sl_next==(NSLOT-1)*SLOTB)?0:sl_next+SLOTB;}while(0)
  DMA_K(2,2*SLOTB);
  WAIT_BAR(3);
  qkt(pA0,pA1,Kbase,qr,negm,r32,hi);asm volatile("s_nop 15\n\ts_nop 7":"+v"(pA0),"+v"(pA1));BIASMASK(pA0,pA1,0);
  START(pA0,pA1);
  _Pragma("unroll") for(int r=0;r<16;++r)pA1[r]=__builtin_amdgcn_exp2f(pA1[r]);
  WAIT_BAR(0);
  DMA_K(3,0);DMA_V(1,SLOTB);
  ROT();
  kload8(kf,kp0+sl_cur);
  WAIT_BAR(2);
  s16x4 vlo[8],vhi[8]; u32x4 pw0,pw1,pw2,pw3;
  #define PKW(P,B) cvtpk_s(P[B],P[B+1])
  #define PAF(k) __builtin_bit_cast(bf16x8,pw##k)
  #define VFR(i) (bf16x8){vlo[i][0],vlo[i][1],vlo[i][2],vlo[i][3],vhi[i][0],vhi[i][1],vhi[i][2],vhi[i][3]}
  #define PIN(x) asm volatile("":"+v"(x))
  #define MX3(a,b,c) __builtin_fmaxf(__builtin_fmaxf((a),(b)),(c))
  #define GAPA(MF,A0,A1,A2,A3,W0,W1,PW) do{ MF; sacc+=A0; sacc+=A1; sacc+=A2; sacc+=A3; PIN(sacc); W0; W1; PIN(PW); SBAR(); }while(0)
  #define EX(v) __builtin_amdgcn_exp2f(v)
  #define GAPB(MF,X,B) do{ MF; X[B]=EX(X[B]); X[B+1]=EX(X[B+1]); X[B+2]=EX(X[B+2]); X[B+3]=EX(X[B+3]); PIN(X); SBAR(); }while(0)
  #define VRD(i) do{ vlo[i]=vtr(vp_+(((i)>>2)*4096+((i)&3)*1024)); vhi[i]=vtr(vp_+(((i)>>2)*4096+((i)&3)*1024+512)); }while(0)
  #define KRD(G,j) do{ if(G){ kload2(kf,kp0+sl_next,j); SBAR(); } }while(0)
  #define STEP(C0,C1,P0,P1,t,GK,GV,GL) do{ SBAR(); \
    const lds_cptr vp_=vp0+sl_prev; \
    VRD(0); SBAR(); float sacc=(P0[0]+P0[1]); \
    GAPA(C0=__builtin_amdgcn_mfma_f32_32x32x16_bf16(kf[0],qr[0],negm,0,0,0), P0[2],P0[3],P0[4],P0[5],     pw0[0]=PKW(P0,0), pw0[1]=PKW(P0,2), pw0); \
    VRD(4); SBAR(); GAPA(C1=__builtin_amdgcn_mfma_f32_32x32x16_bf16(kf[1],qr[0],negm,0,0,0), P0[6],P0[7],P0[8],P0[9],     pw0[2]=PKW(P0,4), pw0[3]=PKW(P0,6), pw0); \
    VRD(1); SBAR(); GAPA(C0=__builtin_amdgcn_mfma_f32_32x32x16_bf16(kf[2],qr[1],C0,0,0,0),   P0[10],P0[11],P0[12],P0[13], pw1[0]=PKW(P0,8), pw1[1]=PKW(P0,10), pw1); \
    VRD(5); SBAR(); GAPA(C1=__builtin_amdgcn_mfma_f32_32x32x16_bf16(kf[3],qr[1],C1,0,0,0),   P0[14],P0[15],P1[0],P1[1],   pw1[2]=PKW(P0,12),pw1[3]=PKW(P0,14), pw1); \
    VRD(2); SBAR(); GAPA(C0=__builtin_amdgcn_mfma_f32_32x32x16_bf16(kf[4],qr[2],C0,0,0,0),   P1[2],P1[3],P1[4],P1[5],     pw2[0]=PKW(P1,0), pw2[1]=PKW(P1,2), pw2); \
    VRD(6); SBAR(); GAPA(C1=__builtin_amdgcn_mfma_f32_32x32x16_bf16(kf[5],qr[2],C1,0,0,0),   P1[6],P1[7],P1[8],P1[9],     pw2[2]=PKW(P1,4), pw2[3]=PKW(P1,6), pw2); \
    VRD(3); SBAR(); GAPA(C0=__builtin_amdgcn_mfma_f32_32x32x16_bf16(kf[6],qr[3],C0,0,0,0),   P1[10],P1[11],P1[12],P1[13], pw3[0]=PKW(P1,8), pw3[1]=PKW(P1,10), pw3); \
    VRD(7); SBAR(); GAPA(C1=__builtin_amdgcn_mfma_f32_32x32x16_bf16(kf[7],qr[3],C1,0,0,0),   P1[14],P1[15],0.f,0.f,       pw3[2]=PKW(P1,12),pw3[3]=PKW(P1,14), pw3); \
    l_reg+=sacc; \
    if(GK){DMA_K((t)+3,sl_cur);} if(GV){DMA_V((t)+1,sl_next);} \
    BIASMASK(C0,C1,t); \
    SBAR(); \
    GAPB(o[0]=__builtin_amdgcn_mfma_f32_32x32x16_bf16(PAF(0),VFR(0),o[0],0,0,0), C0,0); \
    GAPB(o[1]=__builtin_amdgcn_mfma_f32_32x32x16_bf16(PAF(0),VFR(4),o[1],0,0,0), C0,4); \
    KRD(GL,0); GAPB(o[0]=__builtin_amdgcn_mfma_f32_32x32x16_bf16(PAF(1),VFR(1),o[0],0,0,0), C0,8); \
    KRD(GL,1); GAPB(o[1]=__builtin_amdgcn_mfma_f32_32x32x16_bf16(PAF(1),VFR(5),o[1],0,0,0), C0,12); \
    KRD(GL,2); GAPB(o[0]=__builtin_amdgcn_mfma_f32_32x32x16_bf16(PAF(2),VFR(2),o[0],0,0,0), C1,0); \
    KRD(GL,3); GAPB(o[1]=__builtin_amdgcn_mfma_f32_32x32x16_bf16(PAF(2),VFR(6),o[1],0,0,0), C1,4); \
    GAPB(o[0]=__builtin_amdgcn_mfma_f32_32x32x16_bf16(PAF(3),VFR(3),o[0],0,0,0), C1,8); \
    GAPB(o[1]=__builtin_amdgcn_mfma_f32_32x32x16_bf16(PAF(3),VFR(7),o[1],0,0,0), C1,12); \
    }while(0)
  int t=1;
  for(;t+5<NT;t+=2){
    STEP(pB0,pB1,pA0,pA1,t,true,true,true);     WAIT_BAR(2); RESC(); ROT();
    STEP(pA0,pA1,pB0,pB1,t+1,true,true,true);   WAIT_BAR(2); RESC(); ROT();
  }
  #define ENDW(tt) do{ if((tt)+3<NT){WAIT_BAR(2);} else if((tt)+2<NT){WAIT_BAR(1);} else {WAIT_BAR(0);} }while(0)
  for(;t+1<NT;t+=2){
    STEP(pB0,pB1,pA0,pA1,t,(t+3<NT),(t+1<NT),(t+1<NT));       ENDW(t);   RESC(); ROT();
    STEP(pA0,pA1,pB0,pB1,t+1,(t+4<NT),(t+2<NT),(t+2<NT));     ENDW(t+1); RESC(); ROT();
  }
  STEP(pB0,pB1,pA0,pA1,NT-1,false,false,false); RESC();
  { float sacc=pB0[0]+pB0[1]; _Pragma("unroll") for(int r=2;r<16;++r)sacc+=pB0[r]; _Pragma("unroll") for(int r=0;r<16;++r)sacc+=pB1[r]; l_reg+=sacc;
    pw0=(u32x4){PKW(pB0,0),PKW(pB0,2),PKW(pB0,4),PKW(pB0,6)};pw1=(u32x4){PKW(pB0,8),PKW(pB0,10),PKW(pB0,12),PKW(pB0,14)};pw2=(u32x4){PKW(pB1,0),PKW(pB1,2),PKW(pB1,4),PKW(pB1,6)};pw3=(u32x4){PKW(pB1,8),PKW(pB1,10),PKW(pB1,12),PKW(pB1,14)};
    SBAR(); pv(o,vb0+sl_cur,PAF(0),PAF(1),PAF(2),PAF(3)); }
  #undef PKW
  #undef PAF
  #undef VFR
  #undef PIN
  #undef MX3
  #undef GAPA
  #undef GAPB
  #undef EX
  #undef VRD
  #undef KRD
  #undef STEP
  #undef ENDW
  {auto rr=__builtin_amdgcn_permlane32_swap(__float_as_uint(l_reg),__float_as_uint(l_reg),false,false);l_reg=__uint_as_float(rr[0])+__uint_as_float(rr[1]);}
  if(hi==0)wsf[32+r32]=l_reg;asm volatile("s_waitcnt lgkmcnt(0)":::"memory");
  float rli[16];
  #pragma unroll
  for(int r=0;r<16;++r)rli[r]=__builtin_amdgcn_rcpf(wsf[32+crow(r,hi)]);
  bf16*Ow=O+(rowbase+q0+wid*QBLK)*OPITCH+h*D;
  { bf16*stg=(bf16*)(shm+LDS_OST)+wid*2048;
    #pragma unroll
    for(int r=0;r<16;++r){const int orow=crow(r,hi);
      #pragma unroll
      for(int d0=0;d0<2;++d0)stg[orow*64+d0*32+r32]=__float2bfloat16(o[d0][r]*rli[r]);}
    asm volatile("s_waitcnt lgkmcnt(0)":::"memory");
    #pragma unroll
    for(int i=0;i<4;++i){const int row=i*8+(lane>>3),ch=lane&7; const u32x4 v=*(const u32x4*)(stg+row*64+ch*8); ATTN_STORE16(Ow+(long)row*OPITCH+ch*8,v);} }
  asm volatile("s_waitcnt lgkmcnt(0)\n\ts_barrier":::"memory");
  #undef DMA_K
  #undef DMA_V
  #undef BIASMASK
  #undef START
  #undef RESC
  #undef ROT
}
constexpr int ATTN_LDS_BYTES=LDS_BYTES;
struct AttnUnit { int bh; int qb; };
__device__ __forceinline__ void attn_phase(char*lds,const bf16*Q,const bf16*K,const bf16*V,bf16*O,const float*gtab,const float*gcinit,int grid,int block,int tid){
  const int vcu=(block%8)*(grid/8)+block/8, s_=vcu&3, bh=vcu>>2, h=bh&7, b=bh>>3;
  { const f32x4_t* src=(const f32x4_t*)(gtab+(size_t)h*(4*BT_COPY)); __attribute__((address_space(3))) f32x4_t* dst=(__attribute__((address_space(3))) f32x4_t*)((lds_cptr)lds+LDS_BT);
    if(tid<BT_BYTES/16)dst[tid]=src[tid]; }
  const float cinit=__builtin_bit_cast(float,__builtin_amdgcn_readfirstlane(__builtin_bit_cast(int,gcinit[h])));
  asm volatile("s_waitcnt vmcnt(0) lgkmcnt(0)\n\ts_barrier":::"memory");
  for(int i=0;i<4;++i){ const int qb=(i==0)?s_:(i==1)?7-s_:(i==2)?8+s_:15-s_; attn_unit(b,h,qb,Q,K,V,O,lds,cinit,tid); }
}
#undef SBAR
#undef WAIT_BAR
}

struct Args {
    const float *x, *p, *g_mix, *w_in, *b_in, *g_q, *g_k, *rel_bias, *conv_w, *conv_b, *w_pa, *w_pc, *w_o, *g_ffn, *w_group, *b_group, *w_router, *b_router, *w1, *w3, *w2, *g_ple, *w_pg, *b_pg, *w_pp;
    float* out; unsigned char* ws;
};
constexpr int NWAVES = 8, NTHREADS = 512;
constexpr int RING_BYTES = 131072, MISC_OFF = 139264, WSCR = 16640;
constexpr int LDS_BYTES = 163840; static_assert(META_HI + 2048 <= LDS_BYTES, "MoE metadata area");

__device__ __forceinline__ void transpose_item(const float* src, int ldw, bf16_t* dst, int ldT, LAS float* scr, int lane, const float* gain = nullptr, int hi_off = 0) {
    float v[64];
#pragma unroll
    for (int i = 0; i < 64; ++i) v[i] = src[(size_t)i * ldw + lane];
    if (gain) {
#pragma unroll
        for (int i = 0; i < 64; ++i) v[i] *= gain[i];
    }
#pragma unroll
    for (int i = 0; i < 64; ++i) scr[i * 65 + lane] = v[i];
    LDS_WAIT(); asm volatile("" ::: "memory");
    const int c = lane & 7;
#pragma unroll
    for (int j = 0; j < 8; ++j) { const int n = (lane >> 3) + 8 * j; const LAS float* s = scr + (8 * c) * 65 + n;
        u32x4 o; o.x = pk2(s[0 * 65], s[1 * 65]); o.y = pk2(s[2 * 65], s[3 * 65]); o.z = pk2(s[4 * 65], s[5 * 65]); o.w = pk2(s[6 * 65], s[7 * 65]);
        *(u32x4*)(dst + (size_t)(n + (n >= 32 ? hi_off : 0)) * ldT + 8 * c) = o; }
    LDS_WAIT(); asm volatile("" ::: "memory");
}
__device__ __forceinline__ void transpose_item_f8(const float* src, int ldw, unsigned char* dst, int ldTb, LAS float* scr, int lane, const float* gain, float sc) {
    float v[64];
#pragma unroll
    for (int i = 0; i < 64; ++i) v[i] = src[(size_t)i * ldw + lane];
#pragma unroll
    for (int i = 0; i < 64; ++i) scr[i * 65 + lane] = v[i] * (gain ? gain[i] : 1.0f) * sc;
    LDS_WAIT(); asm volatile("" ::: "memory");
    const int c = lane & 3;
#pragma unroll
    for (int j = 0; j < 4; ++j) { const int n = (lane >> 2) + 16 * j; const LAS float* s = scr + (16 * c) * 65 + n; unsigned w[4];
#pragma unroll
        for (int e = 0; e < 4; ++e) w[e] = pk4_fp8(s[(4 * e) * 65], s[(4 * e + 1) * 65], s[(4 * e + 2) * 65], s[(4 * e + 3) * 65]);
        *(u32x4*)(dst + (size_t)n * ldTb + 16 * c) = (u32x4){w[0], w[1], w[2], w[3]}; }
    LDS_WAIT(); asm volatile("" ::: "memory");
}
__device__ __forceinline__ void transpose_item_q8(const float* src, int ldw, signed char* dst, int ldTb, LAS float* scr, int lane, const float* gain, const float* cmax) {
    float v[64];
#pragma unroll
    for (int i = 0; i < 64; ++i) v[i] = src[(size_t)i * ldw + lane];
    const float sc = 127.0f / fmaxf(__builtin_bit_cast(float, __hip_atomic_load((const unsigned*)cmax + lane, __ATOMIC_RELAXED, __HIP_MEMORY_SCOPE_AGENT)), 1e-30f);
#pragma unroll
    for (int i = 0; i < 64; ++i) scr[i * 65 + lane] = v[i] * gain[i] * sc;
    LDS_WAIT(); asm volatile("" ::: "memory");
    const int c = lane & 3;
#pragma unroll
    for (int j = 0; j < 4; ++j) { const int n = (lane >> 2) + 16 * j; const LAS float* s = scr + (16 * c) * 65 + n; unsigned w[4];
#pragma unroll
        for (int e = 0; e < 4; ++e) { const int q0 = __float2int_rn(s[(4 * e) * 65]), q1 = __float2int_rn(s[(4 * e + 1) * 65]), q2 = __float2int_rn(s[(4 * e + 2) * 65]), q3 = __float2int_rn(s[(4 * e + 3) * 65]);
            w[e] = (unsigned)(q0 & 0xff) | ((unsigned)(q1 & 0xff) << 8) | ((unsigned)(q2 & 0xff) << 16) | ((unsigned)(q3 & 0xff) << 24); }
        *(u32x4*)(dst + (size_t)n * ldTb + 16 * c) = (u32x4){w[0], w[1], w[2], w[3]}; }
    LDS_WAIT(); asm volatile("" ::: "memory");
}
__device__ __forceinline__ void colmax_item(const float* src, int ldw, int lane, const float* gain, unsigned* cmax) {
    float v[64]; float m = 0.f;
#pragma unroll
    for (int i = 0; i < 64; ++i) v[i] = src[(size_t)i * ldw + lane];
#pragma unroll
    for (int i = 0; i < 64; ++i) m = fmaxf(m, fabsf(v[i] * gain[i]));
    atomicMax(cmax + lane, __builtin_bit_cast(unsigned, m));
}
__device__ __forceinline__ int win_phys_row(int n) { const int l = n & 255; return (n & ~255) | (((l >> 5) & 1) << 7) | (((l >> 6) & 3) << 5) | (l & 31); }

__device__ __forceinline__ void row2_to_bf16_rstd(const float* xrow, bf16_t* orow, float* rstd2, int lane, unsigned char* qrow = nullptr) {
    const f32x4* xr = (const f32x4*)xrow + lane;
    f32x4 v[2][4]; float s0 = 0.f, s1 = 0.f;
#pragma unroll
    for (int j = 0; j < 4; ++j) { v[0][j] = xr[64 * j]; v[1][j] = xr[256 + 64 * j]; }
    unsigned long long* o8 = (unsigned long long*)orow + lane;
#pragma unroll
    for (int j = 0; j < 4; ++j) { s0 += (v[0][j].x * v[0][j].x + v[0][j].y * v[0][j].y) + (v[0][j].z * v[0][j].z + v[0][j].w * v[0][j].w); s1 += (v[1][j].x * v[1][j].x + v[1][j].y * v[1][j].y) + (v[1][j].z * v[1][j].z + v[1][j].w * v[1][j].w);
        o8[64 * j] = (unsigned long long)pk2(v[0][j].x, v[0][j].y) | ((unsigned long long)pk2(v[0][j].z, v[0][j].w) << 32);
        o8[256 + 64 * j] = (unsigned long long)pk2(v[1][j].x, v[1][j].y) | ((unsigned long long)pk2(v[1][j].z, v[1][j].w) << 32);
        if (qrow) { ((unsigned*)qrow)[64 * j + lane] = pk4_fp8(v[0][j].x, v[0][j].y, v[0][j].z, v[0][j].w); ((unsigned*)qrow)[256 + 64 * j + lane] = pk4_fp8(v[1][j].x, v[1][j].y, v[1][j].z, v[1][j].w); } }
    s0 = wave_sum(s0); s1 = wave_sum(s1);
    if (lane == 0) { rstd2[0] = rsqrtf(s0 * (1.f / D) + EPS); rstd2[1] = rsqrtf(s1 * (1.f / D) + EPS); }
}


typedef __attribute__((address_space(4))) const Args* KArgPtr;
__device__ __forceinline__ KArgPtr kargs() { KArgPtr p = (KArgPtr)__builtin_amdgcn_kernarg_segment_ptr(); asm volatile("" : "+s"(p)); return p; }
#define ctl ((unsigned*)(ws + WS_CTL))
#define wrt ((float*)(ws + WS_TAB))
#define eslot ((int*)(ws + WS_ESLOT))
#define ew ((float*)(ws + WS_EW))
#define Win_t ((bf16_t*)(ws + WS_WIN))
#define Wm_t ((bf16_t*)(ws + WS_WM))
#define Wo_t ((bf16_t*)(ws + WS_WO))
#define Wgp8 ((unsigned char*)(ws + WS_WGP))
#define hp8 ((unsigned char*)(ws + WS_HP))
#define h2b ((bf16_t*)(ws + WS_H2B))
#define xb ((bf16_t*)(ws + WS_XB))
#define A1 ((bf16_t*)(ws + WS_A1))
#define B1 ((bf16_t*)(ws + WS_B1))
#define C1 ((bf16_t*)(ws + WS_C1))
#define sga ((bf16_t*)(ws + WS_SGA))
#define sgc ((bf16_t*)(ws + WS_SGC))
#define mbuf ((bf16_t*)(ws + WS_M))
#define h1b ((bf16_t*)(ws + WS_H1B))
#define rstdv ((float*)(ws + WS_RSTD))
#define W13_t ((bf16_t*)(ws + WS_W13))
#define W2_t ((bf16_t*)(ws + WS_W2))
#define xs ((bf16_t*)(ws + WS_XS))
#define hdn ((bf16_t*)(ws + WS_HDN))
#define contrib ((bf16_t*)(ws + WS_CONTRIB))
#define tile0 ((LAS float*)lds)
#define tile1 (tile0 + 64 * 65)
#define pref ((LAS int*)(lds + MISC_OFF))
#define cnts (pref + 64)
__global__ void __launch_bounds__(NTHREADS, 2) fwd_kernel(Args a) {
    extern __shared__ __attribute__((aligned(16))) unsigned char lds_raw[];
    cg::grid_group grid = cg::this_grid();
    LAS unsigned char* lds = (LAS unsigned char*)lds_raw;
    const int G = gridDim.x, bx = blockIdx.x;
    const int wave_s = __builtin_amdgcn_readfirstlane((int)threadIdx.x >> 6);
    volatile LAS unsigned* bst = (volatile LAS unsigned*)(lds + MISC_OFF + 512);
    if (threadIdx.x < 2) bst[threadIdx.x] = 0u;
    __syncthreads();
    const XcdBarrier bar = xcd_barrier_post((unsigned*)(a.ws + WS_CTL) + CW_BAR, bst);
#ifndef PROBE_A
#define PROBE_A -1
#endif
#ifndef PROBE_B
#define PROBE_B -1
#endif
#define STAMP(i) do { if (PROBE_A >= 0 && bx == 0) { int t_ = lane_id_fresh(); if (wave_s == 0 && t_ == 0) ((volatile LAS unsigned long long*)(lds + MISC_OFF + 1024))[i] = __builtin_amdgcn_s_memrealtime(); } } while (0)
#define XBAR() do { int t_ = (wave_s << 6) | lane_id_fresh(); xcd_barrier(bar, t_); } while (0)
    STAMP(0);
#define PHASE_VARS() const KArgPtr ap = kargs(); unsigned char* const ws = ap->ws; (void)ws; int tid = (wave_s << 6) | lane_id_fresh(); asm volatile("" : "+v"(tid)); const int lane = tid & 63, wave = __builtin_amdgcn_readfirstlane(tid >> 6); \
    const int gw = bx * NWAVES + wave, NGW = G * NWAVES; const size_t gtid = (size_t)bx * NTHREADS + tid, GT = (size_t)G * NTHREADS; (void)lane; (void)gw; (void)NGW; (void)gtid; (void)GT
    {
        PHASE_VARS();
        LAS float* scr = (LAS float*)(lds + wave * WSCR);
        constexpr int I_IN = 16 * 80, I_PA = 8 * 16, I_PC = 8 * 16, I_O = 16 * 16, I_PG = 16 * 16, I_PP = 4 * 16;
        constexpr int NIT = I_IN + I_PA + I_PC + I_O + I_PG + I_PP;
        for (int it = gw; it < NIT; it += NGW) {
            int r = it;
            if (r < I_IN) { const int kb_ = r / 80, nb = r % 80;
#if F8_GATES
                if (nb >= 48) { transpose_item_f8(ap->w_in + (size_t)(kb_ * 64) * NIN + nb * 64, NIN, (unsigned char*)(Win_t + (size_t)3072 * D) + (size_t)((nb - 48) * 64) * D + kb_ * 64, D, scr, lane, ap->g_mix + kb_ * 64, F8W); continue; }
#endif
#if CU_PAIR
                if ((nb >= 24 && nb < 32) || (nb >= 40 && nb < 48)) { const int cg_ = nb >= 40, c = (nb - (cg_ ? 40 : 24)) * 64, t4 = c >> 7, pn_ = t4 < 2 ? 6 + t4 : 8 + t4;
                    transpose_item(ap->w_in + (size_t)(kb_ * 64) * NIN + nb * 64, NIN, Win_t + (size_t)(pn_ * 256 + cg_ * 128 + (c & 127)) * D + kb_ * 64, D, scr, lane, ap->g_mix + kb_ * 64, 0); continue; }
#endif
                transpose_item(ap->w_in + (size_t)(kb_ * 64) * NIN + nb * 64, NIN, Win_t + (size_t)win_phys_row(nb * 64) * D + kb_ * 64, D, scr, lane, ap->g_mix + kb_ * 64, 96); continue; } r -= I_IN;
            if (r < I_PA) { const int kb_ = r / 16, nb = r % 16; transpose_item(ap->w_pa + (size_t)(kb_ * 64) * D + nb * 64, D, Wm_t + (size_t)(nb * 64) * D + kb_ * 64, D, scr, lane); continue; } r -= I_PA;
            if (r < I_PC) { const int kb_ = r / 16, nb = r % 16; transpose_item(ap->w_pc + (size_t)(kb_ * 64) * D + nb * 64, D, Wm_t + (size_t)(nb * 64) * D + 512 + kb_ * 64, D, scr, lane); continue; } r -= I_PC;
            if (r < I_O) { const int kb_ = r / 16, nb = r % 16; transpose_item(ap->w_o + (size_t)(kb_ * 64) * D + nb * 64, D, Wo_t + (size_t)(nb * 64) * D + kb_ * 64, D, scr, lane); continue; } r -= I_O;
            if (r < I_PG) { const int kb_ = r / 16, nb = r % 16; colmax_item(ap->w_pg + (size_t)(kb_ * 64) * D + nb * 64, D, lane, ap->g_ple + kb_ * 64, ctl + CW_CMAXP + nb * 64); continue; } r -= I_PG;
            { const int kb_ = r / 16, nb = r % 16; transpose_item(ap->w_pp + (size_t)(kb_ * 64) * D + nb * 64, D, (bf16_t*)Wgp8 + (size_t)(nb * 64) * HPE + 512 + kb_ * 64, HPE, scr, lane); }
        }
        const size_t rtid = (size_t)(G - 1 - bx) * NTHREADS + tid; const int rgw = (G - 1 - bx) * NWAVES + wave;
        for (size_t i = rtid; i < (size_t)3 * 32 * 64 * 8; i += GT) { const int j = (int)(i & 7), ln = (int)((i >> 3) & 63), s_ = (int)((i >> 9) & 31), nt = (int)(i >> 14);
            const int k = 32 * s_ + 8 * (ln >> 4) + j, col = 16 * nt + (ln & 15);
            wrt[i] = col < 4 ? ap->w_group[k * 4 + col] : (col < 36 ? ap->w_router[k * 32 + (col - 4)] : 0.f); }
        { float* gtab = (float*)(ws + WS_GTAB); float* gcinit = (float*)(ws + WS_GCINIT);
          for (size_t i = rtid; i < (size_t)NH * 4 * 384; i += GT) { const int h = (int)(i / 1536), s_ = (int)((i / 384) & 3), y = (int)(i % 384), x = y + s_;
              int dd = 319 - x; dd = dd < -63 ? -63 : (dd > 256 ? 256 : dd);
              gtab[i] = x <= 382 ? (ap->rel_bias[h * NREL + dd + 63] - ap->rel_bias[h * NREL + 319]) * LOG2E : 0.f; }
          if (rgw < NH) { const int h = rgw;
              float gq = fabsf(ap->g_q[lane]), gk = fabsf(ap->g_k[lane]), mb = -3.0e38f;
#pragma unroll
              for (int j = 0; j < 5; ++j) mb = fmaxf(mb, ap->rel_bias[h * NREL + lane + 64 * j]);
#pragma unroll
              for (int o = 1; o < 64; o <<= 1) { gq = fmaxf(gq, __shfl_xor(gq, o)); gk = fmaxf(gk, __shfl_xor(gk, o)); mb = fmaxf(mb, __shfl_xor(mb, o)); }
              if (lane == 0) gcinit[h] = ap->rel_bias[h * NREL + 319] * LOG2E - (64.f * C2 * gq * gk + mb * LOG2E); } }
        STAMP(12);
        for (int m = 2 * gw; m < T; m += 2 * NGW) row2_to_bf16_rstd(ap->x + (size_t)m * D, xb + (size_t)m * D, rstdv + m, lane, F8_GATES ? ws + WS_XQ + (size_t)m * D : nullptr);
    }
    if (G == 0x7fffff) grid.sync();
    XBAR();
    STAMP(1);

#if F8_GATES
    { PHASE_VARS(); pg8::Gemm g{xb, Win_t, T, 3072, D, D}; pg8::StaticOrder S; S.init(T, 3072, G, bx); EpiInproj E{ws, ap->b_in, ap->g_q, ap->g_k, rstdv};
      pg8::gemm_phase<EpiInproj, pg8::StaticOrder, true, true>(lds, g, S, E, tid); }
    { PHASE_VARS(); pg8::Gemm g{(const bf16_t*)(ws + WS_XQ), Win_t + (size_t)3072 * D, T, 2048, D / 2, D / 2}; StaticOrderId S; S.init(T, 2048, G, bx);
      EpiGateF8 E{(unsigned char*)sga, (unsigned char*)sgc, ap->b_in + 3072, rstdv};
      pg8::gemm_phase<EpiGateF8, StaticOrderId, true, true, 0, 3>(lds, g, S, E, tid); }
#else
    { PHASE_VARS(); pg8::Gemm g{xb, Win_t, T, NIN, D, D}; pg8::StaticOrder S; S.init(T, NIN, G, bx); EpiInproj E{ws, ap->b_in, ap->g_q, ap->g_k, rstdv};
      pg8::gemm_phase<EpiInproj, pg8::StaticOrder, true, true>(lds, g, S, E, tid); }
#endif
    XBAR();
    STAMP(2);

    {
        PHASE_VARS();
        for (size_t i = gtid; i < (size_t)T * (CW / 8); i += GT) {
            const int t = (int)(i >> 6), c8 = (int)(i & 63) * 8, s = t & (SEQ - 1);
            const size_t o = (size_t)t * D + c8;
#if CU_PAIR
            const u32x4 u0 = *(const u32x4*)(C1 + o), b0 = *(const u32x4*)(A1 + o + 512);
            u32x4 u1 = {0u, 0u, 0u, 0u}, u2 = u1;
            if (s >= 1) u1 = *(const u32x4*)(C1 + o - D);
            if (s >= 2) u2 = *(const u32x4*)(C1 + o - 2 * D);
#else
            const u32x4 u0 = *(const u32x4*)(C1 + o), g0 = *(const u32x4*)(C1 + o + 512), b0 = *(const u32x4*)(A1 + o + 512);
            u32x4 u1 = {0u, 0u, 0u, 0u}, g1 = u1, u2 = u1, g2 = u1;
            if (s >= 1) { u1 = *(const u32x4*)(C1 + o - D); g1 = *(const u32x4*)(C1 + o + 512 - D); }
            if (s >= 2) { u2 = *(const u32x4*)(C1 + o - 2 * D); g2 = *(const u32x4*)(C1 + o + 512 - 2 * D); }
#endif
            float y[8];
#pragma unroll
            for (int e = 0; e < 4; ++e) {
#pragma unroll
                for (int hh = 0; hh < 2; ++hh) {
                    const int c = c8 + 2 * e + hh;
#if CU_PAIR
                    const float cu0 = hh ? bf_hi(u0[e]) : bf_lo(u0[e]), cu1 = hh ? bf_hi(u1[e]) : bf_lo(u1[e]), cu2 = hh ? bf_hi(u2[e]) : bf_lo(u2[e]);
#else
                    const float cu0 = hh ? bf_hi(u0[e]) * bf_hi(g0[e]) : bf_lo(u0[e]) * bf_lo(g0[e]);
                    const float cu1 = hh ? bf_hi(u1[e]) * bf_hi(g1[e]) : bf_lo(u1[e]) * bf_lo(g1[e]);
                    const float cu2 = hh ? bf_hi(u2[e]) * bf_hi(g2[e]) : bf_lo(u2[e]) * bf_lo(g2[e]);
#endif
                    const float bgv = hh ? bf_hi(b0[e]) : bf_lo(b0[e]);
                    y[2 * e + hh] = bgv * (ap->conv_b[c] + ap->conv_w[c] * cu2 + ap->conv_w[CW + c] * cu1 + ap->conv_w[2 * CW + c] * cu0);
                }
            }
            u32x4 w; w.x = pk2(y[0], y[1]); w.y = pk2(y[2], y[3]); w.z = pk2(y[4], y[5]); w.w = pk2(y[6], y[7]);
            *(u32x4*)(A1 + o + 512) = w;
        }
        __syncthreads();
        attn_body::attn_phase((char*)lds_raw, (const attn_body::bf16*)A1, (const attn_body::bf16*)B1, (const attn_body::bf16*)(B1 + 512), (attn_body::bf16*)A1, (const float*)(ws + WS_GTAB), (const float*)(ws + WS_GCINIT), G, bx, tid);
    }
    XBAR();
    STAMP(3);

    { PHASE_VARS(); pg8::Gemm g{A1, Wm_t, T, D, D, D}; pg8::PairOrder S; S.init(T, D, G, bx); EpiMerge2 E{(const unsigned char*)sga, (const unsigned char*)sgc, mbuf};
      pg8::gemm_phase<EpiMerge2, pg8::PairOrder, true, true>(lds, g, S, E, tid); }
    XBAR();
    STAMP(4);

    { PHASE_VARS(); pg8::Gemm g{mbuf, Wo_t, T, D, D, D}; pg8::StaticOrder S; S.init(T, D, G, bx); EpiResBf16 E{xb, h1b, F8_MOE ? (unsigned char*)(ws + WS_H1F8) : (unsigned char*)nullptr};
      pg8::gemm_phase<EpiResBf16, pg8::StaticOrder, true, true>(lds, g, S, E, tid); }
    XBAR();
    STAMP(5);

    {
        PHASE_VARS();
        {
            LAS int* lcnt = (LAS int*)(lds + MISC_OFF + 2048); LAS int* lbase = lcnt + 32;
            if (tid < 32) lcnt[tid] = 0;
            __syncthreads();
            int ea = 0, eb = 0, ra = 0, rb = 0; float wa = 0.f, wb = 0.f;
            LAS float* lsc = (LAS float*)(lds + wave * WSCR);
            const int r = lane & 15, q = lane >> 4;
            for (int task = gw; task < T / 16; task += NGW) {
                const int row0 = task * 16;
                const GAS bf16_t* arow = (const GAS bf16_t*)h1b + (size_t)(row0 + r) * D + 8 * q;
                const GAS float* gp = (const GAS float*)ap->g_ffn + 8 * q;
                const GAS f32x4* bp = (const GAS f32x4*)wrt + 2 * lane;
                f32x4 acc0 = {0.f, 0.f, 0.f, 0.f}, acc1 = acc0, acc2 = acc0; float ss = 0.f;
                u32x4 acur[8], anxt[8]; f32x4 bc[2][3][2], bn[2][3][2];
#pragma unroll
                for (int i = 0; i < 8; ++i) acur[i] = *(const GAS u32x4*)(arow + 32 * i);
#pragma unroll
                for (int st = 0; st < 2; ++st)
#pragma unroll
                    for (int nt = 0; nt < 3; ++nt) { bc[st][nt][0] = bp[(nt * 32 + st) * 128]; bc[st][nt][1] = bp[(nt * 32 + st) * 128 + 1]; }
#pragma unroll 1
                for (int ch = 0; ch < 4; ++ch) {
                    const int chn = ch < 3 ? ch + 1 : 3;
#pragma unroll
                    for (int i = 0; i < 8; ++i) anxt[i] = *(const GAS u32x4*)(arow + 32 * (8 * chn + i));
#pragma unroll
                    for (int gq = 0; gq < 4; ++gq) {
                        const int s0 = 8 * ch + 2 * gq, sn = (s0 + 2 < 32) ? s0 + 2 : 30;
#pragma unroll
                        for (int st = 0; st < 2; ++st)
#pragma unroll
                            for (int nt = 0; nt < 3; ++nt) { bn[st][nt][0] = bp[(nt * 32 + sn + st) * 128]; bn[st][nt][1] = bp[(nt * 32 + sn + st) * 128 + 1]; }
#pragma unroll
                        for (int st = 0; st < 2; ++st) {
                            const int s_ = s0 + st;
                            const u32x4 aw = acur[2 * gq + st]; const f32x4 g0 = *(const GAS f32x4*)(gp + 32 * s_), g1 = *(const GAS f32x4*)(gp + 32 * s_ + 4);
                            float av[8] = {bf_lo(aw.x), bf_hi(aw.x), bf_lo(aw.y), bf_hi(aw.y), bf_lo(aw.z), bf_hi(aw.z), bf_lo(aw.w), bf_hi(aw.w)};
#pragma unroll
                            for (int j = 0; j < 8; ++j) { ss += av[j] * av[j]; av[j] *= (j < 4 ? g0[j & 3] : g1[j & 3]); }
#pragma unroll
                            for (int j = 0; j < 8; ++j) {
                                acc0 = __builtin_amdgcn_mfma_f32_16x16x4f32(av[j], bc[st][0][j >> 2][j & 3], acc0, 0, 0, 0);
                                acc1 = __builtin_amdgcn_mfma_f32_16x16x4f32(av[j], bc[st][1][j >> 2][j & 3], acc1, 0, 0, 0);
                                acc2 = __builtin_amdgcn_mfma_f32_16x16x4f32(av[j], bc[st][2][j >> 2][j & 3], acc2, 0, 0, 0);
                            }
                        }
#pragma unroll
                        for (int st = 0; st < 2; ++st)
#pragma unroll
                            for (int nt = 0; nt < 3; ++nt) { bc[st][nt][0] = bn[st][nt][0]; bc[st][nt][1] = bn[st][nt][1]; }
                        asm volatile("" ::: "memory");
                    }
#pragma unroll
                    for (int i = 0; i < 8; ++i) acur[i] = anxt[i];
                }
                ss += __shfl_xor(ss, 16); ss += __shfl_xor(ss, 32);
                const float rstd = rsqrtf(ss * (1.f / D) + EPS);
#pragma unroll
                for (int g_ = 0; g_ < 4; ++g_) { const float rs = __shfl(rstd, 4 * q + g_);
                    lsc[(4 * q + g_) * 48 + r] = acc0[g_] * rs; lsc[(4 * q + g_) * 48 + 16 + r] = acc1[g_] * rs; lsc[(4 * q + g_) * 48 + 32 + r] = acc2[g_] * rs; }
                LDS_WAIT(); asm volatile("" ::: "memory");
                if (lane < 16) {
                    const int m = row0 + lane; float lg[36];
#pragma unroll
                    for (int c = 0; c < 36; ++c) lg[c] = lsc[lane * 48 + c];
                    float gl[4];
#pragma unroll
                    for (int c = 0; c < 4; ++c) gl[c] = lg[c] + ap->b_group[c];
                    int grp = 0; float gmax = gl[0];
#pragma unroll
                    for (int c = 1; c < 4; ++c) if (gl[c] > gmax) { gmax = gl[c]; grp = c; }
                    float gs = 0.f;
#pragma unroll
                    for (int c = 0; c < 4; ++c) gs += __expf(gl[c] - gmax);
                    const float pgrp = 1.f / gs;
                    float el[8];
#pragma unroll
                    for (int c = 0; c < 8; ++c) { const float x0 = lg[4 + c], x1 = lg[12 + c], x2 = lg[20 + c], x3 = lg[28 + c]; el[c] = (grp == 0 ? x0 : grp == 1 ? x1 : grp == 2 ? x2 : x3) + ap->b_router[grp * 8 + c]; }
                    int i0 = 0; float l0 = el[0];
#pragma unroll
                    for (int c = 1; c < 8; ++c) if (el[c] > l0) { l0 = el[c]; i0 = c; }
                    int i1 = -1; float l1 = -3.0e38f;
#pragma unroll
                    for (int c = 0; c < 8; ++c) if (c != i0 && el[c] > l1) { l1 = el[c]; i1 = c; }
                    if (i1 < 0) i1 = i0 ? 0 : 1;
                    const float e1 = __expf(l1 - l0), w0 = pgrp / (1.f + e1), w1 = pgrp * e1 / (1.f + e1);
                    ea = grp * 8 + i0; eb = grp * 8 + i1;
                    ra = (int)__hip_atomic_fetch_add(&lcnt[ea], 1, __ATOMIC_RELAXED, __HIP_MEMORY_SCOPE_WORKGROUP); rb = (int)__hip_atomic_fetch_add(&lcnt[eb], 1, __ATOMIC_RELAXED, __HIP_MEMORY_SCOPE_WORKGROUP);
                    wa = w0; wb = w1;
                    rstdv[m] = rstd;
                }
                LDS_WAIT(); asm volatile("" ::: "memory");
            }
            __syncthreads();
            if (tid < 32) lbase[tid] = (int)atomicAdd(&ctl[tid * CNT_STRIDE], (unsigned)lcnt[tid]);
            __syncthreads();
            if (lane < 16) { const int m = gw * 16 + lane; const int ia = (ea << 15) | (lbase[ea] + ra), ib = (eb << 15) | (lbase[eb] + rb);
                eslot[ia] = 2 * m; ew[ia] = wa; eslot[ib] = 2 * m + 1; ew[ib] = wb; }
        }
        STAMP(11);
        LAS float* scr = (LAS float*)(lds + wave * WSCR);
        constexpr int I_13 = 16 * 8, PER_E = 2 * I_13;
        for (int it = gw; it < NE * PER_E; it += NGW) {
            const int e = it / PER_E; int r = it % PER_E;
            const int which = r / I_13; r %= I_13; const int kb_ = r / 8, nb = r % 8, j0 = nb * 64;
            const float* src = (which ? ap->w3 : ap->w1) + (size_t)e * D * DE + (size_t)(kb_ * 64) * DE + j0;
#if F8_MOE
            transpose_item_f8(src, DE, (unsigned char*)W13_t + (size_t)(e * 1024 + (j0 >> 7) * 256 + which * 128 + (j0 & 127)) * D + kb_ * 64, D, scr, lane, ap->g_ffn + kb_ * 64, F8W);
#else
            transpose_item(src, DE, W13_t + (size_t)(e * 1024 + (j0 >> 7) * 256 + which * 128 + (j0 & 127)) * D + kb_ * 64, D, scr, lane, ap->g_ffn + kb_ * 64);
#endif
        }
    }
    XBAR();
    STAMP(6);

    {
        PHASE_VARS();
        if (tid < NE) cnts[tid] = (int)__hip_atomic_load(&ctl[tid * CNT_STRIDE], __ATOMIC_RELAXED, __HIP_MEMORY_SCOPE_AGENT);
        __syncthreads();
        if (tid == 0) { int acc_ = 0; for (int e = 0; e < NE; ++e) { pref[e] = acc_; acc_ += (cnts[e] + 255) >> 8; } pref[NE] = acc_; }
        __syncthreads();
    }
    STAMP(7);
    const int ntiles = __builtin_amdgcn_readfirstlane(pref[NE]);

#if F8_MOE
    { PHASE_VARS(); pg8::Gemm g{(const bf16_t*)(ws + WS_H1F8), W13_t, XS_ROWS, NE * 1024, D / 2, D / 2}; moe_meta_preload(lds, pref, ntiles * 4, G, bx, eslot, rstdv, true, tid); MoeOrderT<true> S{pref, ntiles * 4, G, bx, lds}; EpiSwigluT<1> E{hdn, lds};
      pg8::gemm_phase<EpiSwigluT<1>, MoeOrderT<true>, true, true, 0, 3>(lds, g, S, E, tid); }
#else
    { PHASE_VARS(); pg8::Gemm g{h1b, W13_t, XS_ROWS, NE * 1024, D, D}; moe_meta_preload(lds, pref, ntiles * 4, G, bx, eslot, rstdv, true, tid); MoeOrderT<true> S{pref, ntiles * 4, G, bx, lds}; EpiSwigluT<0> E{hdn, lds};
      pg8::gemm_phase<EpiSwigluT<0>, MoeOrderT<true>, true, true>(lds, g, S, E, tid); }
#endif
    { PHASE_VARS();
      { const int nun = ntiles * 4, rem = nun % G, nf = rem ? G - rem : G, fb = rem ? bx - rem : bx;
        if (fb >= 0) {
            LAS float* scr = (LAS float*)(lds + wave * WSCR);
            for (int it = fb * NWAVES + wave; it < NE * 128; it += nf * NWAVES) { const int e = it >> 7, r = it & 127, kb_ = r / 16, nb = r % 16;
#if F8_MOE && F8_DOWN
                transpose_item_f8(ap->w2 + (size_t)e * DE * D + (size_t)(kb_ * 64) * D + nb * 64, D, (unsigned char*)W2_t + (size_t)(e * 1024 + nb * 64) * DE + kb_ * 64, DE, scr, lane, nullptr, F8W); }
#else
                transpose_item(ap->w2 + (size_t)e * DE * D + (size_t)(kb_ * 64) * D + nb * 64, D, W2_t + (size_t)(e * 1024 + nb * 64) * DE + kb_ * 64, DE, scr, lane); }
#endif
            for (size_t i = (size_t)fb * NTHREADS + tid; i < 1024; i += (size_t)nf * NTHREADS) ((float*)(ws + WS_CMAXF))[i] = __builtin_bit_cast(float, __hip_atomic_load(ctl + CW_CMAXP + i, __ATOMIC_RELAXED, __HIP_MEMORY_SCOPE_AGENT));
            for (int it = fb * NWAVES + wave; it < 16 * 16; it += nf * NWAVES) { const int kb_ = it / 16, nb = it % 16;
                transpose_item_q8(ap->w_pg + (size_t)(kb_ * 64) * D + nb * 64, D, (signed char*)Wgp8 + (size_t)(nb * 64) * HPB + kb_ * 64, HPB, scr, lane, ap->g_ple + kb_ * 64, (const float*)(ctl + CW_CMAXP) + nb * 64); }
            for (size_t i = (size_t)fb * NTHREADS + tid; i < (size_t)T * PLE / 8; i += (size_t)nf * NTHREADS) { const f32x4 v0 = ((const f32x4*)ap->p)[2 * i], v1 = ((const f32x4*)ap->p)[2 * i + 1];
                u32x4 o; o.x = pk2(v0.x, v0.y); o.y = pk2(v0.z, v0.w); o.z = pk2(v1.x, v1.y); o.w = pk2(v1.z, v1.w); *(u32x4*)(hp8 + (i >> 5) * HPB + 1024 + (i & 31) * 16) = o; }
        } } }
    XBAR();
    STAMP(8);

#if F8_MOE && F8_DOWN
    { PHASE_VARS(); pg8::Gemm g{hdn, W2_t, XS_ROWS, NE * 1024, DE / 2, DE / 2}; moe_meta_preload(lds, pref, ntiles * 4, G, bx, eslot, ew, false, tid); MoeOrderId S{{pref, ntiles * 4, G, bx, lds}}; EpiDownT<1> E{contrib, lds};
      pg8::gemm_phase<EpiDownT<1>, MoeOrderId, true, true, 0, 3>(lds, g, S, E, tid); }
#else
    { PHASE_VARS(); pg8::Gemm g{hdn, W2_t, XS_ROWS, NE * 1024, DE, DE}; moe_meta_preload(lds, pref, ntiles * 4, G, bx, eslot, ew, false, tid); MoeOrderT<false> S{pref, ntiles * 4, G, bx, lds}; EpiDownT<0> E{contrib, lds};
      pg8::gemm_phase<EpiDownT<0>, MoeOrderT<false>, true, true>(lds, g, S, E, tid); }
#endif
    XBAR();
    STAMP(9);

    { PHASE_VARS();
    for (int m0 = 2 * gw; m0 < T; m0 += 2 * NGW) {
#if F8_CONTRIB
        u32x2 hv[2][4]; unsigned p0[2][4], p1[2][4];
#pragma unroll
        for (int rr = 0; rr < 2; ++rr) { const int m = m0 + rr;
            const u32x2* xr = (const u32x2*)(h1b + (size_t)m * D) + lane;
            const unsigned* c0 = (const unsigned*)((const unsigned char*)contrib + (size_t)(2 * m) * D) + lane; const unsigned* c1 = (const unsigned*)((const unsigned char*)contrib + (size_t)(2 * m + 1) * D) + lane;
#pragma unroll
            for (int j = 0; j < 4; ++j) { hv[rr][j] = xr[64 * j]; p0[rr][j] = c0[64 * j]; p1[rr][j] = c1[64 * j]; } }
#else
        u32x2 hv[2][4], p0[2][4], p1[2][4];
#pragma unroll
        for (int rr = 0; rr < 2; ++rr) { const int m = m0 + rr;
            const u32x2* xr = (const u32x2*)(h1b + (size_t)m * D) + lane;
            const u32x2* c0 = (const u32x2*)(contrib + (size_t)(2 * m) * D) + lane; const u32x2* c1 = (const u32x2*)(contrib + (size_t)(2 * m + 1) * D) + lane;
#pragma unroll
            for (int j = 0; j < 4; ++j) { hv[rr][j] = xr[64 * j]; p0[rr][j] = c0[64 * j]; p1[rr][j] = c1[64 * j]; } }
#endif
#pragma unroll
        for (int rr = 0; rr < 2; ++rr) { const int m = m0 + rr; float s = 0.f, am = 0.f; f32x4 h[4];
            unsigned long long* o8 = (unsigned long long*)(h2b + (size_t)m * D) + lane;
#pragma unroll
            for (int j = 0; j < 4; ++j) {
#if F8_CONTRIB
                { const f32x2 a0 = __builtin_amdgcn_cvt_pk_f32_fp8((int)p0[rr][j], false), a1 = __builtin_amdgcn_cvt_pk_f32_fp8((int)p0[rr][j], true), b0 = __builtin_amdgcn_cvt_pk_f32_fp8((int)p1[rr][j], false), b1 = __builtin_amdgcn_cvt_pk_f32_fp8((int)p1[rr][j], true);
                  constexpr float k = 1.0f / CSC;
                  h[j].x = bf_lo(hv[rr][j].x) + (a0[0] + b0[0]) * k; h[j].y = bf_hi(hv[rr][j].x) + (a0[1] + b0[1]) * k; h[j].z = bf_lo(hv[rr][j].y) + (a1[0] + b1[0]) * k; h[j].w = bf_hi(hv[rr][j].y) + (a1[1] + b1[1]) * k; }
#else
                h[j].x = bf_lo(hv[rr][j].x) + bf_lo(p0[rr][j].x) + bf_lo(p1[rr][j].x); h[j].y = bf_hi(hv[rr][j].x) + bf_hi(p0[rr][j].x) + bf_hi(p1[rr][j].x);
                h[j].z = bf_lo(hv[rr][j].y) + bf_lo(p0[rr][j].y) + bf_lo(p1[rr][j].y); h[j].w = bf_hi(hv[rr][j].y) + bf_hi(p0[rr][j].y) + bf_hi(p1[rr][j].y);
#endif
                s += (h[j].x * h[j].x + h[j].y * h[j].y) + (h[j].z * h[j].z + h[j].w * h[j].w);
                am = fmaxf(fmaxf(am, fmaxf(fabsf(h[j].x), fabsf(h[j].y))), fmaxf(fabsf(h[j].z), fabsf(h[j].w)));
                o8[64 * j] = (unsigned long long)pk2(h[j].x, h[j].y) | ((unsigned long long)pk2(h[j].z, h[j].w) << 32); }
            s = wave_sum(s);
#pragma unroll
            for (int o = 1; o < 64; o <<= 1) am = fmaxf(am, __shfl_xor(am, o));
            const float qs = 127.0f / fmaxf(am, 1e-30f);
            unsigned* q4 = (unsigned*)(hp8 + (size_t)m * HPB) + lane;
#pragma unroll
            for (int j = 0; j < 4; ++j) { const int q0 = __float2int_rn(h[j].x * qs), q1 = __float2int_rn(h[j].y * qs), q2 = __float2int_rn(h[j].z * qs), q3 = __float2int_rn(h[j].w * qs);
                q4[64 * j] = (unsigned)(q0 & 0xff) | ((unsigned)(q1 & 0xff) << 8) | ((unsigned)(q2 & 0xff) << 16) | ((unsigned)(q3 & 0xff) << 24); }
            if (lane == 0) rstdv[m] = rsqrtf(s * (1.f / D) + EPS) * am * (1.0f / 127.0f); }
    } }
    XBAR();
    STAMP(10);

    { PHASE_VARS(); pg8::Gemm g{(const bf16_t*)hp8, (const bf16_t*)Wgp8, T, 2 * D, HPE, HPE}; pg8::StaticOrder S; S.init(T, 2 * D, G, bx);
      EpiGateDual E{h2b, rstdv, (const float*)(ws + WS_CMAXF), ap->b_pg, ap->out};
      pg8::gemm_phase<EpiGateDual, pg8::StaticOrder, true, true, 8, 2>(lds, g, S, E, tid); }
    STAMP(15);
    if (PROBE_A >= 0 && bx == 0) { int t_ = lane_id_fresh(); if (wave_s == 0 && t_ == 0) { volatile LAS unsigned long long* ts = (volatile LAS unsigned long long*)(lds + MISC_OFF + 1024);
        const unsigned long long d = 4ull * (ts[PROBE_B] - ts[PROBE_A]), t0 = __builtin_amdgcn_s_memrealtime(); while (__builtin_amdgcn_s_memrealtime() - t0 < d) __builtin_amdgcn_s_sleep(8); } }
}

extern "C" void kernel_launch(void* const* d_in, const int* in_sizes, int n_in, void* d_out, int out_size, void* d_ws, size_t ws_size, hipStream_t stream) {
    static int grid = 0;
    if (grid == 0) {
        if (n_in != 25 || out_size != T * D || ws_size < WS_END) { fprintf(stderr, "kernel_launch: unexpected shapes (n_in %d out %d ws %zu); nothing launched\n", n_in, out_size, ws_size); grid = -1; return; }
        int dev = 0, cus = 0, per_cu = 0;
        if (hipGetDevice(&dev) != hipSuccess || hipDeviceGetAttribute(&cus, hipDeviceAttributeMultiprocessorCount, dev) != hipSuccess) { grid = -1; return; }
        if (hipFuncSetAttribute((const void*)fwd_kernel, hipFuncAttributeMaxDynamicSharedMemorySize, LDS_BYTES) != hipSuccess) { fprintf(stderr, "kernel_launch: hipFuncSetAttribute failed\n"); grid = -1; return; }
        if (hipOccupancyMaxActiveBlocksPerMultiprocessor(&per_cu, (const void*)fwd_kernel, NTHREADS, LDS_BYTES) != hipSuccess || per_cu < 1) { fprintf(stderr, "kernel_launch: occupancy query says %d\n", per_cu); (void)hipGetLastError(); grid = -1; return; }
        if (cus != 256) { fprintf(stderr, "kernel_launch: built for a 256-CU device (got %d)\n", cus); grid = -1; return; }
        grid = cus;
    }
    if (grid < 0) return;
    if (hipMemsetAsync((char*)d_ws + WS_CTL, 0, CTL_ZERO_BYTES, stream) != hipSuccess) { fprintf(stderr, "kernel_launch: memset failed\n"); return; }
    Args a{};
    const float** f = (const float**)&a;
    for (int i = 0; i < 25; ++i) f[i] = (const float*)d_in[i];
    a.out = (float*)d_out; a.ws = (unsigned char*)d_ws;
    void* args[] = {&a};
    hipError_t e = hipLaunchCooperativeKernel((const void*)fwd_kernel, dim3(grid), dim3(NTHREADS), args, LDS_BYTES, stream);
    if (e != hipSuccess) fprintf(stderr, "kernel_launch: cooperative launch failed: %s (grid %d)\n", hipGetErrorString(e), grid);
}
```

```cpp
#include <hip/hip_runtime.h>
#include <hip/hip_cooperative_groups.h>
#include <cstdio>
#include <cstdint>
namespace cg = cooperative_groups;

#define GAS __attribute__((address_space(1)))
#define LAS __attribute__((address_space(3)))
typedef unsigned short bf16_t;
typedef short bf16x8 __attribute__((ext_vector_type(8)));
typedef float f32x4 __attribute__((ext_vector_type(4)));
typedef float f32x2 __attribute__((ext_vector_type(2)));
typedef unsigned u32x4 __attribute__((ext_vector_type(4)));
typedef unsigned u32x2 __attribute__((ext_vector_type(2)));
typedef int i32x4 __attribute__((ext_vector_type(4)));
typedef int i32x8 __attribute__((ext_vector_type(8)));
typedef GAS unsigned gu32;
#define RLX_AGENT __ATOMIC_RELAXED, __HIP_MEMORY_SCOPE_AGENT

constexpr int T = 32768, D = 1024, SEQ = 4096, NBATCH = 8;
constexpr int NIN = 5120, NH = 8, HD = 64, AW = 512, CW = 512;
constexpr int NE = 32, DE = 512, PLE = 256, NREL = 320;
constexpr int XS_ROWS = 65536 + NE * 256;
constexpr float EPS = 1e-6f;
constexpr float LOG2E = 1.4426950408889634f;
constexpr float C2 = 0.125f * LOG2E;

#ifndef F8_MOE
#define F8_MOE 1
#endif
#ifndef F8_GATES
#define F8_GATES 1
#endif
#ifndef CU_PAIR
#define CU_PAIR 1
#endif
#ifndef F8_CONTRIB
#define F8_CONTRIB 1
#endif
constexpr float CSC = 16.0f;
#ifndef F8_DOWN
#define F8_DOWN 1
#endif
constexpr float F8W = 32.0f;
constexpr size_t MiB = 1u << 20;
constexpr size_t WS_CTL = 0, CTL_ZERO_BYTES = 64 * 1024;
constexpr int CW_BAR = 4096, CNT_STRIDE = 64;
constexpr size_t WS_TAB = 1 * MiB;
constexpr size_t WS_GTAB = WS_TAB + 192 * 1024;
constexpr size_t WS_GCINIT = WS_GTAB + 8 * 4 * 384 * 4;
constexpr size_t WS_ROUTE = 2 * MiB;
constexpr size_t WS_CMAXF = 3 * MiB + 512 * 1024;
constexpr size_t WS_RSTD = 3 * MiB;
constexpr size_t WS_ROWMETA = 4 * MiB;
constexpr size_t WS_WIN = 6 * MiB;
constexpr size_t WS_WM = 16 * MiB;
constexpr size_t WS_WO = 18 * MiB;
constexpr size_t WS_WGP = 20 * MiB;
constexpr int HPB = 1536, HPE = HPB / 2;
constexpr size_t WS_HP = 24 * MiB;
constexpr size_t WS_H2B = 232 * MiB;
constexpr int CW_CMAXP = 14336;
constexpr int META_LO = 147456, META_HI = 147456 + 4 * 2048;
constexpr size_t WS_ESLOT = 72 * MiB, WS_EW = 76 * MiB;
constexpr size_t WS_XQ = 24 * MiB;
constexpr size_t WS_XB = 104 * MiB;
constexpr size_t WS_A1 = 168 * MiB;
constexpr size_t WS_B1 = 232 * MiB;
constexpr size_t WS_C1 = 296 * MiB;
constexpr size_t WS_SGA = 360 * MiB, WS_SGC = 424 * MiB;
constexpr size_t WS_M = WS_B1;
constexpr size_t WS_H1F8 = WS_A1;
constexpr size_t WS_H1B = WS_SGC;
constexpr size_t WS_W13 = WS_SGA;
constexpr size_t WS_W2 = 320 * MiB;
constexpr size_t WS_XS = 104 * MiB;
constexpr size_t WS_HDN = 248 * MiB;
constexpr size_t WS_CONTRIB = 104 * MiB;
constexpr size_t WS_END = 488 * MiB;

__device__ __forceinline__ unsigned f2bf(float f) { unsigned u = __builtin_bit_cast(unsigned, f); return (u + 0x7fffu + ((u >> 16) & 1u)) >> 16; }
__device__ __forceinline__ unsigned pk2(float lo, float hi) { return f2bf(lo) | (f2bf(hi) << 16); }
__device__ __forceinline__ float bf_lo(unsigned w) { return __builtin_bit_cast(float, w << 16); }
__device__ __forceinline__ float bf_hi(unsigned w) { return __builtin_bit_cast(float, w & 0xffff0000u); }
__device__ __forceinline__ float bf2f(bf16_t h) { return __builtin_bit_cast(float, (unsigned)h << 16); }
__device__ __forceinline__ float sigmoidf_(float x) { return __builtin_amdgcn_rcpf(1.0f + __builtin_amdgcn_exp2f(-LOG2E * x)); }
__device__ __forceinline__ float wave_sum(float v) {
#pragma unroll
    for (int o = 1; o < 64; o <<= 1) v += __shfl_xor(v, o);
    return v;
}
__device__ __forceinline__ int lane_id_fresh() { int l; asm volatile("v_mbcnt_lo_u32_b32 %0, -1, 0\n\tv_mbcnt_hi_u32_b32 %0, -1, %0" : "=v"(l)); return l; }
__device__ __forceinline__ unsigned pk4_fp8(float a, float b, float c, float d) { unsigned w = (unsigned)__builtin_amdgcn_cvt_pk_fp8_f32(a, b, 0, false); return (unsigned)__builtin_amdgcn_cvt_pk_fp8_f32(c, d, (int)w, true); }
#define LDS_WAIT() asm volatile("s_waitcnt lgkmcnt(0)" ::: "memory")
#define VM_WAIT() asm volatile("s_waitcnt vmcnt(0)" ::: "memory")

namespace pg8 {
#define PG8_LAS __attribute__((address_space(3)))
constexpr int BM = 256, BK = 64, HALF = 128, HTB = HALF * BK * 2  , STAGE_BYTES = 8 * HTB, NXCD = 8, WGM = 8;

__host__ __device__ __forceinline__ int lds_byte(int r, int c) { const int st = (r >> 4) * 2 + (c >> 5), rr = r & 15, cc = c & 31, ob = rr * 64 + cc * 2; return st * 1024 + (ob ^ (((ob >> 9) & 1) << 5)); }
__host__ __device__ __forceinline__ void stage_rc(int b, int& R, int& C) { const int st = b / 1024, sb = b % 1024, swz = sb ^ (((sb >> 9) & 1) << 5); R = (st >> 1) * 16 + swz / 64; C = (st & 1) * 32 + (swz % 64) / 2; }
__host__ __device__ __forceinline__ int perm32(int rho) { const int n = rho >> 4, i = rho & 15; return 8 * (i >> 2) + 4 * n + (i & 3); }

struct Unit { int pm, pn, part; };
struct Gemm { const bf16_t* A; const bf16_t* Bt; int M, N, K, ld; };

struct StaticOrder {
    int nM, nN, nwg, G, c;
    __host__ __device__ void init(int M, int N, int G_, int c_) { nM = M / BM; nN = N / BM; nwg = nM * nN; G = G_; c = c_; }
    __host__ __device__ bool next(int i, Unit& u) const {
        const long L = (long)i * G + c; if (L >= nwg) return false;
        int wgid = (int)L; { const int q = nwg / NXCD, r = nwg % NXCD, xcd = wgid % NXCD, off = wgid / NXCD; wgid = (xcd < r ? xcd * (q + 1) : r * (q + 1) + (xcd - r) * q) + off; }
        const int nig = WGM * nN, gid = wgid / nig, fm = gid * WGM, gsz = (nM - fm) < WGM ? (nM - fm) : WGM;
        u.pm = fm + ((wgid % nig) % gsz); u.pn = (wgid % nig) / gsz; u.part = 0; return true;
    }
    static constexpr bool GATHER = false;
    __device__ __forceinline__ int row_of(const Unit&, int) const { return 0; }
    __device__ __forceinline__ void a_ready(const Unit&) const {}
    __device__ __forceinline__ void done(const Unit&) const {}
};
struct PairOrder : StaticOrder {
    __host__ __device__ bool next(int i, Unit& u) const { if (!StaticOrder::next(i >> 1, u)) return false; u.part = i & 1; return true; }
};
__device__ __forceinline__ unsigned cvt_pk_bf16(float lo, float hi) { unsigned r; asm volatile("v_cvt_pk_bf16_f32 %0, %1, %2" : "=v"(r) : "v"(lo), "v"(hi)); return r; }

template <class Epi> __device__ __forceinline__ size_t koff_of(const Epi& E, const Unit& u) { if constexpr (Epi::MULTI) return (size_t)E.kt0(u.part) * (size_t)(BK * 2); else return (size_t)0; }
template <class Epi, class Sched, bool ALIGN_EPI = false, bool SP2 = false, int DUAL_T = 0, int I8MODE = 0>
__device__ __forceinline__ void gemm_phase(PG8_LAS unsigned char* lds, const Gemm g, const Sched& S, const Epi& E, int tid_) {
    asm volatile("" : "+v"(tid_));
    const int tid = tid_, wid = __builtin_amdgcn_readfirstlane(tid >> 6), lane = tid & 63, wr = wid >> 2, wc = wid & 3, fr = lane & 15, fq = lane >> 4;
    int K = g.K; asm volatile("" : "+s"(K));
    int nt = K / BK; const int LD = g.ld;
#define PG8_KOFF(u) koff_of(E, u)
    constexpr bool GATHER = Sched::GATHER; static_assert(!GATHER || SP2, "GATHER is written for the SP2 loop");
    unsigned voffA[2], voffA1[2], voffB[2]; int gR[2], gC[2];
#pragma unroll
    for (int i = 0; i < 2; ++i) { int R, C; stage_rc(tid * 16 + i * 8192, R, C); const int Rb = Epi::PERM ? ((R & ~31) + perm32(R & 31)) : R; gR[i] = R; gC[i] = C;
        voffA[i] = (unsigned)(R * LD + C) * 2u; voffA1[i] = 0u; voffB[i] = (unsigned)(Rb * LD + C) * 2u; }
#define PG8_GOFF(slot, i) ((unsigned)((((slot) < 0 ? 0 : (slot)) >> 1) * LD + gC[i]) * 2u)
    const size_t kstep = (size_t)(BK * 2);
    const size_t hstep = (size_t)HALF * LD * 2;
    const size_t tstep = 2 * hstep;
    const size_t hstepB = DUAL_T ? 0 : hstep, tstepB = DUAL_T ? hstep : tstep;
    const unsigned ldsw = (unsigned)wid * 1024u;
    const int aoff = lds_byte(wr * 64 + fr, fq * 8), boff = lds_byte(wc * 32 + fr, fq * 8);
#define PG8_SA(b, h) (((b) * 2 + (h)) * HTB)
#define PG8_SB(b, h) ((4 + (b) * 2 + (h)) * HTB)
#define PG8_STAGE(bufoff, gbase, voff) do { _Pragma("unroll") for (int _i = 0; _i < 2; ++_i) \
        __builtin_amdgcn_global_load_lds((const unsigned*)((const char*)(gbase) + (voff)[_i]), (PG8_LAS unsigned*)(lds + (bufoff) + ldsw + _i * 8192), 16, 0, 0); } while (0)
#define PG8_LD32(p_) __builtin_shufflevector(*(const PG8_LAS i32x4*)(p_), *(const PG8_LAS i32x4*)((p_) + 1024), 0, 1, 2, 3, 4, 5, 6, 7)
#define PG8_LDA(dst, b, h) do { if constexpr (I8MODE == 3) { _Pragma("unroll") for (int m = 0; m < 4; ++m) dst##8[m] = PG8_LD32(lds + PG8_SA(b, h) + aoff + m * 2048); } else { \
        _Pragma("unroll") for (int m = 0; m < 4; ++m) _Pragma("unroll") for (int k = 0; k < 2; ++k) dst[m][k] = *(const PG8_LAS bf16x8*)(lds + PG8_SA(b, h) + aoff + m * 2048 + k * 1024); } } while (0)
#define PG8_LDB(dst, b, h) do { if constexpr (I8MODE == 3) { _Pragma("unroll") for (int n = 0; n < 2; ++n) dst##8[n] = PG8_LD32(lds + PG8_SB(b, h) + boff + n * 2048); } else { \
        _Pragma("unroll") for (int n = 0; n < 2; ++n) _Pragma("unroll") for (int k = 0; k < 2; ++k) dst[n][k] = *(const PG8_LAS bf16x8*)(lds + PG8_SB(b, h) + boff + n * 2048 + k * 1024); } } while (0)
#define PG8_MMA(ai, bj, At, Bt) do { __builtin_amdgcn_s_setprio(1); _Pragma("unroll") for (int m = 0; m < 4; ++m) _Pragma("unroll") for (int n = 0; n < 2; ++n) _Pragma("unroll") for (int k = 0; k < 2; ++k) \
        acc[ai][bj][m][n] = __builtin_amdgcn_mfma_f32_16x16x32_bf16(Bt[n][k], At[m][k], acc[ai][bj][m][n], 0, 0, 0); __builtin_amdgcn_s_setprio(0); } while (0)
#define PG8_MMA_I8(ai, bj, At, Bt) do { __builtin_amdgcn_s_setprio(1); _Pragma("unroll") for (int m = 0; m < 4; ++m) _Pragma("unroll") for (int n = 0; n < 2; ++n) _Pragma("unroll") for (int k = 0; k < 2; ++k) \
        acc[ai][bj][m][n] = __builtin_bit_cast(f32x4, __builtin_amdgcn_mfma_i32_16x16x64_i8(__builtin_bit_cast(i32x4, Bt[n][k]), __builtin_bit_cast(i32x4, At[m][k]), __builtin_bit_cast(i32x4, acc[ai][bj][m][n]), 0, 0, 0)); __builtin_amdgcn_s_setprio(0); } while (0)
#define PG8_MMA_F8(ai, bj, At, Bt) do { __builtin_amdgcn_s_setprio(1); _Pragma("unroll") for (int m = 0; m < 4; ++m) _Pragma("unroll") for (int n = 0; n < 2; ++n) \
        acc[ai][bj][m][n] = __builtin_amdgcn_mfma_scale_f32_16x16x128_f8f6f4(Bt##8[n], At##8[m], acc[ai][bj][m][n], 0, 0, 0, 0x7f7f7f7f, 0, 0x7f7f7f7f); __builtin_amdgcn_s_setprio(0); } while (0)
#define PG8_MMA2(ai) do { if constexpr (I8MODE == 3) { PG8_MMA_F8(ai, 0, At, B0); PG8_MMA_F8(ai, 1, At, B1); } else if constexpr (DUAL_T > 0) { if (t < DUAL_T) { if constexpr (I8MODE != 0) { PG8_MMA_I8(ai, 0, At, B0); } else { PG8_MMA(ai, 0, At, B0); } } else { if constexpr (I8MODE == 1) { PG8_MMA_I8(ai, 1, At, B0); } else { PG8_MMA(ai, 1, At, B0); } } } \
        else { if constexpr (I8MODE == 1) { PG8_MMA_I8(ai, 0, At, B0); PG8_MMA_I8(ai, 1, At, B1); } else { PG8_MMA(ai, 0, At, B0); PG8_MMA(ai, 1, At, B1); } } } while (0)
#define PG8_STAGE_B1(buf, base) do { if constexpr (!DUAL_T) { PG8_STAGE(buf, base, voffB); } } while (0)
#define PG8_WAIT_VD(n, nd) do { if constexpr (DUAL_T > 0) { asm volatile("s_waitcnt vmcnt(" #nd ")" ::: "memory"); } else { asm volatile("s_waitcnt vmcnt(" #n ")" ::: "memory"); } } while (0)
#define PG8_WAIT_V(n) asm volatile("s_waitcnt vmcnt(" #n ")" ::: "memory")
#define PG8_WAIT_L(n) asm volatile("s_waitcnt lgkmcnt(" #n ")" ::: "memory")
#define PG8_BAR __builtin_amdgcn_s_barrier()
#define PG8_SCHED __builtin_amdgcn_sched_barrier(0)
    Unit cur, nxt; int ui = 0;
    if (!S.next(0, cur)) return;
    f32x4 acc[2][2][4][2];
#pragma unroll
    for (int a = 0; a < 2; ++a)
#pragma unroll
        for (int b = 0; b < 2; ++b)
#pragma unroll
            for (int m = 0; m < 4; ++m)
#pragma unroll
                for (int n = 0; n < 2; ++n) acc[a][b][m][n] = (f32x4){0.f, 0.f, 0.f, 0.f};
    bf16x8 At[4][2], B0[2][2], B1[2][2]; i32x8 At8[4], B08[2], B18[2];
    const char* cA = (const char*)g.A + (GATHER ? (size_t)0 : (size_t)cur.pm * tstep) + PG8_KOFF(cur); const char* cB = (const char*)g.Bt + (size_t)cur.pn * tstepB + PG8_KOFF(cur);
    if constexpr (Epi::MULTI) { nt = E.nkt(cur.part); asm volatile("" : "+s"(nt)); }
    S.a_ready(cur);
    int ns[4] = {0, 0, 0, 0};
    if constexpr (GATHER) {
#pragma unroll
        for (int i = 0; i < 2; ++i) { voffA[i] = PG8_GOFF(S.row_of(cur, gR[i]), i); voffA1[i] = PG8_GOFF(S.row_of(cur, HALF + gR[i]), i); } }
#define PG8_STAGE_A1(buf, base) do { if constexpr (GATHER) { PG8_STAGE(buf, base, voffA1); } else { PG8_STAGE(buf, (base) + hstep, voffA); } } while (0)
    if constexpr (SP2) {
        PG8_STAGE(PG8_SB(0, 0), cB, voffB); PG8_STAGE_B1(PG8_SB(0, 1), cB + hstepB); PG8_STAGE(PG8_SA(0, 0), cA, voffA); PG8_STAGE_A1(PG8_SA(0, 1), cA);
        if (wr == 1) PG8_BAR;
        PG8_WAIT_V(2); PG8_BAR;
        PG8_STAGE(PG8_SB(1, 0), cB + kstep, voffB); PG8_STAGE(PG8_SA(1, 0), cA + kstep, voffA); PG8_STAGE_B1(PG8_SB(1, 1), cB + hstepB + kstep);
        PG8_WAIT_VD(6, 4); PG8_BAR;
    } else {
        PG8_STAGE(PG8_SB(0, 0), cB, voffB); PG8_STAGE(PG8_SA(0, 0), cA, voffA); PG8_STAGE(PG8_SB(0, 1), cB + hstepB, voffB); PG8_STAGE(PG8_SA(0, 1), cA + hstep, voffA);
        if (wr == 1) PG8_BAR;
        PG8_WAIT_V(4); PG8_BAR;
        PG8_STAGE(PG8_SB(1, 0), cB + kstep, voffB); PG8_STAGE(PG8_SA(1, 0), cA + kstep, voffA); PG8_STAGE(PG8_SB(1, 1), cB + hstepB + kstep, voffB);
        PG8_WAIT_V(6); PG8_BAR;
    }
    for (;;) {
        const bool has_next = S.next(ui + 1, nxt);
        if constexpr (GATHER) { if (has_next) {
#pragma unroll
            for (int i = 0; i < 2; ++i) { ns[i] = S.row_of(nxt, gR[i]); ns[2 + i] = S.row_of(nxt, HALF + gR[i]); } } }
        const char* nA = (has_next && !GATHER) ? (const char*)g.A + (size_t)nxt.pm * tstep + PG8_KOFF(nxt) : cA; const char* nB = has_next ? (const char*)g.Bt + (size_t)nxt.pn * tstepB + PG8_KOFF(nxt) : cB;
        for (int t = 0; t < nt; t += 2) {
            const bool last = (t == nt - 2);
            if constexpr (Epi::MID_T > 0) { if (t == Epi::MID_T) E.mid(acc, cur, wr, wc, fr, fq); }
            const char* a1 = cA + (size_t)(t + 1) * kstep;
            const char* a2 = last ? nA : cA + (size_t)(t + 2) * kstep; const char* b2 = last ? nB : cB + (size_t)(t + 2) * kstep;
            const char* a3 = a2 + kstep; const char* b3 = b2 + kstep;
            if (last && has_next) S.a_ready(nxt);
            if constexpr (SP2) {
            PG8_LDB(B0, 0, 0); if constexpr (!DUAL_T) PG8_LDB(B1, 0, 1); PG8_SCHED; PG8_LDA(At, 0, 0); PG8_STAGE_A1(PG8_SA(1, 1), a1);
            if constexpr (GATHER) { if (last && has_next) {
#pragma unroll
                for (int i = 0; i < 2; ++i) { voffA[i] = PG8_GOFF(ns[i], i); voffA1[i] = PG8_GOFF(ns[2 + i], i); } } }
            PG8_WAIT_VD(8, 6); PG8_WAIT_L(0); PG8_BAR; PG8_MMA2(0); PG8_BAR; PG8_SCHED;
            PG8_LDA(At, 0, 1); PG8_STAGE(PG8_SB(0, 0), b2, voffB); PG8_STAGE_B1(PG8_SB(0, 1), b2 + hstepB); PG8_STAGE(PG8_SA(0, 0), a2, voffA);
            PG8_WAIT_VD(8, 6); PG8_WAIT_L(0); PG8_BAR; PG8_MMA2(1); PG8_BAR; PG8_SCHED;
            PG8_LDB(B0, 1, 0); if constexpr (!DUAL_T) PG8_LDB(B1, 1, 1); PG8_SCHED; PG8_LDA(At, 1, 0); PG8_STAGE_A1(PG8_SA(0, 1), a2);
            PG8_WAIT_VD(8, 6); PG8_WAIT_L(0); PG8_BAR; PG8_MMA2(0); PG8_BAR; PG8_SCHED;
            PG8_LDA(At, 1, 1); PG8_STAGE(PG8_SB(1, 0), b3, voffB); PG8_STAGE_B1(PG8_SB(1, 1), b3 + hstepB); PG8_STAGE(PG8_SA(1, 0), a3, voffA);
            PG8_WAIT_VD(8, 6); PG8_WAIT_L(0); PG8_BAR; PG8_MMA2(1); PG8_BAR; PG8_SCHED;
            } else {
            PG8_LDB(B0, 0, 0); PG8_SCHED; PG8_LDA(At, 0, 0); PG8_STAGE(PG8_SA(1, 1), a1 + hstep, voffA);
            PG8_WAIT_L(8); PG8_BAR; PG8_WAIT_L(0); PG8_MMA(0, 0, At, B0); PG8_BAR; PG8_SCHED;
            PG8_LDB(B1, 0, 1); PG8_STAGE(PG8_SB(0, 0), b2, voffB);
            PG8_BAR; PG8_WAIT_L(0); PG8_MMA(0, 1, At, B1); PG8_BAR;
            PG8_LDA(At, 0, 1); PG8_STAGE(PG8_SA(0, 0), a2, voffA);
            PG8_BAR; PG8_WAIT_L(0); PG8_MMA(1, 0, At, B0); PG8_BAR; PG8_SCHED;
            PG8_STAGE(PG8_SB(0, 1), b2 + hstepB, voffB);
            PG8_WAIT_V(6); PG8_BAR; PG8_MMA(1, 1, At, B1); PG8_BAR;
            PG8_LDB(B0, 1, 0); PG8_SCHED; PG8_LDA(At, 1, 0); PG8_STAGE(PG8_SA(0, 1), a2 + hstep, voffA);
            PG8_WAIT_L(8); PG8_BAR; PG8_WAIT_L(0); PG8_MMA(0, 0, At, B0); PG8_BAR; PG8_SCHED;
            PG8_LDB(B1, 1, 1); PG8_STAGE(PG8_SB(1, 0), b3, voffB);
            PG8_BAR; PG8_WAIT_L(0); PG8_MMA(0, 1, At, B1); PG8_BAR;
            PG8_LDA(At, 1, 1); PG8_STAGE(PG8_SA(1, 0), a3, voffA);
            PG8_BAR; PG8_WAIT_L(0); PG8_MMA(1, 0, At, B0); PG8_BAR; PG8_SCHED;
            PG8_STAGE(PG8_SB(1, 1), b3 + hstepB, voffB);
            PG8_WAIT_V(6); PG8_BAR; PG8_MMA(1, 1, At, B1); PG8_BAR;
            }
        }
        if constexpr (ALIGN_EPI) { if (wr == 0) PG8_BAR; }
        if constexpr (!Epi::AFTER_DRAIN) { E(acc, cur, wr, wc, fr, fq); S.done(cur); }
        if (!has_next) break;
        bool zero_acc = true; if constexpr (Epi::MULTI) zero_acc = E.reset(cur.part);
        if (zero_acc) {
#pragma unroll
        for (int a = 0; a < 2; ++a)
#pragma unroll
            for (int b = 0; b < 2; ++b)
#pragma unroll
                for (int m = 0; m < 4; ++m)
#pragma unroll
                    for (int n = 0; n < 2; ++n) acc[a][b][m][n] = (f32x4){0.f, 0.f, 0.f, 0.f};
        }
        cur = nxt; cA = nA; cB = nB; ++ui;
        if constexpr (Epi::MULTI) { nt = E.nkt(cur.part); asm volatile("" : "+s"(nt)); }
        if constexpr (ALIGN_EPI) { if (wr == 1) PG8_BAR; }
    }
    PG8_WAIT_V(0);
    if constexpr (!ALIGN_EPI) { if (wr == 0) PG8_BAR; }
    PG8_BAR;
#undef PG8_SA
#undef PG8_SB
#undef PG8_STAGE
#undef PG8_LDA
#undef PG8_LD32
#undef PG8_LDB
#undef PG8_MMA
#undef PG8_MMA2
#undef PG8_MMA_I8
#undef PG8_MMA_F8
#undef PG8_KOFF
#undef PG8_STAGE_B1
#undef PG8_WAIT_VD
#undef PG8_STAGE_A1
#undef PG8_GOFF
#undef PG8_WAIT_V
#undef PG8_WAIT_L
#undef PG8_BAR
#undef PG8_SCHED
}
}

typedef f32x4 acc_t[2][2][4][2];
using pg8::Unit; using pg8::HALF; using pg8::BM;

struct EpiInproj {
    static constexpr bool PERM = true, AFTER_DRAIN = false; static constexpr bool MULTI = false; static constexpr int MID_T = 0;
    unsigned char* ws; const float* b_in; const float* g_q; const float* g_k; const float* rstdx;
    __device__ __forceinline__ void operator()(const acc_t& acc, const Unit& u, int wr, int wc, int fr, int fq) const {
        const int pn = u.pn;
        int mode, col0; size_t off;
        if (pn < 12) { const int seg = pn >> 1; mode = seg == 0 ? 1 : (seg == 1 ? 2 : 0); col0 = 256 * (pn & 1) + ((seg == 2 || seg == 4 || seg == 5) ? 512 : 0);
            off = (seg == 0 || seg == 4) ? WS_A1 : ((seg == 1 || seg == 2) ? WS_B1 : WS_C1);
            if (CU_PAIR && (seg == 3 || seg == 5)) mode = 4; }
        else if (pn < 16) { mode = 3; col0 = 256 * (pn - 12); off = WS_SGA; }
        else { mode = 3; col0 = 256 * (pn - 16); off = WS_SGC; }
        constexpr int pitch = 1024;
        bf16_t* base = (bf16_t*)(ws + off);
        const int lc0 = 64 * wc + 8 * fq;
        f32x4 bv[2][2], gv[2][2];
#pragma unroll
        for (int bj = 0; bj < 2; ++bj)
#pragma unroll
            for (int n = 0; n < 2; ++n) {
                bv[bj][n] = (mode == 4) ? *(const f32x4*)(b_in + (bj ? 2560 : 1536) + 128 * (pn < 8 ? pn - 6 : pn - 8) + 32 * wc + 8 * fq + 4 * n) : *(const f32x4*)(b_in + 256 * pn + lc0 + 32 * bj + 4 * n);
                const float* g = (mode == 2) ? g_k : g_q;
                gv[bj][n] = *(const f32x4*)(g + 8 * fq + 32 * bj + 4 * n);
            }
        const float qs = (mode == 1) ? C2 : 1.0f;
        float rsxv[2][4];
#pragma unroll
        for (int ai = 0; ai < 2; ++ai)
#pragma unroll
            for (int m = 0; m < 4; ++m) rsxv[ai][m] = rstdx[u.pm * BM + ai * HALF + wr * 64 + m * 16 + fr];
#pragma unroll
        for (int ai = 0; ai < 2; ++ai)
#pragma unroll
            for (int m = 0; m < 4; ++m) {
                const int row = u.pm * BM + ai * HALF + wr * 64 + m * 16 + fr; const float rsx = rsxv[ai][m];
                f32x4 v[2][2];
#pragma unroll
                for (int bj = 0; bj < 2; ++bj)
#pragma unroll
                    for (int n = 0; n < 2; ++n) v[bj][n] = acc[ai][bj][m][n] * rsx + bv[bj][n];
                if (mode == 1 || mode == 2) {
                    float ss = 0.f;
#pragma unroll
                    for (int bj = 0; bj < 2; ++bj)
#pragma unroll
                        for (int n = 0; n < 2; ++n) { const f32x4 x = v[bj][n]; ss += (x[0] * x[0] + x[1] * x[1]) + (x[2] * x[2] + x[3] * x[3]); }
                    ss += __shfl_xor(ss, 16); ss += __shfl_xor(ss, 32);
                    const float rstd = __frsqrt_rn(ss * (1.0f / 64.0f) + EPS) * qs;
#pragma unroll
                    for (int bj = 0; bj < 2; ++bj)
#pragma unroll
                        for (int n = 0; n < 2; ++n) v[bj][n] = v[bj][n] * rstd * gv[bj][n];
                } else if (mode == 3) {
#pragma unroll
                    for (int bj = 0; bj < 2; ++bj)
#pragma unroll
                        for (int n = 0; n < 2; ++n)
#pragma unroll
                            for (int j = 0; j < 4; ++j) v[bj][n][j] = sigmoidf_(v[bj][n][j]);
                }
                if (mode == 4) {
                    const f32x4 c0 = v[0][0] * v[1][0], c1 = v[0][1] * v[1][1];
                    u32x4 w; w.x = pg8::cvt_pk_bf16(c0[0], c0[1]); w.y = pg8::cvt_pk_bf16(c0[2], c0[3]); w.z = pg8::cvt_pk_bf16(c1[0], c1[1]); w.w = pg8::cvt_pk_bf16(c1[2], c1[3]);
                    *(u32x4*)((bf16_t*)(ws + WS_C1) + (size_t)row * pitch + 128 * (pn < 8 ? pn - 6 : pn - 8) + 32 * wc + 8 * fq) = w;
                    continue;
                }
                if (mode == 3) {
                    unsigned char* rp8 = (unsigned char*)base + (size_t)row * pitch + col0 + lc0; const float lo = (pn >= 16) ? 1.0f : 0.0f;
#pragma unroll
                    for (int bj = 0; bj < 2; ++bj) { unsigned w2[2];
#pragma unroll
                        for (int n = 0; n < 2; ++n) { unsigned b4 = 0;
#pragma unroll
                            for (int j = 0; j < 4; ++j) b4 |= (unsigned)__float2int_rn(fmaxf(v[bj][n][j] * 255.0f, lo)) << (8 * j);
                            w2[n] = b4; }
                        *(u32x2*)(rp8 + 32 * bj) = (u32x2){w2[0], w2[1]}; }
                    continue;
                }
                bf16_t* rowp = base + (size_t)row * pitch + col0 + lc0;
#pragma unroll
                for (int bj = 0; bj < 2; ++bj) {
                    u32x4 w; w.x = pg8::cvt_pk_bf16(v[bj][0][0], v[bj][0][1]); w.y = pg8::cvt_pk_bf16(v[bj][0][2], v[bj][0][3]); w.z = pg8::cvt_pk_bf16(v[bj][1][0], v[bj][1][1]); w.w = pg8::cvt_pk_bf16(v[bj][1][2], v[bj][1][3]);
                    *(u32x4*)(rowp + 32 * bj) = w;
                }
            }
    }
};

struct EpiGateF8 {
    static constexpr bool PERM = true, AFTER_DRAIN = false; static constexpr bool MULTI = false; static constexpr int MID_T = 0;
    unsigned char* sga8; unsigned char* sgc8; const float* bias; const float* rstdx;
    __device__ __forceinline__ void operator()(const acc_t& acc, const Unit& u, int wr, int wc, int fr, int fq) const {
        const int pn = u.pn; unsigned char* base = (pn < 4 ? sga8 : sgc8) + 256 * (pn & 3) + wc * 32 + 8 * fq; const float lo = (pn >= 4) ? 1.0f : 0.0f;
        f32x4 bv[2][2]; float rsxv[2][4];
#pragma unroll
        for (int bj = 0; bj < 2; ++bj)
#pragma unroll
            for (int n = 0; n < 2; ++n) bv[bj][n] = *(const f32x4*)(bias + 256 * pn + wc * 32 + 8 * fq + bj * HALF + 4 * n);
#pragma unroll
        for (int ai = 0; ai < 2; ++ai)
#pragma unroll
            for (int m = 0; m < 4; ++m) rsxv[ai][m] = rstdx[u.pm * BM + ai * HALF + wr * 64 + m * 16 + fr] * (1.0f / F8W);
#pragma unroll
        for (int ai = 0; ai < 2; ++ai)
#pragma unroll
            for (int m = 0; m < 4; ++m) {
                const int row = u.pm * BM + ai * HALF + wr * 64 + m * 16 + fr; const float rs = rsxv[ai][m];
#pragma unroll
                for (int bj = 0; bj < 2; ++bj) { unsigned w2[2];
#pragma unroll
                    for (int n = 0; n < 2; ++n) { unsigned b4 = 0;
#pragma unroll
                        for (int j = 0; j < 4; ++j) b4 |= (unsigned)__float2int_rn(fmaxf(sigmoidf_(acc[ai][bj][m][n][j] * rs + bv[bj][n][j]) * 255.0f, lo)) << (8 * j);
                        w2[n] = b4; }
                    *(u32x2*)(base + (size_t)row * 1024 + bj * HALF) = (u32x2){w2[0], w2[1]}; }
            }
    }
};

struct EpiMergeDual {
    static constexpr bool PERM = true, AFTER_DRAIN = false; static constexpr bool MULTI = false; static constexpr int MID_T = 0;
    const bf16_t* sga; const bf16_t* sgc; bf16_t* mout;
    __device__ __forceinline__ void operator()(const acc_t& acc, const Unit& u, int wr, int wc, int fr, int fq) const {
        const int col0 = u.pn * HALF + wc * 32 + 8 * fq;
#pragma unroll
        for (int ai = 0; ai < 2; ++ai)
#pragma unroll
            for (int m = 0; m < 4; ++m) {
                const size_t ro = (size_t)(u.pm * BM + ai * HALF + wr * 64 + m * 16 + fr) * D + col0;
                const u32x4 a = *(const u32x4*)(sga + ro), c = *(const u32x4*)(sgc + ro);
                const f32x4 x0 = acc[ai][0][m][0], x1 = acc[ai][0][m][1], y0 = acc[ai][1][m][0], y1 = acc[ai][1][m][1];
                u32x4 w;
                w.x = pg8::cvt_pk_bf16(x0[0] * bf_lo(a.x) + y0[0] * bf_lo(c.x), x0[1] * bf_hi(a.x) + y0[1] * bf_hi(c.x));
                w.y = pg8::cvt_pk_bf16(x0[2] * bf_lo(a.y) + y0[2] * bf_lo(c.y), x0[3] * bf_hi(a.y) + y0[3] * bf_hi(c.y));
                w.z = pg8::cvt_pk_bf16(x1[0] * bf_lo(a.z) + y1[0] * bf_lo(c.z), x1[1] * bf_hi(a.z) + y1[1] * bf_hi(c.z));
                w.w = pg8::cvt_pk_bf16(x1[2] * bf_lo(a.w) + y1[2] * bf_lo(c.w), x1[3] * bf_hi(a.w) + y1[3] * bf_hi(c.w));
                *(u32x4*)(mout + ro) = w;
            }
    }
};

struct EpiResBf16 {
    static constexpr bool PERM = true, AFTER_DRAIN = false; static constexpr bool MULTI = false; static constexpr int MID_T = 0;
    const bf16_t* xb; bf16_t* h1b; unsigned char* h1f8;
    __device__ __forceinline__ void operator()(const acc_t& acc, const Unit& u, int wr, int wc, int fr, int fq) const {
        const int col0 = u.pn * BM + wc * 32 + 8 * fq;
        u32x4 xv[2][4][2];
#pragma unroll
        for (int ai = 0; ai < 2; ++ai)
#pragma unroll
            for (int m = 0; m < 4; ++m)
#pragma unroll
                for (int bj = 0; bj < 2; ++bj) xv[ai][m][bj] = *(const u32x4*)(xb + (size_t)(u.pm * BM + ai * HALF + wr * 64 + m * 16 + fr) * D + col0 + bj * HALF);
#pragma unroll
        for (int ai = 0; ai < 2; ++ai)
#pragma unroll
            for (int m = 0; m < 4; ++m) {
                const size_t ro = (size_t)(u.pm * BM + ai * HALF + wr * 64 + m * 16 + fr) * D + col0;
#pragma unroll
                for (int bj = 0; bj < 2; ++bj) {
                    const u32x4 x = xv[ai][m][bj]; const f32x4 v0 = acc[ai][bj][m][0], v1 = acc[ai][bj][m][1];
                    u32x4 w; w.x = pg8::cvt_pk_bf16(v0[0] + bf_lo(x.x), v0[1] + bf_hi(x.x)); w.y = pg8::cvt_pk_bf16(v0[2] + bf_lo(x.y), v0[3] + bf_hi(x.y));
                    w.z = pg8::cvt_pk_bf16(v1[0] + bf_lo(x.z), v1[1] + bf_hi(x.z)); w.w = pg8::cvt_pk_bf16(v1[2] + bf_lo(x.w), v1[3] + bf_hi(x.w));
                    *(u32x4*)(h1b + ro + bj * HALF) = w;
                    if (h1f8) { u32x2 q; q.x = pk4_fp8(v0[0] + bf_lo(x.x), v0[1] + bf_hi(x.x), v0[2] + bf_lo(x.y), v0[3] + bf_hi(x.y)); q.y = pk4_fp8(v1[0] + bf_lo(x.z), v1[1] + bf_hi(x.z), v1[2] + bf_lo(x.w), v1[3] + bf_hi(x.w)); *(u32x2*)(h1f8 + ro + bj * HALF) = q; }
                }
            }
    }
};

__device__ __forceinline__ int moe_local(const LAS int* pref, int e, int rtg, int r) { const int l = (rtg - pref[e]) * pg8::BM + r; return l < pref[64 + e] ? ((e << 15) | l) : -1; }
__device__ __forceinline__ LAS u32x2* moe_meta(LAS unsigned char* lds, int i) { return (LAS u32x2*)(lds + (i < 4 ? META_LO + i * 2048 : META_HI)); }
__device__ __forceinline__ void moe_meta_preload(LAS unsigned char* lds, const LAS int* pref, int nunits, int G, int c, const int* eslot, const float* ftab, bool by_token, int tid) {
    for (int j = tid; j < 5 * 256; j += 512) { const int i = j >> 8, r = j & 255, L = i * G + c;
        int slot = -1; float f = 0.f;
        if (L < nunits) { const int rtg = L >> 2; int e = 0;
#pragma unroll 4
            for (int k = 1; k < NE; ++k) e += (pref[k] <= rtg) ? 1 : 0;
            const int idx = moe_local(pref, e, rtg, r);
            if (idx >= 0) { slot = eslot[idx]; f = by_token ? ftab[slot >> 1] : ftab[idx]; } }
        moe_meta(lds, i)[r] = (u32x2){(unsigned)slot, __builtin_bit_cast(unsigned, f)}; }
    __syncthreads();
}
template <int F8> struct EpiSwigluT {
    static constexpr bool PERM = true, AFTER_DRAIN = false; static constexpr bool MULTI = false; static constexpr int MID_T = 0;
    bf16_t* hdn; LAS unsigned char* lds; static constexpr float wsc = F8 ? 1.0f / F8W : 1.0f; static constexpr int f8out = F8 && F8_DOWN;
    __device__ __forceinline__ void operator()(const acc_t& acc, const Unit& u, int wr, int wc, int fr, int fq) const {
        const int col0 = 128 * (u.pn & 3) + wc * 32 + 8 * fq;
        float rsv[2][4]; const LAS float* mp = (const LAS float*)moe_meta(lds, u.part) + 1;
#pragma unroll
        for (int ai = 0; ai < 2; ++ai)
#pragma unroll
            for (int m = 0; m < 4; ++m) rsv[ai][m] = mp[2 * (ai * HALF + wr * 64 + m * 16 + fr)] * wsc;
#pragma unroll
        for (int ai = 0; ai < 2; ++ai)
#pragma unroll
            for (int m = 0; m < 4; ++m) {
                const int row = u.pm * BM + ai * HALF + wr * 64 + m * 16 + fr; const float rs = rsv[ai][m];
                const size_t ro = (size_t)row * DE + col0;
                float h[8];
#pragma unroll
                for (int n = 0; n < 2; ++n)
#pragma unroll
                    for (int j = 0; j < 4; ++j) { const float a = acc[ai][0][m][n][j] * rs, b = acc[ai][1][m][n][j] * rs; h[4 * n + j] = a * sigmoidf_(a) * b; }
                if (f8out) { u32x2 q; q.x = pk4_fp8(h[0], h[1], h[2], h[3]); q.y = pk4_fp8(h[4], h[5], h[6], h[7]); *(u32x2*)((unsigned char*)hdn + ro) = q; }
                else { u32x4 w; w.x = pg8::cvt_pk_bf16(h[0], h[1]); w.y = pg8::cvt_pk_bf16(h[2], h[3]); w.z = pg8::cvt_pk_bf16(h[4], h[5]); w.w = pg8::cvt_pk_bf16(h[6], h[7]);
                *(u32x4*)(hdn + ro) = w; }
            }
    }
};

template <int F8> struct EpiDownT {
    static constexpr bool PERM = true, AFTER_DRAIN = false; static constexpr bool MULTI = false; static constexpr int MID_T = 0;
    bf16_t* contrib; LAS unsigned char* lds; static constexpr float wsc = (F8 ? 1.0f / F8W : 1.0f) * (F8_CONTRIB ? CSC : 1.0f);
    __device__ __forceinline__ void operator()(const acc_t& acc, const Unit& u, int wr, int wc, int fr, int fq) const {
        const int col0 = 256 * (u.pn & 3) + wc * 32 + 8 * fq;
#pragma unroll
        for (int ai = 0; ai < 2; ++ai) {
            int sl[4]; float wv[4];
#pragma unroll
            for (int m = 0; m < 4; ++m) { const LAS unsigned* mq = (const LAS unsigned*)moe_meta(lds, u.part) + 2 * (ai * HALF + wr * 64 + m * 16 + fr); sl[m] = (int)mq[0]; wv[m] = __builtin_bit_cast(float, mq[1]) * wsc; }
#pragma unroll
            for (int m = 0; m < 4; ++m) {
                const int slot = sl[m]; const float w = wv[m];
                if (slot >= 0) {
#pragma unroll
                    for (int bj = 0; bj < 2; ++bj) {
                        const f32x4 v0 = acc[ai][bj][m][0] * w, v1 = acc[ai][bj][m][1] * w;
#if F8_CONTRIB
                        *(u32x2*)((unsigned char*)contrib + (size_t)slot * D + col0 + bj * HALF) = (u32x2){pk4_fp8(v0[0], v0[1], v0[2], v0[3]), pk4_fp8(v1[0], v1[1], v1[2], v1[3])};
#else
                        u32x4 o; o.x = pg8::cvt_pk_bf16(v0[0], v0[1]); o.y = pg8::cvt_pk_bf16(v0[2], v0[3]); o.z = pg8::cvt_pk_bf16(v1[0], v1[1]); o.w = pg8::cvt_pk_bf16(v1[2], v1[3]);
                        *(u32x4*)(contrib + (size_t)slot * D + col0 + bj * HALF) = o;
#endif
                    }
                }
                asm volatile("" ::: "memory");
            }
        }
    }
};

struct EpiGateDual {
    static constexpr bool PERM = false, AFTER_DRAIN = false; static constexpr bool MULTI = false; static constexpr int MID_T = 0;
    const bf16_t* h2b; const float* rsc; const float* cmax; const float* bpg; float* out;
    __device__ __forceinline__ void operator()(const acc_t& acc, const Unit& u, int wr, int wc, int fr, int fq) const {
        const int col0 = u.pn * HALF + wc * 32 + 4 * fq;
        f32x4 cs[2], bv[2]; float rsv[2][4]; u32x2 hv[2][4][2];
#pragma unroll
        for (int n = 0; n < 2; ++n) { cs[n] = *(const f32x4*)(cmax + col0 + n * 16) * (1.0f / 127.0f); bv[n] = *(const f32x4*)(bpg + col0 + n * 16); }
#pragma unroll
        for (int ai = 0; ai < 2; ++ai)
#pragma unroll
            for (int m = 0; m < 4; ++m) { const int row = u.pm * BM + ai * HALF + wr * 64 + m * 16 + fr; rsv[ai][m] = rsc[row];
#pragma unroll
                for (int n = 0; n < 2; ++n) hv[ai][m][n] = *(const u32x2*)(h2b + (size_t)row * D + col0 + n * 16); }
#pragma unroll
        for (int ai = 0; ai < 2; ++ai)
#pragma unroll
            for (int m = 0; m < 4; ++m) {
                const int row = u.pm * BM + ai * HALF + wr * 64 + m * 16 + fr; const float rs = rsv[ai][m];
#pragma unroll
                for (int n = 0; n < 2; ++n) {
                    const int c = col0 + n * 16;
                    const u32x2 hw = hv[ai][m][n];
                    const i32x4 ia = __builtin_bit_cast(i32x4, acc[ai][0][m][n]); const f32x4 pv = acc[ai][1][m][n];
                    f32x4 a; a[0] = (float)ia[0] * rs * cs[n][0] + bv[n][0]; a[1] = (float)ia[1] * rs * cs[n][1] + bv[n][1]; a[2] = (float)ia[2] * rs * cs[n][2] + bv[n][2]; a[3] = (float)ia[3] * rs * cs[n][3] + bv[n][3];
                    f32x4 r;
                    r[0] = bf_lo(hw.x) + sigmoidf_(a[0]) * pv[0]; r[1] = bf_hi(hw.x) + sigmoidf_(a[1]) * pv[1];
                    r[2] = bf_lo(hw.y) + sigmoidf_(a[2]) * pv[2]; r[3] = bf_hi(hw.y) + sigmoidf_(a[3]) * pv[3];
                    *(f32x4*)(out + (size_t)row * D + c) = r;
                }
            }
    }
};

struct EpiMerge2 {
    static constexpr bool PERM = true, AFTER_DRAIN = false; static constexpr bool MULTI = true; static constexpr int MID_T = 0;
    const unsigned char* sga; const unsigned char* sgc; bf16_t* mout;
    __device__ __forceinline__ int kt0(int part) const { return 8 * part; }
    __device__ __forceinline__ int nkt(int) const { return 8; }
    __device__ __forceinline__ bool reset(int part) const { return part == 1; }
    static __device__ __forceinline__ float u8(unsigned w, int j) { return (float)((w >> (8 * j)) & 0xffu); }
    __device__ __forceinline__ void operator()(acc_t& acc, const Unit& u, int wr, int wc, int fr, int fq) const {
        const int col0 = u.pn * BM + wc * 32 + 8 * fq;
        if (u.part == 0) {
            u32x2 av[2][4][2], cv[2][4][2];
#pragma unroll
            for (int ai = 0; ai < 2; ++ai)
#pragma unroll
                for (int m = 0; m < 4; ++m)
#pragma unroll
                    for (int bj = 0; bj < 2; ++bj) { const size_t o = (size_t)(u.pm * BM + ai * HALF + wr * 64 + m * 16 + fr) * D + col0 + bj * HALF; av[ai][m][bj] = *(const u32x2*)(sga + o); cv[ai][m][bj] = *(const u32x2*)(sgc + o); }
#pragma unroll
            for (int ai = 0; ai < 2; ++ai)
#pragma unroll
                for (int m = 0; m < 4; ++m)
#pragma unroll
                    for (int bj = 0; bj < 2; ++bj) {
                        const u32x2 a = av[ai][m][bj], c = cv[ai][m][bj];
#pragma unroll
                        for (int j = 0; j < 4; ++j) { acc[ai][bj][m][0][j] *= u8(a.x, j) * __builtin_amdgcn_rcpf(u8(c.x, j)); acc[ai][bj][m][1][j] *= u8(a.y, j) * __builtin_amdgcn_rcpf(u8(c.y, j)); }
                    }
        } else {
            u32x2 cv[2][4][2];
#pragma unroll
            for (int ai = 0; ai < 2; ++ai)
#pragma unroll
                for (int m = 0; m < 4; ++m)
#pragma unroll
                    for (int bj = 0; bj < 2; ++bj) cv[ai][m][bj] = *(const u32x2*)(sgc + (size_t)(u.pm * BM + ai * HALF + wr * 64 + m * 16 + fr) * D + col0 + bj * HALF);
#pragma unroll
            for (int ai = 0; ai < 2; ++ai)
#pragma unroll
                for (int m = 0; m < 4; ++m) {
                    const size_t ro = (size_t)(u.pm * BM + ai * HALF + wr * 64 + m * 16 + fr) * D + col0;
#pragma unroll
                    for (int bj = 0; bj < 2; ++bj) {
                        const u32x2 c = cv[ai][m][bj]; const f32x4 v0 = acc[ai][bj][m][0], v1 = acc[ai][bj][m][1]; constexpr float k = 1.0f / 255.0f;
                        u32x4 w; w.x = pg8::cvt_pk_bf16(v0[0] * u8(c.x, 0) * k, v0[1] * u8(c.x, 1) * k); w.y = pg8::cvt_pk_bf16(v0[2] * u8(c.x, 2) * k, v0[3] * u8(c.x, 3) * k);
                        w.z = pg8::cvt_pk_bf16(v1[0] * u8(c.y, 0) * k, v1[1] * u8(c.y, 1) * k); w.w = pg8::cvt_pk_bf16(v1[2] * u8(c.y, 2) * k, v1[3] * u8(c.y, 3) * k);
                        *(u32x4*)(mout + ro + bj * HALF) = w;
                    }
                }
        }
    }
};

template <bool GATHER_> struct MoeOrderT {
    static constexpr bool GATHER = GATHER_;
    const LAS int* pref;
    int nunits, G, c; LAS unsigned char* lds;
    __device__ __forceinline__ int row_of(const Unit& u, int r) const { return ((const LAS int*)moe_meta(lds, u.part))[2 * r]; }
    __device__ __forceinline__ bool next(int i, Unit& u) const {
        const int L = i * G + c; if (L >= nunits) return false;
        const int rtg = L >> 2, pnl = L & 3; int e = 0;
#pragma unroll 4
        for (int k = 1; k < NE; ++k) e += (pref[k] <= rtg) ? 1 : 0;
        e = __builtin_amdgcn_readfirstlane(e);
        u.pm = rtg; u.pn = 4 * e + pnl; u.part = i; return true;
    }
    __device__ __forceinline__ void a_ready(const Unit&) const {}
    __device__ __forceinline__ void done(const Unit&) const {}
};
struct StaticOrderId : pg8::StaticOrder {
    static constexpr bool GATHER = true;
    __device__ __forceinline__ int row_of(const Unit& u, int r) const { return 2 * (u.pm * pg8::BM + r); }
};
struct MoeOrderId : MoeOrderT<true> {
    __device__ __forceinline__ int row_of(const Unit& u, int r) const { return 2 * (u.pm * pg8::BM + r); }
};

#define XB_TMO      128
#define XB_XCNT(j)  (256  + 64 * (j))
#define XB_XSUB(j)  (1280 + 64 * (j))
#define XB_XGEN(j)  (2304 + 64 * (j))
#define XB_TOP      3328
#define XB_TOPGEN   3392
#define XCD_BAR_WORDS 3456
#define XB_SPIN_CAP (1u << 18)

__device__ __forceinline__ unsigned xb_ld(unsigned* p)              { return __hip_atomic_load(p, __ATOMIC_RELAXED, __HIP_MEMORY_SCOPE_AGENT); }
__device__ __forceinline__ unsigned xb_add(unsigned* p, unsigned v) { return __hip_atomic_fetch_add(p, v, __ATOMIC_RELAXED, __HIP_MEMORY_SCOPE_AGENT); }
__device__ __forceinline__ unsigned xb_xcc_id() { return (unsigned)__builtin_amdgcn_s_getreg((3 << 11) | 20) & 0xFu; }
#define XB_SPIN(cond, bar) do { unsigned _sp = 0; while (cond) { __builtin_amdgcn_s_sleep(1); \
    if ((++_sp & 255u) == 0u) { if (xb_ld(&(bar)[XB_TMO])) break; if (_sp > XB_SPIN_CAP) { atomicAdd(&(bar)[XB_TMO], 1u); break; } } } } while (0)

struct XcdBarrier {
    unsigned* bar; unsigned x;
    volatile LAS unsigned* st;
};

__device__ __forceinline__ XcdBarrier xcd_barrier_post(unsigned* bar, volatile LAS unsigned* st) {
    XcdBarrier b; b.bar = bar; b.x = xb_xcc_id(); b.st = st;
    if (threadIdx.x == 0) (void)xb_add(&bar[XB_XCNT(b.x)], 1u);
    return b;
}
__device__ __forceinline__ void xcd_barrier_complete(unsigned* bar, unsigned x, unsigned& nloc, unsigned& nx) {
    const unsigned G = gridDim.x * gridDim.y * gridDim.z;
    unsigned sum, cnt, mine, sp = 0u;
    for (;;) {
        sum = 0u; cnt = 0u; mine = 0u;
#pragma unroll
        for (unsigned j = 0; j < 16; ++j) { const unsigned c = xb_ld(&bar[XB_XCNT(j)]); sum += c; cnt += (c > 0u) ? 1u : 0u; mine = (j == x) ? c : mine; }
        if (sum == G) break;
        __builtin_amdgcn_s_sleep(1);
        if ((++sp & 255u) == 0u) { if (xb_ld(&bar[XB_TMO])) break; if (sp > XB_SPIN_CAP) { atomicAdd(&bar[XB_TMO], 1u); break; } }
    }
    nloc = mine > 0u ? mine : 1u; nx = cnt > 0u ? cnt : 1u;
}

__device__ __forceinline__ void xcd_barrier(const XcdBarrier& b, int tid) {
    asm volatile("s_waitcnt vmcnt(0)" ::: "memory");
    __syncthreads();
    if (tid == 0) {
        unsigned* bar = b.bar;
        __builtin_amdgcn_s_waitcnt(0);
        unsigned nloc = b.st[0], nx = b.st[1];
        if (nloc == 0u) { xcd_barrier_complete(bar, b.x, nloc, nx); b.st[0] = nloc; b.st[1] = nx; }
        const unsigned old = xb_add(&bar[XB_XSUB(b.x)], 1u);
        const unsigned gen = old / nloc;
        if (old + 1u == (gen + 1u) * nloc) {
            __builtin_amdgcn_fence(__ATOMIC_RELEASE, "agent");
            asm volatile("s_waitcnt vmcnt(0)" ::: "memory");
            const unsigned og = xb_add(&bar[XB_TOP], 1u);
            const unsigned tg = og / nx;
            if (og + 1u == (tg + 1u) * nx) xb_add(&bar[XB_TOPGEN], 1u);
            else XB_SPIN(xb_ld(&bar[XB_TOPGEN]) == tg, bar);
            __builtin_amdgcn_fence(__ATOMIC_ACQUIRE, "agent");
            xb_add(&bar[XB_XGEN(b.x)], 1u);
            asm volatile("s_waitcnt vmcnt(0)" ::: "memory");
        } else {
            XB_SPIN(xb_ld(&bar[XB_XGEN(b.x)]) == gen, bar);
            __builtin_amdgcn_fence(__ATOMIC_ACQUIRE, "agent");
            asm volatile("s_waitcnt vmcnt(0)" ::: "memory");
        }
    }
    __syncthreads();
}

#include <hip/hip_bf16.h>
#include <cmath>
namespace attn_body {
using bf16=__hip_bfloat16;
using bf16x8=__attribute__((ext_vector_type(8)))short;
using s16x4=__attribute__((ext_vector_type(4)))short;
using f32x16=__attribute__((ext_vector_type(16)))float;
using u32x4=__attribute__((ext_vector_type(4)))unsigned;
constexpr int BATCH=8,NHEAD=8,SEQ=4096,D=64,DM=1024,OPITCH=1024;
constexpr int NW=8,QBLK=32,QB=QBLK*NW,KVBLK=64,NQB=SEQ/QB;
constexpr int ATTN_PITCH=DM, ATTN_UNIT_ROWS=QB;
constexpr int BT_COPY=384, BT_BYTES=4*BT_COPY*4;
__device__ __forceinline__ int crow(int r,int hi){return (r&3)+8*(r>>2)+4*hi;}
#define SBAR() __builtin_amdgcn_sched_barrier(0)
constexpr int NSLOT=3, SLOTB=8192;
constexpr int LDS_K=0, LDS_V=NSLOT*SLOTB, LDS_WS=2*NSLOT*SLOTB, LDS_OST=LDS_WS+NW*64*4, LDS_BT=LDS_OST+NW*4096, LDS_BYTES=LDS_BT+BT_BYTES;
__device__ __forceinline__ void glds16(const void*gsrc,unsigned lds_dst){unsigned keep;
  asm volatile("s_mov_b32 %0, m0\n\ts_mov_b32 m0, %2\n\ts_nop 0\n\tglobal_load_lds_dwordx4 %1, off\n\ts_mov_b32 m0, %0":"=&s"(keep):"v"(gsrc),"s"(lds_dst):"memory");}
__device__ __forceinline__ float max3f(float a,float b,float c){float r;asm("v_max3_f32 %0, %1, %2, %3":"=v"(r):"v"(a),"v"(b),"v"(c));return r;}
__device__ __forceinline__ float max2f(float a,float b){float r;asm("v_max_f32_e32 %0, %1, %2":"=v"(r):"v"(a),"v"(b));return r;}
__device__ __forceinline__ float fadd_s(float a,float b){float r;asm("v_add_f32_e32 %0, %1, %2":"=v"(r):"v"(a),"v"(b));return r;}
__device__ __forceinline__ float fsub_s(float a,float b){float r;asm("v_sub_f32_e32 %0, %1, %2":"=v"(r):"v"(a),"v"(b));return r;}
typedef float f32x2_t __attribute__((ext_vector_type(2))); typedef float f32x4_t __attribute__((ext_vector_type(4))); typedef __bf16 bf16x2_t __attribute__((ext_vector_type(2)));
__device__ __forceinline__ unsigned cvtpk_s(float lo,float hi){f32x2_t v={lo,hi};bf16x2_t b=__builtin_convertvector(v,bf16x2_t);return __builtin_bit_cast(unsigned,b);}
#define WAIT_BAR(N) asm volatile("s_waitcnt vmcnt(" #N ") lgkmcnt(0)\n\ts_barrier":::"memory")

__device__ __forceinline__ void qkt(f32x16&p0,f32x16&p1,const char*Kslot,const bf16x8*qr,const f32x16&negm,int r32,int hi){
  const char*kb=Kslot+hi*1024+r32*16;
  #pragma unroll
  for(int d0=0;d0<4;++d0){
    const bf16x8 b0=*reinterpret_cast<const bf16x8*>(kb+d0*2048);
    const bf16x8 b1=*reinterpret_cast<const bf16x8*>(kb+d0*2048+512);
    if(d0==0){p0=__builtin_amdgcn_mfma_f32_32x32x16_bf16(b0,qr[0],negm,0,0,0);p1=__builtin_amdgcn_mfma_f32_32x32x16_bf16(b1,qr[0],negm,0,0,0);}
    else{p0=__builtin_amdgcn_mfma_f32_32x32x16_bf16(b0,qr[d0],p0,0,0,0);p1=__builtin_amdgcn_mfma_f32_32x32x16_bf16(b1,qr[d0],p1,0,0,0);}}
}
typedef __attribute__((address_space(3))) const char* lds_cptr;
typedef short v4i16_t __attribute__((ext_vector_type(4)));
__device__ __forceinline__ void kload8(bf16x8*kf,lds_cptr kp){
  kf[0]=*(const __attribute__((address_space(3))) bf16x8*)(kp);      kf[1]=*(const __attribute__((address_space(3))) bf16x8*)(kp+512);
  kf[2]=*(const __attribute__((address_space(3))) bf16x8*)(kp+2048); kf[3]=*(const __attribute__((address_space(3))) bf16x8*)(kp+2560);
  kf[4]=*(const __attribute__((address_space(3))) bf16x8*)(kp+4096); kf[5]=*(const __attribute__((address_space(3))) bf16x8*)(kp+4608);
  kf[6]=*(const __attribute__((address_space(3))) bf16x8*)(kp+6144); kf[7]=*(const __attribute__((address_space(3))) bf16x8*)(kp+6656);
}
__device__ __forceinline__ void kload2(bf16x8*kf,lds_cptr kp,int j){ kf[2*j]=*(const __attribute__((address_space(3))) bf16x8*)(kp+j*2048); kf[2*j+1]=*(const __attribute__((address_space(3))) bf16x8*)(kp+j*2048+512); }
__device__ __forceinline__ s16x4 vtr(lds_cptr p){ return __builtin_bit_cast(s16x4,__builtin_amdgcn_ds_read_tr16_b64_v4i16((__attribute__((address_space(3))) v4i16_t*)p)); }
__device__ __forceinline__ float rowmax(const f32x16&p0,const f32x16&p1){
  float a=max3f(p0[0],p0[1],p1[0]),b=max3f(p0[2],p0[3],p1[1]);a=max3f(a,p1[2],p1[3]);
  #pragma unroll
  for(int r=4;r<16;r+=4){a=max3f(a,p0[r],p0[r+1]);b=max3f(b,p0[r+2],p0[r+3]);a=max3f(a,p1[r],p1[r+1]);b=max3f(b,p1[r+2],p1[r+3]);}
  const float m=max2f(a,b);
  auto rr=__builtin_amdgcn_permlane32_swap(__float_as_uint(m),__float_as_uint(m),false,false);
  return max2f(__uint_as_float(rr[0]),__uint_as_float(rr[1]));
}
__device__ __forceinline__ void pv(f32x16*o,int vb,bf16x8 pa0,bf16x8 pa1,bf16x8 pa2,bf16x8 pa3){
  #pragma unroll
  for(int d0=0;d0<2;++d0){s16x4 lo[4],hi[4];
    #pragma unroll
    for(int ks=0;ks<4;++ks){
      asm volatile("ds_read_b64_tr_b16 %0,%1 offset:%c2":"=&v"(lo[ks]):"v"(vb),"i"(d0*4096+ks*1024):"memory");
      asm volatile("ds_read_b64_tr_b16 %0,%1 offset:%c2":"=&v"(hi[ks]):"v"(vb),"i"(d0*4096+ks*1024+512):"memory");}
    asm volatile("s_waitcnt lgkmcnt(0)":::"memory");SBAR();
    #define PK(k) (bf16x8){lo[k][0],lo[k][1],lo[k][2],lo[k][3],hi[k][0],hi[k][1],hi[k][2],hi[k][3]}
    o[d0]=__builtin_amdgcn_mfma_f32_32x32x16_bf16(pa0,PK(0),o[d0],0,0,0);
    o[d0]=__builtin_amdgcn_mfma_f32_32x32x16_bf16(pa1,PK(1),o[d0],0,0,0);
    o[d0]=__builtin_amdgcn_mfma_f32_32x32x16_bf16(pa2,PK(2),o[d0],0,0,0);
    o[d0]=__builtin_amdgcn_mfma_f32_32x32x16_bf16(pa3,PK(3),o[d0],0,0,0);
    #undef PK
  }
}

#ifndef ATTN_STORE16
#define ATTN_STORE16(p,v) (*(u32x4*)(p)=(v))
#endif
__device__ __forceinline__ void attn_unit(int b,int h,int qb,const bf16*Q,const bf16*K,const bf16*V,bf16*O,char*shm,float cinit,int tid){
  asm volatile("":"+v"(tid));
  const int lane=tid&63,r32=lane&31,hi=lane>>5; const int wid=__builtin_amdgcn_readfirstlane(tid>>6);
  const long rowbase=(long)b*SEQ; const int q0=qb*QB;
  const bf16*Qw=Q+(rowbase+q0+wid*QBLK)*DM+h*D;
  const int t0=(4*qb-8)>0?(4*qb-8):0;
  const bf16*Kh=K+(rowbase+(long)t0*KVBLK)*DM+h*D,*Vh=V+(rowbase+(long)t0*KVBLK)*DM+h*D;
  const int tb=t0-4*qb-(wid>>1)+8;
  const unsigned lds0=(unsigned)(uintptr_t)shm;
  float*wsf=(float*)(shm+LDS_WS)+wid*64;
  const bf16*ksrc=Kh+(long)lane*DM+wid*8;
  const bf16*vsrc=Vh+(long)(16*(wid&3)+(lane>>2))*DM+(wid>>2)*32+(lane&3)*8;
  const unsigned kdst=lds0+LDS_K+wid*1024, vdst=lds0+LDS_V+wid*1024;
  #define DMA_K(t,slot) glds16(ksrc+(long)(t)*KVBLK*DM,(unsigned)__builtin_amdgcn_readfirstlane(kdst+(slot)))
  #define DMA_V(t,slot) glds16(vsrc+(long)(t)*KVBLK*DM,(unsigned)__builtin_amdgcn_readfirstlane(vdst+(slot)))
  const int vb0=(int)(lds0+LDS_V)+((lane>>4)&1)*32+(lane&3)*8+(4*hi+((lane&15)>>2))*64;
  const char*Kbase=shm+LDS_K; bf16x8 kf[8];
  const lds_cptr shm3=(lds_cptr)shm; const lds_cptr kp0=shm3+LDS_K+hi*1024+r32*16; const lds_cptr vp0=shm3+LDS_V+((lane>>4)&1)*32+(lane&3)*8+(4*hi+((lane&15)>>2))*64;
  const int NT=4*qb+4-t0;
  const lds_cptr btl=shm3+LDS_BT+((3-r32)&3)*(BT_COPY*4)+4*(-193-32*(wid&1)-r32-((3-r32)&3)+4*hi);
  DMA_K(0,0);DMA_V(0,0);DMA_K(1,SLOTB);
  bf16x8 qr[4];
  #pragma unroll
  for(int d0=0;d0<4;++d0)qr[d0]=*reinterpret_cast<const bf16x8*>(&Qw[(long)r32*DM+d0*16+hi*8]);
  float l_reg=0.f;f32x16 o[2];o[0]=f32x16{};o[1]=f32x16{};f32x16 negm;
  asm volatile("":"+s"(cinit));
  _Pragma("unroll") for(int r=0;r<16;++r)negm[r]=cinit; asm volatile("":"+v"(negm));
  #define BIASMASK(P0,P1,t) do{ const int tau_=(t)+tb; \
    if(tau_<0||tau_>8){ _Pragma("unroll") for(int r=0;r<16;++r){P0[r]=-INFINITY;P1[r]=-INFINITY;} } \
    else if(tau_>=4){ const lds_cptr bp_=btl+256*tau_; \
      _Pragma("unroll") for(int g=0;g<4;++g){ const f32x4_t d0_=*(const __attribute__((address_space(3))) f32x4_t*)(bp_+32*g), d1_=*(const __attribute__((address_space(3))) f32x4_t*)(bp_+32*g+128); \
        _Pragma("unroll") for(int j=0;j<4;++j){P0[4*g+j]+=d0_[j];P1[4*g+j]+=d1_[j];} } } }while(0)
  #define START(P0,P1) do{ _Pragma("unroll") for(int r=0;r<16;++r)P0[r]=__builtin_amdgcn_exp2f(P0[r]); }while(0)
  #define RESC() do{}while(0)
  f32x16 pA0,pA1,pB0,pB1;
  int sl_prev=0,sl_cur=0,sl_next=SLOTB;
  #define ROT() do{sl_prev=sl_cur;sl_cur=sl_next;sl_next=(sl_next==(NSLOT-1)*SLOTB)?0:sl_next+SLOTB;}while(0)
  DMA_K(2,2*SLOTB);
  WAIT_BAR(3);
  qkt(pA0,pA1,Kbase,qr,negm,r32,hi);asm volatile("s_nop 15\n\ts_nop 7":"+v"(pA0),"+v"(pA1));BIASMASK(pA0,pA1,0);
  START(pA0,pA1);
  _Pragma("unroll") for(int r=0;r<16;++r)pA1[r]=__builtin_amdgcn_exp2f(pA1[r]);
  WAIT_BAR(0);
  DMA_K(3,0);DMA_V(1,SLOTB);
  ROT();
  kload8(kf,kp0+sl_cur);
  WAIT_BAR(2);
  s16x4 vlo[8],vhi[8]; u32x4 pw0,pw1,pw2,pw3;
  #define PKW(P,B) cvtpk_s(P[B],P[B+1])
  #define PAF(k) __builtin_bit_cast(bf16x8,pw##k)
  #define VFR(i) (bf16x8){vlo[i][0],vlo[i][1],vlo[i][2],vlo[i][3],vhi[i][0],vhi[i][1],vhi[i][2],vhi[i][3]}
  #define PIN(x) asm volatile("":"+v"(x))
  #define MX3(a,b,c) __builtin_fmaxf(__builtin_fmaxf((a),(b)),(c))
  #define GAPA(MF,A0,A1,A2,A3,W0,W1,PW) do{ MF; sacc+=A0; sacc+=A1; sacc+=A2; sacc+=A3; PIN(sacc); W0; W1; PIN(PW); SBAR(); }while(0)
  #define EX(v) __builtin_amdgcn_exp2f(v)
  #define GAPB(MF,X,B) do{ MF; X[B]=EX(X[B]); X[B+1]=EX(X[B+1]); X[B+2]=EX(X[B+2]); X[B+3]=EX(X[B+3]); PIN(X); SBAR(); }while(0)
  #define VRD(i) do{ vlo[i]=vtr(vp_+(((i)>>2)*4096+((i)&3)*1024)); vhi[i]=vtr(vp_+(((i)>>2)*4096+((i)&3)*1024+512)); }while(0)
  #define KRD(G,j) do{ if(G){ kload2(kf,kp0+sl_next,j); SBAR(); } }while(0)
  #define STEP(C0,C1,P0,P1,t,GK,GV,GL) do{ SBAR(); \
    const lds_cptr vp_=vp0+sl_prev; \
    VRD(0); SBAR(); float sacc=(P0[0]+P0[1]); \
    GAPA(C0=__builtin_amdgcn_mfma_f32_32x32x16_bf16(kf[0],qr[0],negm,0,0,0), P0[2],P0[3],P0[4],P0[5],     pw0[0]=PKW(P0,0), pw0[1]=PKW(P0,2), pw0); \
    VRD(4); SBAR(); GAPA(C1=__builtin_amdgcn_mfma_f32_32x32x16_bf16(kf[1],qr[0],negm,0,0,0), P0[6],P0[7],P0[8],P0[9],     pw0[2]=PKW(P0,4), pw0[3]=PKW(P0,6), pw0); \
    VRD(1); SBAR(); GAPA(C0=__builtin_amdgcn_mfma_f32_32x32x16_bf16(kf[2],qr[1],C0,0,0,0),   P0[10],P0[11],P0[12],P0[13], pw1[0]=PKW(P0,8), pw1[1]=PKW(P0,10), pw1); \
    VRD(5); SBAR(); GAPA(C1=__builtin_amdgcn_mfma_f32_32x32x16_bf16(kf[3],qr[1],C1,0,0,0),   P0[14],P0[15],P1[0],P1[1],   pw1[2]=PKW(P0,12),pw1[3]=PKW(P0,14), pw1); \
    VRD(2); SBAR(); GAPA(C0=__builtin_amdgcn_mfma_f32_32x32x16_bf16(kf[4],qr[2],C0,0,0,0),   P1[2],P1[3],P1[4],P1[5],     pw2[0]=PKW(P1,0), pw2[1]=PKW(P1,2), pw2); \
    VRD(6); SBAR(); GAPA(C1=__builtin_amdgcn_mfma_f32_32x32x16_bf16(kf[5],qr[2],C1,0,0,0),   P1[6],P1[7],P1[8],P1[9],     pw2[2]=PKW(P1,4), pw2[3]=PKW(P1,6), pw2); \
    VRD(3); SBAR(); GAPA(C0=__builtin_amdgcn_mfma_f32_32x32x16_bf16(kf[6],qr[3],C0,0,0,0),   P1[10],P1[11],P1[12],P1[13], pw3[0]=PKW(P1,8), pw3[1]=PKW(P1,10), pw3); \
    VRD(7); SBAR(); GAPA(C1=__builtin_amdgcn_mfma_f32_32x32x16_bf16(kf[7],qr[3],C1,0,0,0),   P1[14],P1[15],0.f,0.f,       pw3[2]=PKW(P1,12),pw3[3]=PKW(P1,14), pw3); \
    l_reg+=sacc; \
    if(GK){DMA_K((t)+3,sl_cur);} if(GV){DMA_V((t)+1,sl_next);} \
    BIASMASK(C0,C1,t); \
    SBAR(); \
    GAPB(o[0]=__builtin_amdgcn_mfma_f32_32x32x16_bf16(PAF(0),VFR(0),o[0],0,0,0), C0,0); \
    GAPB(o[1]=__builtin_amdgcn_mfma_f32_32x32x16_bf16(PAF(0),VFR(4),o[1],0,0,0), C0,4); \
    KRD(GL,0); GAPB(o[0]=__builtin_amdgcn_mfma_f32_32x32x16_bf16(PAF(1),VFR(1),o[0],0,0,0), C0,8); \
    KRD(GL,1); GAPB(o[1]=__builtin_amdgcn_mfma_f32_32x32x16_bf16(PAF(1),VFR(5),o[1],0,0,0), C0,12); \
    KRD(GL,2); GAPB(o[0]=__builtin_amdgcn_mfma_f32_32x32x16_bf16(PAF(2),VFR(2),o[0],0,0,0), C1,0); \
    KRD(GL,3); GAPB(o[1]=__builtin_amdgcn_mfma_f32_32x32x16_bf16(PAF(2),VFR(6),o[1],0,0,0), C1,4); \
    GAPB(o[0]=__builtin_amdgcn_mfma_f32_32x32x16_bf16(PAF(3),VFR(3),o[0],0,0,0), C1,8); \
    GAPB(o[1]=__builtin_amdgcn_mfma_f32_32x32x16_bf16(PAF(3),VFR(7),o[1],0,0,0), C1,12); \
    }while(0)
  int t=1;
  for(;t+5<NT;t+=2){
    STEP(pB0,pB1,pA0,pA1,t,true,true,true);     WAIT_BAR(2); RESC(); ROT();
    STEP(pA0,pA1,pB0,pB1,t+1,true,true,true);   WAIT_BAR(2); RESC(); ROT();
  }
  #define ENDW(tt) do{ if((tt)+3<NT){WAIT_BAR(2);} else if((tt)+2<NT){WAIT_BAR(1);} else {WAIT_BAR(0);} }while(0)
  for(;t+1<NT;t+=2){
    STEP(pB0,pB1,pA0,pA1,t,(t+3<NT),(t+1<NT),(t+1<NT));       ENDW(t);   RESC(); ROT();
    STEP(pA0,pA1,pB0,pB1,t+1,(t+4<NT),(t+2<NT),(t+2<NT));     ENDW(t+1); RESC(); ROT();
  }
  STEP(pB0,pB1,pA0,pA1,NT-1,false,false,false); RESC();
  { float sacc=pB0[0]+pB0[1]; _Pragma("unroll") for(int r=2;r<16;++r)sacc+=pB0[r]; _Pragma("unroll") for(int r=0;r<16;++r)sacc+=pB1[r]; l_reg+=sacc;
    pw0=(u32x4){PKW(pB0,0),PKW(pB0,2),PKW(pB0,4),PKW(pB0,6)};pw1=(u32x4){PKW(pB0,8),PKW(pB0,10),PKW(pB0,12),PKW(pB0,14)};pw2=(u32x4){PKW(pB1,0),PKW(pB1,2),PKW(pB1,4),PKW(pB1,6)};pw3=(u32x4){PKW(pB1,8),PKW(pB1,10),PKW(pB1,12),PKW(pB1,14)};
    SBAR(); pv(o,vb0+sl_cur,PAF(0),PAF(1),PAF(2),PAF(3)); }
  #undef PKW
  #undef PAF
  #undef VFR
  #undef PIN
  #undef MX3
  #undef GAPA
  #undef GAPB
  #undef EX
  #undef VRD
  #undef KRD
  #undef STEP
  #undef ENDW
  {auto rr=__builtin_amdgcn_permlane32_swap(__float_as_uint(l_reg),__float_as_uint(l_reg),false,false);l_reg=__uint_as_float(rr[0])+__uint_as_float(rr[1]);}
  if(hi==0)wsf[32+r32]=l_reg;asm volatile("s_waitcnt lgkmcnt(0)":::"memory");
  float rli[16];
  #pragma unroll
  for(int r=0;r<16;++r)rli[r]=__builtin_amdgcn_rcpf(wsf[32+crow(r,hi)]);
  bf16*Ow=O+(rowbase+q0+wid*QBLK)*OPITCH+h*D;
  { bf16*stg=(bf16*)(shm+LDS_OST)+wid*2048;
    #pragma unroll
    for(int r=0;r<16;++r){const int orow=crow(r,hi);
      #pragma unroll
      for(int d0=0;d0<2;++d0)stg[orow*64+d0*32+r32]=__float2bfloat16(o[d0][r]*rli[r]);}
    asm volatile("s_waitcnt lgkmcnt(0)":::"memory");
    #pragma unroll
    for(int i=0;i<4;++i){const int row=i*8+(lane>>3),ch=lane&7; const u32x4 v=*(const u32x4*)(stg+row*64+ch*8); ATTN_STORE16(Ow+(long)row*OPITCH+ch*8,v);} }
  asm volatile("s_waitcnt lgkmcnt(0)\n\ts_barrier":::"memory");
  #undef DMA_K
  #undef DMA_V
  #undef BIASMASK
  #undef START
  #undef RESC
  #undef ROT
}
constexpr int ATTN_LDS_BYTES=LDS_BYTES;
struct AttnUnit { int bh; int qb; };
__device__ __forceinline__ void attn_phase(char*lds,const bf16*Q,const bf16*K,const bf16*V,bf16*O,const float*gtab,const float*gcinit,int grid,int block,int tid){
  const int vcu=(block%8)*(grid/8)+block/8, s_=vcu&3, bh=vcu>>2, h=bh&7, b=bh>>3;
  { const f32x4_t* src=(const f32x4_t*)(gtab+(size_t)h*(4*BT_COPY)); __attribute__((address_space(3))) f32x4_t* dst=(__attribute__((address_space(3))) f32x4_t*)((lds_cptr)lds+LDS_BT);
    if(tid<BT_BYTES/16)dst[tid]=src[tid]; }
  const float cinit=__builtin_bit_cast(float,__builtin_amdgcn_readfirstlane(__builtin_bit_cast(int,gcinit[h])));
  asm volatile("s_waitcnt vmcnt(0) lgkmcnt(0)\n\ts_barrier":::"memory");
  for(int i=0;i<4;++i){ const int qb=(i==0)?s_:(i==1)?7-s_:(i==2)?8+s_:15-s_; attn_unit(b,h,qb,Q,K,V,O,lds,cinit,tid); }
}
#undef SBAR
#undef WAIT_BAR
}

struct Args {
    const float *x, *p, *g_mix, *w_in, *b_in, *g_q, *g_k, *rel_bias, *conv_w, *conv_b, *w_pa, *w_pc, *w_o, *g_ffn, *w_group, *b_group, *w_router, *b_router, *w1, *w3, *w2, *g_ple, *w_pg, *b_pg, *w_pp;
    float* out; unsigned char* ws;
};
constexpr int NWAVES = 8, NTHREADS = 512;
constexpr int RING_BYTES = 131072, MISC_OFF = 139264, WSCR = 16640;
constexpr int LDS_BYTES = 163840; static_assert(META_HI + 2048 <= LDS_BYTES, "MoE metadata area");

__device__ __forceinline__ void transpose_item(const float* src, int ldw, bf16_t* dst, int ldT, LAS float* scr, int lane, const float* gain = nullptr, int hi_off = 0) {
    float v[64];
#pragma unroll
    for (int i = 0; i < 64; ++i) v[i] = src[(size_t)i * ldw + lane];
    if (gain) {
#pragma unroll
        for (int i = 0; i < 64; ++i) v[i] *= gain[i];
    }
#pragma unroll
    for (int i = 0; i < 64; ++i) scr[i * 65 + lane] = v[i];
    LDS_WAIT(); asm volatile("" ::: "memory");
    const int c = lane & 7;
#pragma unroll
    for (int j = 0; j < 8; ++j) { const int n = (lane >> 3) + 8 * j; const LAS float* s = scr + (8 * c) * 65 + n;
        u32x4 o; o.x = pk2(s[0 * 65], s[1 * 65]); o.y = pk2(s[2 * 65], s[3 * 65]); o.z = pk2(s[4 * 65], s[5 * 65]); o.w = pk2(s[6 * 65], s[7 * 65]);
        *(u32x4*)(dst + (size_t)(n + (n >= 32 ? hi_off : 0)) * ldT + 8 * c) = o; }
    LDS_WAIT(); asm volatile("" ::: "memory");
}
__device__ __forceinline__ void transpose_item_f8(const float* src, int ldw, unsigned char* dst, int ldTb, LAS float* scr, int lane, const float* gain, float sc) {
    float v[64];
#pragma unroll
    for (int i = 0; i < 64; ++i) v[i] = src[(size_t)i * ldw + lane];
#pragma unroll
    for (int i = 0; i < 64; ++i) scr[i * 65 + lane] = v[i] * (gain ? gain[i] : 1.0f) * sc;
    LDS_WAIT(); asm volatile("" ::: "memory");
    const int c = lane & 3;
#pragma unroll
    for (int j = 0; j < 4; ++j) { const int n = (lane >> 2) + 16 * j; const LAS float* s = scr + (16 * c) * 65 + n; unsigned w[4];
#pragma unroll
        for (int e = 0; e < 4; ++e) w[e] = pk4_fp8(s[(4 * e) * 65], s[(4 * e + 1) * 65], s[(4 * e + 2) * 65], s[(4 * e + 3) * 65]);
        *(u32x4*)(dst + (size_t)n * ldTb + 16 * c) = (u32x4){w[0], w[1], w[2], w[3]}; }
    LDS_WAIT(); asm volatile("" ::: "memory");
}
__device__ __forceinline__ void transpose_item_q8(const float* src, int ldw, signed char* dst, int ldTb, LAS float* scr, int lane, const float* gain, const float* cmax) {
    float v[64];
#pragma unroll
    for (int i = 0; i < 64; ++i) v[i] = src[(size_t)i * ldw + lane];
    const float sc = 127.0f / fmaxf(__builtin_bit_cast(float, __hip_atomic_load((const unsigned*)cmax + lane, __ATOMIC_RELAXED, __HIP_MEMORY_SCOPE_AGENT)), 1e-30f);
#pragma unroll
    for (int i = 0; i < 64; ++i) scr[i * 65 + lane] = v[i] * gain[i] * sc;
    LDS_WAIT(); asm volatile("" ::: "memory");
    const int c = lane & 3;
#pragma unroll
    for (int j = 0; j < 4; ++j) { const int n = (lane >> 2) + 16 * j; const LAS float* s = scr + (16 * c) * 65 + n; unsigned w[4];
#pragma unroll
        for (int e = 0; e < 4; ++e) { const int q0 = __float2int_rn(s[(4 * e) * 65]), q1 = __float2int_rn(s[(4 * e + 1) * 65]), q2 = __float2int_rn(s[(4 * e + 2) * 65]), q3 = __float2int_rn(s[(4 * e + 3) * 65]);
            w[e] = (unsigned)(q0 & 0xff) | ((unsigned)(q1 & 0xff) << 8) | ((unsigned)(q2 & 0xff) << 16) | ((unsigned)(q3 & 0xff) << 24); }
        *(u32x4*)(dst + (size_t)n * ldTb + 16 * c) = (u32x4){w[0], w[1], w[2], w[3]}; }
    LDS_WAIT(); asm volatile("" ::: "memory");
}
__device__ __forceinline__ void colmax_item(const float* src, int ldw, int lane, const float* gain, unsigned* cmax) {
    float v[64]; float m = 0.f;
#pragma unroll
    for (int i = 0; i < 64; ++i) v[i] = src[(size_t)i * ldw + lane];
#pragma unroll
    for (int i = 0; i < 64; ++i) m = fmaxf(m, fabsf(v[i] * gain[i]));
    atomicMax(cmax + lane, __builtin_bit_cast(unsigned, m));
}
__device__ __forceinline__ int win_phys_row(int n) { const int l = n & 255; return (n & ~255) | (((l >> 5) & 1) << 7) | (((l >> 6) & 3) << 5) | (l & 31); }

__device__ __forceinline__ void row2_to_bf16_rstd(const float* xrow, bf16_t* orow, float* rstd2, int lane, unsigned char* qrow = nullptr) {
    const f32x4* xr = (const f32x4*)xrow + lane;
    f32x4 v[2][4]; float s0 = 0.f, s1 = 0.f;
#pragma unroll
    for (int j = 0; j < 4; ++j) { v[0][j] = xr[64 * j]; v[1][j] = xr[256 + 64 * j]; }
    unsigned long long* o8 = (unsigned long long*)orow + lane;
#pragma unroll
    for (int j = 0; j < 4; ++j) { s0 += (v[0][j].x * v[0][j].x + v[0][j].y * v[0][j].y) + (v[0][j].z * v[0][j].z + v[0][j].w * v[0][j].w); s1 += (v[1][j].x * v[1][j].x + v[1][j].y * v[1][j].y) + (v[1][j].z * v[1][j].z + v[1][j].w * v[1][j].w);
        o8[64 * j] = (unsigned long long)pk2(v[0][j].x, v[0][j].y) | ((unsigned long long)pk2(v[0][j].z, v[0][j].w) << 32);
        o8[256 + 64 * j] = (unsigned long long)pk2(v[1][j].x, v[1][j].y) | ((unsigned long long)pk2(v[1][j].z, v[1][j].w) << 32);
        if (qrow) { ((unsigned*)qrow)[64 * j + lane] = pk4_fp8(v[0][j].x, v[0][j].y, v[0][j].z, v[0][j].w); ((unsigned*)qrow)[256 + 64 * j + lane] = pk4_fp8(v[1][j].x, v[1][j].y, v[1][j].z, v[1][j].w); } }
    s0 = wave_sum(s0); s1 = wave_sum(s1);
    if (lane == 0) { rstd2[0] = rsqrtf(s0 * (1.f / D) + EPS); rstd2[1] = rsqrtf(s1 * (1.f / D) + EPS); }
}


typedef __attribute__((address_space(4))) const Args* KArgPtr;
__device__ __forceinline__ KArgPtr kargs() { KArgPtr p = (KArgPtr)__builtin_amdgcn_kernarg_segment_ptr(); asm volatile("" : "+s"(p)); return p; }
#define ctl ((unsigned*)(ws + WS_CTL))
#define wrt ((float*)(ws + WS_TAB))
#define eslot ((int*)(ws + WS_ESLOT))
#define ew ((float*)(ws + WS_EW))
#define Win_t ((bf16_t*)(ws + WS_WIN))
#define Wm_t ((bf16_t*)(ws + WS_WM))
#define Wo_t ((bf16_t*)(ws + WS_WO))
#define Wgp8 ((unsigned char*)(ws + WS_WGP))
#define hp8 ((unsigned char*)(ws + WS_HP))
#define h2b ((bf16_t*)(ws + WS_H2B))
#define xb ((bf16_t*)(ws + WS_XB))
#define A1 ((bf16_t*)(ws + WS_A1))
#define B1 ((bf16_t*)(ws + WS_B1))
#define C1 ((bf16_t*)(ws + WS_C1))
#define sga ((bf16_t*)(ws + WS_SGA))
#define sgc ((bf16_t*)(ws + WS_SGC))
#define mbuf ((bf16_t*)(ws + WS_M))
#define h1b ((bf16_t*)(ws + WS_H1B))
#define rstdv ((float*)(ws + WS_RSTD))
#define W13_t ((bf16_t*)(ws + WS_W13))
#define W2_t ((bf16_t*)(ws + WS_W2))
#define xs ((bf16_t*)(ws + WS_XS))
#define hdn ((bf16_t*)(ws + WS_HDN))
#define contrib ((bf16_t*)(ws + WS_CONTRIB))
#define tile0 ((LAS float*)lds)
#define tile1 (tile0 + 64 * 65)
#define pref ((LAS int*)(lds + MISC_OFF))
#define cnts (pref + 64)
__global__ void __launch_bounds__(NTHREADS, 2) fwd_kernel(Args a) {
    extern __shared__ __attribute__((aligned(16))) unsigned char lds_raw[];
    cg::grid_group grid = cg::this_grid();
    LAS unsigned char* lds = (LAS unsigned char*)lds_raw;
    const int G = gridDim.x, bx = blockIdx.x;
    const int wave_s = __builtin_amdgcn_readfirstlane((int)threadIdx.x >> 6);
    volatile LAS unsigned* bst = (volatile LAS unsigned*)(lds + MISC_OFF + 512);
    if (threadIdx.x < 2) bst[threadIdx.x] = 0u;
    __syncthreads();
    const XcdBarrier bar = xcd_barrier_post((unsigned*)(a.ws + WS_CTL) + CW_BAR, bst);
#ifndef PROBE_A
#define PROBE_A -1
#endif
#ifndef PROBE_B
#define PROBE_B -1
#endif
#define STAMP(i) do { if (PROBE_A >= 0 && bx == 0) { int t_ = lane_id_fresh(); if (wave_s == 0 && t_ == 0) ((volatile LAS unsigned long long*)(lds + MISC_OFF + 1024))[i] = __builtin_amdgcn_s_memrealtime(); } } while (0)
#define XBAR() do { int t_ = (wave_s << 6) | lane_id_fresh(); xcd_barrier(bar, t_); } while (0)
    STAMP(0);
#define PHASE_VARS() const KArgPtr ap = kargs(); unsigned char* const ws = ap->ws; (void)ws; int tid = (wave_s << 6) | lane_id_fresh(); asm volatile("" : "+v"(tid)); const int lane = tid & 63, wave = __builtin_amdgcn_readfirstlane(tid >> 6); \
    const int gw = bx * NWAVES + wave, NGW = G * NWAVES; const size_t gtid = (size_t)bx * NTHREADS + tid, GT = (size_t)G * NTHREADS; (void)lane; (void)gw; (void)NGW; (void)gtid; (void)GT
    {
        PHASE_VARS();
        LAS float* scr = (LAS float*)(lds + wave * WSCR);
        constexpr int I_IN = 16 * 80, I_PA = 8 * 16, I_PC = 8 * 16, I_O = 16 * 16, I_PG = 16 * 16, I_PP = 4 * 16;
        constexpr int NIT = I_IN + I_PA + I_PC + I_O + I_PG + I_PP;
        for (int it = gw; it < NIT; it += NGW) {
            int r = it;
            if (r < I_IN) { const int kb_ = r / 80, nb = r % 80;
#if F8_GATES
                if (nb >= 48) { transpose_item_f8(ap->w_in + (size_t)(kb_ * 64) * NIN + nb * 64, NIN, (unsigned char*)(Win_t + (size_t)3072 * D) + (size_t)((nb - 48) * 64) * D + kb_ * 64, D, scr, lane, ap->g_mix + kb_ * 64, F8W); continue; }
#endif
#if CU_PAIR
                if ((nb >= 24 && nb < 32) || (nb >= 40 && nb < 48)) { const int cg_ = nb >= 40, c = (nb - (cg_ ? 40 : 24)) * 64, t4 = c >> 7, pn_ = t4 < 2 ? 6 + t4 : 8 + t4;
                    transpose_item(ap->w_in + (size_t)(kb_ * 64) * NIN + nb * 64, NIN, Win_t + (size_t)(pn_ * 256 + cg_ * 128 + (c & 127)) * D + kb_ * 64, D, scr, lane, ap->g_mix + kb_ * 64, 0); continue; }
#endif
                transpose_item(ap->w_in + (size_t)(kb_ * 64) * NIN + nb * 64, NIN, Win_t + (size_t)win_phys_row(nb * 64) * D + kb_ * 64, D, scr, lane, ap->g_mix + kb_ * 64, 96); continue; } r -= I_IN;
            if (r < I_PA) { const int kb_ = r / 16, nb = r % 16; transpose_item(ap->w_pa + (size_t)(kb_ * 64) * D + nb * 64, D, Wm_t + (size_t)(nb * 64) * D + kb_ * 64, D, scr, lane); continue; } r -= I_PA;
            if (r < I_PC) { const int kb_ = r / 16, nb = r % 16; transpose_item(ap->w_pc + (size_t)(kb_ * 64) * D + nb * 64, D, Wm_t + (size_t)(nb * 64) * D + 512 + kb_ * 64, D, scr, lane); continue; } r -= I_PC;
            if (r < I_O) { const int kb_ = r / 16, nb = r % 16; transpose_item(ap->w_o + (size_t)(kb_ * 64) * D + nb * 64, D, Wo_t + (size_t)(nb * 64) * D + kb_ * 64, D, scr, lane); continue; } r -= I_O;
            if (r < I_PG) { const int kb_ = r / 16, nb = r % 16; colmax_item(ap->w_pg + (size_t)(kb_ * 64) * D + nb * 64, D, lane, ap->g_ple + kb_ * 64, ctl + CW_CMAXP + nb * 64); continue; } r -= I_PG;
            { const int kb_ = r / 16, nb = r % 16; transpose_item(ap->w_pp + (size_t)(kb_ * 64) * D + nb * 64, D, (bf16_t*)Wgp8 + (size_t)(nb * 64) * HPE + 512 + kb_ * 64, HPE, scr, lane); }
        }
        const size_t rtid = (size_t)(G - 1 - bx) * NTHREADS + tid; const int rgw = (G - 1 - bx) * NWAVES + wave;
        for (size_t i = rtid; i < (size_t)3 * 32 * 64 * 8; i += GT) { const int j = (int)(i & 7), ln = (int)((i >> 3) & 63), s_ = (int)((i >> 9) & 31), nt = (int)(i >> 14);
            const int k = 32 * s_ + 8 * (ln >> 4) + j, col = 16 * nt + (ln & 15);
            const float wv_ = ap->g_ffn[k] * (col < 4 ? ap->w_group[k * 4 + col] : (col < 36 ? ap->w_router[k * 32 + (col - 4)] : 0.f));
            const unsigned hi_ = f2bf(wv_); const float lo_ = wv_ - __builtin_bit_cast(float, hi_ << 16);
            ((unsigned short*)wrt)[i] = (unsigned short)hi_; ((unsigned short*)wrt)[(size_t)3 * 32 * 64 * 8 + i] = (unsigned short)f2bf(lo_); }
        { float* gtab = (float*)(ws + WS_GTAB); float* gcinit = (float*)(ws + WS_GCINIT);
          for (size_t i = rtid; i < (size_t)NH * 4 * 384; i += GT) { const int h = (int)(i / 1536), s_ = (int)((i / 384) & 3), y = (int)(i % 384), x = y + s_;
              int dd = 319 - x; dd = dd < -63 ? -63 : (dd > 256 ? 256 : dd);
              gtab[i] = x <= 382 ? (ap->rel_bias[h * NREL + dd + 63] - ap->rel_bias[h * NREL + 319]) * LOG2E : 0.f; }
          if (rgw < NH) { const int h = rgw;
              float gq = fabsf(ap->g_q[lane]), gk = fabsf(ap->g_k[lane]), mb = -3.0e38f;
#pragma unroll
              for (int j = 0; j < 5; ++j) mb = fmaxf(mb, ap->rel_bias[h * NREL + lane + 64 * j]);
#pragma unroll
              for (int o = 1; o < 64; o <<= 1) { gq = fmaxf(gq, __shfl_xor(gq, o)); gk = fmaxf(gk, __shfl_xor(gk, o)); mb = fmaxf(mb, __shfl_xor(mb, o)); }
              if (lane == 0) gcinit[h] = ap->rel_bias[h * NREL + 319] * LOG2E - (64.f * C2 * gq * gk + mb * LOG2E); } }
        STAMP(12);
        for (int m = 2 * gw; m < T; m += 2 * NGW) row2_to_bf16_rstd(ap->x + (size_t)m * D, xb + (size_t)m * D, rstdv + m, lane, F8_GATES ? ws + WS_XQ + (size_t)m * D : nullptr);
    }
    if (G == 0x7fffff) grid.sync();
    XBAR();
    STAMP(1);

#if F8_GATES
    { PHASE_VARS(); pg8::Gemm g{xb, Win_t, T, 3072, D, D}; pg8::StaticOrder S; S.init(T, 3072, G, bx); EpiInproj E{ws, ap->b_in, ap->g_q, ap->g_k, rstdv};
      pg8::gemm_phase<EpiInproj, pg8::StaticOrder, true, true>(lds, g, S, E, tid); }
    { PHASE_VARS(); pg8::Gemm g{(const bf16_t*)(ws + WS_XQ), Win_t + (size_t)3072 * D, T, 2048, D / 2, D / 2}; StaticOrderId S; S.init(T, 2048, G, bx);
      EpiGateF8 E{(unsigned char*)sga, (unsigned char*)sgc, ap->b_in + 3072, rstdv};
      pg8::gemm_phase<EpiGateF8, StaticOrderId, true, true, 0, 3>(lds, g, S, E, tid); }
#else
    { PHASE_VARS(); pg8::Gemm g{xb, Win_t, T, NIN, D, D}; pg8::StaticOrder S; S.init(T, NIN, G, bx); EpiInproj E{ws, ap->b_in, ap->g_q, ap->g_k, rstdv};
      pg8::gemm_phase<EpiInproj, pg8::StaticOrder, true, true>(lds, g, S, E, tid); }
#endif
    XBAR();
    STAMP(2);

    {
        PHASE_VARS();
        for (size_t i = gtid; i < (size_t)T * (CW / 8); i += GT) {
            const int t = (int)(i >> 6), c8 = (int)(i & 63) * 8, s = t & (SEQ - 1);
            const size_t o = (size_t)t * D + c8;
#if CU_PAIR
            const u32x4 u0 = *(const u32x4*)(C1 + o), b0 = *(const u32x4*)(A1 + o + 512);
            u32x4 u1 = {0u, 0u, 0u, 0u}, u2 = u1;
            if (s >= 1) u1 = *(const u32x4*)(C1 + o - D);
            if (s >= 2) u2 = *(const u32x4*)(C1 + o - 2 * D);
#else
            const u32x4 u0 = *(const u32x4*)(C1 + o), g0 = *(const u32x4*)(C1 + o + 512), b0 = *(const u32x4*)(A1 + o + 512);
            u32x4 u1 = {0u, 0u, 0u, 0u}, g1 = u1, u2 = u1, g2 = u1;
            if (s >= 1) { u1 = *(const u32x4*)(C1 + o - D); g1 = *(const u32x4*)(C1 + o + 512 - D); }
            if (s >= 2) { u2 = *(const u32x4*)(C1 + o - 2 * D); g2 = *(const u32x4*)(C1 + o + 512 - 2 * D); }
#endif
            float y[8];
#pragma unroll
            for (int e = 0; e < 4; ++e) {
#pragma unroll
                for (int hh = 0; hh < 2; ++hh) {
                    const int c = c8 + 2 * e + hh;
#if CU_PAIR
                    const float cu0 = hh ? bf_hi(u0[e]) : bf_lo(u0[e]), cu1 = hh ? bf_hi(u1[e]) : bf_lo(u1[e]), cu2 = hh ? bf_hi(u2[e]) : bf_lo(u2[e]);
#else
                    const float cu0 = hh ? bf_hi(u0[e]) * bf_hi(g0[e]) : bf_lo(u0[e]) * bf_lo(g0[e]);
                    const float cu1 = hh ? bf_hi(u1[e]) * bf_hi(g1[e]) : bf_lo(u1[e]) * bf_lo(g1[e]);
                    const float cu2 = hh ? bf_hi(u2[e]) * bf_hi(g2[e]) : bf_lo(u2[e]) * bf_lo(g2[e]);
#endif
                    const float bgv = hh ? bf_hi(b0[e]) : bf_lo(b0[e]);
                    y[2 * e + hh] = bgv * (ap->conv_b[c] + ap->conv_w[c] * cu2 + ap->conv_w[CW + c] * cu1 + ap->conv_w[2 * CW + c] * cu0);
                }
            }
            u32x4 w; w.x = pk2(y[0], y[1]); w.y = pk2(y[2], y[3]); w.z = pk2(y[4], y[5]); w.w = pk2(y[6], y[7]);
            *(u32x4*)(A1 + o + 512) = w;
        }
        __syncthreads();
        attn_body::attn_phase((char*)lds_raw, (const attn_body::bf16*)A1, (const attn_body::bf16*)B1, (const attn_body::bf16*)(B1 + 512), (attn_body::bf16*)A1, (const float*)(ws + WS_GTAB), (const float*)(ws + WS_GCINIT), G, bx, tid);
    }
    XBAR();
    STAMP(3);

    { PHASE_VARS(); pg8::Gemm g{A1, Wm_t, T, D, D, D}; pg8::PairOrder S; S.init(T, D, G, bx); EpiMerge2 E{(const unsigned char*)sga, (const unsigned char*)sgc, mbuf};
      pg8::gemm_phase<EpiMerge2, pg8::PairOrder, true, true>(lds, g, S, E, tid); }
    XBAR();
    STAMP(4);

    { PHASE_VARS(); pg8::Gemm g{mbuf, Wo_t, T, D, D, D}; pg8::StaticOrder S; S.init(T, D, G, bx); EpiResBf16 E{xb, h1b, F8_MOE ? (unsigned char*)(ws + WS_H1F8) : (unsigned char*)nullptr};
      pg8::gemm_phase<EpiResBf16, pg8::StaticOrder, true, true>(lds, g, S, E, tid); }
    XBAR();
    STAMP(5);

    {
        PHASE_VARS();
        {
            LAS int* lcnt = (LAS int*)(lds + MISC_OFF + 2048); LAS int* lbase = lcnt + 32;
            if (tid < 32) lcnt[tid] = 0;
            __syncthreads();
            int ea = 0, eb = 0, ra = 0, rb = 0; float wa = 0.f, wb = 0.f;
            LAS float* lsc = (LAS float*)(lds + wave * WSCR);
            const int r = lane & 15, q = lane >> 4;
            for (int task = gw; task < T / 16; task += NGW) {
                const int row0 = task * 16;
                const GAS bf16_t* arow = (const GAS bf16_t*)h1b + (size_t)(row0 + r) * D + 8 * q;
                const GAS bf16x8* bp = (const GAS bf16x8*)wrt + lane;
                constexpr int LO = 3 * 32 * 64;
                f32x4 acc0 = {0.f, 0.f, 0.f, 0.f}, acc1 = acc0, acc2 = acc0; float ss = 0.f;
                u32x4 acur[8], anxt[8]; bf16x8 bc[2][3][2], bn[2][3][2];
#pragma unroll
                for (int i = 0; i < 8; ++i) acur[i] = *(const GAS u32x4*)(arow + 32 * i);
#pragma unroll
                for (int st = 0; st < 2; ++st)
#pragma unroll
                    for (int nt = 0; nt < 3; ++nt) { bc[st][nt][0] = bp[(nt * 32 + st) * 64]; bc[st][nt][1] = bp[LO + (nt * 32 + st) * 64]; }
#pragma unroll 1
                for (int ch = 0; ch < 4; ++ch) {
                    const int chn = ch < 3 ? ch + 1 : 3;
#pragma unroll
                    for (int i = 0; i < 8; ++i) anxt[i] = *(const GAS u32x4*)(arow + 32 * (8 * chn + i));
#pragma unroll
                    for (int gq = 0; gq < 4; ++gq) {
                        const int s0 = 8 * ch + 2 * gq, sn = (s0 + 2 < 32) ? s0 + 2 : 30;
#pragma unroll
                        for (int st = 0; st < 2; ++st)
#pragma unroll
                            for (int nt = 0; nt < 3; ++nt) { bn[st][nt][0] = bp[(nt * 32 + sn + st) * 64]; bn[st][nt][1] = bp[LO + (nt * 32 + sn + st) * 64]; }
#pragma unroll
                        for (int st = 0; st < 2; ++st) {
                            const u32x4 aw = acur[2 * gq + st]; const bf16x8 af = __builtin_bit_cast(bf16x8, aw);
                            const float av[8] = {bf_lo(aw.x), bf_hi(aw.x), bf_lo(aw.y), bf_hi(aw.y), bf_lo(aw.z), bf_hi(aw.z), bf_lo(aw.w), bf_hi(aw.w)};
#pragma unroll
                            for (int j = 0; j < 8; ++j) ss += av[j] * av[j];
                            acc0 = __builtin_amdgcn_mfma_f32_16x16x32_bf16(af, bc[st][0][0], acc0, 0, 0, 0); acc0 = __builtin_amdgcn_mfma_f32_16x16x32_bf16(af, bc[st][0][1], acc0, 0, 0, 0);
                            acc1 = __builtin_amdgcn_mfma_f32_16x16x32_bf16(af, bc[st][1][0], acc1, 0, 0, 0); acc1 = __builtin_amdgcn_mfma_f32_16x16x32_bf16(af, bc[st][1][1], acc1, 0, 0, 0);
                            acc2 = __builtin_amdgcn_mfma_f32_16x16x32_bf16(af, bc[st][2][0], acc2, 0, 0, 0); acc2 = __builtin_amdgcn_mfma_f32_16x16x32_bf16(af, bc[st][2][1], acc2, 0, 0, 0);
                        }
#pragma unroll
                        for (int st = 0; st < 2; ++st)
#pragma unroll
                            for (int nt = 0; nt < 3; ++nt) { bc[st][nt][0] = bn[st][nt][0]; bc[st][nt][1] = bn[st][nt][1]; }
                        asm volatile("" ::: "memory");
                    }
#pragma unroll
                    for (int i = 0; i < 8; ++i) acur[i] = anxt[i];
                }
                ss += __shfl_xor(ss, 16); ss += __shfl_xor(ss, 32);
                const float rstd = rsqrtf(ss * (1.f / D) + EPS);
#pragma unroll
                for (int g_ = 0; g_ < 4; ++g_) { const float rs = __shfl(rstd, 4 * q + g_);
                    lsc[(4 * q + g_) * 48 + r] = acc0[g_] * rs; lsc[(4 * q + g_) * 48 + 16 + r] = acc1[g_] * rs; lsc[(4 * q + g_) * 48 + 32 + r] = acc2[g_] * rs; }
                LDS_WAIT(); asm volatile("" ::: "memory");
                if (lane < 16) {
                    const int m = row0 + lane; float lg[36];
#pragma unroll
                    for (int c = 0; c < 36; ++c) lg[c] = lsc[lane * 48 + c];
                    float gl[4];
#pragma unroll
                    for (int c = 0; c < 4; ++c) gl[c] = lg[c] + ap->b_group[c];
                    int grp = 0; float gmax = gl[0];
#pragma unroll
                    for (int c = 1; c < 4; ++c) if (gl[c] > gmax) { gmax = gl[c]; grp = c; }
                    float gs = 0.f;
#pragma unroll
                    for (int c = 0; c < 4; ++c) gs += __expf(gl[c] - gmax);
                    const float pgrp = 1.f / gs;
                    float el[8];
#pragma unroll
                    for (int c = 0; c < 8; ++c) { const float x0 = lg[4 + c], x1 = lg[12 + c], x2 = lg[20 + c], x3 = lg[28 + c]; el[c] = (grp == 0 ? x0 : grp == 1 ? x1 : grp == 2 ? x2 : x3) + ap->b_router[grp * 8 + c]; }
                    int i0 = 0; float l0 = el[0];
#pragma unroll
                    for (int c = 1; c < 8; ++c) if (el[c] > l0) { l0 = el[c]; i0 = c; }
                    int i1 = -1; float l1 = -3.0e38f;
#pragma unroll
                    for (int c = 0; c < 8; ++c) if (c != i0 && el[c] > l1) { l1 = el[c]; i1 = c; }
                    if (i1 < 0) i1 = i0 ? 0 : 1;
                    const float e1 = __expf(l1 - l0), w0 = pgrp / (1.f + e1), w1 = pgrp * e1 / (1.f + e1);
                    ea = grp * 8 + i0; eb = grp * 8 + i1;
                    ra = (int)__hip_atomic_fetch_add(&lcnt[ea], 1, __ATOMIC_RELAXED, __HIP_MEMORY_SCOPE_WORKGROUP); rb = (int)__hip_atomic_fetch_add(&lcnt[eb], 1, __ATOMIC_RELAXED, __HIP_MEMORY_SCOPE_WORKGROUP);
                    wa = w0; wb = w1;
                    rstdv[m] = rstd;
                }
                LDS_WAIT(); asm volatile("" ::: "memory");
            }
            __syncthreads();
            if (tid < 32) lbase[tid] = (int)atomicAdd(&ctl[tid * CNT_STRIDE], (unsigned)lcnt[tid]);
            __syncthreads();
            if (lane < 16) { const int m = gw * 16 + lane; const int ia = (ea << 15) | (lbase[ea] + ra), ib = (eb << 15) | (lbase[eb] + rb);
                eslot[ia] = 2 * m; ew[ia] = wa; eslot[ib] = 2 * m + 1; ew[ib] = wb; }
        }
        STAMP(11);
        LAS float* scr = (LAS float*)(lds + wave * WSCR);
        constexpr int I_13 = 16 * 8, PER_E = 2 * I_13;
        for (int it = gw; it < NE * PER_E; it += NGW) {
            const int e = it / PER_E; int r = it % PER_E;
            const int which = r / I_13; r %= I_13; const int kb_ = r / 8, nb = r % 8, j0 = nb * 64;
            const float* src = (which ? ap->w3 : ap->w1) + (size_t)e * D * DE + (size_t)(kb_ * 64) * DE + j0;
#if F8_MOE
            transpose_item_f8(src, DE, (unsigned char*)W13_t + (size_t)(e * 1024 + (j0 >> 7) * 256 + which * 128 + (j0 & 127)) * D + kb_ * 64, D, scr, lane, ap->g_ffn + kb_ * 64, F8W);
#else
            transpose_item(src, DE, W13_t + (size_t)(e * 1024 + (j0 >> 7) * 256 + which * 128 + (j0 & 127)) * D + kb_ * 64, D, scr, lane, ap->g_ffn + kb_ * 64);
#endif
        }
    }
    XBAR();
    STAMP(6);

    {
        PHASE_VARS();
        if (tid < NE) cnts[tid] = (int)__hip_atomic_load(&ctl[tid * CNT_STRIDE], __ATOMIC_RELAXED, __HIP_MEMORY_SCOPE_AGENT);
        __syncthreads();
        if (tid == 0) { int acc_ = 0; for (int e = 0; e < NE; ++e) { pref[e] = acc_; acc_ += (cnts[e] + 255) >> 8; } pref[NE] = acc_; }
        __syncthreads();
    }
    STAMP(7);
    const int ntiles = __builtin_amdgcn_readfirstlane(pref[NE]);

#if F8_MOE
    { PHASE_VARS(); pg8::Gemm g{(const bf16_t*)(ws + WS_H1F8), W13_t, XS_ROWS, NE * 1024, D / 2, D / 2}; moe_meta_preload(lds, pref, ntiles * 4, G, bx, eslot, rstdv, true, tid); MoeOrderT<true> S{pref, ntiles * 4, G, bx, lds}; EpiSwigluT<1> E{hdn, lds};
      pg8::gemm_phase<EpiSwigluT<1>, MoeOrderT<true>, true, true, 0, 3>(lds, g, S, E, tid); }
#else
    { PHASE_VARS(); pg8::Gemm g{h1b, W13_t, XS_ROWS, NE * 1024, D, D}; moe_meta_preload(lds, pref, ntiles * 4, G, bx, eslot, rstdv, true, tid); MoeOrderT<true> S{pref, ntiles * 4, G, bx, lds}; EpiSwigluT<0> E{hdn, lds};
      pg8::gemm_phase<EpiSwigluT<0>, MoeOrderT<true>, true, true>(lds, g, S, E, tid); }
#endif
    { PHASE_VARS();
      { const int nun = ntiles * 4, rem = nun % G, nf = rem ? G - rem : G, fb = rem ? bx - rem : bx;
        if (fb >= 0) {
            LAS float* scr = (LAS float*)(lds + wave * WSCR);
            for (int it = fb * NWAVES + wave; it < NE * 128; it += nf * NWAVES) { const int e = it >> 7, r = it & 127, kb_ = r / 16, nb = r % 16;
#if F8_MOE && F8_DOWN
                transpose_item_f8(ap->w2 + (size_t)e * DE * D + (size_t)(kb_ * 64) * D + nb * 64, D, (unsigned char*)W2_t + (size_t)(e * 1024 + nb * 64) * DE + kb_ * 64, DE, scr, lane, nullptr, F8W); }
#else
                transpose_item(ap->w2 + (size_t)e * DE * D + (size_t)(kb_ * 64) * D + nb * 64, D, W2_t + (size_t)(e * 1024 + nb * 64) * DE + kb_ * 64, DE, scr, lane); }
#endif
            for (size_t i = (size_t)fb * NTHREADS + tid; i < 1024; i += (size_t)nf * NTHREADS) ((float*)(ws + WS_CMAXF))[i] = __builtin_bit_cast(float, __hip_atomic_load(ctl + CW_CMAXP + i, __ATOMIC_RELAXED, __HIP_MEMORY_SCOPE_AGENT));
            for (int it = fb * NWAVES + wave; it < 16 * 16; it += nf * NWAVES) { const int kb_ = it / 16, nb = it % 16;
                transpose_item_q8(ap->w_pg + (size_t)(kb_ * 64) * D + nb * 64, D, (signed char*)Wgp8 + (size_t)(nb * 64) * HPB + kb_ * 64, HPB, scr, lane, ap->g_ple + kb_ * 64, (const float*)(ctl + CW_CMAXP) + nb * 64); }
            for (size_t i = (size_t)fb * NTHREADS + tid; i < (size_t)T * PLE / 8; i += (size_t)nf * NTHREADS) { const f32x4 v0 = ((const f32x4*)ap->p)[2 * i], v1 = ((const f32x4*)ap->p)[2 * i + 1];
                u32x4 o; o.x = pk2(v0.x, v0.y); o.y = pk2(v0.z, v0.w); o.z = pk2(v1.x, v1.y); o.w = pk2(v1.z, v1.w); *(u32x4*)(hp8 + (i >> 5) * HPB + 1024 + (i & 31) * 16) = o; }
        } } }
    XBAR();
    STAMP(8);

#if F8_MOE && F8_DOWN
    { PHASE_VARS(); pg8::Gemm g{hdn, W2_t, XS_ROWS, NE * 1024, DE / 2, DE / 2}; moe_meta_preload(lds, pref, ntiles * 4, G, bx, eslot, ew, false, tid); MoeOrderId S{{pref, ntiles * 4, G, bx, lds}}; EpiDownT<1> E{contrib, lds};
      pg8::gemm_phase<EpiDownT<1>, MoeOrderId, true, true, 0, 3>(lds, g, S, E, tid); }
#else
    { PHASE_VARS(); pg8::Gemm g{hdn, W2_t, XS_ROWS, NE * 1024, DE, DE}; moe_meta_preload(lds, pref, ntiles * 4, G, bx, eslot, ew, false, tid); MoeOrderT<false> S{pref, ntiles * 4, G, bx, lds}; EpiDownT<0> E{contrib, lds};
      pg8::gemm_phase<EpiDownT<0>, MoeOrderT<false>, true, true>(lds, g, S, E, tid); }
#endif
    XBAR();
    STAMP(9);

    { PHASE_VARS();
    for (int m0 = 2 * gw; m0 < T; m0 += 2 * NGW) {
#if F8_CONTRIB
        u32x2 hv[2][4]; unsigned p0[2][4], p1[2][4];
#pragma unroll
        for (int rr = 0; rr < 2; ++rr) { const int m = m0 + rr;
            const u32x2* xr = (const u32x2*)(h1b + (size_t)m * D) + lane;
            const unsigned* c0 = (const unsigned*)((const unsigned char*)contrib + (size_t)(2 * m) * D) + lane; const unsigned* c1 = (const unsigned*)((const unsigned char*)contrib + (size_t)(2 * m + 1) * D) + lane;
#pragma unroll
            for (int j = 0; j < 4; ++j) { hv[rr][j] = xr[64 * j]; p0[rr][j] = c0[64 * j]; p1[rr][j] = c1[64 * j]; } }
#else
        u32x2 hv[2][4], p0[2][4], p1[2][4];
#pragma unroll
        for (int rr = 0; rr < 2; ++rr) { const int m = m0 + rr;
            const u32x2* xr = (const u32x2*)(h1b + (size_t)m * D) + lane;
            const u32x2* c0 = (const u32x2*)(contrib + (size_t)(2 * m) * D) + lane; const u32x2* c1 = (const u32x2*)(contrib + (size_t)(2 * m + 1) * D) + lane;
#pragma unroll
            for (int j = 0; j < 4; ++j) { hv[rr][j] = xr[64 * j]; p0[rr][j] = c0[64 * j]; p1[rr][j] = c1[64 * j]; } }
#endif
#pragma unroll
        for (int rr = 0; rr < 2; ++rr) { const int m = m0 + rr; float s = 0.f, am = 0.f; f32x4 h[4];
            unsigned long long* o8 = (unsigned long long*)(h2b + (size_t)m * D) + lane;
#pragma unroll
            for (int j = 0; j < 4; ++j) {
#if F8_CONTRIB
                { const f32x2 a0 = __builtin_amdgcn_cvt_pk_f32_fp8((int)p0[rr][j], false), a1 = __builtin_amdgcn_cvt_pk_f32_fp8((int)p0[rr][j], true), b0 = __builtin_amdgcn_cvt_pk_f32_fp8((int)p1[rr][j], false), b1 = __builtin_amdgcn_cvt_pk_f32_fp8((int)p1[rr][j], true);
                  constexpr float k = 1.0f / CSC;
                  h[j].x = bf_lo(hv[rr][j].x) + (a0[0] + b0[0]) * k; h[j].y = bf_hi(hv[rr][j].x) + (a0[1] + b0[1]) * k; h[j].z = bf_lo(hv[rr][j].y) + (a1[0] + b1[0]) * k; h[j].w = bf_hi(hv[rr][j].y) + (a1[1] + b1[1]) * k; }
#else
                h[j].x = bf_lo(hv[rr][j].x) + bf_lo(p0[rr][j].x) + bf_lo(p1[rr][j].x); h[j].y = bf_hi(hv[rr][j].x) + bf_hi(p0[rr][j].x) + bf_hi(p1[rr][j].x);
                h[j].z = bf_lo(hv[rr][j].y) + bf_lo(p0[rr][j].y) + bf_lo(p1[rr][j].y); h[j].w = bf_hi(hv[rr][j].y) + bf_hi(p0[rr][j].y) + bf_hi(p1[rr][j].y);
#endif
                s += (h[j].x * h[j].x + h[j].y * h[j].y) + (h[j].z * h[j].z + h[j].w * h[j].w);
                am = fmaxf(fmaxf(am, fmaxf(fabsf(h[j].x), fabsf(h[j].y))), fmaxf(fabsf(h[j].z), fabsf(h[j].w)));
                o8[64 * j] = (unsigned long long)pk2(h[j].x, h[j].y) | ((unsigned long long)pk2(h[j].z, h[j].w) << 32); }
            s = wave_sum(s);
#pragma unroll
            for (int o = 1; o < 64; o <<= 1) am = fmaxf(am, __shfl_xor(am, o));
            const float qs = 127.0f / fmaxf(am, 1e-30f);
            unsigned* q4 = (unsigned*)(hp8 + (size_t)m * HPB) + lane;
#pragma unroll
            for (int j = 0; j < 4; ++j) { const int q0 = __float2int_rn(h[j].x * qs), q1 = __float2int_rn(h[j].y * qs), q2 = __float2int_rn(h[j].z * qs), q3 = __float2int_rn(h[j].w * qs);
                q4[64 * j] = (unsigned)(q0 & 0xff) | ((unsigned)(q1 & 0xff) << 8) | ((unsigned)(q2 & 0xff) << 16) | ((unsigned)(q3 & 0xff) << 24); }
            if (lane == 0) rstdv[m] = rsqrtf(s * (1.f / D) + EPS) * am * (1.0f / 127.0f); }
    } }
    XBAR();
    STAMP(10);

    { PHASE_VARS(); pg8::Gemm g{(const bf16_t*)hp8, (const bf16_t*)Wgp8, T, 2 * D, HPE, HPE}; pg8::StaticOrder S; S.init(T, 2 * D, G, bx);
      EpiGateDual E{h2b, rstdv, (const float*)(ws + WS_CMAXF), ap->b_pg, ap->out};
      pg8::gemm_phase<EpiGateDual, pg8::StaticOrder, true, true, 8, 2>(lds, g, S, E, tid); }
    STAMP(15);
    if (PROBE_A >= 0 && bx == 0) { int t_ = lane_id_fresh(); if (wave_s == 0 && t_ == 0) { volatile LAS unsigned long long* ts = (volatile LAS unsigned long long*)(lds + MISC_OFF + 1024);
        const unsigned long long d = 4ull * (ts[PROBE_B] - ts[PROBE_A]), t0 = __builtin_amdgcn_s_memrealtime(); while (__builtin_amdgcn_s_memrealtime() - t0 < d) __builtin_amdgcn_s_sleep(8); } }
}

extern "C" void kernel_launch(void* const* d_in, const int* in_sizes, int n_in, void* d_out, int out_size, void* d_ws, size_t ws_size, hipStream_t stream) {
    static int grid = 0;
    if (grid == 0) {
        if (n_in != 25 || out_size != T * D || ws_size < WS_END) { fprintf(stderr, "kernel_launch: unexpected shapes (n_in %d out %d ws %zu); nothing launched\n", n_in, out_size, ws_size); grid = -1; return; }
        int dev = 0, cus = 0, per_cu = 0;
        if (hipGetDevice(&dev) != hipSuccess || hipDeviceGetAttribute(&cus, hipDeviceAttributeMultiprocessorCount, dev) != hipSuccess) { grid = -1; return; }
        if (hipFuncSetAttribute((const void*)fwd_kernel, hipFuncAttributeMaxDynamicSharedMemorySize, LDS_BYTES) != hipSuccess) { fprintf(stderr, "kernel_launch: hipFuncSetAttribute failed\n"); grid = -1; return; }
        if (hipOccupancyMaxActiveBlocksPerMultiprocessor(&per_cu, (const void*)fwd_kernel, NTHREADS, LDS_BYTES) != hipSuccess || per_cu < 1) { fprintf(stderr, "kernel_launch: occupancy query says %d\n", per_cu); (void)hipGetLastError(); grid = -1; return; }
        if (cus != 256) { fprintf(stderr, "kernel_launch: built for a 256-CU device (got %d)\n", cus); grid = -1; return; }
        grid = cus;
    }
    if (grid < 0) return;
    if (hipMemsetAsync((char*)d_ws + WS_CTL, 0, CTL_ZERO_BYTES, stream) != hipSuccess) { fprintf(stderr, "kernel_launch: memset failed\n"); return; }
    Args a{};
    const float** f = (const float**)&a;
    for (int i = 0; i < 25; ++i) f[i] = (const float*)d_in[i];
    a.out = (float*)d_out; a.ws = (unsigned char*)d_ws;
    void* args[] = {&a};
    hipError_t e = hipLaunchCooperativeKernel((const void*)fwd_kernel, dim3(grid), dim3(NTHREADS), args, LDS_BYTES, stream);
    if (e != hipSuccess) fprintf(stderr, "kernel_launch: cooperative launch failed: %s (grid %d)\n", hipGetErrorString(e), grid);
}
```

```cpp
#include <hip/hip_runtime.h>
#include <hip/hip_cooperative_groups.h>
#include <cstdio>
#include <cstdint>
namespace cg = cooperative_groups;

#define GAS __attribute__((address_space(1)))
#define LAS __attribute__((address_space(3)))
typedef unsigned short bf16_t;
typedef short bf16x8 __attribute__((ext_vector_type(8)));
typedef float f32x4 __attribute__((ext_vector_type(4)));
typedef float f32x2 __attribute__((ext_vector_type(2)));
typedef unsigned u32x4 __attribute__((ext_vector_type(4)));
typedef unsigned u32x2 __attribute__((ext_vector_type(2)));
typedef int i32x4 __attribute__((ext_vector_type(4)));
typedef int i32x8 __attribute__((ext_vector_type(8)));
typedef GAS unsigned gu32;
#define RLX_AGENT __ATOMIC_RELAXED, __HIP_MEMORY_SCOPE_AGENT

constexpr int T = 32768, D = 1024, SEQ = 4096, NBATCH = 8;
constexpr int NIN = 5120, NH = 8, HD = 64, AW = 512, CW = 512;
constexpr int NE = 32, DE = 512, PLE = 256, NREL = 320;
constexpr int XS_ROWS = 65536 + NE * 256;
constexpr float EPS = 1e-6f;
constexpr float LOG2E = 1.4426950408889634f;
constexpr float C2 = 0.125f * LOG2E;

#ifndef F8_MOE
#define F8_MOE 1
#endif
#ifndef F8_GATES
#define F8_GATES 1
#endif
#ifndef CU_PAIR
#define CU_PAIR 1
#endif
#ifndef F8_CONTRIB
#define F8_CONTRIB 1
#endif
constexpr float CSC = 16.0f;
#ifndef F8_DOWN
#define F8_DOWN 1
#endif
constexpr float F8W = 32.0f;
constexpr size_t MiB = 1u << 20;
constexpr size_t WS_CTL = 0, CTL_ZERO_BYTES = 64 * 1024;
constexpr int CW_BAR = 4096, CNT_STRIDE = 64;
constexpr size_t WS_TAB = 1 * MiB;
constexpr size_t WS_GTAB = WS_TAB + 192 * 1024;
constexpr size_t WS_GCINIT = WS_GTAB + 8 * 4 * 384 * 4;
constexpr size_t WS_ROUTE = 2 * MiB;
constexpr size_t WS_CMAXF = 3 * MiB + 512 * 1024;
constexpr size_t WS_RSTD = 3 * MiB;
constexpr size_t WS_ROWMETA = 4 * MiB;
constexpr size_t WS_WIN = 6 * MiB;
constexpr size_t WS_WM = 16 * MiB;
constexpr size_t WS_WO = 18 * MiB;
constexpr size_t WS_WGP = 20 * MiB;
constexpr int HPB = 1536, HPE = HPB / 2;
constexpr size_t WS_HP = 24 * MiB;
constexpr size_t WS_H2B = 232 * MiB;
constexpr int CW_CMAXP = 14336;
constexpr int META_LO = 147456, META_HI = 147456 + 4 * 2048;
constexpr size_t WS_ESLOT = 72 * MiB, WS_EW = 76 * MiB;
constexpr size_t WS_XQ = 24 * MiB;
constexpr size_t WS_XB = 104 * MiB;
constexpr size_t WS_A1 = 168 * MiB;
constexpr size_t WS_B1 = 232 * MiB;
constexpr size_t WS_C1 = 296 * MiB;
constexpr size_t WS_SGA = 360 * MiB, WS_SGC = 424 * MiB;
constexpr size_t WS_M = WS_B1;
constexpr size_t WS_H1F8 = WS_A1;
constexpr size_t WS_H1B = WS_SGC;
constexpr size_t WS_W13 = WS_SGA;
constexpr size_t WS_W2 = 320 * MiB;
constexpr size_t WS_XS = 104 * MiB;
constexpr size_t WS_HDN = 248 * MiB;
constexpr size_t WS_CONTRIB = 104 * MiB;
constexpr size_t WS_END = 488 * MiB;

__device__ __forceinline__ unsigned f2bf(float f) { unsigned u = __builtin_bit_cast(unsigned, f); return (u + 0x7fffu + ((u >> 16) & 1u)) >> 16; }
__device__ __forceinline__ unsigned pk2(float lo, float hi) { return f2bf(lo) | (f2bf(hi) << 16); }
__device__ __forceinline__ float bf_lo(unsigned w) { return __builtin_bit_cast(float, w << 16); }
__device__ __forceinline__ float bf_hi(unsigned w) { return __builtin_bit_cast(float, w & 0xffff0000u); }
__device__ __forceinline__ float bf2f(bf16_t h) { return __builtin_bit_cast(float, (unsigned)h << 16); }
__device__ __forceinline__ float sigmoidf_(float x) { return __builtin_amdgcn_rcpf(1.0f + __builtin_amdgcn_exp2f(-LOG2E * x)); }
__device__ __forceinline__ float wave_sum(float v) {
#pragma unroll
    for (int o = 1; o < 64; o <<= 1) v += __shfl_xor(v, o);
    return v;
}
__device__ __forceinline__ int lane_id_fresh() { int l; asm volatile("v_mbcnt_lo_u32_b32 %0, -1, 0\n\tv_mbcnt_hi_u32_b32 %0, -1, %0" : "=v"(l)); return l; }
__device__ __forceinline__ unsigned pk4_fp8(float a, float b, float c, float d) { unsigned w = (unsigned)__builtin_amdgcn_cvt_pk_fp8_f32(a, b, 0, false); return (unsigned)__builtin_amdgcn_cvt_pk_fp8_f32(c, d, (int)w, true); }
#define LDS_WAIT() asm volatile("s_waitcnt lgkmcnt(0)" ::: "memory")
#define VM_WAIT() asm volatile("s_waitcnt vmcnt(0)" ::: "memory")

namespace pg8 {
#define PG8_LAS __attribute__((address_space(3)))
constexpr int BM = 256, BK = 64, HALF = 128, HTB = HALF * BK * 2  , STAGE_BYTES = 8 * HTB, NXCD = 8, WGM = 8;

__host__ __device__ __forceinline__ int lds_byte(int r, int c) { const int st = (r >> 4) * 2 + (c >> 5), rr = r & 15, cc = c & 31, ob = rr * 64 + cc * 2; return st * 1024 + (ob ^ (((ob >> 9) & 1) << 5)); }
__host__ __device__ __forceinline__ void stage_rc(int b, int& R, int& C) { const int st = b / 1024, sb = b % 1024, swz = sb ^ (((sb >> 9) & 1) << 5); R = (st >> 1) * 16 + swz / 64; C = (st & 1) * 32 + (swz % 64) / 2; }
__host__ __device__ __forceinline__ int perm32(int rho) { const int n = rho >> 4, i = rho & 15; return 8 * (i >> 2) + 4 * n + (i & 3); }

struct Unit { int pm, pn, part; };
struct Gemm { const bf16_t* A; const bf16_t* Bt; int M, N, K, ld; };

struct StaticOrder {
    int nM, nN, nwg, G, c;
    __host__ __device__ void init(int M, int N, int G_, int c_) { nM = M / BM; nN = N / BM; nwg = nM * nN; G = G_; c = c_; }
    __host__ __device__ bool next(int i, Unit& u) const {
        const long L = (long)i * G + c; if (L >= nwg) return false;
        int wgid = (int)L; { const int q = nwg / NXCD, r = nwg % NXCD, xcd = wgid % NXCD, off = wgid / NXCD; wgid = (xcd < r ? xcd * (q + 1) : r * (q + 1) + (xcd - r) * q) + off; }
        const int nig = WGM * nN, gid = wgid / nig, fm = gid * WGM, gsz = (nM - fm) < WGM ? (nM - fm) : WGM;
        u.pm = fm + ((wgid % nig) % gsz); u.pn = (wgid % nig) / gsz; u.part = 0; return true;
    }
    static constexpr bool GATHER = false;
    __device__ __forceinline__ int row_of(const Unit&, int) const { return 0; }
    __device__ __forceinline__ void a_ready(const Unit&) const {}
    __device__ __forceinline__ void done(const Unit&) const {}
};
struct PairOrder : StaticOrder {
    __host__ __device__ bool next(int i, Unit& u) const { if (!StaticOrder::next(i >> 1, u)) return false; u.part = i & 1; return true; }
};
__device__ __forceinline__ unsigned cvt_pk_bf16(float lo, float hi) { unsigned r; asm volatile("v_cvt_pk_bf16_f32 %0, %1, %2" : "=v"(r) : "v"(lo), "v"(hi)); return r; }

template <class Epi> __device__ __forceinline__ size_t koff_of(const Epi& E, const Unit& u) { if constexpr (Epi::MULTI) return (size_t)E.kt0(u.part) * (size_t)(BK * 2); else return (size_t)0; }
template <class Epi, class Sched, bool ALIGN_EPI = false, bool SP2 = false, int DUAL_T = 0, int I8MODE = 0>
__device__ __forceinline__ void gemm_phase(PG8_LAS unsigned char* lds, const Gemm g, const Sched& S, const Epi& E, int tid_) {
    asm volatile("" : "+v"(tid_));
    const int tid = tid_, wid = __builtin_amdgcn_readfirstlane(tid >> 6), lane = tid & 63, wr = wid >> 2, wc = wid & 3, fr = lane & 15, fq = lane >> 4;
    int K = g.K; asm volatile("" : "+s"(K));
    int nt = K / BK; const int LD = g.ld;
#define PG8_KOFF(u) koff_of(E, u)
    constexpr bool GATHER = Sched::GATHER; static_assert(!GATHER || SP2, "GATHER is written for the SP2 loop");
    unsigned voffA[2], voffA1[2], voffB[2]; int gR[2], gC[2];
#pragma unroll
    for (int i = 0; i < 2; ++i) { int R, C; stage_rc(tid * 16 + i * 8192, R, C); const int Rb = Epi::PERM ? ((R & ~31) + perm32(R & 31)) : R; gR[i] = R; gC[i] = C;
        voffA[i] = (unsigned)(R * LD + C) * 2u; voffA1[i] = 0u; voffB[i] = (unsigned)(Rb * LD + C) * 2u; }
#define PG8_GOFF(slot, i) ((unsigned)((((slot) < 0 ? 0 : (slot)) >> 1) * LD + gC[i]) * 2u)
    const size_t kstep = (size_t)(BK * 2);
    const size_t hstep = (size_t)HALF * LD * 2;
    const size_t tstep = 2 * hstep;
    const size_t hstepB = DUAL_T ? 0 : hstep, tstepB = DUAL_T ? hstep : tstep;
    const unsigned ldsw = (unsigned)wid * 1024u;
    const int aoff = lds_byte(wr * 64 + fr, fq * 8), boff = lds_byte(wc * 32 + fr, fq * 8);
#define PG8_SA(b, h) (((b) * 2 + (h)) * HTB)
#define PG8_SB(b, h) ((4 + (b) * 2 + (h)) * HTB)
#define PG8_STAGE(bufoff, gbase, voff) do { _Pragma("unroll") for (int _i = 0; _i < 2; ++_i) \
        __builtin_amdgcn_global_load_lds((const unsigned*)((const char*)(gbase) + (voff)[_i]), (PG8_LAS unsigned*)(lds + (bufoff) + ldsw + _i * 8192), 16, 0, 0); } while (0)
#define PG8_LD32(p_) __builtin_shufflevector(*(const PG8_LAS i32x4*)(p_), *(const PG8_LAS i32x4*)((p_) + 1024), 0, 1, 2, 3, 4, 5, 6, 7)
#define PG8_LDA(dst, b, h) do { if constexpr (I8MODE == 3) { _Pragma("unroll") for (int m = 0; m < 4; ++m) dst##8[m] = PG8_LD32(lds + PG8_SA(b, h) + aoff + m * 2048); } else { \
        _Pragma("unroll") for (int m = 0; m < 4; ++m) _Pragma("unroll") for (int k = 0; k < 2; ++k) dst[m][k] = *(const PG8_LAS bf16x8*)(lds + PG8_SA(b, h) + aoff + m * 2048 + k * 1024); } } while (0)
#define PG8_LDB(dst, b, h) do { if constexpr (I8MODE == 3) { _Pragma("unroll") for (int n = 0; n < 2; ++n) dst##8[n] = PG8_LD32(lds + PG8_SB(b, h) + boff + n * 2048); } else { \
        _Pragma("unroll") for (int n = 0; n < 2; ++n) _Pragma("unroll") for (int k = 0; k < 2; ++k) dst[n][k] = *(const PG8_LAS bf16x8*)(lds + PG8_SB(b, h) + boff + n * 2048 + k * 1024); } } while (0)
#define PG8_MMA(ai, bj, At, Bt) do { __builtin_amdgcn_s_setprio(1); _Pragma("unroll") for (int m = 0; m < 4; ++m) _Pragma("unroll") for (int n = 0; n < 2; ++n) _Pragma("unroll") for (int k = 0; k < 2; ++k) \
        acc[ai][bj][m][n] = __builtin_amdgcn_mfma_f32_16x16x32_bf16(Bt[n][k], At[m][k], acc[ai][bj][m][n], 0, 0, 0); __builtin_amdgcn_s_setprio(0); } while (0)
#define PG8_MMA_I8(ai, bj, At, Bt) do { __builtin_amdgcn_s_setprio(1); _Pragma("unroll") for (int m = 0; m < 4; ++m) _Pragma("unroll") for (int n = 0; n < 2; ++n) _Pragma("unroll") for (int k = 0; k < 2; ++k) \
        acc[ai][bj][m][n] = __builtin_bit_cast(f32x4, __builtin_amdgcn_mfma_i32_16x16x64_i8(__builtin_bit_cast(i32x4, Bt[n][k]), __builtin_bit_cast(i32x4, At[m][k]), __builtin_bit_cast(i32x4, acc[ai][bj][m][n]), 0, 0, 0)); __builtin_amdgcn_s_setprio(0); } while (0)
#define PG8_MMA_F8(ai, bj, At, Bt) do { __builtin_amdgcn_s_setprio(1); _Pragma("unroll") for (int m = 0; m < 4; ++m) _Pragma("unroll") for (int n = 0; n < 2; ++n) \
        acc[ai][bj][m][n] = __builtin_amdgcn_mfma_scale_f32_16x16x128_f8f6f4(Bt##8[n], At##8[m], acc[ai][bj][m][n], 0, 0, 0, 0x7f7f7f7f, 0, 0x7f7f7f7f); __builtin_amdgcn_s_setprio(0); } while (0)
#define PG8_MMA2(ai) do { if constexpr (I8MODE == 3) { PG8_MMA_F8(ai, 0, At, B0); PG8_MMA_F8(ai, 1, At, B1); } else if constexpr (DUAL_T > 0) { if (t < DUAL_T) { if constexpr (I8MODE != 0) { PG8_MMA_I8(ai, 0, At, B0); } else { PG8_MMA(ai, 0, At, B0); } } else { if constexpr (I8MODE == 1) { PG8_MMA_I8(ai, 1, At, B0); } else { PG8_MMA(ai, 1, At, B0); } } } \
        else { if constexpr (I8MODE == 1) { PG8_MMA_I8(ai, 0, At, B0); PG8_MMA_I8(ai, 1, At, B1); } else { PG8_MMA(ai, 0, At, B0); PG8_MMA(ai, 1, At, B1); } } } while (0)
#define PG8_STAGE_B1(buf, base) do { if constexpr (!DUAL_T) { PG8_STAGE(buf, base, voffB); } } while (0)
#define PG8_WAIT_VD(n, nd) do { if constexpr (DUAL_T > 0) { asm volatile("s_waitcnt vmcnt(" #nd ")" ::: "memory"); } else { asm volatile("s_waitcnt vmcnt(" #n ")" ::: "memory"); } } while (0)
#define PG8_WAIT_V(n) asm volatile("s_waitcnt vmcnt(" #n ")" ::: "memory")
#define PG8_WAIT_L(n) asm volatile("s_waitcnt lgkmcnt(" #n ")" ::: "memory")
#define PG8_BAR __builtin_amdgcn_s_barrier()
#define PG8_SCHED __builtin_amdgcn_sched_barrier(0)
    Unit cur, nxt; int ui = 0;
    if (!S.next(0, cur)) return;
    f32x4 acc[2][2][4][2];
#pragma unroll
    for (int a = 0; a < 2; ++a)
#pragma unroll
        for (int b = 0; b < 2; ++b)
#pragma unroll
            for (int m = 0; m < 4; ++m)
#pragma unroll
                for (int n = 0; n < 2; ++n) acc[a][b][m][n] = (f32x4){0.f, 0.f, 0.f, 0.f};
    bf16x8 At[4][2], B0[2][2], B1[2][2]; i32x8 At8[4], B08[2], B18[2];
    const char* cA = (const char*)g.A + (GATHER ? (size_t)0 : (size_t)cur.pm * tstep) + PG8_KOFF(cur); const char* cB = (const char*)g.Bt + (size_t)cur.pn * tstepB + PG8_KOFF(cur);
    if constexpr (Epi::MULTI) { nt = E.nkt(cur.part); asm volatile("" : "+s"(nt)); }
    S.a_ready(cur);
    int ns[4] = {0, 0, 0, 0};
    if constexpr (GATHER) {
#pragma unroll
        for (int i = 0; i < 2; ++i) { voffA[i] = PG8_GOFF(S.row_of(cur, gR[i]), i); voffA1[i] = PG8_GOFF(S.row_of(cur, HALF + gR[i]), i); } }
#define PG8_STAGE_A1(buf, base) do { if constexpr (GATHER) { PG8_STAGE(buf, base, voffA1); } else { PG8_STAGE(buf, (base) + hstep, voffA); } } while (0)
    if constexpr (SP2) {
        PG8_STAGE(PG8_SB(0, 0), cB, voffB); PG8_STAGE_B1(PG8_SB(0, 1), cB + hstepB); PG8_STAGE(PG8_SA(0, 0), cA, voffA); PG8_STAGE_A1(PG8_SA(0, 1), cA);
        if (wr == 1) PG8_BAR;
        PG8_WAIT_V(2); PG8_BAR;
        PG8_STAGE(PG8_SB(1, 0), cB + kstep, voffB); PG8_STAGE(PG8_SA(1, 0), cA + kstep, voffA); PG8_STAGE_B1(PG8_SB(1, 1), cB + hstepB + kstep);
        PG8_WAIT_VD(6, 4); PG8_BAR;
    } else {
        PG8_STAGE(PG8_SB(0, 0), cB, voffB); PG8_STAGE(PG8_SA(0, 0), cA, voffA); PG8_STAGE(PG8_SB(0, 1), cB + hstepB, voffB); PG8_STAGE(PG8_SA(0, 1), cA + hstep, voffA);
        if (wr == 1) PG8_BAR;
        PG8_WAIT_V(4); PG8_BAR;
        PG8_STAGE(PG8_SB(1, 0), cB + kstep, voffB); PG8_STAGE(PG8_SA(1, 0), cA + kstep, voffA); PG8_STAGE(PG8_SB(1, 1), cB + hstepB + kstep, voffB);
        PG8_WAIT_V(6); PG8_BAR;
    }
    for (;;) {
        const bool has_next = S.next(ui + 1, nxt);
        if constexpr (GATHER) { if (has_next) {
#pragma unroll
            for (int i = 0; i < 2; ++i) { ns[i] = S.row_of(nxt, gR[i]); ns[2 + i] = S.row_of(nxt, HALF + gR[i]); } } }
        const char* nA = (has_next && !GATHER) ? (const char*)g.A + (size_t)nxt.pm * tstep + PG8_KOFF(nxt) : cA; const char* nB = has_next ? (const char*)g.Bt + (size_t)nxt.pn * tstepB + PG8_KOFF(nxt) : cB;
        for (int t = 0; t < nt; t += 2) {
            const bool last = (t == nt - 2);
            if constexpr (Epi::MID_T > 0) { if (t == Epi::MID_T) E.mid(acc, cur, wr, wc, fr, fq); }
            const char* a1 = cA + (size_t)(t + 1) * kstep;
            const char* a2 = last ? nA : cA + (size_t)(t + 2) * kstep; const char* b2 = last ? nB : cB + (size_t)(t + 2) * kstep;
            const char* a3 = a2 + kstep; const char* b3 = b2 + kstep;
            if (last && has_next) S.a_ready(nxt);
            if constexpr (SP2) {
            PG8_LDB(B0, 0, 0); if constexpr (!DUAL_T) PG8_LDB(B1, 0, 1); PG8_SCHED; PG8_LDA(At, 0, 0); PG8_STAGE_A1(PG8_SA(1, 1), a1);
            if constexpr (GATHER) { if (last && has_next) {
#pragma unroll
                for (int i = 0; i < 2; ++i) { voffA[i] = PG8_GOFF(ns[i], i); voffA1[i] = PG8_GOFF(ns[2 + i], i); } } }
            PG8_WAIT_VD(8, 6); PG8_WAIT_L(0); PG8_BAR; PG8_MMA2(0); PG8_BAR; PG8_SCHED;
            PG8_LDA(At, 0, 1); PG8_STAGE(PG8_SB(0, 0), b2, voffB); PG8_STAGE_B1(PG8_SB(0, 1), b2 + hstepB); PG8_STAGE(PG8_SA(0, 0), a2, voffA);
            PG8_WAIT_VD(8, 6); PG8_WAIT_L(0); PG8_BAR; PG8_MMA2(1); PG8_BAR; PG8_SCHED;
            PG8_LDB(B0, 1, 0); if constexpr (!DUAL_T) PG8_LDB(B1, 1, 1); PG8_SCHED; PG8_LDA(At, 1, 0); PG8_STAGE_A1(PG8_SA(0, 1), a2);
            PG8_WAIT_VD(8, 6); PG8_WAIT_L(0); PG8_BAR; PG8_MMA2(0); PG8_BAR; PG8_SCHED;
            PG8_LDA(At, 1, 1); PG8_STAGE(PG8_SB(1, 0), b3, voffB); PG8_STAGE_B1(PG8_SB(1, 1), b3 + hstepB); PG8_STAGE(PG8_SA(1, 0), a3, voffA);
            PG8_WAIT_VD(8, 6); PG8_WAIT_L(0); PG8_BAR; PG8_MMA2(1); PG8_BAR; PG8_SCHED;
            } else {
            PG8_LDB(B0, 0, 0); PG8_SCHED; PG8_LDA(At, 0, 0); PG8_STAGE(PG8_SA(1, 1), a1 + hstep, voffA);
            PG8_WAIT_L(8); PG8_BAR; PG8_WAIT_L(0); PG8_MMA(0, 0, At, B0); PG8_BAR; PG8_SCHED;
            PG8_LDB(B1, 0, 1); PG8_STAGE(PG8_SB(0, 0), b2, voffB);
            PG8_BAR; PG8_WAIT_L(0); PG8_MMA(0, 1, At, B1); PG8_BAR;
            PG8_LDA(At, 0, 1); PG8_STAGE(PG8_SA(0, 0), a2, voffA);
            PG8_BAR; PG8_WAIT_L(0); PG8_MMA(1, 0, At, B0); PG8_BAR; PG8_SCHED;
            PG8_STAGE(PG8_SB(0, 1), b2 + hstepB, voffB);
            PG8_WAIT_V(6); PG8_BAR; PG8_MMA(1, 1, At, B1); PG8_BAR;
            PG8_LDB(B0, 1, 0); PG8_SCHED; PG8_LDA(At, 1, 0); PG8_STAGE(PG8_SA(0, 1), a2 + hstep, voffA);
            PG8_WAIT_L(8); PG8_BAR; PG8_WAIT_L(0); PG8_MMA(0, 0, At, B0); PG8_BAR; PG8_SCHED;
            PG8_LDB(B1, 1, 1); PG8_STAGE(PG8_SB(1, 0), b3, voffB);
            PG8_BAR; PG8_WAIT_L(0); PG8_MMA(0, 1, At, B1); PG8_BAR;
            PG8_LDA(At, 1, 1); PG8_STAGE(PG8_SA(1, 0), a3, voffA);
            PG8_BAR; PG8_WAIT_L(0); PG8_MMA(1, 0, At, B0); PG8_BAR; PG8_SCHED;
            PG8_STAGE(PG8_SB(1, 1), b3 + hstepB, voffB);
            PG8_WAIT_V(6); PG8_BAR; PG8_MMA(1, 1, At, B1); PG8_BAR;
            }
        }
        if constexpr (ALIGN_EPI) { if (wr == 0) PG8_BAR; }
        if constexpr (!Epi::AFTER_DRAIN) { E(acc, cur, wr, wc, fr, fq); S.done(cur); }
        if (!has_next) break;
        bool zero_acc = true; if constexpr (Epi::MULTI) zero_acc = E.reset(cur.part);
        if (zero_acc) {
#pragma unroll
        for (int a = 0; a < 2; ++a)
#pragma unroll
            for (int b = 0; b < 2; ++b)
#pragma unroll
                for (int m = 0; m < 4; ++m)
#pragma unroll
                    for (int n = 0; n < 2; ++n) acc[a][b][m][n] = (f32x4){0.f, 0.f, 0.f, 0.f};
        }
        cur = nxt; cA = nA; cB = nB; ++ui;
        if constexpr (Epi::MULTI) { nt = E.nkt(cur.part); asm volatile("" : "+s"(nt)); }
        if constexpr (ALIGN_EPI) { if (wr == 1) PG8_BAR; }
    }
    PG8_WAIT_V(0);
    if constexpr (!ALIGN_EPI) { if (wr == 0) PG8_BAR; }
    PG8_BAR;
#undef PG8_SA
#undef PG8_SB
#undef PG8_STAGE
#undef PG8_LDA
#undef PG8_LD32
#undef PG8_LDB
#undef PG8_MMA
#undef PG8_MMA2
#undef PG8_MMA_I8
#undef PG8_MMA_F8
#undef PG8_KOFF
#undef PG8_STAGE_B1
#undef PG8_WAIT_VD
#undef PG8_STAGE_A1
#undef PG8_GOFF
#undef PG8_WAIT_V
#undef PG8_WAIT_L
#undef PG8_BAR
#undef PG8_SCHED
}
}

typedef f32x4 acc_t[2][2][4][2];
using pg8::Unit; using pg8::HALF; using pg8::BM;

struct EpiInproj {
    static constexpr bool PERM = true, AFTER_DRAIN = false; static constexpr bool MULTI = false; static constexpr int MID_T = 0;
    unsigned char* ws; const float* b_in; const float* g_q; const float* g_k; const float* rstdx;
    __device__ __forceinline__ void operator()(const acc_t& acc, const Unit& u, int wr, int wc, int fr, int fq) const {
        const int pn = u.pn;
        int mode, col0; size_t off;
        if (pn < 12) { const int seg = pn >> 1; mode = seg == 0 ? 1 : (seg == 1 ? 2 : 0); col0 = 256 * (pn & 1) + ((seg == 2 || seg == 4 || seg == 5) ? 512 : 0);
            off = (seg == 0 || seg == 4) ? WS_A1 : ((seg == 1 || seg == 2) ? WS_B1 : WS_C1);
            if (CU_PAIR && (seg == 3 || seg == 5)) mode = 4; }
        else if (pn < 16) { mode = 3; col0 = 256 * (pn - 12); off = WS_SGA; }
        else { mode = 3; col0 = 256 * (pn - 16); off = WS_SGC; }
        constexpr int pitch = 1024;
        bf16_t* base = (bf16_t*)(ws + off);
        const int lc0 = 64 * wc + 8 * fq;
        f32x4 bv[2][2], gv[2][2];
#pragma unroll
        for (int bj = 0; bj < 2; ++bj)
#pragma unroll
            for (int n = 0; n < 2; ++n) {
                bv[bj][n] = (mode == 4) ? *(const f32x4*)(b_in + (bj ? 2560 : 1536) + 128 * (pn < 8 ? pn - 6 : pn - 8) + 32 * wc + 8 * fq + 4 * n) : *(const f32x4*)(b_in + 256 * pn + lc0 + 32 * bj + 4 * n);
                const float* g = (mode == 2) ? g_k : g_q;
                gv[bj][n] = *(const f32x4*)(g + 8 * fq + 32 * bj + 4 * n);
            }
        const float qs = (mode == 1) ? C2 : 1.0f;
        float rsxv[2][4];
#pragma unroll
        for (int ai = 0; ai < 2; ++ai)
#pragma unroll
            for (int m = 0; m < 4; ++m) rsxv[ai][m] = rstdx[u.pm * BM + ai * HALF + wr * 64 + m * 16 + fr];
#pragma unroll
        for (int ai = 0; ai < 2; ++ai)
#pragma unroll
            for (int m = 0; m < 4; ++m) {
                const int row = u.pm * BM + ai * HALF + wr * 64 + m * 16 + fr; const float rsx = rsxv[ai][m];
                f32x4 v[2][2];
#pragma unroll
                for (int bj = 0; bj < 2; ++bj)
#pragma unroll
                    for (int n = 0; n < 2; ++n) v[bj][n] = acc[ai][bj][m][n] * rsx + bv[bj][n];
                if (mode == 1 || mode == 2) {
                    float ss = 0.f;
#pragma unroll
                    for (int bj = 0; bj < 2; ++bj)
#pragma unroll
                        for (int n = 0; n < 2; ++n) { const f32x4 x = v[bj][n]; ss += (x[0] * x[0] + x[1] * x[1]) + (x[2] * x[2] + x[3] * x[3]); }
                    ss += __shfl_xor(ss, 16); ss += __shfl_xor(ss, 32);
                    const float rstd = __frsqrt_rn(ss * (1.0f / 64.0f) + EPS) * qs;
#pragma unroll
                    for (int bj = 0; bj < 2; ++bj)
#pragma unroll
                        for (int n = 0; n < 2; ++n) v[bj][n] = v[bj][n] * rstd * gv[bj][n];
                } else if (mode == 3) {
#pragma unroll
                    for (int bj = 0; bj < 2; ++bj)
#pragma unroll
                        for (int n = 0; n < 2; ++n)
#pragma unroll
                            for (int j = 0; j < 4; ++j) v[bj][n][j] = sigmoidf_(v[bj][n][j]);
                }
                if (mode == 4) {
                    const f32x4 c0 = v[0][0] * v[1][0], c1 = v[0][1] * v[1][1];
                    u32x4 w; w.x = pg8::cvt_pk_bf16(c0[0], c0[1]); w.y = pg8::cvt_pk_bf16(c0[2], c0[3]); w.z = pg8::cvt_pk_bf16(c1[0], c1[1]); w.w = pg8::cvt_pk_bf16(c1[2], c1[3]);
                    *(u32x4*)((bf16_t*)(ws + WS_C1) + (size_t)row * pitch + 128 * (pn < 8 ? pn - 6 : pn - 8) + 32 * wc + 8 * fq) = w;
                    continue;
                }
                if (mode == 3) {
                    unsigned char* rp8 = (unsigned char*)base + (size_t)row * pitch + col0 + lc0; const float lo = (pn >= 16) ? 1.0f : 0.0f;
#pragma unroll
                    for (int bj = 0; bj < 2; ++bj) { unsigned w2[2];
#pragma unroll
                        for (int n = 0; n < 2; ++n) { unsigned b4 = 0;
#pragma unroll
                            for (int j = 0; j < 4; ++j) b4 |= (unsigned)__float2int_rn(fmaxf(v[bj][n][j] * 255.0f, lo)) << (8 * j);
                            w2[n] = b4; }
                        *(u32x2*)(rp8 + 32 * bj) = (u32x2){w2[0], w2[1]}; }
                    continue;
                }
                bf16_t* rowp = base + (size_t)row * pitch + col0 + lc0;
#pragma unroll
                for (int bj = 0; bj < 2; ++bj) {
                    u32x4 w; w.x = pg8::cvt_pk_bf16(v[bj][0][0], v[bj][0][1]); w.y = pg8::cvt_pk_bf16(v[bj][0][2], v[bj][0][3]); w.z = pg8::cvt_pk_bf16(v[bj][1][0], v[bj][1][1]); w.w = pg8::cvt_pk_bf16(v[bj][1][2], v[bj][1][3]);
                    *(u32x4*)(rowp + 32 * bj) = w;
                }
            }
    }
};

struct EpiGateF8 {
    static constexpr bool PERM = true, AFTER_DRAIN = false; static constexpr bool MULTI = false; static constexpr int MID_T = 0;
    unsigned char* sga8; unsigned char* sgc8; const float* bias; const float* rstdx;
    __device__ __forceinline__ void operator()(const acc_t& acc, const Unit& u, int wr, int wc, int fr, int fq) const {
        const int pn = u.pn; unsigned char* base = (pn < 4 ? sga8 : sgc8) + 256 * (pn & 3) + wc * 32 + 8 * fq; const float lo = (pn >= 4) ? 1.0f : 0.0f;
        f32x4 bv[2][2]; float rsxv[2][4];
#pragma unroll
        for (int bj = 0; bj < 2; ++bj)
#pragma unroll
            for (int n = 0; n < 2; ++n) bv[bj][n] = *(const f32x4*)(bias + 256 * pn + wc * 32 + 8 * fq + bj * HALF + 4 * n);
#pragma unroll
        for (int ai = 0; ai < 2; ++ai)
#pragma unroll
            for (int m = 0; m < 4; ++m) rsxv[ai][m] = rstdx[u.pm * BM + ai * HALF + wr * 64 + m * 16 + fr] * (1.0f / F8W);
#pragma unroll
        for (int ai = 0; ai < 2; ++ai)
#pragma unroll
            for (int m = 0; m < 4; ++m) {
                const int row = u.pm * BM + ai * HALF + wr * 64 + m * 16 + fr; const float rs = rsxv[ai][m];
#pragma unroll
                for (int bj = 0; bj < 2; ++bj) { unsigned w2[2];
#pragma unroll
                    for (int n = 0; n < 2; ++n) { unsigned b4 = 0;
#pragma unroll
                        for (int j = 0; j < 4; ++j) b4 |= (unsigned)__float2int_rn(fmaxf(sigmoidf_(acc[ai][bj][m][n][j] * rs + bv[bj][n][j]) * 255.0f, lo)) << (8 * j);
                        w2[n] = b4; }
                    *(u32x2*)(base + (size_t)row * 1024 + bj * HALF) = (u32x2){w2[0], w2[1]}; }
            }
    }
};

struct EpiMergeDual {
    static constexpr bool PERM = true, AFTER_DRAIN = false; static constexpr bool MULTI = false; static constexpr int MID_T = 0;
    const bf16_t* sga; const bf16_t* sgc; bf16_t* mout;
    __device__ __forceinline__ void operator()(const acc_t& acc, const Unit& u, int wr, int wc, int fr, int fq) const {
        const int col0 = u.pn * HALF + wc * 32 + 8 * fq;
#pragma unroll
        for (int ai = 0; ai < 2; ++ai)
#pragma unroll
            for (int m = 0; m < 4; ++m) {
                const size_t ro = (size_t)(u.pm * BM + ai * HALF + wr * 64 + m * 16 + fr) * D + col0;
                const u32x4 a = *(const u32x4*)(sga + ro), c = *(const u32x4*)(sgc + ro);
                const f32x4 x0 = acc[ai][0][m][0], x1 = acc[ai][0][m][1], y0 = acc[ai][1][m][0], y1 = acc[ai][1][m][1];
                u32x4 w;
                w.x = pg8::cvt_pk_bf16(x0[0] * bf_lo(a.x) + y0[0] * bf_lo(c.x), x0[1] * bf_hi(a.x) + y0[1] * bf_hi(c.x));
                w.y = pg8::cvt_pk_bf16(x0[2] * bf_lo(a.y) + y0[2] * bf_lo(c.y), x0[3] * bf_hi(a.y) + y0[3] * bf_hi(c.y));
                w.z = pg8::cvt_pk_bf16(x1[0] * bf_lo(a.z) + y1[0] * bf_lo(c.z), x1[1] * bf_hi(a.z) + y1[1] * bf_hi(c.z));
                w.w = pg8::cvt_pk_bf16(x1[2] * bf_lo(a.w) + y1[2] * bf_lo(c.w), x1[3] * bf_hi(a.w) + y1[3] * bf_hi(c.w));
                *(u32x4*)(mout + ro) = w;
            }
    }
};

struct EpiResBf16 {
    static constexpr bool PERM = true, AFTER_DRAIN = false; static constexpr bool MULTI = false; static constexpr int MID_T = 0;
    const bf16_t* xb; bf16_t* h1b; unsigned char* h1f8;
    __device__ __forceinline__ void operator()(const acc_t& acc, const Unit& u, int wr, int wc, int fr, int fq) const {
        const int col0 = u.pn * BM + wc * 32 + 8 * fq;
        u32x4 xv[2][4][2];
#pragma unroll
        for (int ai = 0; ai < 2; ++ai)
#pragma unroll
            for (int m = 0; m < 4; ++m)
#pragma unroll
                for (int bj = 0; bj < 2; ++bj) xv[ai][m][bj] = *(const u32x4*)(xb + (size_t)(u.pm * BM + ai * HALF + wr * 64 + m * 16 + fr) * D + col0 + bj * HALF);
#pragma unroll
        for (int ai = 0; ai < 2; ++ai)
#pragma unroll
            for (int m = 0; m < 4; ++m) {
                const size_t ro = (size_t)(u.pm * BM + ai * HALF + wr * 64 + m * 16 + fr) * D + col0;
#pragma unroll
                for (int bj = 0; bj < 2; ++bj) {
                    const u32x4 x = xv[ai][m][bj]; const f32x4 v0 = acc[ai][bj][m][0], v1 = acc[ai][bj][m][1];
                    u32x4 w; w.x = pg8::cvt_pk_bf16(v0[0] + bf_lo(x.x), v0[1] + bf_hi(x.x)); w.y = pg8::cvt_pk_bf16(v0[2] + bf_lo(x.y), v0[3] + bf_hi(x.y));
                    w.z = pg8::cvt_pk_bf16(v1[0] + bf_lo(x.z), v1[1] + bf_hi(x.z)); w.w = pg8::cvt_pk_bf16(v1[2] + bf_lo(x.w), v1[3] + bf_hi(x.w));
                    *(u32x4*)(h1b + ro + bj * HALF) = w;
                    if (h1f8) { u32x2 q; q.x = pk4_fp8(v0[0] + bf_lo(x.x), v0[1] + bf_hi(x.x), v0[2] + bf_lo(x.y), v0[3] + bf_hi(x.y)); q.y = pk4_fp8(v1[0] + bf_lo(x.z), v1[1] + bf_hi(x.z), v1[2] + bf_lo(x.w), v1[3] + bf_hi(x.w)); *(u32x2*)(h1f8 + ro + bj * HALF) = q; }
                }
            }
    }
};

__device__ __forceinline__ int moe_local(const LAS int* pref, int e, int rtg, int r) { const int l = (rtg - pref[e]) * pg8::BM + r; return l < pref[64 + e] ? ((e << 15) | l) : -1; }
__device__ __forceinline__ LAS u32x2* moe_meta(LAS unsigned char* lds, int i) { return (LAS u32x2*)(lds + (i < 4 ? META_LO + i * 2048 : META_HI)); }
__device__ __forceinline__ void moe_meta_preload(LAS unsigned char* lds, const LAS int* pref, int nunits, int G, int c, const int* eslot, const float* ftab, bool by_token, int tid) {
    for (int j = tid; j < 5 * 256; j += 512) { const int i = j >> 8, r = j & 255, L = i * G + c;
        int slot = -1; float f = 0.f;
        if (L < nunits) { const int rtg = L >> 2; int e = 0;
#pragma unroll 4
            for (int k = 1; k < NE; ++k) e += (pref[k] <= rtg) ? 1 : 0;
            const int idx = moe_local(pref, e, rtg, r);
            if (idx >= 0) { slot = eslot[idx]; f = by_token ? ftab[slot >> 1] : ftab[idx]; } }
        moe_meta(lds, i)[r] = (u32x2){(unsigned)slot, __builtin_bit_cast(unsigned, f)}; }
    __syncthreads();
}
template <int F8> struct EpiSwigluT {
    static constexpr bool PERM = true, AFTER_DRAIN = false; static constexpr bool MULTI = false; static constexpr int MID_T = 0;
    bf16_t* hdn; LAS unsigned char* lds; static constexpr float wsc = F8 ? 1.0f / F8W : 1.0f; static constexpr int f8out = F8 && F8_DOWN;
    __device__ __forceinline__ void operator()(const acc_t& acc, const Unit& u, int wr, int wc, int fr, int fq) const {
        const int col0 = 128 * (u.pn & 3) + wc * 32 + 8 * fq;
        float rsv[2][4]; const LAS float* mp = (const LAS float*)moe_meta(lds, u.part) + 1;
#pragma unroll
        for (int ai = 0; ai < 2; ++ai)
#pragma unroll
            for (int m = 0; m < 4; ++m) rsv[ai][m] = mp[2 * (ai * HALF + wr * 64 + m * 16 + fr)] * wsc;
#pragma unroll
        for (int ai = 0; ai < 2; ++ai)
#pragma unroll
            for (int m = 0; m < 4; ++m) {
                const int row = u.pm * BM + ai * HALF + wr * 64 + m * 16 + fr; const float rs = rsv[ai][m];
                const size_t ro = (size_t)row * DE + col0;
                float h[8];
#pragma unroll
                for (int n = 0; n < 2; ++n)
#pragma unroll
                    for (int j = 0; j < 4; ++j) { const float a = acc[ai][0][m][n][j] * rs, b = acc[ai][1][m][n][j] * rs; h[4 * n + j] = a * sigmoidf_(a) * b; }
                if (f8out) { u32x2 q; q.x = pk4_fp8(h[0], h[1], h[2], h[3]); q.y = pk4_fp8(h[4], h[5], h[6], h[7]); *(u32x2*)((unsigned char*)hdn + ro) = q; }
                else { u32x4 w; w.x = pg8::cvt_pk_bf16(h[0], h[1]); w.y = pg8::cvt_pk_bf16(h[2], h[3]); w.z = pg8::cvt_pk_bf16(h[4], h[5]); w.w = pg8::cvt_pk_bf16(h[6], h[7]);
                *(u32x4*)(hdn + ro) = w; }
            }
    }
};

template <int F8> struct EpiDownT {
    static constexpr bool PERM = true, AFTER_DRAIN = false; static constexpr bool MULTI = false; static constexpr int MID_T = 0;
    bf16_t* contrib; LAS unsigned char* lds; static constexpr float wsc = (F8 ? 1.0f / F8W : 1.0f) * (F8_CONTRIB ? CSC : 1.0f);
    __device__ __forceinline__ void operator()(const acc_t& acc, const Unit& u, int wr, int wc, int fr, int fq) const {
        const int col0 = 256 * (u.pn & 3) + wc * 32 + 8 * fq;
#pragma unroll
        for (int ai = 0; ai < 2; ++ai) {
            int sl[4]; float wv[4];
#pragma unroll
            for (int m = 0; m < 4; ++m) { const LAS unsigned* mq = (const LAS unsigned*)moe_meta(lds, u.part) + 2 * (ai * HALF + wr * 64 + m * 16 + fr); sl[m] = (int)mq[0]; wv[m] = __builtin_bit_cast(float, mq[1]) * wsc; }
#pragma unroll
            for (int m = 0; m < 4; ++m) {
                const int slot = sl[m]; const float w = wv[m];
                if (slot >= 0) {
#pragma unroll
                    for (int bj = 0; bj < 2; ++bj) {
                        const f32x4 v0 = acc[ai][bj][m][0] * w, v1 = acc[ai][bj][m][1] * w;
#if F8_CONTRIB
                        *(u32x2*)((unsigned char*)contrib + (size_t)slot * D + col0 + bj * HALF) = (u32x2){pk4_fp8(v0[0], v0[1], v0[2], v0[3]), pk4_fp8(v1[0], v1[1], v1[2], v1[3])};
#else
                        u32x4 o; o.x = pg8::cvt_pk_bf16(v0[0], v0[1]); o.y = pg8::cvt_pk_bf16(v0[2], v0[3]); o.z = pg8::cvt_pk_bf16(v1[0], v1[1]); o.w = pg8::cvt_pk_bf16(v1[2], v1[3]);
                        *(u32x4*)(contrib + (size_t)slot * D + col0 + bj * HALF) = o;
#endif
                    }
                }
                asm volatile("" ::: "memory");
            }
        }
    }
};

struct EpiGateDual {
    static constexpr bool PERM = false, AFTER_DRAIN = false; static constexpr bool MULTI = false; static constexpr int MID_T = 0;
    const bf16_t* h2b; const float* rsc; const float* cmax; const float* bpg; float* out;
    __device__ __forceinline__ void operator()(const acc_t& acc, const Unit& u, int wr, int wc, int fr, int fq) const {
        const int col0 = u.pn * HALF + wc * 32 + 4 * fq;
        f32x4 cs[2], bv[2]; float rsv[2][4]; u32x2 hv[2][4][2];
#pragma unroll
        for (int n = 0; n < 2; ++n) { cs[n] = *(const f32x4*)(cmax + col0 + n * 16) * (1.0f / 127.0f); bv[n] = *(const f32x4*)(bpg + col0 + n * 16); }
#pragma unroll
        for (int ai = 0; ai < 2; ++ai)
#pragma unroll
            for (int m = 0; m < 4; ++m) { const int row = u.pm * BM + ai * HALF + wr * 64 + m * 16 + fr; rsv[ai][m] = rsc[row];
#pragma unroll
                for (int n = 0; n < 2; ++n) hv[ai][m][n] = *(const u32x2*)(h2b + (size_t)row * D + col0 + n * 16); }
#pragma unroll
        for (int ai = 0; ai < 2; ++ai)
#pragma unroll
            for (int m = 0; m < 4; ++m) {
                const int row = u.pm * BM + ai * HALF + wr * 64 + m * 16 + fr; const float rs = rsv[ai][m];
#pragma unroll
                for (int n = 0; n < 2; ++n) {
                    const int c = col0 + n * 16;
                    const u32x2 hw = hv[ai][m][n];
                    const i32x4 ia = __builtin_bit_cast(i32x4, acc[ai][0][m][n]); const f32x4 pv = acc[ai][1][m][n];
                    f32x4 a; a[0] = (float)ia[0] * rs * cs[n][0] + bv[n][0]; a[1] = (float)ia[1] * rs * cs[n][1] + bv[n][1]; a[2] = (float)ia[2] * rs * cs[n][2] + bv[n][2]; a[3] = (float)ia[3] * rs * cs[n][3] + bv[n][3];
                    f32x4 r;
                    r[0] = bf_lo(hw.x) + sigmoidf_(a[0]) * pv[0]; r[1] = bf_hi(hw.x) + sigmoidf_(a[1]) * pv[1];
                    r[2] = bf_lo(hw.y) + sigmoidf_(a[2]) * pv[2]; r[3] = bf_hi(hw.y) + sigmoidf_(a[3]) * pv[3];
                    *(f32x4*)(out + (size_t)row * D + c) = r;
                }
            }
    }
};

struct EpiMerge2 {
    static constexpr bool PERM = true, AFTER_DRAIN = false; static constexpr bool MULTI = true; static constexpr int MID_T = 0;
    const unsigned char* sga; const unsigned char* sgc; bf16_t* mout;
    __device__ __forceinline__ int kt0(int part) const { return 8 * part; }
    __device__ __forceinline__ int nkt(int) const { return 8; }
    __device__ __forceinline__ bool reset(int part) const { return part == 1; }
    static __device__ __forceinline__ float u8(unsigned w, int j) { return (float)((w >> (8 * j)) & 0xffu); }
    __device__ __forceinline__ void operator()(acc_t& acc, const Unit& u, int wr, int wc, int fr, int fq) const {
        const int col0 = u.pn * BM + wc * 32 + 8 * fq;
        if (u.part == 0) {
            u32x2 av[2][4][2], cv[2][4][2];
#pragma unroll
            for (int ai = 0; ai < 2; ++ai)
#pragma unroll
                for (int m = 0; m < 4; ++m)
#pragma unroll
                    for (int bj = 0; bj < 2; ++bj) { const size_t o = (size_t)(u.pm * BM + ai * HALF + wr * 64 + m * 16 + fr) * D + col0 + bj * HALF; av[ai][m][bj] = *(const u32x2*)(sga + o); cv[ai][m][bj] = *(const u32x2*)(sgc + o); }
#pragma unroll
            for (int ai = 0; ai < 2; ++ai)
#pragma unroll
                for (int m = 0; m < 4; ++m)
#pragma unroll
                    for (int bj = 0; bj < 2; ++bj) {
                        const u32x2 a = av[ai][m][bj], c = cv[ai][m][bj];
#pragma unroll
                        for (int j = 0; j < 4; ++j) { acc[ai][bj][m][0][j] *= u8(a.x, j) * __builtin_amdgcn_rcpf(u8(c.x, j)); acc[ai][bj][m][1][j] *= u8(a.y, j) * __builtin_amdgcn_rcpf(u8(c.y, j)); }
                    }
        } else {
            u32x2 cv[2][4][2];
#pragma unroll
            for (int ai = 0; ai < 2; ++ai)
#pragma unroll
                for (int m = 0; m < 4; ++m)
#pragma unroll
                    for (int bj = 0; bj < 2; ++bj) cv[ai][m][bj] = *(const u32x2*)(sgc + (size_t)(u.pm * BM + ai * HALF + wr * 64 + m * 16 + fr) * D + col0 + bj * HALF);
#pragma unroll
            for (int ai = 0; ai < 2; ++ai)
#pragma unroll
                for (int m = 0; m < 4; ++m) {
                    const size_t ro = (size_t)(u.pm * BM + ai * HALF + wr * 64 + m * 16 + fr) * D + col0;
#pragma unroll
                    for (int bj = 0; bj < 2; ++bj) {
                        const u32x2 c = cv[ai][m][bj]; const f32x4 v0 = acc[ai][bj][m][0], v1 = acc[ai][bj][m][1]; constexpr float k = 1.0f / 255.0f;
                        u32x4 w; w.x = pg8::cvt_pk_bf16(v0[0] * u8(c.x, 0) * k, v0[1] * u8(c.x, 1) * k); w.y = pg8::cvt_pk_bf16(v0[2] * u8(c.x, 2) * k, v0[3] * u8(c.x, 3) * k);
                        w.z = pg8::cvt_pk_bf16(v1[0] * u8(c.y, 0) * k, v1[1] * u8(c.y, 1) * k); w.w = pg8::cvt_pk_bf16(v1[2] * u8(c.y, 2) * k, v1[3] * u8(c.y, 3) * k);
                        *(u32x4*)(mout + ro + bj * HALF) = w;
                    }
                }
        }
    }
};

template <bool GATHER_> struct MoeOrderT {
    static constexpr bool GATHER = GATHER_;
    const LAS int* pref;
    int nunits, G, c; LAS unsigned char* lds;
    __device__ __forceinline__ int row_of(const Unit& u, int r) const { return ((const LAS int*)moe_meta(lds, u.part))[2 * r]; }
    __device__ __forceinline__ bool next(int i, Unit& u) const {
        const int L = i * G + c; if (L >= nunits) return false;
        const int rtg = L >> 2, pnl = L & 3; int e = 0;
#pragma unroll 4
        for (int k = 1; k < NE; ++k) e += (pref[k] <= rtg) ? 1 : 0;
        e = __builtin_amdgcn_readfirstlane(e);
        u.pm = rtg; u.pn = 4 * e + pnl; u.part = i; return true;
    }
    __device__ __forceinline__ void a_ready(const Unit&) const {}
    __device__ __forceinline__ void done(const Unit&) const {}
};
struct StaticOrderId : pg8::StaticOrder {
    static constexpr bool GATHER = true;
    __device__ __forceinline__ int row_of(const Unit& u, int r) const { return 2 * (u.pm * pg8::BM + r); }
};
struct MoeOrderId : MoeOrderT<true> {
    __device__ __forceinline__ int row_of(const Unit& u, int r) const { return 2 * (u.pm * pg8::BM + r); }
};

#define XB_TMO      128
#define XB_XCNT(j)  (256  + 64 * (j))
#define XB_XSUB(j)  (1280 + 64 * (j))
#define XB_XGEN(j)  (2304 + 64 * (j))
#define XB_TOP      3328
#define XB_TOPGEN   3392
#define XCD_BAR_WORDS 3456
#define XB_SPIN_CAP (1u << 18)

__device__ __forceinline__ unsigned xb_ld(unsigned* p)              { return __hip_atomic_load(p, __ATOMIC_RELAXED, __HIP_MEMORY_SCOPE_AGENT); }
__device__ __forceinline__ unsigned xb_add(unsigned* p, unsigned v) { return __hip_atomic_fetch_add(p, v, __ATOMIC_RELAXED, __HIP_MEMORY_SCOPE_AGENT); }
__device__ __forceinline__ unsigned xb_xcc_id() { return (unsigned)__builtin_amdgcn_s_getreg((3 << 11) | 20) & 0xFu; }
#define XB_SPIN(cond, bar) do { unsigned _sp = 0; while (cond) { __builtin_amdgcn_s_sleep(1); \
    if ((++_sp & 255u) == 0u) { if (xb_ld(&(bar)[XB_TMO])) break; if (_sp > XB_SPIN_CAP) { atomicAdd(&(bar)[XB_TMO], 1u); break; } } } } while (0)

struct XcdBarrier {
    unsigned* bar; unsigned x;
    volatile LAS unsigned* st;
};

__device__ __forceinline__ XcdBarrier xcd_barrier_post(unsigned* bar, volatile LAS unsigned* st) {
    XcdBarrier b; b.bar = bar; b.x = xb_xcc_id(); b.st = st;
    if (threadIdx.x == 0) (void)xb_add(&bar[XB_XCNT(b.x)], 1u);
    return b;
}
__device__ __forceinline__ void xcd_barrier_complete(unsigned* bar, unsigned x, unsigned& nloc, unsigned& nx) {
    const unsigned G = gridDim.x * gridDim.y * gridDim.z;
    unsigned sum, cnt, mine, sp = 0u;
    for (;;) {
        sum = 0u; cnt = 0u; mine = 0u;
#pragma unroll
        for (unsigned j = 0; j < 16; ++j) { const unsigned c = xb_ld(&bar[XB_XCNT(j)]); sum += c; cnt += (c > 0u) ? 1u : 0u; mine = (j == x) ? c : mine; }
        if (sum == G) break;
        __builtin_amdgcn_s_sleep(1);
        if ((++sp & 255u) == 0u) { if (xb_ld(&bar[XB_TMO])) break; if (sp > XB_SPIN_CAP) { atomicAdd(&bar[XB_TMO], 1u); break; } }
    }
    nloc = mine > 0u ? mine : 1u; nx = cnt > 0u ? cnt : 1u;
}

__device__ __forceinline__ void xcd_barrier(const XcdBarrier& b, int tid) {
    asm volatile("s_waitcnt vmcnt(0)" ::: "memory");
    __syncthreads();
    if (tid == 0) {
        unsigned* bar = b.bar;
        __builtin_amdgcn_s_waitcnt(0);
        unsigned nloc = b.st[0], nx = b.st[1];
        if (nloc == 0u) { xcd_barrier_complete(bar, b.x, nloc, nx); b.st[0] = nloc; b.st[1] = nx; }
        const unsigned old = xb_add(&bar[XB_XSUB(b.x)], 1u);
        const unsigned gen = old / nloc;
        if (old + 1u == (gen + 1u) * nloc) {
            __builtin_amdgcn_fence(__ATOMIC_RELEASE, "agent");
            asm volatile("s_waitcnt vmcnt(0)" ::: "memory");
            const unsigned og = xb_add(&bar[XB_TOP], 1u);
            const unsigned tg = og / nx;
            if (og + 1u == (tg + 1u) * nx) xb_add(&bar[XB_TOPGEN], 1u);
            else XB_SPIN(xb_ld(&bar[XB_TOPGEN]) == tg, bar);
            __builtin_amdgcn_fence(__ATOMIC_ACQUIRE, "agent");
            xb_add(&bar[XB_XGEN(b.x)], 1u);
            asm volatile("s_waitcnt vmcnt(0)" ::: "memory");
        } else {
            XB_SPIN(xb_ld(&bar[XB_XGEN(b.x)]) == gen, bar);
            __builtin_amdgcn_fence(__ATOMIC_ACQUIRE, "agent");
            asm volatile("s_waitcnt vmcnt(0)" ::: "memory");
        }
    }
    __syncthreads();
}

#include <hip/hip_bf16.h>
#include <cmath>
namespace attn_body {
using bf16=__hip_bfloat16;
using bf16x8=__attribute__((ext_vector_type(8)))short;
using s16x4=__attribute__((ext_vector_type(4)))short;
using f32x16=__attribute__((ext_vector_type(16)))float;
using u32x4=__attribute__((ext_vector_type(4)))unsigned;
constexpr int BATCH=8,NHEAD=8,SEQ=4096,D=64,DM=1024,OPITCH=1024;
constexpr int NW=8,QBLK=32,QB=QBLK*NW,KVBLK=64,NQB=SEQ/QB;
constexpr int ATTN_PITCH=DM, ATTN_UNIT_ROWS=QB;
constexpr int BT_COPY=384, BT_BYTES=4*BT_COPY*4;
__device__ __forceinline__ int crow(int r,int hi){return (r&3)+8*(r>>2)+4*hi;}
#define SBAR() __builtin_amdgcn_sched_barrier(0)
constexpr int NSLOT=3, SLOTB=8192;
constexpr int LDS_K=0, LDS_V=NSLOT*SLOTB, LDS_WS=2*NSLOT*SLOTB, LDS_OST=LDS_WS+NW*64*4, LDS_BT=LDS_OST+NW*4096, LDS_BYTES=LDS_BT+BT_BYTES;
__device__ __forceinline__ void glds16(const void*gsrc,unsigned lds_dst){unsigned keep;
  asm volatile("s_mov_b32 %0, m0\n\ts_mov_b32 m0, %2\n\ts_nop 0\n\tglobal_load_lds_dwordx4 %1, off\n\ts_mov_b32 m0, %0":"=&s"(keep):"v"(gsrc),"s"(lds_dst):"memory");}
__device__ __forceinline__ float max3f(float a,float b,float c){float r;asm("v_max3_f32 %0, %1, %2, %3":"=v"(r):"v"(a),"v"(b),"v"(c));return r;}
__device__ __forceinline__ float max2f(float a,float b){float r;asm("v_max_f32_e32 %0, %1, %2":"=v"(r):"v"(a),"v"(b));return r;}
__device__ __forceinline__ float fadd_s(float a,float b){float r;asm("v_add_f32_e32 %0, %1, %2":"=v"(r):"v"(a),"v"(b));return r;}
__device__ __forceinline__ float fsub_s(float a,float b){float r;asm("v_sub_f32_e32 %0, %1, %2":"=v"(r):"v"(a),"v"(b));return r;}
typedef float f32x2_t __attribute__((ext_vector_type(2))); typedef float f32x4_t __attribute__((ext_vector_type(4))); typedef __bf16 bf16x2_t __attribute__((ext_vector_type(2)));
__device__ __forceinline__ unsigned cvtpk_s(float lo,float hi){f32x2_t v={lo,hi};bf16x2_t b=__builtin_convertvector(v,bf16x2_t);return __builtin_bit_cast(unsigned,b);}
#define WAIT_BAR(N) asm volatile("s_waitcnt vmcnt(" #N ") lgkmcnt(0)\n\ts_barrier":::"memory")

__device__ __forceinline__ void qkt(f32x16&p0,f32x16&p1,const char*Kslot,const bf16x8*qr,const f32x16&negm,int r32,int hi){
  const char*kb=Kslot+hi*1024+r32*16;
  #pragma unroll
  for(int d0=0;d0<4;++d0){
    const bf16x8 b0=*reinterpret_cast<const bf16x8*>(kb+d0*2048);
    const bf16x8 b1=*reinterpret_cast<const bf16x8*>(kb+d0*2048+512);
    if(d0==0){p0=__builtin_amdgcn_mfma_f32_32x32x16_bf16(b0,qr[0],negm,0,0,0);p1=__builtin_amdgcn_mfma_f32_32x32x16_bf16(b1,qr[0],negm,0,0,0);}
    else{p0=__builtin_amdgcn_mfma_f32_32x32x16_bf16(b0,qr[d0],p0,0,0,0);p1=__builtin_amdgcn_mfma_f32_32x32x16_bf16(b1,qr[d0],p1,0,0,0);}}
}
typedef __attribute__((address_space(3))) const char* lds_cptr;
typedef short v4i16_t __attribute__((ext_vector_type(4)));
__device__ __forceinline__ void kload8(bf16x8*kf,lds_cptr kp){
  kf[0]=*(const __attribute__((address_space(3))) bf16x8*)(kp);      kf[1]=*(const __attribute__((address_space(3))) bf16x8*)(kp+512);
  kf[2]=*(const __attribute__((address_space(3))) bf16x8*)(kp+2048); kf[3]=*(const __attribute__((address_space(3))) bf16x8*)(kp+2560);
  kf[4]=*(const __attribute__((address_space(3))) bf16x8*)(kp+4096); kf[5]=*(const __attribute__((address_space(3))) bf16x8*)(kp+4608);
  kf[6]=*(const __attribute__((address_space(3))) bf16x8*)(kp+6144); kf[7]=*(const __attribute__((address_space(3))) bf16x8*)(kp+6656);
}
__device__ __forceinline__ void kload2(bf16x8*kf,lds_cptr kp,int j){ kf[2*j]=*(const __attribute__((address_space(3))) bf16x8*)(kp+j*2048); kf[2*j+1]=*(const __attribute__((address_space(3))) bf16x8*)(kp+j*2048+512); }
__device__ __forceinline__ s16x4 vtr(lds_cptr p){ return __builtin_bit_cast(s16x4,__builtin_amdgcn_ds_read_tr16_b64_v4i16((__attribute__((address_space(3))) v4i16_t*)p)); }
__device__ __forceinline__ float rowmax(const f32x16&p0,const f32x16&p1){
  float a=max3f(p0[0],p0[1],p1[0]),b=max3f(p0[2],p0[3],p1[1]);a=max3f(a,p1[2],p1[3]);
  #pragma unroll
  for(int r=4;r<16;r+=4){a=max3f(a,p0[r],p0[r+1]);b=max3f(b,p0[r+2],p0[r+3]);a=max3f(a,p1[r],p1[r+1]);b=max3f(b,p1[r+2],p1[r+3]);}
  const float m=max2f(a,b);
  auto rr=__builtin_amdgcn_permlane32_swap(__float_as_uint(m),__float_as_uint(m),false,false);
  return max2f(__uint_as_float(rr[0]),__uint_as_float(rr[1]));
}
__device__ __forceinline__ void pv(f32x16*o,int vb,bf16x8 pa0,bf16x8 pa1,bf16x8 pa2,bf16x8 pa3){
  #pragma unroll
  for(int d0=0;d0<2;++d0){s16x4 lo[4],hi[4];
    #pragma unroll
    for(int ks=0;ks<4;++ks){
      asm volatile("ds_read_b64_tr_b16 %0,%1 offset:%c2":"=&v"(lo[ks]):"v"(vb),"i"(d0*4096+ks*1024):"memory");
      asm volatile("ds_read_b64_tr_b16 %0,%1 offset:%c2":"=&v"(hi[ks]):"v"(vb),"i"(d0*4096+ks*1024+512):"memory");}
    asm volatile("s_waitcnt lgkmcnt(0)":::"memory");SBAR();
    #define PK(k) (bf16x8){lo[k][0],lo[k][1],lo[k][2],lo[k][3],hi[k][0],hi[k][1],hi[k][2],hi[k][3]}
    o[d0]=__builtin_amdgcn_mfma_f32_32x32x16_bf16(pa0,PK(0),o[d0],0,0,0);
    o[d0]=__builtin_amdgcn_mfma_f32_32x32x16_bf16(pa1,PK(1),o[d0],0,0,0);
    o[d0]=__builtin_amdgcn_mfma_f32_32x32x16_bf16(pa2,PK(2),o[d0],0,0,0);
    o[d0]=__builtin_amdgcn_mfma_f32_32x32x16_bf16(pa3,PK(3),o[d0],0,0,0);
    #undef PK
  }
}

#ifndef ATTN_STORE16
#define ATTN_STORE16(p,v) (*(u32x4*)(p)=(v))
#endif
__device__ __forceinline__ void attn_unit(int b,int h,int qb,const bf16*Q,const bf16*K,const bf16*V,bf16*O,char*shm,float cinit,int tid){
  asm volatile("":"+v"(tid));
  const int lane=tid&63,r32=lane&31,hi=lane>>5; const int wid=__builtin_amdgcn_readfirstlane(tid>>6);
  const long rowbase=(long)b*SEQ; const int q0=qb*QB;
  const bf16*Qw=Q+(rowbase+q0+wid*QBLK)*DM+h*D;
  const int t0=(4*qb-8)>0?(4*qb-8):0;
  const bf16*Kh=K+(rowbase+(long)t0*KVBLK)*DM+h*D,*Vh=V+(rowbase+(long)t0*KVBLK)*DM+h*D;
  const int tb=t0-4*qb-(wid>>1)+8;
  const unsigned lds0=(unsigned)(uintptr_t)shm;
  float*wsf=(float*)(shm+LDS_WS)+wid*64;
  const bf16*ksrc=Kh+(long)lane*DM+wid*8;
  const bf16*vsrc=Vh+(long)(16*(wid&3)+(lane>>2))*DM+(wid>>2)*32+(lane&3)*8;
  const unsigned kdst=lds0+LDS_K+wid*1024, vdst=lds0+LDS_V+wid*1024;
  #define DMA_K(t,slot) glds16(ksrc+(long)(t)*KVBLK*DM,(unsigned)__builtin_amdgcn_readfirstlane(kdst+(slot)))
  #define DMA_V(t,slot) glds16(vsrc+(long)(t)*KVBLK*DM,(unsigned)__builtin_amdgcn_readfirstlane(vdst+(slot)))
  const int vb0=(int)(lds0+LDS_V)+((lane>>4)&1)*32+(lane&3)*8+(4*hi+((lane&15)>>2))*64;
  const char*Kbase=shm+LDS_K; bf16x8 kf[8];
  const lds_cptr shm3=(lds_cptr)shm; const lds_cptr kp0=shm3+LDS_K+hi*1024+r32*16; const lds_cptr vp0=shm3+LDS_V+((lane>>4)&1)*32+(lane&3)*8+(4*hi+((lane&15)>>2))*64;
  const int NT=4*qb+4-t0;
  const lds_cptr btl=shm3+LDS_BT+((3-r32)&3)*(BT_COPY*4)+4*(-193-32*(wid&1)-r32-((3-r32)&3)+4*hi);
  DMA_K(0,0);DMA_V(0,0);DMA_K(1,SLOTB);
  bf16x8 qr[4];
  #pragma unroll
  for(int d0=0;d0<4;++d0)qr[d0]=*reinterpret_cast<const bf16x8*>(&Qw[(long)r32*DM+d0*16+hi*8]);
  float l_reg=0.f;f32x16 o[2];o[0]=f32x16{};o[1]=f32x16{};f32x16 negm;
  asm volatile("":"+s"(cinit));
  _Pragma("unroll") for(int r=0;r<16;++r)negm[r]=cinit; asm volatile("":"+v"(negm));
  #define BIASMASK(P0,P1,t) do{ const int tau_=(t)+tb; \
    if(tau_<0||tau_>8){ _Pragma("unroll") for(int r=0;r<16;++r){P0[r]=-INFINITY;P1[r]=-INFINITY;} } \
    else if(tau_>=4){ const lds_cptr bp_=btl+256*tau_; \
      _Pragma("unroll") for(int g=0;g<4;++g){ const f32x4_t d0_=*(const __attribute__((address_space(3))) f32x4_t*)(bp_+32*g), d1_=*(const __attribute__((address_space(3))) f32x4_t*)(bp_+32*g+128); \
        _Pragma("unroll") for(int j=0;j<4;++j){P0[4*g+j]+=d0_[j];P1[4*g+j]+=d1_[j];} } } }while(0)
  #define START(P0,P1) do{ _Pragma("unroll") for(int r=0;r<16;++r)P0[r]=__builtin_amdgcn_exp2f(P0[r]); }while(0)
  #define RESC() do{}while(0)
  f32x16 pA0,pA1,pB0,pB1;
  int sl_prev=0,sl_cur=0,sl_next=SLOTB;
  #define ROT() do{sl_prev=sl_cur;sl_cur=sl_next;sl_next=(sl_next==(NSLOT-1)*SLOTB)?0:sl_next+SLOTB;}while(0)
  DMA_K(2,2*SLOTB);
  WAIT_BAR(3);
  qkt(pA0,pA1,Kbase,qr,negm,r32,hi);asm volatile("s_nop 15\n\ts_nop 7":"+v"(pA0),"+v"(pA1));BIASMASK(pA0,pA1,0);
  START(pA0,pA1);
  _Pragma("unroll") for(int r=0;r<16;++r)pA1[r]=__builtin_amdgcn_exp2f(pA1[r]);
  WAIT_BAR(0);
  DMA_K(3,0);DMA_V(1,SLOTB);
  ROT();
  kload8(kf,kp0+sl_cur);
  WAIT_BAR(2);
  s16x4 vlo[8],vhi[8]; u32x4 pw0,pw1,pw2,pw3;
  #define PKW(P,B) cvtpk_s(P[B],P[B+1])
  #define PAF(k) __builtin_bit_cast(bf16x8,pw##k)
  #define VFR(i) (bf16x8){vlo[i][0],vlo[i][1],vlo[i][2],vlo[i][3],vhi[i][0],vhi[i][1],vhi[i][2],vhi[i][3]}
  #define PIN(x) asm volatile("":"+v"(x))
  #define MX3(a,b,c) __builtin_fmaxf(__builtin_fmaxf((a),(b)),(c))
  #define GAPA(MF,A0,A1,A2,A3,W0,W1,PW) do{ MF; sacc+=A0; sacc+=A1; sacc+=A2; sacc+=A3; PIN(sacc); W0; W1; PIN(PW); SBAR(); }while(0)
  #define EX(v) __builtin_amdgcn_exp2f(v)
  #define GAPB(MF,X,B) do{ MF; X[B]=EX(X[B]); X[B+1]=EX(X[B+1]); X[B+2]=EX(X[B+2]); X[B+3]=EX(X[B+3]); PIN(X); SBAR(); }while(0)
  #define VRD(i) do{ vlo[i]=vtr(vp_+(((i)>>2)*4096+((i)&3)*1024)); vhi[i]=vtr(vp_+(((i)>>2)*4096+((i)&3)*1024+512)); }while(0)
  #define KRD(G,j) do{ if(G){ kload2(kf,kp0+sl_next,j); SBAR(); } }while(0)
  #define STEP(C0,C1,P0,P1,t,GK,GV,GL) do{ SBAR(); \
    const lds_cptr vp_=vp0+sl_prev; \
    VRD(0); SBAR(); float sacc=(P0[0]+P0[1]); \
    GAPA(C0=__builtin_amdgcn_mfma_f32_32x32x16_bf16(kf[0],qr[0],negm,0,0,0), P0[2],P0[3],P0[4],P0[5],     pw0[0]=PKW(P0,0), pw0[1]=PKW(P0,2), pw0); \
    VRD(4); SBAR(); GAPA(C1=__builtin_amdgcn_mfma_f32_32x32x16_bf16(kf[1],qr[0],negm,0,0,0), P0[6],P0[7],P0[8],P0[9],     pw0[2]=PKW(P0,4), pw0[3]=PKW(P0,6), pw0); \
    VRD(1); SBAR(); GAPA(C0=__builtin_amdgcn_mfma_f32_32x32x16_bf16(kf[2],qr[1],C0,0,0,0),   P0[10],P0[11],P0[12],P0[13], pw1[0]=PKW(P0,8), pw1[1]=PKW(P0,10), pw1); \
    VRD(5); SBAR(); GAPA(C1=__builtin_amdgcn_mfma_f32_32x32x16_bf16(kf[3],qr[1],C1,0,0,0),   P0[14],P0[15],P1[0],P1[1],   pw1[2]=PKW(P0,12),pw1[3]=PKW(P0,14), pw1); \
    VRD(2); SBAR(); GAPA(C0=__builtin_amdgcn_mfma_f32_32x32x16_bf16(kf[4],qr[2],C0,0,0,0),   P1[2],P1[3],P1[4],P1[5],     pw2[0]=PKW(P1,0), pw2[1]=PKW(P1,2), pw2); \
    VRD(6); SBAR(); GAPA(C1=__builtin_amdgcn_mfma_f32_32x32x16_bf16(kf[5],qr[2],C1,0,0,0),   P1[6],P1[7],P1[8],P1[9],     pw2[2]=PKW(P1,4), pw2[3]=PKW(P1,6), pw2); \
    VRD(3); SBAR(); GAPA(C0=__builtin_amdgcn_mfma_f32_32x32x16_bf16(kf[6],qr[3],C0,0,0,0),   P1[10],P1[11],P1[12],P1[13], pw3[0]=PKW(P1,8), pw3[1]=PKW(P1,10), pw3); \
    VRD(7); SBAR(); GAPA(C1=__builtin_amdgcn_mfma_f32_32x32x16_bf16(kf[7],qr[3],C1,0,0,0),   P1[14],P1[15],0.f,0.f,       pw3[2]=PKW(P1,12),pw3[3]=PKW(P1,14), pw3); \
    l_reg+=sacc; \
    if(GK){DMA_K((t)+3,sl_cur);} if(GV){DMA_V((t)+1,sl_next);} \
    BIASMASK(C0,C1,t); \
    SBAR(); \
    GAPB(o[0]=__builtin_amdgcn_mfma_f32_32x32x16_bf16(PAF(0),VFR(0),o[0],0,0,0), C0,0); \
    GAPB(o[1]=__builtin_amdgcn_mfma_f32_32x32x16_bf16(PAF(0),VFR(4),o[1],0,0,0), C0,4); \
    KRD(GL,0); GAPB(o[0]=__builtin_amdgcn_mfma_f32_32x32x16_bf16(PAF(1),VFR(1),o[0],0,0,0), C0,8); \
    KRD(GL,1); GAPB(o[1]=__builtin_amdgcn_mfma_f32_32x32x16_bf16(PAF(1),VFR(5),o[1],0,0,0), C0,12); \
    KRD(GL,2); GAPB(o[0]=__builtin_amdgcn_mfma_f32_32x32x16_bf16(PAF(2),VFR(2),o[0],0,0,0), C1,0); \
    KRD(GL,3); GAPB(o[1]=__builtin_amdgcn_mfma_f32_32x32x16_bf16(PAF(2),VFR(6),o[1],0,0,0), C1,4); \
    GAPB(o[0]=__builtin_amdgcn_mfma_f32_32x32x16_bf16(PAF(3),VFR(3),o[0],0,0,0), C1,8); \
    GAPB(o[1]=__builtin_amdgcn_mfma_f32_32x32x16_bf16(PAF(3),VFR(7),o[1],0,0,0), C1,12); \
    }while(0)
  int t=1;
  for(;t+5<NT;t+=2){
    STEP(pB0,pB1,pA0,pA1,t,true,true,true);     WAIT_BAR(2); RESC(); ROT();
    STEP(pA0,pA1,pB0,pB1,t+1,true,true,true);   WAIT_BAR(2); RESC(); ROT();
  }
  #define ENDW(tt) do{ if((tt)+3<NT){WAIT_BAR(2);} else if((tt)+2<NT){WAIT_BAR(1);} else {WAIT_BAR(0);} }while(0)
  for(;t+1<NT;t+=2){
    STEP(pB0,pB1,pA0,pA1,t,(t+3<NT),(t+1<NT),(t+1<NT));       ENDW(t);   RESC(); ROT();
    STEP(pA0,pA1,pB0,pB1,t+1,(t+4<NT),(t+2<NT),(t+2<NT));     ENDW(t+1); RESC(); ROT();
  }
  STEP(pB0,pB1,pA0,pA1,NT-1,false,false,false); RESC();
  { float sacc=pB0[0]+pB0[1]; _Pragma("unroll") for(int r=2;r<16;++r)sacc+=pB0[r]; _Pragma("unroll") for(int r=0;r<16;++r)sacc+=pB1[r]; l_reg+=sacc;
    pw0=(u32x4){PKW(pB0,0),PKW(pB0,2),PKW(pB0,4),PKW(pB0,6)};pw1=(u32x4){PKW(pB0,8),PKW(pB0,10),PKW(pB0,12),PKW(pB0,14)};pw2=(u32x4){PKW(pB1,0),PKW(pB1,2),PKW(pB1,4),PKW(pB1,6)};pw3=(u32x4){PKW(pB1,8),PKW(pB1,10),PKW(pB1,12),PKW(pB1,14)};
    SBAR(); pv(o,vb0+sl_cur,PAF(0),PAF(1),PAF(2),PAF(3)); }
  #undef PKW
  #undef PAF
  #undef VFR
  #undef PIN
  #undef MX3
  #undef GAPA
  #undef GAPB
  #undef EX
  #undef VRD
  #undef KRD
  #undef STEP
  #undef ENDW
  {auto rr=__builtin_amdgcn_permlane32_swap(__float_as_uint(l_reg),__float_as_uint(l_reg),false,false);l_reg=__uint_as_float(rr[0])+__uint_as_float(rr[1]);}
  if(hi==0)wsf[32+r32]=l_reg;asm volatile("s_waitcnt lgkmcnt(0)":::"memory");
  float rli[16];
  #pragma unroll
  for(int r=0;r<16;++r)rli[r]=__builtin_amdgcn_rcpf(wsf[32+crow(r,hi)]);
  bf16*Ow=O+(rowbase+q0+wid*QBLK)*OPITCH+h*D;
  { bf16*stg=(bf16*)(shm+LDS_OST)+wid*2048;
    #pragma unroll
    for(int r=0;r<16;++r){const int orow=crow(r,hi);
      #pragma unroll
      for(int d0=0;d0<2;++d0)stg[orow*64+d0*32+r32]=__float2bfloat16(o[d0][r]*rli[r]);}
    asm volatile("s_waitcnt lgkmcnt(0)":::"memory");
    #pragma unroll
    for(int i=0;i<4;++i){const int row=i*8+(lane>>3),ch=lane&7; const u32x4 v=*(const u32x4*)(stg+row*64+ch*8); ATTN_STORE16(Ow+(long)row*OPITCH+ch*8,v);} }
  asm volatile("s_waitcnt lgkmcnt(0)\n\ts_barrier":::"memory");
  #undef DMA_K
  #undef DMA_V
  #undef BIASMASK
  #undef START
  #undef RESC
  #undef ROT
}
constexpr int ATTN_LDS_BYTES=LDS_BYTES;
struct AttnUnit { int bh; int qb; };
__device__ __forceinline__ void attn_phase(char*lds,const bf16*Q,const bf16*K,const bf16*V,bf16*O,const float*gtab,const float*gcinit,int grid,int block,int tid){
  const int vcu=(block%8)*(grid/8)+block/8, s_=vcu&3, bh=vcu>>2, h=bh&7, b=bh>>3;
  { const f32x4_t* src=(const f32x4_t*)(gtab+(size_t)h*(4*BT_COPY)); __attribute__((address_space(3))) f32x4_t* dst=(__attribute__((address_space(3))) f32x4_t*)((lds_cptr)lds+LDS_BT);
    if(tid<BT_BYTES/16)dst[tid]=src[tid]; }
  const float cinit=__builtin_bit_cast(float,__builtin_amdgcn_readfirstlane(__builtin_bit_cast(int,gcinit[h])));
  asm volatile("s_waitcnt vmcnt(0) lgkmcnt(0)\n\ts_barrier":::"memory");
  for(int i=0;i<4;++i){ const int qb=(i==0)?s_:(i==1)?7-s_:(i==2)?8+s_:15-s_; attn_unit(b,h,qb,Q,K,V,O,lds,cinit,tid); }
}
#undef SBAR
#undef WAIT_BAR
}

struct Args {
    const float *x, *p, *g_mix, *w_in, *b_in, *g_q, *g_k, *rel_bias, *conv_w, *conv_b, *w_pa, *w_pc, *w_o, *g_ffn, *w_group, *b_group, *w_router, *b_router, *w1, *w3, *w2, *g_ple, *w_pg, *b_pg, *w_pp;
    float* out; unsigned char* ws;
};
constexpr int NWAVES = 8, NTHREADS = 512;
constexpr int RING_BYTES = 131072, MISC_OFF = 139264, WSCR = 16640;
constexpr int LDS_BYTES = 163840; static_assert(META_HI + 2048 <= LDS_BYTES, "MoE metadata area");

__device__ __forceinline__ void transpose_item(const float* src, int ldw, bf16_t* dst, int ldT, LAS float* scr, int lane, const float* gain = nullptr, int hi_off = 0) {
    float v[64];
#pragma unroll
    for (int i = 0; i < 64; ++i) v[i] = src[(size_t)i * ldw + lane];
    if (gain) {
#pragma unroll
        for (int i = 0; i < 64; ++i) v[i] *= gain[i];
    }
#pragma unroll
    for (int i = 0; i < 64; ++i) scr[i * 65 + lane] = v[i];
    LDS_WAIT(); asm volatile("" ::: "memory");
    const int c = lane & 7;
#pragma unroll
    for (int j = 0; j < 8; ++j) { const int n = (lane >> 3) + 8 * j; const LAS float* s = scr + (8 * c) * 65 + n;
        u32x4 o; o.x = pk2(s[0 * 65], s[1 * 65]); o.y = pk2(s[2 * 65], s[3 * 65]); o.z = pk2(s[4 * 65], s[5 * 65]); o.w = pk2(s[6 * 65], s[7 * 65]);
        *(u32x4*)(dst + (size_t)(n + (n >= 32 ? hi_off : 0)) * ldT + 8 * c) = o; }
    LDS_WAIT(); asm volatile("" ::: "memory");
}
__device__ __forceinline__ void transpose_item_f8(const float* src, int ldw, unsigned char* dst, int ldTb, LAS float* scr, int lane, const float* gain, float sc) {
    float v[64];
#pragma unroll
    for (int i = 0; i < 64; ++i) v[i] = src[(size_t)i * ldw + lane];
#pragma unroll
    for (int i = 0; i < 64; ++i) scr[i * 65 + lane] = v[i] * (gain ? gain[i] : 1.0f) * sc;
    LDS_WAIT(); asm volatile("" ::: "memory");
    const int c = lane & 3;
#pragma unroll
    for (int j = 0; j < 4; ++j) { const int n = (lane >> 2) + 16 * j; const LAS float* s = scr + (16 * c) * 65 + n; unsigned w[4];
#pragma unroll
        for (int e = 0; e < 4; ++e) w[e] = pk4_fp8(s[(4 * e) * 65], s[(4 * e + 1) * 65], s[(4 * e + 2) * 65], s[(4 * e + 3) * 65]);
        *(u32x4*)(dst + (size_t)n * ldTb + 16 * c) = (u32x4){w[0], w[1], w[2], w[3]}; }
    LDS_WAIT(); asm volatile("" ::: "memory");
}
__device__ __forceinline__ void transpose_item_q8(const float* src, int ldw, signed char* dst, int ldTb, LAS float* scr, int lane, const float* gain, const float* cmax) {
    float v[64];
#pragma unroll
    for (int i = 0; i < 64; ++i) v[i] = src[(size_t)i * ldw + lane];
    const float sc = 127.0f / fmaxf(__builtin_bit_cast(float, __hip_atomic_load((const unsigned*)cmax + lane, __ATOMIC_RELAXED, __HIP_MEMORY_SCOPE_AGENT)), 1e-30f);
#pragma unroll
    for (int i = 0; i < 64; ++i) scr[i * 65 + lane] = v[i] * gain[i] * sc;
    LDS_WAIT(); asm volatile("" ::: "memory");
    const int c = lane & 3;
#pragma unroll
    for (int j = 0; j < 4; ++j) { const int n = (lane >> 2) + 16 * j; const LAS float* s = scr + (16 * c) * 65 + n; unsigned w[4];
#pragma unroll
        for (int e = 0; e < 4; ++e) { const int q0 = __float2int_rn(s[(4 * e) * 65]), q1 = __float2int_rn(s[(4 * e + 1) * 65]), q2 = __float2int_rn(s[(4 * e + 2) * 65]), q3 = __float2int_rn(s[(4 * e + 3) * 65]);
            w[e] = (unsigned)(q0 & 0xff) | ((unsigned)(q1 & 0xff) << 8) | ((unsigned)(q2 & 0xff) << 16) | ((unsigned)(q3 & 0xff) << 24); }
        *(u32x4*)(dst + (size_t)n * ldTb + 16 * c) = (u32x4){w[0], w[1], w[2], w[3]}; }
    LDS_WAIT(); asm volatile("" ::: "memory");
}
__device__ __forceinline__ void colmax_item(const float* src, int ldw, int lane, const float* gain, unsigned* cmax) {
    float v[64]; float m = 0.f;
#pragma unroll
    for (int i = 0; i < 64; ++i) v[i] = src[(size_t)i * ldw + lane];
#pragma unroll
    for (int i = 0; i < 64; ++i) m = fmaxf(m, fabsf(v[i] * gain[i]));
    atomicMax(cmax + lane, __builtin_bit_cast(unsigned, m));
}
__device__ __forceinline__ int win_phys_row(int n) { const int l = n & 255; return (n & ~255) | (((l >> 5) & 1) << 7) | (((l >> 6) & 3) << 5) | (l & 31); }

__device__ __forceinline__ void row2_to_bf16_rstd(const float* xrow, bf16_t* orow, float* rstd2, int lane, unsigned char* qrow = nullptr) {
    const f32x4* xr = (const f32x4*)xrow + lane;
    f32x4 v[2][4]; float s0 = 0.f, s1 = 0.f;
#pragma unroll
    for (int j = 0; j < 4; ++j) { v[0][j] = xr[64 * j]; v[1][j] = xr[256 + 64 * j]; }
    unsigned long long* o8 = (unsigned long long*)orow + lane;
#pragma unroll
    for (int j = 0; j < 4; ++j) { s0 += (v[0][j].x * v[0][j].x + v[0][j].y * v[0][j].y) + (v[0][j].z * v[0][j].z + v[0][j].w * v[0][j].w); s1 += (v[1][j].x * v[1][j].x + v[1][j].y * v[1][j].y) + (v[1][j].z * v[1][j].z + v[1][j].w * v[1][j].w);
        o8[64 * j] = (unsigned long long)pk2(v[0][j].x, v[0][j].y) | ((unsigned long long)pk2(v[0][j].z, v[0][j].w) << 32);
        o8[256 + 64 * j] = (unsigned long long)pk2(v[1][j].x, v[1][j].y) | ((unsigned long long)pk2(v[1][j].z, v[1][j].w) << 32);
        if (qrow) { ((unsigned*)qrow)[64 * j + lane] = pk4_fp8(v[0][j].x, v[0][j].y, v[0][j].z, v[0][j].w); ((unsigned*)qrow)[256 + 64 * j + lane] = pk4_fp8(v[1][j].x, v[1][j].y, v[1][j].z, v[1][j].w); } }
    s0 = wave_sum(s0); s1 = wave_sum(s1);
    if (lane == 0) { rstd2[0] = rsqrtf(s0 * (1.f / D) + EPS); rstd2[1] = rsqrtf(s1 * (1.f / D) + EPS); }
}


typedef __attribute__((address_space(4))) const Args* KArgPtr;
__device__ __forceinline__ KArgPtr kargs() { KArgPtr p = (KArgPtr)__builtin_amdgcn_kernarg_segment_ptr(); asm volatile("" : "+s"(p)); return p; }
#define ctl ((unsigned*)(ws + WS_CTL))
#define wrt ((float*)(ws + WS_TAB))
#define eslot ((int*)(ws + WS_ESLOT))
#define ew ((float*)(ws + WS_EW))
#define Win_t ((bf16_t*)(ws + WS_WIN))
#define Wm_t ((bf16_t*)(ws + WS_WM))
#define Wo_t ((bf16_t*)(ws + WS_WO))
#define Wgp8 ((unsigned char*)(ws + WS_WGP))
#define hp8 ((unsigned char*)(ws + WS_HP))
#define h2b ((bf16_t*)(ws + WS_H2B))
#define xb ((bf16_t*)(ws + WS_XB))
#define A1 ((bf16_t*)(ws + WS_A1))
#define B1 ((bf16_t*)(ws + WS_B1))
#define C1 ((bf16_t*)(ws + WS_C1))
#define sga ((bf16_t*)(ws + WS_SGA))
#define sgc ((bf16_t*)(ws + WS_SGC))
#define mbuf ((bf16_t*)(ws + WS_M))
#define h1b ((bf16_t*)(ws + WS_H1B))
#define rstdv ((float*)(ws + WS_RSTD))
#define W13_t ((bf16_t*)(ws + WS_W13))
#define W2_t ((bf16_t*)(ws + WS_W2))
#define xs ((bf16_t*)(ws + WS_XS))
#define hdn ((bf16_t*)(ws + WS_HDN))
#define contrib ((bf16_t*)(ws + WS_CONTRIB))
#define tile0 ((LAS float*)lds)
#define tile1 (tile0 + 64 * 65)
#define pref ((LAS int*)(lds + MISC_OFF))
#define cnts (pref + 64)
__global__ void __launch_bounds__(NTHREADS, 2) fwd_kernel(Args a) {
    extern __shared__ __attribute__((aligned(16))) unsigned char lds_raw[];
    cg::grid_group grid = cg::this_grid();
    LAS unsigned char* lds = (LAS unsigned char*)lds_raw;
    const int G = gridDim.x, bx = blockIdx.x;
    const int wave_s = __builtin_amdgcn_readfirstlane((int)threadIdx.x >> 6);
    volatile LAS unsigned* bst = (volatile LAS unsigned*)(lds + MISC_OFF + 512);
    if (threadIdx.x < 2) bst[threadIdx.x] = 0u;
    __syncthreads();
    const XcdBarrier bar = xcd_barrier_post((unsigned*)(a.ws + WS_CTL) + CW_BAR, bst);
#ifndef PROBE_A
#define PROBE_A -1
#endif
#ifndef PROBE_B
#define PROBE_B -1
#endif
#define STAMP(i) do { if (PROBE_A >= 0 && bx == 0) { int t_ = lane_id_fresh(); if (wave_s == 0 && t_ == 0) ((volatile LAS unsigned long long*)(lds + MISC_OFF + 1024))[i] = __builtin_amdgcn_s_memrealtime(); } } while (0)
#define XBAR() do { int t_ = (wave_s << 6) | lane_id_fresh(); xcd_barrier(bar, t_); } while (0)
    STAMP(0);
#define PHASE_VARS() const KArgPtr ap = kargs(); unsigned char* const ws = ap->ws; (void)ws; int tid = (wave_s << 6) | lane_id_fresh(); asm volatile("" : "+v"(tid)); const int lane = tid & 63, wave = __builtin_amdgcn_readfirstlane(tid >> 6); \
    const int gw = bx * NWAVES + wave, NGW = G * NWAVES; const size_t gtid = (size_t)bx * NTHREADS + tid, GT = (size_t)G * NTHREADS; (void)lane; (void)gw; (void)NGW; (void)gtid; (void)GT
    {
        PHASE_VARS();
        LAS float* scr = (LAS float*)(lds + wave * WSCR);
        constexpr int I_IN = 16 * 80, I_PA = 8 * 16, I_PC = 8 * 16, I_O = 16 * 16, I_PG = 16 * 16, I_PP = 4 * 16;
        constexpr int NIT = I_IN + I_PA + I_PC + I_O + I_PG + I_PP;
        for (int it = gw; it < NIT; it += NGW) {
            int r = it;
            if (r < I_IN) { const int kb_ = r / 80, nb = r % 80;
#if F8_GATES
                if (nb >= 48) { transpose_item_f8(ap->w_in + (size_t)(kb_ * 64) * NIN + nb * 64, NIN, (unsigned char*)(Win_t + (size_t)3072 * D) + (size_t)((nb - 48) * 64) * D + kb_ * 64, D, scr, lane, ap->g_mix + kb_ * 64, F8W); continue; }
#endif
#if CU_PAIR
                if ((nb >= 24 && nb < 32) || (nb >= 40 && nb < 48)) { const int cg_ = nb >= 40, c = (nb - (cg_ ? 40 : 24)) * 64, t4 = c >> 7, pn_ = t4 < 2 ? 6 + t4 : 8 + t4;
                    transpose_item(ap->w_in + (size_t)(kb_ * 64) * NIN + nb * 64, NIN, Win_t + (size_t)(pn_ * 256 + cg_ * 128 + (c & 127)) * D + kb_ * 64, D, scr, lane, ap->g_mix + kb_ * 64, 0); continue; }
#endif
                transpose_item(ap->w_in + (size_t)(kb_ * 64) * NIN + nb * 64, NIN, Win_t + (size_t)win_phys_row(nb * 64) * D + kb_ * 64, D, scr, lane, ap->g_mix + kb_ * 64, 96); continue; } r -= I_IN;
            if (r < I_PA) { const int kb_ = r / 16, nb = r % 16; transpose_item(ap->w_pa + (size_t)(kb_ * 64) * D + nb * 64, D, Wm_t + (size_t)(nb * 64) * D + kb_ * 64, D, scr, lane); continue; } r -= I_PA;
            if (r < I_PC) { const int kb_ = r / 16, nb = r % 16; transpose_item(ap->w_pc + (size_t)(kb_ * 64) * D + nb * 64, D, Wm_t + (size_t)(nb * 64) * D + 512 + kb_ * 64, D, scr, lane); continue; } r -= I_PC;
            if (r < I_O) { const int kb_ = r / 16, nb = r % 16; transpose_item(ap->w_o + (size_t)(kb_ * 64) * D + nb * 64, D, Wo_t + (size_t)(nb * 64) * D + kb_ * 64, D, scr, lane); continue; } r -= I_O;
            if (r < I_PG) { const int kb_ = r / 16, nb = r % 16; colmax_item(ap->w_pg + (size_t)(kb_ * 64) * D + nb * 64, D, lane, ap->g_ple + kb_ * 64, ctl + CW_CMAXP + nb * 64); continue; } r -= I_PG;
            { const int kb_ = r / 16, nb = r % 16; transpose_item(ap->w_pp + (size_t)(kb_ * 64) * D + nb * 64, D, (bf16_t*)Wgp8 + (size_t)(nb * 64) * HPE + 512 + kb_ * 64, HPE, scr, lane); }
        }
        const size_t rtid = (size_t)(G - 1 - bx) * NTHREADS + tid; const int rgw = (G - 1 - bx) * NWAVES + wave;
        for (size_t i = rtid; i < (size_t)3 * 32 * 64 * 8; i += GT) { const int j = (int)(i & 7), ln = (int)((i >> 3) & 63), s_ = (int)((i >> 9) & 31), nt = (int)(i >> 14);
            const int k = 32 * s_ + 8 * (ln >> 4) + j, col = 16 * nt + (ln & 15);
            const float wv_ = ap->g_ffn[k] * (col < 4 ? ap->w_group[k * 4 + col] : (col < 36 ? ap->w_router[k * 32 + (col - 4)] : 0.f));
            const unsigned hi_ = f2bf(wv_); const float lo_ = wv_ - __builtin_bit_cast(float, hi_ << 16);
            ((unsigned short*)wrt)[i] = (unsigned short)hi_; ((unsigned short*)wrt)[(size_t)3 * 32 * 64 * 8 + i] = (unsigned short)f2bf(lo_); }
        { float* gtab = (float*)(ws + WS_GTAB); float* gcinit = (float*)(ws + WS_GCINIT);
          for (size_t i = rtid; i < (size_t)NH * 4 * 384; i += GT) { const int h = (int)(i / 1536), s_ = (int)((i / 384) & 3), y = (int)(i % 384), x = y + s_;
              int dd = 319 - x; dd = dd < -63 ? -63 : (dd > 256 ? 256 : dd);
              gtab[i] = x <= 382 ? (ap->rel_bias[h * NREL + dd + 63] - ap->rel_bias[h * NREL + 319]) * LOG2E : 0.f; }
          if (rgw < NH) { const int h = rgw;
              float gq = fabsf(ap->g_q[lane]), gk = fabsf(ap->g_k[lane]), mb = -3.0e38f;
#pragma unroll
              for (int j = 0; j < 5; ++j) mb = fmaxf(mb, ap->rel_bias[h * NREL + lane + 64 * j]);
#pragma unroll
              for (int o = 1; o < 64; o <<= 1) { gq = fmaxf(gq, __shfl_xor(gq, o)); gk = fmaxf(gk, __shfl_xor(gk, o)); mb = fmaxf(mb, __shfl_xor(mb, o)); }
              if (lane == 0) gcinit[h] = ap->rel_bias[h * NREL + 319] * LOG2E - (64.f * C2 * gq * gk + mb * LOG2E); } }
        STAMP(12);
        for (int m = 2 * gw; m < T; m += 2 * NGW) row2_to_bf16_rstd(ap->x + (size_t)m * D, xb + (size_t)m * D, rstdv + m, lane, F8_GATES ? ws + WS_XQ + (size_t)m * D : nullptr);
    }
    if (G == 0x7fffff) grid.sync();
    XBAR();
    STAMP(1);

#if F8_GATES
    { PHASE_VARS(); pg8::Gemm g{xb, Win_t, T, 3072, D, D}; pg8::StaticOrder S; S.init(T, 3072, G, bx); EpiInproj E{ws, ap->b_in, ap->g_q, ap->g_k, rstdv};
      pg8::gemm_phase<EpiInproj, pg8::StaticOrder, true, true>(lds, g, S, E, tid); }
    { PHASE_VARS(); pg8::Gemm g{(const bf16_t*)(ws + WS_XQ), Win_t + (size_t)3072 * D, T, 2048, D / 2, D / 2}; StaticOrderId S; S.init(T, 2048, G, bx);
      EpiGateF8 E{(unsigned char*)sga, (unsigned char*)sgc, ap->b_in + 3072, rstdv};
      pg8::gemm_phase<EpiGateF8, StaticOrderId, true, true, 0, 3>(lds, g, S, E, tid); }
#else
    { PHASE_VARS(); pg8::Gemm g{xb, Win_t, T, NIN, D, D}; pg8::StaticOrder S; S.init(T, NIN, G, bx); EpiInproj E{ws, ap->b_in, ap->g_q, ap->g_k, rstdv};
      pg8::gemm_phase<EpiInproj, pg8::StaticOrder, true, true>(lds, g, S, E, tid); }
#endif
    XBAR();
    STAMP(2);

    {
        PHASE_VARS();
        for (size_t i = gtid; i < (size_t)T * (CW / 8); i += GT) {
            const int t = (int)(i >> 6), c8 = (int)(i & 63) * 8, s = t & (SEQ - 1);
            const size_t o = (size_t)t * D + c8;
#if CU_PAIR
            const u32x4 u0 = *(const u32x4*)(C1 + o), b0 = *(const u32x4*)(A1 + o + 512);
            u32x4 u1 = {0u, 0u, 0u, 0u}, u2 = u1;
            if (s >= 1) u1 = *(const u32x4*)(C1 + o - D);
            if (s >= 2) u2 = *(const u32x4*)(C1 + o - 2 * D);
#else
            const u32x4 u0 = *(const u32x4*)(C1 + o), g0 = *(const u32x4*)(C1 + o + 512), b0 = *(const u32x4*)(A1 + o + 512);
            u32x4 u1 = {0u, 0u, 0u, 0u}, g1 = u1, u2 = u1, g2 = u1;
            if (s >= 1) { u1 = *(const u32x4*)(C1 + o - D); g1 = *(const u32x4*)(C1 + o + 512 - D); }
            if (s >= 2) { u2 = *(const u32x4*)(C1 + o - 2 * D); g2 = *(const u32x4*)(C1 + o + 512 - 2 * D); }
#endif
            float y[8];
#pragma unroll
            for (int e = 0; e < 4; ++e) {
#pragma unroll
                for (int hh = 0; hh < 2; ++hh) {
                    const int c = c8 + 2 * e + hh;
#if CU_PAIR
                    const float cu0 = hh ? bf_hi(u0[e]) : bf_lo(u0[e]), cu1 = hh ? bf_hi(u1[e]) : bf_lo(u1[e]), cu2 = hh ? bf_hi(u2[e]) : bf_lo(u2[e]);
#else
                    const float cu0 = hh ? bf_hi(u0[e]) * bf_hi(g0[e]) : bf_lo(u0[e]) * bf_lo(g0[e]);
                    const float cu1 = hh ? bf_hi(u1[e]) * bf_hi(g1[e]) : bf_lo(u1[e]) * bf_lo(g1[e]);
                    const float cu2 = hh ? bf_hi(u2[e]) * bf_hi(g2[e]) : bf_lo(u2[e]) * bf_lo(g2[e]);
#endif
                    const float bgv = hh ? bf_hi(b0[e]) : bf_lo(b0[e]);
                    y[2 * e + hh] = bgv * (ap->conv_b[c] + ap->conv_w[c] * cu2 + ap->conv_w[CW + c] * cu1 + ap->conv_w[2 * CW + c] * cu0);
                }
            }
            u32x4 w; w.x = pk2(y[0], y[1]); w.y = pk2(y[2], y[3]); w.z = pk2(y[4], y[5]); w.w = pk2(y[6], y[7]);
            *(u32x4*)(A1 + o + 512) = w;
        }
        __syncthreads();
        attn_body::attn_phase((char*)lds_raw, (const attn_body::bf16*)A1, (const attn_body::bf16*)B1, (const attn_body::bf16*)(B1 + 512), (attn_body::bf16*)A1, (const float*)(ws + WS_GTAB), (const float*)(ws + WS_GCINIT), G, bx, tid);
    }
    XBAR();
    STAMP(3);

    { PHASE_VARS(); pg8::Gemm g{A1, Wm_t, T, D, D, D}; pg8::PairOrder S; S.init(T, D, G, bx); EpiMerge2 E{(const unsigned char*)sga, (const unsigned char*)sgc, mbuf};
      pg8::gemm_phase<EpiMerge2, pg8::PairOrder, true, true>(lds, g, S, E, tid); }
    XBAR();
    STAMP(4);

    { PHASE_VARS(); pg8::Gemm g{mbuf, Wo_t, T, D, D, D}; pg8::StaticOrder S; S.init(T, D, G, bx); EpiResBf16 E{xb, h1b, F8_MOE ? (unsigned char*)(ws + WS_H1F8) : (unsigned char*)nullptr};
      pg8::gemm_phase<EpiResBf16, pg8::StaticOrder, true, true>(lds, g, S, E, tid); }
    XBAR();
    STAMP(5);

    {
        PHASE_VARS();
        {
            LAS int* lcnt = (LAS int*)(lds + MISC_OFF + 2048); LAS int* lbase = lcnt + 32;
            if (tid < 32) lcnt[tid] = 0;
            __syncthreads();
            int ea = 0, eb = 0, ra = 0, rb = 0; float wa = 0.f, wb = 0.f;
            LAS float* lsc = (LAS float*)(lds + 98304 + wave * 4096);
            static_assert(T / 16 == 256 * NWAVES, "routing: exactly one 16-token task per wave (the weight stage below is filled with workgroup barriers inside the task loop)");
            const int r = lane & 15, q = lane >> 4;
            for (int task = gw; task < T / 16; task += NGW) {
                const int row0 = task * 16;
                const GAS bf16_t* arow = (const GAS bf16_t*)h1b + (size_t)(row0 + r) * D + 8 * q;
                const GAS bf16x8* bp = (const GAS bf16x8*)wrt + lane;
                constexpr int LO = 3 * 32 * 64;
                f32x4 acc0 = {0.f, 0.f, 0.f, 0.f}, acc1 = acc0, acc2 = acc0; float ss = 0.f;
                u32x4 acur[8], anxt[8];
#pragma unroll
                for (int i = 0; i < 8; ++i) acur[i] = *(const GAS u32x4*)(arow + 32 * i);
#pragma unroll 1
                for (int ch = 0; ch < 4; ++ch) {
                    const int chn = ch < 3 ? ch + 1 : 3;
                    if ((ch & 1) == 0) {
                        __syncthreads();
#pragma unroll
                        for (int i = 0; i < 12; ++i) { const int row_ = wave * 12 + i, part = row_ / 48, nt = (row_ / 16) % 3, sl = row_ & 15;
                            __builtin_amdgcn_global_load_lds((const GAS unsigned*)(bp + part * LO + (nt * 32 + 8 * ch + sl) * 64), (LAS unsigned*)(lds + row_ * 1024), 16, 0, 0); }
                    }
#pragma unroll
                    for (int i = 0; i < 8; ++i) anxt[i] = *(const GAS u32x4*)(arow + 32 * (8 * chn + i));
                    if ((ch & 1) == 0) { asm volatile("s_waitcnt vmcnt(8)" ::: "memory"); __syncthreads(); }
#pragma unroll
                    for (int st = 0; st < 8; ++st) {
                        const int sl = 8 * (ch & 1) + st;
                        const u32x4 aw = acur[st]; const bf16x8 af = __builtin_bit_cast(bf16x8, aw);
                        const float av[8] = {bf_lo(aw.x), bf_hi(aw.x), bf_lo(aw.y), bf_hi(aw.y), bf_lo(aw.z), bf_hi(aw.z), bf_lo(aw.w), bf_hi(aw.w)};
#pragma unroll
                        for (int j = 0; j < 8; ++j) ss += av[j] * av[j];
                        const LAS bf16x8* bl = (const LAS bf16x8*)(lds + sl * 1024) + lane;
                        acc0 = __builtin_amdgcn_mfma_f32_16x16x32_bf16(af, bl[(0 * 16) * 64], acc0, 0, 0, 0); acc0 = __builtin_amdgcn_mfma_f32_16x16x32_bf16(af, bl[(3 * 16) * 64], acc0, 0, 0, 0);
                        acc1 = __builtin_amdgcn_mfma_f32_16x16x32_bf16(af, bl[(1 * 16) * 64], acc1, 0, 0, 0); acc1 = __builtin_amdgcn_mfma_f32_16x16x32_bf16(af, bl[(4 * 16) * 64], acc1, 0, 0, 0);
                        acc2 = __builtin_amdgcn_mfma_f32_16x16x32_bf16(af, bl[(2 * 16) * 64], acc2, 0, 0, 0); acc2 = __builtin_amdgcn_mfma_f32_16x16x32_bf16(af, bl[(5 * 16) * 64], acc2, 0, 0, 0);
                    }
#pragma unroll
                    for (int i = 0; i < 8; ++i) acur[i] = anxt[i];
                }
                ss += __shfl_xor(ss, 16); ss += __shfl_xor(ss, 32);
                const float rstd = rsqrtf(ss * (1.f / D) + EPS);
#pragma unroll
                for (int g_ = 0; g_ < 4; ++g_) { const float rs = __shfl(rstd, 4 * q + g_);
                    lsc[(4 * q + g_) * 48 + r] = acc0[g_] * rs; lsc[(4 * q + g_) * 48 + 16 + r] = acc1[g_] * rs; lsc[(4 * q + g_) * 48 + 32 + r] = acc2[g_] * rs; }
                LDS_WAIT(); asm volatile("" ::: "memory");
                if (lane < 16) {
                    const int m = row0 + lane; float lg[36];
#pragma unroll
                    for (int c = 0; c < 36; ++c) lg[c] = lsc[lane * 48 + c];
                    float gl[4];
#pragma unroll
                    for (int c = 0; c < 4; ++c) gl[c] = lg[c] + ap->b_group[c];
                    int grp = 0; float gmax = gl[0];
#pragma unroll
                    for (int c = 1; c < 4; ++c) if (gl[c] > gmax) { gmax = gl[c]; grp = c; }
                    float gs = 0.f;
#pragma unroll
                    for (int c = 0; c < 4; ++c) gs += __expf(gl[c] - gmax);
                    const float pgrp = 1.f / gs;
                    float el[8];
#pragma unroll
                    for (int c = 0; c < 8; ++c) { const float x0 = lg[4 + c], x1 = lg[12 + c], x2 = lg[20 + c], x3 = lg[28 + c]; el[c] = (grp == 0 ? x0 : grp == 1 ? x1 : grp == 2 ? x2 : x3) + ap->b_router[grp * 8 + c]; }
                    int i0 = 0; float l0 = el[0];
#pragma unroll
                    for (int c = 1; c < 8; ++c) if (el[c] > l0) { l0 = el[c]; i0 = c; }
                    int i1 = -1; float l1 = -3.0e38f;
#pragma unroll
                    for (int c = 0; c < 8; ++c) if (c != i0 && el[c] > l1) { l1 = el[c]; i1 = c; }
                    if (i1 < 0) i1 = i0 ? 0 : 1;
                    const float e1 = __expf(l1 - l0), w0 = pgrp / (1.f + e1), w1 = pgrp * e1 / (1.f + e1);
                    ea = grp * 8 + i0; eb = grp * 8 + i1;
                    ra = (int)__hip_atomic_fetch_add(&lcnt[ea], 1, __ATOMIC_RELAXED, __HIP_MEMORY_SCOPE_WORKGROUP); rb = (int)__hip_atomic_fetch_add(&lcnt[eb], 1, __ATOMIC_RELAXED, __HIP_MEMORY_SCOPE_WORKGROUP);
                    wa = w0; wb = w1;
                    rstdv[m] = rstd;
                }
                LDS_WAIT(); asm volatile("" ::: "memory");
            }
            __syncthreads();
            if (tid < 32) lbase[tid] = (int)atomicAdd(&ctl[tid * CNT_STRIDE], (unsigned)lcnt[tid]);
            __syncthreads();
            if (lane < 16) { const int m = gw * 16 + lane; const int ia = (ea << 15) | (lbase[ea] + ra), ib = (eb << 15) | (lbase[eb] + rb);
                eslot[ia] = 2 * m; ew[ia] = wa; eslot[ib] = 2 * m + 1; ew[ib] = wb; }
        }
        STAMP(11);
        LAS float* scr = (LAS float*)(lds + wave * WSCR);
        constexpr int I_13 = 16 * 8, PER_E = 2 * I_13;
        for (int it = gw; it < NE * PER_E; it += NGW) {
            const int e = it / PER_E; int r = it % PER_E;
            const int which = r / I_13; r %= I_13; const int kb_ = r / 8, nb = r % 8, j0 = nb * 64;
            const float* src = (which ? ap->w3 : ap->w1) + (size_t)e * D * DE + (size_t)(kb_ * 64) * DE + j0;
#if F8_MOE
            transpose_item_f8(src, DE, (unsigned char*)W13_t + (size_t)(e * 1024 + (j0 >> 7) * 256 + which * 128 + (j0 & 127)) * D + kb_ * 64, D, scr, lane, ap->g_ffn + kb_ * 64, F8W);
#else
            transpose_item(src, DE, W13_t + (size_t)(e * 1024 + (j0 >> 7) * 256 + which * 128 + (j0 & 127)) * D + kb_ * 64, D, scr, lane, ap->g_ffn + kb_ * 64);
#endif
        }
    }
    XBAR();
    STAMP(6);

    {
        PHASE_VARS();
        if (tid < NE) cnts[tid] = (int)__hip_atomic_load(&ctl[tid * CNT_STRIDE], __ATOMIC_RELAXED, __HIP_MEMORY_SCOPE_AGENT);
        __syncthreads();
        if (tid == 0) { int acc_ = 0; for (int e = 0; e < NE; ++e) { pref[e] = acc_; acc_ += (cnts[e] + 255) >> 8; } pref[NE] = acc_; }
        __syncthreads();
    }
    STAMP(7);
    const int ntiles = __builtin_amdgcn_readfirstlane(pref[NE]);

#if F8_MOE
    { PHASE_VARS(); pg8::Gemm g{(const bf16_t*)(ws + WS_H1F8), W13_t, XS_ROWS, NE * 1024, D / 2, D / 2}; moe_meta_preload(lds, pref, ntiles * 4, G, bx, eslot, rstdv, true, tid); MoeOrderT<true> S{pref, ntiles * 4, G, bx, lds}; EpiSwigluT<1> E{hdn, lds};
      pg8::gemm_phase<EpiSwigluT<1>, MoeOrderT<true>, true, true, 0, 3>(lds, g, S, E, tid); }
#else
    { PHASE_VARS(); pg8::Gemm g{h1b, W13_t, XS_ROWS, NE * 1024, D, D}; moe_meta_preload(lds, pref, ntiles * 4, G, bx, eslot, rstdv, true, tid); MoeOrderT<true> S{pref, ntiles * 4, G, bx, lds}; EpiSwigluT<0> E{hdn, lds};
      pg8::gemm_phase<EpiSwigluT<0>, MoeOrderT<true>, true, true>(lds, g, S, E, tid); }
#endif
    { PHASE_VARS();
      { const int nun = ntiles * 4, rem = nun % G, nf = rem ? G - rem : G, fb = rem ? bx - rem : bx;
        if (fb >= 0) {
            LAS float* scr = (LAS float*)(lds + wave * WSCR);
            for (int it = fb * NWAVES + wave; it < NE * 128; it += nf * NWAVES) { const int e = it >> 7, r = it & 127, kb_ = r / 16, nb = r % 16;
#if F8_MOE && F8_DOWN
                transpose_item_f8(ap->w2 + (size_t)e * DE * D + (size_t)(kb_ * 64) * D + nb * 64, D, (unsigned char*)W2_t + (size_t)(e * 1024 + nb * 64) * DE + kb_ * 64, DE, scr, lane, nullptr, F8W); }
#else
                transpose_item(ap->w2 + (size_t)e * DE * D + (size_t)(kb_ * 64) * D + nb * 64, D, W2_t + (size_t)(e * 1024 + nb * 64) * DE + kb_ * 64, DE, scr, lane); }
#endif
            for (size_t i = (size_t)fb * NTHREADS + tid; i < 1024; i += (size_t)nf * NTHREADS) ((float*)(ws + WS_CMAXF))[i] = __builtin_bit_cast(float, __hip_atomic_load(ctl + CW_CMAXP + i, __ATOMIC_RELAXED, __HIP_MEMORY_SCOPE_AGENT));
            for (int it = fb * NWAVES + wave; it < 16 * 16; it += nf * NWAVES) { const int kb_ = it / 16, nb = it % 16;
                transpose_item_q8(ap->w_pg + (size_t)(kb_ * 64) * D + nb * 64, D, (signed char*)Wgp8 + (size_t)(nb * 64) * HPB + kb_ * 64, HPB, scr, lane, ap->g_ple + kb_ * 64, (const float*)(ctl + CW_CMAXP) + nb * 64); }
            for (size_t i = (size_t)fb * NTHREADS + tid; i < (size_t)T * PLE / 8; i += (size_t)nf * NTHREADS) { const f32x4 v0 = ((const f32x4*)ap->p)[2 * i], v1 = ((const f32x4*)ap->p)[2 * i + 1];
                u32x4 o; o.x = pk2(v0.x, v0.y); o.y = pk2(v0.z, v0.w); o.z = pk2(v1.x, v1.y); o.w = pk2(v1.z, v1.w); *(u32x4*)(hp8 + (i >> 5) * HPB + 1024 + (i & 31) * 16) = o; }
        } } }
    XBAR();
    STAMP(8);

#if F8_MOE && F8_DOWN
    { PHASE_VARS(); pg8::Gemm g{hdn, W2_t, XS_ROWS, NE * 1024, DE / 2, DE / 2}; moe_meta_preload(lds, pref, ntiles * 4, G, bx, eslot, ew, false, tid); MoeOrderId S{{pref, ntiles * 4, G, bx, lds}}; EpiDownT<1> E{contrib, lds};
      pg8::gemm_phase<EpiDownT<1>, MoeOrderId, true, true, 0, 3>(lds, g, S, E, tid); }
#else
    { PHASE_VARS(); pg8::Gemm g{hdn, W2_t, XS_ROWS, NE * 1024, DE, DE}; moe_meta_preload(lds, pref, ntiles * 4, G, bx, eslot, ew, false, tid); MoeOrderT<false> S{pref, ntiles * 4, G, bx, lds}; EpiDownT<0> E{contrib, lds};
      pg8::gemm_phase<EpiDownT<0>, MoeOrderT<false>, true, true>(lds, g, S, E, tid); }
#endif
    XBAR();
    STAMP(9);

    { PHASE_VARS();
    for (int m0 = 2 * gw; m0 < T; m0 += 2 * NGW) {
#if F8_CONTRIB
        u32x2 hv[2][4]; unsigned p0[2][4], p1[2][4];
#pragma unroll
        for (int rr = 0; rr < 2; ++rr) { const int m = m0 + rr;
            const u32x2* xr = (const u32x2*)(h1b + (size_t)m * D) + lane;
            const unsigned* c0 = (const unsigned*)((const unsigned char*)contrib + (size_t)(2 * m) * D) + lane; const unsigned* c1 = (const unsigned*)((const unsigned char*)contrib + (size_t)(2 * m + 1) * D) + lane;
#pragma unroll
            for (int j = 0; j < 4; ++j) { hv[rr][j] = xr[64 * j]; p0[rr][j] = c0[64 * j]; p1[rr][j] = c1[64 * j]; } }
#else
        u32x2 hv[2][4], p0[2][4], p1[2][4];
#pragma unroll
        for (int rr = 0; rr < 2; ++rr) { const int m = m0 + rr;
            const u32x2* xr = (const u32x2*)(h1b + (size_t)m * D) + lane;
            const u32x2* c0 = (const u32x2*)(contrib + (size_t)(2 * m) * D) + lane; const u32x2* c1 = (const u32x2*)(contrib + (size_t)(2 * m + 1) * D) + lane;
#pragma unroll
            for (int j = 0; j < 4; ++j) { hv[rr][j] = xr[64 * j]; p0[rr][j] = c0[64 * j]; p1[rr][j] = c1[64 * j]; } }
#endif
#pragma unroll
        for (int rr = 0; rr < 2; ++rr) { const int m = m0 + rr; float s = 0.f, am = 0.f; f32x4 h[4];
            unsigned long long* o8 = (unsigned long long*)(h2b + (size_t)m * D) + lane;
#pragma unroll
            for (int j = 0; j < 4; ++j) {
#if F8_CONTRIB
                { const f32x2 a0 = __builtin_amdgcn_cvt_pk_f32_fp8((int)p0[rr][j], false), a1 = __builtin_amdgcn_cvt_pk_f32_fp8((int)p0[rr][j], true), b0 = __builtin_amdgcn_cvt_pk_f32_fp8((int)p1[rr][j], false), b1 = __builtin_amdgcn_cvt_pk_f32_fp8((int)p1[rr][j], true);
                  constexpr float k = 1.0f / CSC;
                  h[j].x = bf_lo(hv[rr][j].x) + (a0[0] + b0[0]) * k; h[j].y = bf_hi(hv[rr][j].x) + (a0[1] + b0[1]) * k; h[j].z = bf_lo(hv[rr][j].y) + (a1[0] + b1[0]) * k; h[j].w = bf_hi(hv[rr][j].y) + (a1[1] + b1[1]) * k; }
#else
                h[j].x = bf_lo(hv[rr][j].x) + bf_lo(p0[rr][j].x) + bf_lo(p1[rr][j].x); h[j].y = bf_hi(hv[rr][j].x) + bf_hi(p0[rr][j].x) + bf_hi(p1[rr][j].x);
                h[j].z = bf_lo(hv[rr][j].y) + bf_lo(p0[rr][j].y) + bf_lo(p1[rr][j].y); h[j].w = bf_hi(hv[rr][j].y) + bf_hi(p0[rr][j].y) + bf_hi(p1[rr][j].y);
#endif
                s += (h[j].x * h[j].x + h[j].y * h[j].y) + (h[j].z * h[j].z + h[j].w * h[j].w);
                am = fmaxf(fmaxf(am, fmaxf(fabsf(h[j].x), fabsf(h[j].y))), fmaxf(fabsf(h[j].z), fabsf(h[j].w)));
                o8[64 * j] = (unsigned long long)pk2(h[j].x, h[j].y) | ((unsigned long long)pk2(h[j].z, h[j].w) << 32); }
            s = wave_sum(s);
#pragma unroll
            for (int o = 1; o < 64; o <<= 1) am = fmaxf(am, __shfl_xor(am, o));
            const float qs = 127.0f / fmaxf(am, 1e-30f);
            unsigned* q4 = (unsigned*)(hp8 + (size_t)m * HPB) + lane;
#pragma unroll
            for (int j = 0; j < 4; ++j) { const int q0 = __float2int_rn(h[j].x * qs), q1 = __float2int_rn(h[j].y * qs), q2 = __float2int_rn(h[j].z * qs), q3 = __float2int_rn(h[j].w * qs);
                q4[64 * j] = (unsigned)(q0 & 0xff) | ((unsigned)(q1 & 0xff) << 8) | ((unsigned)(q2 & 0xff) << 16) | ((unsigned)(q3 & 0xff) << 24); }
            if (lane == 0) rstdv[m] = rsqrtf(s * (1.f / D) + EPS) * am * (1.0f / 127.0f); }
    } }
    XBAR();
    STAMP(10);

    { PHASE_VARS(); pg8::Gemm g{(const bf16_t*)hp8, (const bf16_t*)Wgp8, T, 2 * D, HPE, HPE}; pg8::StaticOrder S; S.init(T, 2 * D, G, bx);
      EpiGateDual E{h2b, rstdv, (const float*)(ws + WS_CMAXF), ap->b_pg, ap->out};
      pg8::gemm_phase<EpiGateDual, pg8::StaticOrder, true, true, 8, 2>(lds, g, S, E, tid); }
    STAMP(15);
    if (PROBE_A >= 0 && bx == 0) { int t_ = lane_id_fresh(); if (wave_s == 0 && t_ == 0) { volatile LAS unsigned long long* ts = (volatile LAS unsigned long long*)(lds + MISC_OFF + 1024);
        const unsigned long long d = 4ull * (ts[PROBE_B] - ts[PROBE_A]), t0 = __builtin_amdgcn_s_memrealtime(); while (__builtin_amdgcn_s_memrealtime() - t0 < d) __builtin_amdgcn_s_sleep(8); } }
}

extern "C" void kernel_launch(void* const* d_in, const int* in_sizes, int n_in, void* d_out, int out_size, void* d_ws, size_t ws_size, hipStream_t stream) {
    static int grid = 0;
    if (grid == 0) {
        if (n_in != 25 || out_size != T * D || ws_size < WS_END) { fprintf(stderr, "kernel_launch: unexpected shapes (n_in %d out %d ws %zu); nothing launched\n", n_in, out_size, ws_size); grid = -1; return; }
        int dev = 0, cus = 0, per_cu = 0;
        if (hipGetDevice(&dev) != hipSuccess || hipDeviceGetAttribute(&cus, hipDeviceAttributeMultiprocessorCount, dev) != hipSuccess) { grid = -1; return; }
        if (hipFuncSetAttribute((const void*)fwd_kernel, hipFuncAttributeMaxDynamicSharedMemorySize, LDS_BYTES) != hipSuccess) { fprintf(stderr, "kernel_launch: hipFuncSetAttribute failed\n"); grid = -1; return; }
        if (hipOccupancyMaxActiveBlocksPerMultiprocessor(&per_cu, (const void*)fwd_kernel, NTHREADS, LDS_BYTES) != hipSuccess || per_cu < 1) { fprintf(stderr, "kernel_launch: occupancy query says %d\n", per_cu); (void)hipGetLastError(); grid = -1; return; }
        if (cus != 256) { fprintf(stderr, "kernel_launch: built for a 256-CU device (got %d)\n", cus); grid = -1; return; }
        grid = cus;
    }
    if (grid < 0) return;
    if (hipMemsetAsync((char*)d_ws + WS_CTL, 0, CTL_ZERO_BYTES, stream) != hipSuccess) { fprintf(stderr, "kernel_launch: memset failed\n"); return; }
    Args a{};
    const float** f = (const float**)&a;
    for (int i = 0; i < 25; ++i) f[i] = (const float*)d_in[i];
    a.out = (float*)d_out; a.ws = (unsigned char*)d_ws;
    void* args[] = {&a};
    hipError_t e = hipLaunchCooperativeKernel((const void*)fwd_kernel, dim3(grid), dim3(NTHREADS), args, LDS_BYTES, stream);
    if (e != hipSuccess) fprintf(stderr, "kernel_launch: cooperative launch failed: %s (grid %d)\n", hipGetErrorString(e), grid);
}
```

```cpp
#include <hip/hip_runtime.h>
#include <hip/hip_cooperative_groups.h>
#include <cstdio>
#include <cstdint>
namespace cg = cooperative_groups;

#define GAS __attribute__((address_space(1)))
#define LAS __attribute__((address_space(3)))
typedef unsigned short bf16_t;
typedef short bf16x8 __attribute__((ext_vector_type(8)));
typedef float f32x4 __attribute__((ext_vector_type(4)));
typedef float f32x2 __attribute__((ext_vector_type(2)));
typedef unsigned u32x4 __attribute__((ext_vector_type(4)));
typedef unsigned u32x2 __attribute__((ext_vector_type(2)));
typedef int i32x4 __attribute__((ext_vector_type(4)));
typedef int i32x8 __attribute__((ext_vector_type(8)));
typedef GAS unsigned gu32;
#define RLX_AGENT __ATOMIC_RELAXED, __HIP_MEMORY_SCOPE_AGENT

constexpr int T = 32768, D = 1024, SEQ = 4096, NBATCH = 8;
constexpr int NIN = 5120, NH = 8, HD = 64, AW = 512, CW = 512;
constexpr int NE = 32, DE = 512, PLE = 256, NREL = 320;
constexpr int XS_ROWS = 65536 + NE * 256;
constexpr float EPS = 1e-6f;
constexpr float LOG2E = 1.4426950408889634f;
constexpr float C2 = 0.125f * LOG2E;

#ifndef F8_MOE
#define F8_MOE 1
#endif
#ifndef F8_GATES
#define F8_GATES 1
#endif
#ifndef CU_PAIR
#define CU_PAIR 1
#endif
#ifndef RES8
#define RES8 1
#endif
#ifndef OUT_AUX
#define OUT_AUX 18
#endif
#ifndef F8_CONTRIB
#define F8_CONTRIB 1
#endif
constexpr float CSC = 16.0f;
#ifndef F8_DOWN
#define F8_DOWN 1
#endif
constexpr float F8W = 32.0f;
constexpr size_t MiB = 1u << 20;
constexpr size_t WS_CTL = 0, CTL_ZERO_BYTES = 64 * 1024;
constexpr int CW_BAR = 4096, CNT_STRIDE = 64;
constexpr size_t WS_TAB = 1 * MiB;
constexpr size_t WS_GTAB = WS_TAB + 192 * 1024;
constexpr size_t WS_GCINIT = WS_GTAB + 8 * 4 * 384 * 4;
constexpr size_t WS_ROUTE = 2 * MiB;
constexpr size_t WS_CMAXF = 3 * MiB + 512 * 1024;
constexpr size_t WS_RSTD = 3 * MiB;
constexpr size_t WS_ROWMETA = 4 * MiB;
constexpr size_t WS_WIN = 6 * MiB;
constexpr size_t WS_WM = 16 * MiB;
constexpr size_t WS_WO = 18 * MiB;
constexpr size_t WS_WGP = 20 * MiB;
constexpr int HPB = 1536, HPE = HPB / 2;
constexpr size_t WS_HP = 24 * MiB;
constexpr size_t WS_H2B = 232 * MiB;
constexpr int CW_CMAXP = 14336;
constexpr int META_LO = 147456, META_HI = 147456 + 4 * 2048;
constexpr size_t WS_ESLOT = 72 * MiB, WS_EW = 76 * MiB;
constexpr size_t WS_XQ = 24 * MiB;
constexpr size_t WS_XB = 104 * MiB;
constexpr size_t WS_A1 = 168 * MiB;
constexpr size_t WS_B1 = 232 * MiB;
constexpr size_t WS_C1 = 296 * MiB;
constexpr size_t WS_SGA = 360 * MiB, WS_SGC = 424 * MiB;
constexpr size_t WS_M = WS_B1;
constexpr size_t WS_H1F8 = WS_SGC;
constexpr size_t WS_H1B = WS_C1;
constexpr size_t WS_W13 = 392 * MiB;
static_assert(F8_MOE == 1, "workspace map assumes e4m3 expert weights");
constexpr size_t WS_W2 = 456 * MiB;
constexpr size_t WS_XS = 104 * MiB;
constexpr size_t WS_HDN = 248 * MiB;
constexpr size_t WS_CONTRIB = 104 * MiB;
constexpr size_t WS_END = 488 * MiB;

__device__ __forceinline__ unsigned f2bf(float f) { unsigned u = __builtin_bit_cast(unsigned, f); return (u + 0x7fffu + ((u >> 16) & 1u)) >> 16; }
__device__ __forceinline__ unsigned pk2(float lo, float hi) { return f2bf(lo) | (f2bf(hi) << 16); }
__device__ __forceinline__ float bf_lo(unsigned w) { return __builtin_bit_cast(float, w << 16); }
__device__ __forceinline__ float bf_hi(unsigned w) { return __builtin_bit_cast(float, w & 0xffff0000u); }
__device__ __forceinline__ float bf2f(bf16_t h) { return __builtin_bit_cast(float, (unsigned)h << 16); }
__device__ __forceinline__ float sigmoidf_(float x) { return __builtin_amdgcn_rcpf(1.0f + __builtin_amdgcn_exp2f(-LOG2E * x)); }
__device__ __forceinline__ float wave_sum(float v) {
#pragma unroll
    for (int o = 1; o < 64; o <<= 1) v += __shfl_xor(v, o);
    return v;
}
__device__ __forceinline__ int lane_id_fresh() { int l; asm volatile("v_mbcnt_lo_u32_b32 %0, -1, 0\n\tv_mbcnt_hi_u32_b32 %0, -1, %0" : "=v"(l)); return l; }
__device__ __forceinline__ unsigned pk4_fp8(float a, float b, float c, float d) { unsigned w = (unsigned)__builtin_amdgcn_cvt_pk_fp8_f32(a, b, 0, false); return (unsigned)__builtin_amdgcn_cvt_pk_fp8_f32(c, d, (int)w, true); }
#define LDS_WAIT() asm volatile("s_waitcnt lgkmcnt(0)" ::: "memory")
#define VM_WAIT() asm volatile("s_waitcnt vmcnt(0)" ::: "memory")

namespace pg8 {
#define PG8_LAS __attribute__((address_space(3)))
constexpr int BM = 256, BK = 64, HALF = 128, HTB = HALF * BK * 2  , STAGE_BYTES = 8 * HTB, NXCD = 8, WGM = 4;

__host__ __device__ __forceinline__ int lds_byte(int r, int c) { const int st = (r >> 4) * 2 + (c >> 5), rr = r & 15, cc = c & 31, ob = rr * 64 + cc * 2; return st * 1024 + (ob ^ (((ob >> 9) & 1) << 5)); }
__host__ __device__ __forceinline__ void stage_rc(int b, int& R, int& C) { const int st = b / 1024, sb = b % 1024, swz = sb ^ (((sb >> 9) & 1) << 5); R = (st >> 1) * 16 + swz / 64; C = (st & 1) * 32 + (swz % 64) / 2; }
__host__ __device__ __forceinline__ int perm32(int rho) { const int n = rho >> 4, i = rho & 15; return 8 * (i >> 2) + 4 * n + (i & 3); }

struct Unit { int pm, pn, part; };
struct Gemm { const bf16_t* A; const bf16_t* Bt; int M, N, K, ld; };

struct StaticOrder {
    int nM, nN, nwg, G, c;
    __host__ __device__ void init(int M, int N, int G_, int c_) { nM = M / BM; nN = N / BM; nwg = nM * nN; G = G_; c = c_; }
    __host__ __device__ bool next(int i, Unit& u) const {
        const long L = (long)i * G + c; if (L >= nwg) return false;
        int wgid = (int)L; { const int q = nwg / NXCD, r = nwg % NXCD, xcd = wgid % NXCD, off = wgid / NXCD; wgid = (xcd < r ? xcd * (q + 1) : r * (q + 1) + (xcd - r) * q) + off; }
        const int nig = WGM * nN, gid = wgid / nig, fm = gid * WGM, gsz = (nM - fm) < WGM ? (nM - fm) : WGM;
        u.pm = fm + ((wgid % nig) % gsz); u.pn = (wgid % nig) / gsz; u.part = 0; return true;
    }
    static constexpr bool GATHER = false;
    __device__ __forceinline__ int row_of(const Unit&, int) const { return 0; }
    __device__ __forceinline__ void a_ready(const Unit&) const {}
    __device__ __forceinline__ void done(const Unit&) const {}
};
struct PairOrder : StaticOrder {
    __host__ __device__ bool next(int i, Unit& u) const { if (!StaticOrder::next(i >> 1, u)) return false; u.part = i & 1; return true; }
};
__device__ __forceinline__ unsigned cvt_pk_bf16(float lo, float hi) { unsigned r; asm volatile("v_cvt_pk_bf16_f32 %0, %1, %2" : "=v"(r) : "v"(lo), "v"(hi)); return r; }

template <class Epi> __device__ __forceinline__ size_t koff_of(const Epi& E, const Unit& u) { if constexpr (Epi::MULTI) return (size_t)E.kt0(u.part) * (size_t)(BK * 2); else return (size_t)0; }
template <class Epi, class Sched, bool ALIGN_EPI = false, bool SP2 = false, int DUAL_T = 0, int I8MODE = 0>
__device__ __forceinline__ void gemm_phase(PG8_LAS unsigned char* lds, const Gemm g, const Sched& S, const Epi& E, int tid_) {
    asm volatile("" : "+v"(tid_));
    const int tid = tid_, wid = __builtin_amdgcn_readfirstlane(tid >> 6), lane = tid & 63, wr = wid >> 2, wc = wid & 3, fr = lane & 15, fq = lane >> 4;
    int K = g.K; asm volatile("" : "+s"(K));
    int nt = K / BK; const int LD = g.ld;
#define PG8_KOFF(u) koff_of(E, u)
    constexpr bool GATHER = Sched::GATHER; static_assert(!GATHER || SP2, "GATHER is written for the SP2 loop");
    unsigned voffA[2], voffA1[2], voffB[2]; int gR[2], gC[2];
#pragma unroll
    for (int i = 0; i < 2; ++i) { int R, C; stage_rc(tid * 16 + i * 8192, R, C); const int Rb = Epi::PERM ? ((R & ~31) + perm32(R & 31)) : R; gR[i] = R; gC[i] = C;
        voffA[i] = (unsigned)(R * LD + C) * 2u; voffA1[i] = 0u; voffB[i] = (unsigned)(Rb * LD + C) * 2u; }
#define PG8_GOFF(slot, i) ((unsigned)((((slot) < 0 ? 0 : (slot)) >> 1) * LD + gC[i]) * 2u)
    const size_t kstep = (size_t)(BK * 2);
    const size_t hstep = (size_t)HALF * LD * 2;
    const size_t tstep = 2 * hstep;
    const size_t hstepB = DUAL_T ? 0 : hstep, tstepB = DUAL_T ? hstep : tstep;
    const unsigned ldsw = (unsigned)wid * 1024u;
    const int aoff = lds_byte(wr * 64 + fr, fq * 8), boff = lds_byte(wc * 32 + fr, fq * 8);
#define PG8_SA(b, h) (((b) * 2 + (h)) * HTB)
#define PG8_SB(b, h) ((4 + (b) * 2 + (h)) * HTB)
#define PG8_STAGE(bufoff, gbase, voff) do { _Pragma("unroll") for (int _i = 0; _i < 2; ++_i) \
        __builtin_amdgcn_global_load_lds((const unsigned*)((const char*)(gbase) + (voff)[_i]), (PG8_LAS unsigned*)(lds + (bufoff) + ldsw + _i * 8192), 16, 0, 0); } while (0)
#define PG8_LD32(p_) __builtin_shufflevector(*(const PG8_LAS i32x4*)(p_), *(const PG8_LAS i32x4*)((p_) + 1024), 0, 1, 2, 3, 4, 5, 6, 7)
#define PG8_LDA(dst, b, h) do { if constexpr (I8MODE == 3) { _Pragma("unroll") for (int m = 0; m < 4; ++m) dst##8[m] = PG8_LD32(lds + PG8_SA(b, h) + aoff + m * 2048); } else { \
        _Pragma("unroll") for (int m = 0; m < 4; ++m) _Pragma("unroll") for (int k = 0; k < 2; ++k) dst[m][k] = *(const PG8_LAS bf16x8*)(lds + PG8_SA(b, h) + aoff + m * 2048 + k * 1024); } } while (0)
#define PG8_LDB(dst, b, h) do { if constexpr (I8MODE == 3) { _Pragma("unroll") for (int n = 0; n < 2; ++n) dst##8[n] = PG8_LD32(lds + PG8_SB(b, h) + boff + n * 2048); } else { \
        _Pragma("unroll") for (int n = 0; n < 2; ++n) _Pragma("unroll") for (int k = 0; k < 2; ++k) dst[n][k] = *(const PG8_LAS bf16x8*)(lds + PG8_SB(b, h) + boff + n * 2048 + k * 1024); } } while (0)
#define PG8_MMA(ai, bj, At, Bt) do { __builtin_amdgcn_s_setprio(1); _Pragma("unroll") for (int m = 0; m < 4; ++m) _Pragma("unroll") for (int n = 0; n < 2; ++n) _Pragma("unroll") for (int k = 0; k < 2; ++k) \
        acc[ai][bj][m][n] = __builtin_amdgcn_mfma_f32_16x16x32_bf16(Bt[n][k], At[m][k], acc[ai][bj][m][n], 0, 0, 0); __builtin_amdgcn_s_setprio(0); } while (0)
#define PG8_MMA_I8(ai, bj, At, Bt) do { __builtin_amdgcn_s_setprio(1); _Pragma("unroll") for (int m = 0; m < 4; ++m) _Pragma("unroll") for (int n = 0; n < 2; ++n) _Pragma("unroll") for (int k = 0; k < 2; ++k) \
        acc[ai][bj][m][n] = __builtin_bit_cast(f32x4, __builtin_amdgcn_mfma_i32_16x16x64_i8(__builtin_bit_cast(i32x4, Bt[n][k]), __builtin_bit_cast(i32x4, At[m][k]), __builtin_bit_cast(i32x4, acc[ai][bj][m][n]), 0, 0, 0)); __builtin_amdgcn_s_setprio(0); } while (0)
#define PG8_MMA_F8(ai, bj, At, Bt) do { __builtin_amdgcn_s_setprio(1); _Pragma("unroll") for (int m = 0; m < 4; ++m) _Pragma("unroll") for (int n = 0; n < 2; ++n) \
        acc[ai][bj][m][n] = __builtin_amdgcn_mfma_scale_f32_16x16x128_f8f6f4(Bt##8[n], At##8[m], acc[ai][bj][m][n], 0, 0, 0, 0x7f7f7f7f, 0, 0x7f7f7f7f); __builtin_amdgcn_s_setprio(0); } while (0)
#define PG8_MMA2(ai) do { if constexpr (I8MODE == 3) { PG8_MMA_F8(ai, 0, At, B0); PG8_MMA_F8(ai, 1, At, B1); } else if constexpr (DUAL_T > 0) { if (t < DUAL_T) { if constexpr (I8MODE != 0) { PG8_MMA_I8(ai, 0, At, B0); } else { PG8_MMA(ai, 0, At, B0); } } else { if constexpr (I8MODE == 1) { PG8_MMA_I8(ai, 1, At, B0); } else { PG8_MMA(ai, 1, At, B0); } } } \
        else { if constexpr (I8MODE == 1) { PG8_MMA_I8(ai, 0, At, B0); PG8_MMA_I8(ai, 1, At, B1); } else { PG8_MMA(ai, 0, At, B0); PG8_MMA(ai, 1, At, B1); } } } while (0)
#define PG8_STAGE_B1(buf, base) do { if constexpr (!DUAL_T) { PG8_STAGE(buf, base, voffB); } } while (0)
#define PG8_WAIT_VD(n, nd) do { if constexpr (DUAL_T > 0) { asm volatile("s_waitcnt vmcnt(" #nd ")" ::: "memory"); } else { asm volatile("s_waitcnt vmcnt(" #n ")" ::: "memory"); } } while (0)
#define PG8_WAIT_V(n) asm volatile("s_waitcnt vmcnt(" #n ")" ::: "memory")
#define PG8_WAIT_L(n) asm volatile("s_waitcnt lgkmcnt(" #n ")" ::: "memory")
#define PG8_BAR __builtin_amdgcn_s_barrier()
#define PG8_SCHED __builtin_amdgcn_sched_barrier(0)
    Unit cur, nxt; int ui = 0;
    if (!S.next(0, cur)) return;
    f32x4 acc[2][2][4][2];
#pragma unroll
    for (int a = 0; a < 2; ++a)
#pragma unroll
        for (int b = 0; b < 2; ++b)
#pragma unroll
            for (int m = 0; m < 4; ++m)
#pragma unroll
                for (int n = 0; n < 2; ++n) acc[a][b][m][n] = (f32x4){0.f, 0.f, 0.f, 0.f};
    bf16x8 At[4][2], B0[2][2], B1[2][2]; i32x8 At8[4], B08[2], B18[2];
    const char* cA = (const char*)g.A + (GATHER ? (size_t)0 : (size_t)cur.pm * tstep) + PG8_KOFF(cur); const char* cB = (const char*)g.Bt + (size_t)cur.pn * tstepB + PG8_KOFF(cur);
    if constexpr (Epi::MULTI) { nt = E.nkt(cur.part); asm volatile("" : "+s"(nt)); }
    S.a_ready(cur);
    int ns[4] = {0, 0, 0, 0};
    if constexpr (GATHER) {
#pragma unroll
        for (int i = 0; i < 2; ++i) { voffA[i] = PG8_GOFF(S.row_of(cur, gR[i]), i); voffA1[i] = PG8_GOFF(S.row_of(cur, HALF + gR[i]), i); } }
#define PG8_STAGE_A1(buf, base) do { if constexpr (GATHER) { PG8_STAGE(buf, base, voffA1); } else { PG8_STAGE(buf, (base) + hstep, voffA); } } while (0)
    if constexpr (SP2) {
        PG8_STAGE(PG8_SB(0, 0), cB, voffB); PG8_STAGE_B1(PG8_SB(0, 1), cB + hstepB); PG8_STAGE(PG8_SA(0, 0), cA, voffA); PG8_STAGE_A1(PG8_SA(0, 1), cA);
        if (wr == 1) PG8_BAR;
        PG8_WAIT_V(2); PG8_BAR;
        PG8_STAGE(PG8_SB(1, 0), cB + kstep, voffB); PG8_STAGE(PG8_SA(1, 0), cA + kstep, voffA); PG8_STAGE_B1(PG8_SB(1, 1), cB + hstepB + kstep);
        PG8_WAIT_VD(6, 4); PG8_BAR;
    } else {
        PG8_STAGE(PG8_SB(0, 0), cB, voffB); PG8_STAGE(PG8_SA(0, 0), cA, voffA); PG8_STAGE(PG8_SB(0, 1), cB + hstepB, voffB); PG8_STAGE(PG8_SA(0, 1), cA + hstep, voffA);
        if (wr == 1) PG8_BAR;
        PG8_WAIT_V(4); PG8_BAR;
        PG8_STAGE(PG8_SB(1, 0), cB + kstep, voffB); PG8_STAGE(PG8_SA(1, 0), cA + kstep, voffA); PG8_STAGE(PG8_SB(1, 1), cB + hstepB + kstep, voffB);
        PG8_WAIT_V(6); PG8_BAR;
    }
    for (;;) {
        const bool has_next = S.next(ui + 1, nxt);
        if constexpr (GATHER) { if (has_next) {
#pragma unroll
            for (int i = 0; i < 2; ++i) { ns[i] = S.row_of(nxt, gR[i]); ns[2 + i] = S.row_of(nxt, HALF + gR[i]); } } }
        const char* nA = (has_next && !GATHER) ? (const char*)g.A + (size_t)nxt.pm * tstep + PG8_KOFF(nxt) : cA; const char* nB = has_next ? (const char*)g.Bt + (size_t)nxt.pn * tstepB + PG8_KOFF(nxt) : cB;
        for (int t = 0; t < nt; t += 2) {
            const bool last = (t == nt - 2);
            if constexpr (Epi::MID_T > 0) { if (t == Epi::MID_T) E.mid(acc, cur, wr, wc, fr, fq); }
            const char* a1 = cA + (size_t)(t + 1) * kstep;
            const char* a2 = last ? nA : cA + (size_t)(t + 2) * kstep; const char* b2 = last ? nB : cB + (size_t)(t + 2) * kstep;
            const char* a3 = a2 + kstep; const char* b3 = b2 + kstep;
            if (last && has_next) S.a_ready(nxt);
            if constexpr (SP2) {
            PG8_LDB(B0, 0, 0); if constexpr (!DUAL_T) PG8_LDB(B1, 0, 1); PG8_SCHED; PG8_LDA(At, 0, 0); PG8_STAGE_A1(PG8_SA(1, 1), a1);
            if constexpr (GATHER) { if (last && has_next) {
#pragma unroll
                for (int i = 0; i < 2; ++i) { voffA[i] = PG8_GOFF(ns[i], i); voffA1[i] = PG8_GOFF(ns[2 + i], i); } } }
            PG8_WAIT_VD(8, 6); PG8_WAIT_L(0); PG8_BAR; PG8_MMA2(0); PG8_BAR; PG8_SCHED;
            PG8_LDA(At, 0, 1); PG8_STAGE(PG8_SB(0, 0), b2, voffB); PG8_STAGE_B1(PG8_SB(0, 1), b2 + hstepB); PG8_STAGE(PG8_SA(0, 0), a2, voffA);
            PG8_WAIT_VD(8, 6); PG8_WAIT_L(0); PG8_BAR; PG8_MMA2(1); PG8_BAR; PG8_SCHED;
            PG8_LDB(B0, 1, 0); if constexpr (!DUAL_T) PG8_LDB(B1, 1, 1); PG8_SCHED; PG8_LDA(At, 1, 0); PG8_STAGE_A1(PG8_SA(0, 1), a2);
            PG8_WAIT_VD(8, 6); PG8_WAIT_L(0); PG8_BAR; PG8_MMA2(0); PG8_BAR; PG8_SCHED;
            PG8_LDA(At, 1, 1); PG8_STAGE(PG8_SB(1, 0), b3, voffB); PG8_STAGE_B1(PG8_SB(1, 1), b3 + hstepB); PG8_STAGE(PG8_SA(1, 0), a3, voffA);
            PG8_WAIT_VD(8, 6); PG8_WAIT_L(0); PG8_BAR; PG8_MMA2(1); PG8_BAR; PG8_SCHED;
            } else {
            PG8_LDB(B0, 0, 0); PG8_SCHED; PG8_LDA(At, 0, 0); PG8_STAGE(PG8_SA(1, 1), a1 + hstep, voffA);
            PG8_WAIT_L(8); PG8_BAR; PG8_WAIT_L(0); PG8_MMA(0, 0, At, B0); PG8_BAR; PG8_SCHED;
            PG8_LDB(B1, 0, 1); PG8_STAGE(PG8_SB(0, 0), b2, voffB);
            PG8_BAR; PG8_WAIT_L(0); PG8_MMA(0, 1, At, B1); PG8_BAR;
            PG8_LDA(At, 0, 1); PG8_STAGE(PG8_SA(0, 0), a2, voffA);
            PG8_BAR; PG8_WAIT_L(0); PG8_MMA(1, 0, At, B0); PG8_BAR; PG8_SCHED;
            PG8_STAGE(PG8_SB(0, 1), b2 + hstepB, voffB);
            PG8_WAIT_V(6); PG8_BAR; PG8_MMA(1, 1, At, B1); PG8_BAR;
            PG8_LDB(B0, 1, 0); PG8_SCHED; PG8_LDA(At, 1, 0); PG8_STAGE(PG8_SA(0, 1), a2 + hstep, voffA);
            PG8_WAIT_L(8); PG8_BAR; PG8_WAIT_L(0); PG8_MMA(0, 0, At, B0); PG8_BAR; PG8_SCHED;
            PG8_LDB(B1, 1, 1); PG8_STAGE(PG8_SB(1, 0), b3, voffB);
            PG8_BAR; PG8_WAIT_L(0); PG8_MMA(0, 1, At, B1); PG8_BAR;
            PG8_LDA(At, 1, 1); PG8_STAGE(PG8_SA(1, 0), a3, voffA);
            PG8_BAR; PG8_WAIT_L(0); PG8_MMA(1, 0, At, B0); PG8_BAR; PG8_SCHED;
            PG8_STAGE(PG8_SB(1, 1), b3 + hstepB, voffB);
            PG8_WAIT_V(6); PG8_BAR; PG8_MMA(1, 1, At, B1); PG8_BAR;
            }
        }
        if constexpr (ALIGN_EPI) { if (wr == 0) PG8_BAR; }
        if constexpr (!Epi::AFTER_DRAIN) { E(acc, cur, wr, wc, fr, fq); S.done(cur); }
        if (!has_next) break;
        bool zero_acc = true; if constexpr (Epi::MULTI) zero_acc = E.reset(cur.part);
        if (zero_acc) {
#pragma unroll
        for (int a = 0; a < 2; ++a)
#pragma unroll
            for (int b = 0; b < 2; ++b)
#pragma unroll
                for (int m = 0; m < 4; ++m)
#pragma unroll
                    for (int n = 0; n < 2; ++n) acc[a][b][m][n] = (f32x4){0.f, 0.f, 0.f, 0.f};
        }
        cur = nxt; cA = nA; cB = nB; ++ui;
        if constexpr (Epi::MULTI) { nt = E.nkt(cur.part); asm volatile("" : "+s"(nt)); }
        if constexpr (ALIGN_EPI) { if (wr == 1) PG8_BAR; }
    }
    PG8_WAIT_V(0);
    if constexpr (!ALIGN_EPI) { if (wr == 0) PG8_BAR; }
    PG8_BAR;
#undef PG8_SA
#undef PG8_SB
#undef PG8_STAGE
#undef PG8_LDA
#undef PG8_LD32
#undef PG8_LDB
#undef PG8_MMA
#undef PG8_MMA2
#undef PG8_MMA_I8
#undef PG8_MMA_F8
#undef PG8_KOFF
#undef PG8_STAGE_B1
#undef PG8_WAIT_VD
#undef PG8_STAGE_A1
#undef PG8_GOFF
#undef PG8_WAIT_V
#undef PG8_WAIT_L
#undef PG8_BAR
#undef PG8_SCHED
}
}

typedef f32x4 acc_t[2][2][4][2];
using pg8::Unit; using pg8::HALF; using pg8::BM;

struct EpiInproj {
    static constexpr bool PERM = true, AFTER_DRAIN = false; static constexpr bool MULTI = false; static constexpr int MID_T = 0;
    unsigned char* ws; const float* b_in; const float* g_q; const float* g_k; const float* rstdx;
    __device__ __forceinline__ void operator()(const acc_t& acc, const Unit& u, int wr, int wc, int fr, int fq) const {
        const int pn = u.pn;
        int mode, col0; size_t off;
        if (pn < 12) { const int seg = pn >> 1; mode = seg == 0 ? 1 : (seg == 1 ? 2 : 0); col0 = 256 * (pn & 1) + ((seg == 2 || seg == 4 || seg == 5) ? 512 : 0);
            off = (seg == 0 || seg == 4) ? WS_A1 : ((seg == 1 || seg == 2) ? WS_B1 : WS_C1);
            if (CU_PAIR && (seg == 3 || seg == 5)) mode = 4; }
        else if (pn < 16) { mode = 3; col0 = 256 * (pn - 12); off = WS_SGA; }
        else { mode = 3; col0 = 256 * (pn - 16); off = WS_SGC; }
        constexpr int pitch = 1024;
        bf16_t* base = (bf16_t*)(ws + off);
        const int lc0 = 64 * wc + 8 * fq;
        f32x4 bv[2][2], gv[2][2];
#pragma unroll
        for (int bj = 0; bj < 2; ++bj)
#pragma unroll
            for (int n = 0; n < 2; ++n) {
                bv[bj][n] = (mode == 4) ? *(const f32x4*)(b_in + (bj ? 2560 : 1536) + 128 * (pn < 8 ? pn - 6 : pn - 8) + 32 * wc + 8 * fq + 4 * n) : *(const f32x4*)(b_in + 256 * pn + lc0 + 32 * bj + 4 * n);
                const float* g = (mode == 2) ? g_k : g_q;
                gv[bj][n] = *(const f32x4*)(g + 8 * fq + 32 * bj + 4 * n);
            }
        const float qs = (mode == 1) ? C2 : 1.0f;
        float rsxv[2][4];
#pragma unroll
        for (int ai = 0; ai < 2; ++ai)
#pragma unroll
            for (int m = 0; m < 4; ++m) rsxv[ai][m] = rstdx[u.pm * BM + ai * HALF + wr * 64 + m * 16 + fr];
#pragma unroll
        for (int ai = 0; ai < 2; ++ai)
#pragma unroll
            for (int m = 0; m < 4; ++m) {
                const int row = u.pm * BM + ai * HALF + wr * 64 + m * 16 + fr; const float rsx = rsxv[ai][m];
                f32x4 v[2][2];
#pragma unroll
                for (int bj = 0; bj < 2; ++bj)
#pragma unroll
                    for (int n = 0; n < 2; ++n) v[bj][n] = acc[ai][bj][m][n] * rsx + bv[bj][n];
                if (mode == 1 || mode == 2) {
                    float ss = 0.f;
#pragma unroll
                    for (int bj = 0; bj < 2; ++bj)
#pragma unroll
                        for (int n = 0; n < 2; ++n) { const f32x4 x = v[bj][n]; ss += (x[0] * x[0] + x[1] * x[1]) + (x[2] * x[2] + x[3] * x[3]); }
                    ss += __shfl_xor(ss, 16); ss += __shfl_xor(ss, 32);
                    const float rstd = __frsqrt_rn(ss * (1.0f / 64.0f) + EPS) * qs;
#pragma unroll
                    for (int bj = 0; bj < 2; ++bj)
#pragma unroll
                        for (int n = 0; n < 2; ++n) v[bj][n] = v[bj][n] * rstd * gv[bj][n];
                } else if (mode == 3) {
#pragma unroll
                    for (int bj = 0; bj < 2; ++bj)
#pragma unroll
                        for (int n = 0; n < 2; ++n)
#pragma unroll
                            for (int j = 0; j < 4; ++j) v[bj][n][j] = sigmoidf_(v[bj][n][j]);
                }
                if (mode == 4) {
                    const f32x4 c0 = v[0][0] * v[1][0], c1 = v[0][1] * v[1][1];
                    u32x4 w; w.x = pg8::cvt_pk_bf16(c0[0], c0[1]); w.y = pg8::cvt_pk_bf16(c0[2], c0[3]); w.z = pg8::cvt_pk_bf16(c1[0], c1[1]); w.w = pg8::cvt_pk_bf16(c1[2], c1[3]);
                    __builtin_nontemporal_store(w, (u32x4*)((bf16_t*)(ws + WS_C1) + (size_t)row * pitch + 128 * (pn < 8 ? pn - 6 : pn - 8) + 32 * wc + 8 * fq));
                    continue;
                }
                if (mode == 3) {
                    unsigned char* rp8 = (unsigned char*)base + (size_t)row * pitch + col0 + lc0; const float lo = (pn >= 16) ? 1.0f : 0.0f;
#pragma unroll
                    for (int bj = 0; bj < 2; ++bj) { unsigned w2[2];
#pragma unroll
                        for (int n = 0; n < 2; ++n) { unsigned b4 = 0;
#pragma unroll
                            for (int j = 0; j < 4; ++j) b4 |= (unsigned)__float2int_rn(fmaxf(v[bj][n][j] * 255.0f, lo)) << (8 * j);
                            w2[n] = b4; }
                        *(u32x2*)(rp8 + 32 * bj) = (u32x2){w2[0], w2[1]}; }
                    continue;
                }
                bf16_t* rowp = base + (size_t)row * pitch + col0 + lc0;
#pragma unroll
                for (int bj = 0; bj < 2; ++bj) {
                    u32x4 w; w.x = pg8::cvt_pk_bf16(v[bj][0][0], v[bj][0][1]); w.y = pg8::cvt_pk_bf16(v[bj][0][2], v[bj][0][3]); w.z = pg8::cvt_pk_bf16(v[bj][1][0], v[bj][1][1]); w.w = pg8::cvt_pk_bf16(v[bj][1][2], v[bj][1][3]);
                    __builtin_nontemporal_store(w, (u32x4*)(rowp + 32 * bj));
                }
            }
    }
};

struct EpiGateF8 {
    static constexpr bool PERM = true, AFTER_DRAIN = false; static constexpr bool MULTI = false; static constexpr int MID_T = 0;
    unsigned char* sga8; unsigned char* sgc8; const float* bias; const float* rstdx;
    __device__ __forceinline__ void operator()(const acc_t& acc, const Unit& u, int wr, int wc, int fr, int fq) const {
        const int pn = u.pn; unsigned char* base = (pn < 4 ? sga8 : sgc8) + 256 * (pn & 3) + wc * 32 + 8 * fq; const float lo = (pn >= 4) ? 1.0f : 0.0f;
        f32x4 bv[2][2]; float rsxv[2][4];
#pragma unroll
        for (int bj = 0; bj < 2; ++bj)
#pragma unroll
            for (int n = 0; n < 2; ++n) bv[bj][n] = *(const f32x4*)(bias + 256 * pn + wc * 32 + 8 * fq + bj * HALF + 4 * n) * (-LOG2E);
#pragma unroll
        for (int ai = 0; ai < 2; ++ai)
#pragma unroll
            for (int m = 0; m < 4; ++m) rsxv[ai][m] = rstdx[u.pm * BM + ai * HALF + wr * 64 + m * 16 + fr] * (-LOG2E / F8W);
#pragma unroll
        for (int ai = 0; ai < 2; ++ai)
#pragma unroll
            for (int m = 0; m < 4; ++m) {
                const int row = u.pm * BM + ai * HALF + wr * 64 + m * 16 + fr; const float rs = rsxv[ai][m];
#pragma unroll
                for (int bj = 0; bj < 2; ++bj) { unsigned w2[2];
#pragma unroll
                    for (int n = 0; n < 2; ++n) { unsigned b4 = 0;
#pragma unroll
                        for (int j = 0; j < 4; ++j) { constexpr float k = 1.0f / 255.0f; const float e_ = __builtin_amdgcn_exp2f(acc[ai][bj][m][n][j] * rs + bv[bj][n][j]);
                            b4 |= (unsigned)(fmaxf(__builtin_amdgcn_rcpf(e_ * k + k), lo) + 0.5f) << (8 * j); }
                        w2[n] = b4; }
                    __builtin_nontemporal_store((u32x2){w2[0], w2[1]}, (u32x2*)(base + (size_t)row * 1024 + bj * HALF)); }
            }
    }
};

struct EpiMergeDual {
    static constexpr bool PERM = true, AFTER_DRAIN = false; static constexpr bool MULTI = false; static constexpr int MID_T = 0;
    const bf16_t* sga; const bf16_t* sgc; bf16_t* mout;
    __device__ __forceinline__ void operator()(const acc_t& acc, const Unit& u, int wr, int wc, int fr, int fq) const {
        const int col0 = u.pn * HALF + wc * 32 + 8 * fq;
#pragma unroll
        for (int ai = 0; ai < 2; ++ai)
#pragma unroll
            for (int m = 0; m < 4; ++m) {
                const size_t ro = (size_t)(u.pm * BM + ai * HALF + wr * 64 + m * 16 + fr) * D + col0;
                const u32x4 a = *(const u32x4*)(sga + ro), c = *(const u32x4*)(sgc + ro);
                const f32x4 x0 = acc[ai][0][m][0], x1 = acc[ai][0][m][1], y0 = acc[ai][1][m][0], y1 = acc[ai][1][m][1];
                u32x4 w;
                w.x = pg8::cvt_pk_bf16(x0[0] * bf_lo(a.x) + y0[0] * bf_lo(c.x), x0[1] * bf_hi(a.x) + y0[1] * bf_hi(c.x));
                w.y = pg8::cvt_pk_bf16(x0[2] * bf_lo(a.y) + y0[2] * bf_lo(c.y), x0[3] * bf_hi(a.y) + y0[3] * bf_hi(c.y));
                w.z = pg8::cvt_pk_bf16(x1[0] * bf_lo(a.z) + y1[0] * bf_lo(c.z), x1[1] * bf_hi(a.z) + y1[1] * bf_hi(c.z));
                w.w = pg8::cvt_pk_bf16(x1[2] * bf_lo(a.w) + y1[2] * bf_lo(c.w), x1[3] * bf_hi(a.w) + y1[3] * bf_hi(c.w));
                *(u32x4*)(mout + ro) = w;
            }
    }
};

struct EpiResBf16 {
    static constexpr bool PERM = true, AFTER_DRAIN = false; static constexpr bool MULTI = false; static constexpr int MID_T = 0;
    const bf16_t* xb; bf16_t* h1b; unsigned char* h1f8;
    __device__ __forceinline__ void operator()(const acc_t& acc, const Unit& u, int wr, int wc, int fr, int fq) const {
        const int col0 = u.pn * BM + wc * 32 + 8 * fq;
        u32x4 xv[2][4][2];
#pragma unroll
        for (int ai = 0; ai < 2; ++ai)
#pragma unroll
            for (int m = 0; m < 4; ++m)
#pragma unroll
                for (int bj = 0; bj < 2; ++bj) xv[ai][m][bj] = *(const u32x4*)(xb + (size_t)(u.pm * BM + ai * HALF + wr * 64 + m * 16 + fr) * D + col0 + bj * HALF);
#pragma unroll
        for (int ai = 0; ai < 2; ++ai)
#pragma unroll
            for (int m = 0; m < 4; ++m) {
                const size_t ro = (size_t)(u.pm * BM + ai * HALF + wr * 64 + m * 16 + fr) * D + col0;
#pragma unroll
                for (int bj = 0; bj < 2; ++bj) {
                    const u32x4 x = xv[ai][m][bj]; const f32x4 v0 = acc[ai][bj][m][0], v1 = acc[ai][bj][m][1];
                    u32x4 w; w.x = pg8::cvt_pk_bf16(v0[0] + bf_lo(x.x), v0[1] + bf_hi(x.x)); w.y = pg8::cvt_pk_bf16(v0[2] + bf_lo(x.y), v0[3] + bf_hi(x.y));
                    w.z = pg8::cvt_pk_bf16(v1[0] + bf_lo(x.z), v1[1] + bf_hi(x.z)); w.w = pg8::cvt_pk_bf16(v1[2] + bf_lo(x.w), v1[3] + bf_hi(x.w));
                    *(u32x4*)(h1b + ro + bj * HALF) = w;
                    if (h1f8) { u32x2 q; q.x = pk4_fp8(v0[0] + bf_lo(x.x), v0[1] + bf_hi(x.x), v0[2] + bf_lo(x.y), v0[3] + bf_hi(x.y)); q.y = pk4_fp8(v1[0] + bf_lo(x.z), v1[1] + bf_hi(x.z), v1[2] + bf_lo(x.w), v1[3] + bf_hi(x.w)); *(u32x2*)(h1f8 + ro + bj * HALF) = q; }
                }
            }
    }
};

__device__ __forceinline__ int moe_local(const LAS int* pref, int e, int rtg, int r) { const int l = (rtg - pref[e]) * pg8::BM + r; return l < pref[64 + e] ? ((e << 15) | l) : -1; }
__device__ __forceinline__ LAS u32x2* moe_meta(LAS unsigned char* lds, int i) { return (LAS u32x2*)(lds + (i < 4 ? META_LO + i * 2048 : META_HI)); }
__device__ __forceinline__ void moe_meta_preload(LAS unsigned char* lds, const LAS int* pref, int nunits, int G, int c, const int* eslot, const float* ftab, bool by_token, int tid) {
    for (int j = tid; j < 5 * 256; j += 512) { const int i = j >> 8, r = j & 255, L = i * G + c;
        int slot = -1; float f = 0.f;
        if (L < nunits) { const int rtg = L >> 2; int e = 0;
#pragma unroll 4
            for (int k = 1; k < NE; ++k) e += (pref[k] <= rtg) ? 1 : 0;
            const int idx = moe_local(pref, e, rtg, r);
            if (idx >= 0) { slot = eslot[idx]; f = by_token ? ftab[slot >> 1] : ftab[idx]; } }
        moe_meta(lds, i)[r] = (u32x2){(unsigned)slot, __builtin_bit_cast(unsigned, f)}; }
    __syncthreads();
}
template <int F8> struct EpiSwigluT {
    static constexpr bool PERM = true, AFTER_DRAIN = false; static constexpr bool MULTI = false; static constexpr int MID_T = 0;
    bf16_t* hdn; LAS unsigned char* lds; static constexpr float wsc = F8 ? 1.0f / F8W : 1.0f; static constexpr int f8out = F8 && F8_DOWN;
    __device__ __forceinline__ void operator()(const acc_t& acc, const Unit& u, int wr, int wc, int fr, int fq) const {
        const int col0 = 128 * (u.pn & 3) + wc * 32 + 8 * fq;
        float rsv[2][4]; const LAS float* mp = (const LAS float*)moe_meta(lds, u.part) + 1;
#pragma unroll
        for (int ai = 0; ai < 2; ++ai)
#pragma unroll
            for (int m = 0; m < 4; ++m) rsv[ai][m] = mp[2 * (ai * HALF + wr * 64 + m * 16 + fr)] * wsc;
#pragma unroll
        for (int ai = 0; ai < 2; ++ai)
#pragma unroll
            for (int m = 0; m < 4; ++m) {
                const int row = u.pm * BM + ai * HALF + wr * 64 + m * 16 + fr; const float rs = rsv[ai][m];
                const size_t ro = (size_t)row * DE + col0;
                float h[8];
#pragma unroll
                for (int n = 0; n < 2; ++n)
#pragma unroll
                    for (int j = 0; j < 4; ++j) { const float a = acc[ai][0][m][n][j] * rs, b = acc[ai][1][m][n][j] * rs; h[4 * n + j] = a * sigmoidf_(a) * b; }
                if (f8out) { u32x2 q; q.x = pk4_fp8(h[0], h[1], h[2], h[3]); q.y = pk4_fp8(h[4], h[5], h[6], h[7]); *(u32x2*)((unsigned char*)hdn + ro) = q; }
                else { u32x4 w; w.x = pg8::cvt_pk_bf16(h[0], h[1]); w.y = pg8::cvt_pk_bf16(h[2], h[3]); w.z = pg8::cvt_pk_bf16(h[4], h[5]); w.w = pg8::cvt_pk_bf16(h[6], h[7]);
                *(u32x4*)(hdn + ro) = w; }
            }
    }
};

template <int F8> struct EpiDownT {
    static constexpr bool PERM = true, AFTER_DRAIN = false; static constexpr bool MULTI = false; static constexpr int MID_T = 0;
    bf16_t* contrib; LAS unsigned char* lds; static constexpr float wsc = (F8 ? 1.0f / F8W : 1.0f) * (F8_CONTRIB ? CSC : 1.0f);
    __device__ __forceinline__ void operator()(const acc_t& acc, const Unit& u, int wr, int wc, int fr, int fq) const {
        const int col0 = 256 * (u.pn & 3) + wc * 32 + 8 * fq;
#pragma unroll
        for (int ai = 0; ai < 2; ++ai) {
            int sl[4]; float wv[4];
#pragma unroll
            for (int m = 0; m < 4; ++m) { const LAS unsigned* mq = (const LAS unsigned*)moe_meta(lds, u.part) + 2 * (ai * HALF + wr * 64 + m * 16 + fr); sl[m] = (int)mq[0]; wv[m] = __builtin_bit_cast(float, mq[1]) * wsc; }
#pragma unroll
            for (int m = 0; m < 4; ++m) {
                const int slot = sl[m]; const float w = wv[m];
                if (slot >= 0) {
#pragma unroll
                    for (int bj = 0; bj < 2; ++bj) {
                        const f32x4 v0 = acc[ai][bj][m][0] * w, v1 = acc[ai][bj][m][1] * w;
#if F8_CONTRIB
                        *(u32x2*)((unsigned char*)contrib + (size_t)slot * D + col0 + bj * HALF) = (u32x2){pk4_fp8(v0[0], v0[1], v0[2], v0[3]), pk4_fp8(v1[0], v1[1], v1[2], v1[3])};
#else
                        u32x4 o; o.x = pg8::cvt_pk_bf16(v0[0], v0[1]); o.y = pg8::cvt_pk_bf16(v0[2], v0[3]); o.z = pg8::cvt_pk_bf16(v1[0], v1[1]); o.w = pg8::cvt_pk_bf16(v1[2], v1[3]);
                        *(u32x4*)(contrib + (size_t)slot * D + col0 + bj * HALF) = o;
#endif
                    }
                }
                asm volatile("" ::: "memory");
            }
        }
    }
};

struct EpiGateDual {
    static constexpr bool PERM = false, AFTER_DRAIN = false; static constexpr bool MULTI = false; static constexpr int MID_T = 0;
    const bf16_t* h2b; const float* rsc; const float* cmax; const float* bpg; float* out; const unsigned char* hq8; const float* hsc;
    __device__ __forceinline__ void operator()(const acc_t& acc, const Unit& u, int wr, int wc, int fr, int fq) const {
        const int col0 = u.pn * HALF + wc * 32 + 4 * fq;
        const __amdgpu_buffer_rsrc_t orr = __builtin_amdgcn_make_buffer_rsrc((void*)out, (short)0, T * D * 4, 0x00020000);
        f32x4 cs[2], bv[2]; float rsv[2][4]; u32x2 hv[2][4][2]; float hsv[2][4];
#pragma unroll
        for (int n = 0; n < 2; ++n) { cs[n] = *(const f32x4*)(cmax + col0 + n * 16) * (1.0f / 127.0f); bv[n] = *(const f32x4*)(bpg + col0 + n * 16); }
#pragma unroll
        for (int ai = 0; ai < 2; ++ai)
#pragma unroll
            for (int m = 0; m < 4; ++m) { const int row = u.pm * BM + ai * HALF + wr * 64 + m * 16 + fr; rsv[ai][m] = rsc[row]; hsv[ai][m] = RES8 ? hsc[row] : 0.f;
#pragma unroll
                for (int n = 0; n < 2; ++n) { if (RES8) { hv[ai][m][n].x = *(const unsigned*)(hq8 + (size_t)row * HPB + col0 + n * 16); hv[ai][m][n].y = 0u; } else hv[ai][m][n] = *(const u32x2*)(h2b + (size_t)row * D + col0 + n * 16); } }
#pragma unroll
        for (int ai = 0; ai < 2; ++ai)
#pragma unroll
            for (int m = 0; m < 4; ++m) {
                const int row = u.pm * BM + ai * HALF + wr * 64 + m * 16 + fr; const float rs = rsv[ai][m];
#pragma unroll
                for (int n = 0; n < 2; ++n) {
                    const int c = col0 + n * 16;
                    const u32x2 hw = hv[ai][m][n];
                    const i32x4 ia = __builtin_bit_cast(i32x4, acc[ai][0][m][n]); const f32x4 pv = acc[ai][1][m][n];
                    f32x4 a; a[0] = (float)ia[0] * rs * cs[n][0] + bv[n][0]; a[1] = (float)ia[1] * rs * cs[n][1] + bv[n][1]; a[2] = (float)ia[2] * rs * cs[n][2] + bv[n][2]; a[3] = (float)ia[3] * rs * cs[n][3] + bv[n][3];
                    f32x4 r, hf;
                    if (RES8) { const float hs_ = hsv[ai][m]; const int w_ = (int)hw.x; hf[0] = (float)((w_ << 24) >> 24) * hs_; hf[1] = (float)((w_ << 16) >> 24) * hs_; hf[2] = (float)((w_ << 8) >> 24) * hs_; hf[3] = (float)(w_ >> 24) * hs_; }
                    else { hf[0] = bf_lo(hw.x); hf[1] = bf_hi(hw.x); hf[2] = bf_lo(hw.y); hf[3] = bf_hi(hw.y); }
                    r[0] = hf[0] + sigmoidf_(a[0]) * pv[0]; r[1] = hf[1] + sigmoidf_(a[1]) * pv[1];
                    r[2] = hf[2] + sigmoidf_(a[2]) * pv[2]; r[3] = hf[3] + sigmoidf_(a[3]) * pv[3];
                    __builtin_amdgcn_raw_buffer_store_b128(__builtin_bit_cast(u32x4, r), orr, (unsigned)(((size_t)row * D + c) * 4), 0, OUT_AUX);
                }
            }
    }
};

struct EpiMerge2 {
    static constexpr bool PERM = true, AFTER_DRAIN = false; static constexpr bool MULTI = true; static constexpr int MID_T = 0;
    const unsigned char* sga; const unsigned char* sgc; bf16_t* mout;
    __device__ __forceinline__ int kt0(int part) const { return 8 * part; }
    __device__ __forceinline__ int nkt(int) const { return 8; }
    __device__ __forceinline__ bool reset(int part) const { return part == 1; }
    static __device__ __forceinline__ float u8(unsigned w, int j) { return (float)((w >> (8 * j)) & 0xffu); }
    __device__ __forceinline__ void operator()(acc_t& acc, const Unit& u, int wr, int wc, int fr, int fq) const {
        const int col0 = u.pn * BM + wc * 32 + 8 * fq;
        if (u.part == 0) {
            u32x2 av[2][4][2], cv[2][4][2];
#pragma unroll
            for (int ai = 0; ai < 2; ++ai)
#pragma unroll
                for (int m = 0; m < 4; ++m)
#pragma unroll
                    for (int bj = 0; bj < 2; ++bj) { const size_t o = (size_t)(u.pm * BM + ai * HALF + wr * 64 + m * 16 + fr) * D + col0 + bj * HALF; av[ai][m][bj] = *(const u32x2*)(sga + o); cv[ai][m][bj] = *(const u32x2*)(sgc + o); }
#pragma unroll
            for (int ai = 0; ai < 2; ++ai)
#pragma unroll
                for (int m = 0; m < 4; ++m)
#pragma unroll
                    for (int bj = 0; bj < 2; ++bj) {
                        const u32x2 a = av[ai][m][bj], c = cv[ai][m][bj];
#pragma unroll
                        for (int j = 0; j < 4; ++j) { acc[ai][bj][m][0][j] *= u8(a.x, j) * __builtin_amdgcn_rcpf(u8(c.x, j)); acc[ai][bj][m][1][j] *= u8(a.y, j) * __builtin_amdgcn_rcpf(u8(c.y, j)); }
                    }
        } else {
            u32x2 cv[2][4][2];
#pragma unroll
            for (int ai = 0; ai < 2; ++ai)
#pragma unroll
                for (int m = 0; m < 4; ++m)
#pragma unroll
                    for (int bj = 0; bj < 2; ++bj) cv[ai][m][bj] = *(const u32x2*)(sgc + (size_t)(u.pm * BM + ai * HALF + wr * 64 + m * 16 + fr) * D + col0 + bj * HALF);
#pragma unroll
            for (int ai = 0; ai < 2; ++ai)
#pragma unroll
                for (int m = 0; m < 4; ++m) {
                    const size_t ro = (size_t)(u.pm * BM + ai * HALF + wr * 64 + m * 16 + fr) * D + col0;
#pragma unroll
                    for (int bj = 0; bj < 2; ++bj) {
                        const u32x2 c = cv[ai][m][bj]; const f32x4 v0 = acc[ai][bj][m][0], v1 = acc[ai][bj][m][1]; constexpr float k = 1.0f / 255.0f;
                        u32x4 w; w.x = pg8::cvt_pk_bf16(v0[0] * u8(c.x, 0) * k, v0[1] * u8(c.x, 1) * k); w.y = pg8::cvt_pk_bf16(v0[2] * u8(c.x, 2) * k, v0[3] * u8(c.x, 3) * k);
                        w.z = pg8::cvt_pk_bf16(v1[0] * u8(c.y, 0) * k, v1[1] * u8(c.y, 1) * k); w.w = pg8::cvt_pk_bf16(v1[2] * u8(c.y, 2) * k, v1[3] * u8(c.y, 3) * k);
                        *(u32x4*)(mout + ro + bj * HALF) = w;
                    }
                }
        }
    }
};

template <bool GATHER_> struct MoeOrderT {
    static constexpr bool GATHER = GATHER_;
    const LAS int* pref;
    int nunits, G, c; LAS unsigned char* lds;
    __device__ __forceinline__ int row_of(const Unit& u, int r) const { return ((const LAS int*)moe_meta(lds, u.part))[2 * r]; }
    __device__ __forceinline__ bool next(int i, Unit& u) const {
        const int L = i * G + c; if (L >= nunits) return false;
        const int rtg = L >> 2, pnl = L & 3; int e = 0;
#pragma unroll 4
        for (int k = 1; k < NE; ++k) e += (pref[k] <= rtg) ? 1 : 0;
        e = __builtin_amdgcn_readfirstlane(e);
        u.pm = rtg; u.pn = 4 * e + pnl; u.part = i; return true;
    }
    __device__ __forceinline__ void a_ready(const Unit&) const {}
    __device__ __forceinline__ void done(const Unit&) const {}
};
struct StaticOrderId : pg8::StaticOrder {
    static constexpr bool GATHER = true;
    __device__ __forceinline__ int row_of(const Unit& u, int r) const { return 2 * (u.pm * pg8::BM + r); }
};
struct MoeOrderId : MoeOrderT<true> {
    __device__ __forceinline__ int row_of(const Unit& u, int r) const { return 2 * (u.pm * pg8::BM + r); }
};

#define XB_TMO      128
#define XB_XCNT(j)  (256  + 64 * (j))
#define XB_XSUB(j)  (1280 + 64 * (j))
#define XB_XGEN(j)  (2304 + 64 * (j))
#define XB_TOP      3328
#define XB_TOPGEN   3392
#define XCD_BAR_WORDS 3456
#define XB_SPIN_CAP (1u << 18)

__device__ __forceinline__ unsigned xb_ld(unsigned* p)              { return __hip_atomic_load(p, __ATOMIC_RELAXED, __HIP_MEMORY_SCOPE_AGENT); }
__device__ __forceinline__ unsigned xb_add(unsigned* p, unsigned v) { return __hip_atomic_fetch_add(p, v, __ATOMIC_RELAXED, __HIP_MEMORY_SCOPE_AGENT); }
__device__ __forceinline__ unsigned xb_xcc_id() { return (unsigned)__builtin_amdgcn_s_getreg((3 << 11) | 20) & 0xFu; }
#define XB_SPIN(cond, bar) do { unsigned _sp = 0; while (cond) { __builtin_amdgcn_s_sleep(1); \
    if ((++_sp & 255u) == 0u) { if (xb_ld(&(bar)[XB_TMO])) break; if (_sp > XB_SPIN_CAP) { atomicAdd(&(bar)[XB_TMO], 1u); break; } } } } while (0)

struct XcdBarrier {
    unsigned* bar; unsigned x;
    volatile LAS unsigned* st;
};

__device__ __forceinline__ XcdBarrier xcd_barrier_post(unsigned* bar, volatile LAS unsigned* st) {
    XcdBarrier b; b.bar = bar; b.x = xb_xcc_id(); b.st = st;
    if (threadIdx.x == 0) st[2] = xb_add(&bar[XB_XCNT(b.x)], 1u);
    return b;
}
__device__ __forceinline__ void xcd_barrier_complete(unsigned* bar, unsigned x, unsigned& nloc, unsigned& nx, unsigned& even) {
    const unsigned G = gridDim.x * gridDim.y * gridDim.z;
    unsigned sum, cnt, mine, ev, sp = 0u;
    for (;;) {
        sum = 0u; cnt = 0u; mine = 0u; ev = 1u;
#pragma unroll
        for (unsigned j = 0; j < 16; ++j) { const unsigned c = xb_ld(&bar[XB_XCNT(j)]); sum += c; cnt += (c > 0u) ? 1u : 0u; mine = (j == x) ? c : mine; ev &= (c == (j < 8u ? G / 8u : 0u)) ? 1u : 0u; }
        if (sum == G) break;
        __builtin_amdgcn_s_sleep(1);
        if ((++sp & 255u) == 0u) { if (xb_ld(&bar[XB_TMO])) break; if (sp > XB_SPIN_CAP) { atomicAdd(&bar[XB_TMO], 1u); break; } }
    }
    nloc = mine > 0u ? mine : 1u; nx = cnt > 0u ? cnt : 1u; even = (sum == G && (G & 7u) == 0u) ? ev : 0u;
}

__device__ __forceinline__ void xcd_barrier(const XcdBarrier& b, int tid) {
    asm volatile("s_waitcnt vmcnt(0)" ::: "memory");
    __syncthreads();
    if (tid == 0) {
        unsigned* bar = b.bar;
        __builtin_amdgcn_s_waitcnt(0);
        unsigned nloc = b.st[0], nx = b.st[1];
        if (nloc == 0u) { unsigned even; xcd_barrier_complete(bar, b.x, nloc, nx, even); b.st[0] = nloc; b.st[1] = nx; b.st[3] = even; }
        const unsigned old = xb_add(&bar[XB_XSUB(b.x)], 1u);
        const unsigned gen = old / nloc;
        if (old + 1u == (gen + 1u) * nloc) {
            __builtin_amdgcn_fence(__ATOMIC_RELEASE, "agent");
            asm volatile("s_waitcnt vmcnt(0)" ::: "memory");
            const unsigned og = xb_add(&bar[XB_TOP], 1u);
            const unsigned tg = og / nx;
            if (og + 1u == (tg + 1u) * nx) xb_add(&bar[XB_TOPGEN], 1u);
            else XB_SPIN(xb_ld(&bar[XB_TOPGEN]) == tg, bar);
            __builtin_amdgcn_fence(__ATOMIC_ACQUIRE, "agent");
            xb_add(&bar[XB_XGEN(b.x)], 1u);
            asm volatile("s_waitcnt vmcnt(0)" ::: "memory");
        } else {
            XB_SPIN(xb_ld(&bar[XB_XGEN(b.x)]) == gen, bar);
            __builtin_amdgcn_fence(__ATOMIC_ACQUIRE, "agent");
            asm volatile("s_waitcnt vmcnt(0)" ::: "memory");
        }
    }
    __syncthreads();
}

__device__ __forceinline__ void xcd_barrier_local(const XcdBarrier& b, int tid) {
    asm volatile("s_waitcnt vmcnt(0)" ::: "memory");
    __syncthreads();
    if (tid == 0) {
        unsigned* bar = b.bar;
        __builtin_amdgcn_s_waitcnt(0);
        const unsigned nloc = b.st[0];
        const unsigned old = xb_add(&bar[XB_XSUB(b.x)], 1u);
        const unsigned gen = old / nloc;
        if (old + 1u == (gen + 1u) * nloc) xb_add(&bar[XB_XGEN(b.x)], 1u);
        else XB_SPIN(xb_ld(&bar[XB_XGEN(b.x)]) == gen, bar);
        __builtin_amdgcn_fence(__ATOMIC_ACQUIRE, "agent");
        asm volatile("s_waitcnt vmcnt(0)" ::: "memory");
    }
    __syncthreads();
}

#include <hip/hip_bf16.h>
#include <cmath>
namespace attn_body {
using bf16=__hip_bfloat16;
using bf16x8=__attribute__((ext_vector_type(8)))short;
using s16x4=__attribute__((ext_vector_type(4)))short;
using f32x16=__attribute__((ext_vector_type(16)))float;
using u32x4=__attribute__((ext_vector_type(4)))unsigned;
constexpr int BATCH=8,NHEAD=8,SEQ=4096,D=64,DM=1024,OPITCH=1024;
constexpr int NW=8,QBLK=32,QB=QBLK*NW,KVBLK=64,NQB=SEQ/QB;
constexpr int ATTN_PITCH=DM, ATTN_UNIT_ROWS=QB;
constexpr int BT_COPY=384, BT_BYTES=4*BT_COPY*4;
__device__ __forceinline__ int crow(int r,int hi){return (r&3)+8*(r>>2)+4*hi;}
#define SBAR() __builtin_amdgcn_sched_barrier(0)
constexpr int NSLOT=3, SLOTB=8192;
constexpr int LDS_K=0, LDS_V=NSLOT*SLOTB, LDS_WS=2*NSLOT*SLOTB, LDS_OST=LDS_WS+NW*64*4, LDS_BT=LDS_OST+NW*4096, LDS_BYTES=LDS_BT+BT_BYTES;
__device__ __forceinline__ void glds16(const void*gsrc,unsigned lds_dst){unsigned keep;
  asm volatile("s_mov_b32 %0, m0\n\ts_mov_b32 m0, %2\n\ts_nop 0\n\tglobal_load_lds_dwordx4 %1, off\n\ts_mov_b32 m0, %0":"=&s"(keep):"v"(gsrc),"s"(lds_dst):"memory");}
__device__ __forceinline__ float max3f(float a,float b,float c){float r;asm("v_max3_f32 %0, %1, %2, %3":"=v"(r):"v"(a),"v"(b),"v"(c));return r;}
__device__ __forceinline__ float max2f(float a,float b){float r;asm("v_max_f32_e32 %0, %1, %2":"=v"(r):"v"(a),"v"(b));return r;}
__device__ __forceinline__ float fadd_s(float a,float b){float r;asm("v_add_f32_e32 %0, %1, %2":"=v"(r):"v"(a),"v"(b));return r;}
__device__ __forceinline__ float fsub_s(float a,float b){float r;asm("v_sub_f32_e32 %0, %1, %2":"=v"(r):"v"(a),"v"(b));return r;}
typedef float f32x2_t __attribute__((ext_vector_type(2))); typedef float f32x4_t __attribute__((ext_vector_type(4))); typedef __bf16 bf16x2_t __attribute__((ext_vector_type(2)));
__device__ __forceinline__ unsigned cvtpk_s(float lo,float hi){f32x2_t v={lo,hi};bf16x2_t b=__builtin_convertvector(v,bf16x2_t);return __builtin_bit_cast(unsigned,b);}
#define WAIT_BAR(N) asm volatile("s_waitcnt vmcnt(" #N ") lgkmcnt(0)\n\ts_barrier":::"memory")

__device__ __forceinline__ void qkt(f32x16&p0,f32x16&p1,const char*Kslot,const bf16x8*qr,const f32x16&negm,int r32,int hi){
  const char*kb=Kslot+hi*1024+r32*16;
  #pragma unroll
  for(int d0=0;d0<4;++d0){
    const bf16x8 b0=*reinterpret_cast<const bf16x8*>(kb+d0*2048);
    const bf16x8 b1=*reinterpret_cast<const bf16x8*>(kb+d0*2048+512);
    if(d0==0){p0=__builtin_amdgcn_mfma_f32_32x32x16_bf16(b0,qr[0],negm,0,0,0);p1=__builtin_amdgcn_mfma_f32_32x32x16_bf16(b1,qr[0],negm,0,0,0);}
    else{p0=__builtin_amdgcn_mfma_f32_32x32x16_bf16(b0,qr[d0],p0,0,0,0);p1=__builtin_amdgcn_mfma_f32_32x32x16_bf16(b1,qr[d0],p1,0,0,0);}}
}
typedef __attribute__((address_space(3))) const char* lds_cptr;
typedef short v4i16_t __attribute__((ext_vector_type(4)));
__device__ __forceinline__ void kload8(bf16x8*kf,lds_cptr kp){
  kf[0]=*(const __attribute__((address_space(3))) bf16x8*)(kp);      kf[1]=*(const __attribute__((address_space(3))) bf16x8*)(kp+512);
  kf[2]=*(const __attribute__((address_space(3))) bf16x8*)(kp+2048); kf[3]=*(const __attribute__((address_space(3))) bf16x8*)(kp+2560);
  kf[4]=*(const __attribute__((address_space(3))) bf16x8*)(kp+4096); kf[5]=*(const __attribute__((address_space(3))) bf16x8*)(kp+4608);
  kf[6]=*(const __attribute__((address_space(3))) bf16x8*)(kp+6144); kf[7]=*(const __attribute__((address_space(3))) bf16x8*)(kp+6656);
}
__device__ __forceinline__ void kload2(bf16x8*kf,lds_cptr kp,int j){ kf[2*j]=*(const __attribute__((address_space(3))) bf16x8*)(kp+j*2048); kf[2*j+1]=*(const __attribute__((address_space(3))) bf16x8*)(kp+j*2048+512); }
__device__ __forceinline__ s16x4 vtr(lds_cptr p){ return __builtin_bit_cast(s16x4,__builtin_amdgcn_ds_read_tr16_b64_v4i16((__attribute__((address_space(3))) v4i16_t*)p)); }
__device__ __forceinline__ float rowmax(const f32x16&p0,const f32x16&p1){
  float a=max3f(p0[0],p0[1],p1[0]),b=max3f(p0[2],p0[3],p1[1]);a=max3f(a,p1[2],p1[3]);
  #pragma unroll
  for(int r=4;r<16;r+=4){a=max3f(a,p0[r],p0[r+1]);b=max3f(b,p0[r+2],p0[r+3]);a=max3f(a,p1[r],p1[r+1]);b=max3f(b,p1[r+2],p1[r+3]);}
  const float m=max2f(a,b);
  auto rr=__builtin_amdgcn_permlane32_swap(__float_as_uint(m),__float_as_uint(m),false,false);
  return max2f(__uint_as_float(rr[0]),__uint_as_float(rr[1]));
}
__device__ __forceinline__ void pv(f32x16*o,int vb,bf16x8 pa0,bf16x8 pa1,bf16x8 pa2,bf16x8 pa3){
  #pragma unroll
  for(int d0=0;d0<2;++d0){s16x4 lo[4],hi[4];
    #pragma unroll
    for(int ks=0;ks<4;++ks){
      asm volatile("ds_read_b64_tr_b16 %0,%1 offset:%c2":"=&v"(lo[ks]):"v"(vb),"i"(d0*4096+ks*1024):"memory");
      asm volatile("ds_read_b64_tr_b16 %0,%1 offset:%c2":"=&v"(hi[ks]):"v"(vb),"i"(d0*4096+ks*1024+512):"memory");}
    asm volatile("s_waitcnt lgkmcnt(0)":::"memory");SBAR();
    #define PK(k) (bf16x8){lo[k][0],lo[k][1],lo[k][2],lo[k][3],hi[k][0],hi[k][1],hi[k][2],hi[k][3]}
    o[d0]=__builtin_amdgcn_mfma_f32_32x32x16_bf16(pa0,PK(0),o[d0],0,0,0);
    o[d0]=__builtin_amdgcn_mfma_f32_32x32x16_bf16(pa1,PK(1),o[d0],0,0,0);
    o[d0]=__builtin_amdgcn_mfma_f32_32x32x16_bf16(pa2,PK(2),o[d0],0,0,0);
    o[d0]=__builtin_amdgcn_mfma_f32_32x32x16_bf16(pa3,PK(3),o[d0],0,0,0);
    #undef PK
  }
}

#ifndef ATTN_STORE16
#define ATTN_STORE16(p,v) (*(u32x4*)(p)=(v))
#endif
__device__ __forceinline__ void attn_unit(int b,int h,int qb,const bf16*Q,const bf16*K,const bf16*V,bf16*O,char*shm,float cinit,int tid){
  asm volatile("":"+v"(tid));
  const int lane=tid&63,r32=lane&31,hi=lane>>5; const int wid=__builtin_amdgcn_readfirstlane(tid>>6);
  const long rowbase=(long)b*SEQ; const int q0=qb*QB;
  const bf16*Qw=Q+(rowbase+q0+wid*QBLK)*DM+h*D;
  const int t0=(4*qb-8)>0?(4*qb-8):0;
  const bf16*Kh=K+(rowbase+(long)t0*KVBLK)*DM+h*D,*Vh=V+(rowbase+(long)t0*KVBLK)*DM+h*D;
  const int tb=t0-4*qb-(wid>>1)+8;
  const unsigned lds0=(unsigned)(uintptr_t)shm;
  float*wsf=(float*)(shm+LDS_WS)+wid*64;
  const bf16*ksrc=Kh+(long)lane*DM+wid*8;
  const bf16*vsrc=Vh+(long)(16*(wid&3)+(lane>>2))*DM+(wid>>2)*32+(lane&3)*8;
  const unsigned kdst=lds0+LDS_K+wid*1024, vdst=lds0+LDS_V+wid*1024;
  #define DMA_K(t,slot) glds16(ksrc+(long)(t)*KVBLK*DM,(unsigned)__builtin_amdgcn_readfirstlane(kdst+(slot)))
  #define DMA_V(t,slot) glds16(vsrc+(long)(t)*KVBLK*DM,(unsigned)__builtin_amdgcn_readfirstlane(vdst+(slot)))
  const int vb0=(int)(lds0+LDS_V)+((lane>>4)&1)*32+(lane&3)*8+(4*hi+((lane&15)>>2))*64;
  const char*Kbase=shm+LDS_K; bf16x8 kf[8];
  const lds_cptr shm3=(lds_cptr)shm; const lds_cptr kp0=shm3+LDS_K+hi*1024+r32*16; const lds_cptr vp0=shm3+LDS_V+((lane>>4)&1)*32+(lane&3)*8+(4*hi+((lane&15)>>2))*64;
  const int NT=4*qb+4-t0;
  const lds_cptr btl=shm3+LDS_BT+((3-r32)&3)*(BT_COPY*4)+4*(-193-32*(wid&1)-r32-((3-r32)&3)+4*hi);
  DMA_K(0,0);DMA_V(0,0);DMA_K(1,SLOTB);
  bf16x8 qr[4];
  #pragma unroll
  for(int d0=0;d0<4;++d0)qr[d0]=*reinterpret_cast<const bf16x8*>(&Qw[(long)r32*DM+d0*16+hi*8]);
  float l_reg=0.f;f32x16 o[2];o[0]=f32x16{};o[1]=f32x16{};f32x16 negm;
  asm volatile("":"+s"(cinit));
  _Pragma("unroll") for(int r=0;r<16;++r)negm[r]=cinit; asm volatile("":"+v"(negm));
  #define BIASMASK(P0,P1,t) do{ const int tau_=(t)+tb; \
    if(tau_<0||tau_>8){ _Pragma("unroll") for(int r=0;r<16;++r){P0[r]=-INFINITY;P1[r]=-INFINITY;} } \
    else if(tau_>=4){ const lds_cptr bp_=btl+256*tau_; \
      _Pragma("unroll") for(int g=0;g<4;++g){ const f32x4_t d0_=*(const __attribute__((address_space(3))) f32x4_t*)(bp_+32*g), d1_=*(const __attribute__((address_space(3))) f32x4_t*)(bp_+32*g+128); \
        _Pragma("unroll") for(int j=0;j<4;++j){P0[4*g+j]+=d0_[j];P1[4*g+j]+=d1_[j];} } } }while(0)
  #define START(P0,P1) do{ _Pragma("unroll") for(int r=0;r<16;++r)P0[r]=__builtin_amdgcn_exp2f(P0[r]); }while(0)
  #define RESC() do{}while(0)
  f32x16 pA0,pA1,pB0,pB1;
  int sl_prev=0,sl_cur=0,sl_next=SLOTB;
  #define ROT() do{sl_prev=sl_cur;sl_cur=sl_next;sl_next=(sl_next==(NSLOT-1)*SLOTB)?0:sl_next+SLOTB;}while(0)
  DMA_K(2,2*SLOTB);
  WAIT_BAR(3);
  qkt(pA0,pA1,Kbase,qr,negm,r32,hi);asm volatile("s_nop 15\n\ts_nop 7":"+v"(pA0),"+v"(pA1));BIASMASK(pA0,pA1,0);
  START(pA0,pA1);
  _Pragma("unroll") for(int r=0;r<16;++r)pA1[r]=__builtin_amdgcn_exp2f(pA1[r]);
  WAIT_BAR(0);
  DMA_K(3,0);DMA_V(1,SLOTB);
  ROT();
  kload8(kf,kp0+sl_cur);
  WAIT_BAR(2);
  s16x4 vlo[8],vhi[8]; u32x4 pw0,pw1,pw2,pw3;
  #define PKW(P,B) cvtpk_s(P[B],P[B+1])
  #define PAF(k) __builtin_bit_cast(bf16x8,pw##k)
  #define VFR(i) (bf16x8){vlo[i][0],vlo[i][1],vlo[i][2],vlo[i][3],vhi[i][0],vhi[i][1],vhi[i][2],vhi[i][3]}
  #define PIN(x) asm volatile("":"+v"(x))
  #define MX3(a,b,c) __builtin_fmaxf(__builtin_fmaxf((a),(b)),(c))
  #define GAPA(MF,A0,A1,A2,A3,W0,W1,PW) do{ MF; sacc+=A0; sacc+=A1; sacc+=A2; sacc+=A3; PIN(sacc); W0; W1; PIN(PW); SBAR(); }while(0)
  #define EX(v) __builtin_amdgcn_exp2f(v)
  #define GAPB(MF,X,B) do{ MF; X[B]=EX(X[B]); X[B+1]=EX(X[B+1]); X[B+2]=EX(X[B+2]); X[B+3]=EX(X[B+3]); PIN(X); SBAR(); }while(0)
  #define VRD(i) do{ vlo[i]=vtr(vp_+(((i)>>2)*4096+((i)&3)*1024)); vhi[i]=vtr(vp_+(((i)>>2)*4096+((i)&3)*1024+512)); }while(0)
  #define KRD(G,j) do{ if(G){ kload2(kf,kp0+sl_next,j); SBAR(); } }while(0)
  #define STEP(C0,C1,P0,P1,t,GK,GV,GL) do{ SBAR(); \
    const lds_cptr vp_=vp0+sl_prev; \
    VRD(0); SBAR(); float sacc=(P0[0]+P0[1]); \
    GAPA(C0=__builtin_amdgcn_mfma_f32_32x32x16_bf16(kf[0],qr[0],negm,0,0,0), P0[2],P0[3],P0[4],P0[5],     pw0[0]=PKW(P0,0), pw0[1]=PKW(P0,2), pw0); \
    VRD(4); SBAR(); GAPA(C1=__builtin_amdgcn_mfma_f32_32x32x16_bf16(kf[1],qr[0],negm,0,0,0), P0[6],P0[7],P0[8],P0[9],     pw0[2]=PKW(P0,4), pw0[3]=PKW(P0,6), pw0); \
    VRD(1); SBAR(); GAPA(C0=__builtin_amdgcn_mfma_f32_32x32x16_bf16(kf[2],qr[1],C0,0,0,0),   P0[10],P0[11],P0[12],P0[13], pw1[0]=PKW(P0,8), pw1[1]=PKW(P0,10), pw1); \
    VRD(5); SBAR(); GAPA(C1=__builtin_amdgcn_mfma_f32_32x32x16_bf16(kf[3],qr[1],C1,0,0,0),   P0[14],P0[15],P1[0],P1[1],   pw1[2]=PKW(P0,12),pw1[3]=PKW(P0,14), pw1); \
    VRD(2); SBAR(); GAPA(C0=__builtin_amdgcn_mfma_f32_32x32x16_bf16(kf[4],qr[2],C0,0,0,0),   P1[2],P1[3],P1[4],P1[5],     pw2[0]=PKW(P1,0), pw2[1]=PKW(P1,2), pw2); \
    VRD(6); SBAR(); GAPA(C1=__builtin_amdgcn_mfma_f32_32x32x16_bf16(kf[5],qr[2],C1,0,0,0),   P1[6],P1[7],P1[8],P1[9],     pw2[2]=PKW(P1,4), pw2[3]=PKW(P1,6), pw2); \
    VRD(3); SBAR(); GAPA(C0=__builtin_amdgcn_mfma_f32_32x32x16_bf16(kf[6],qr[3],C0,0,0,0),   P1[10],P1[11],P1[12],P1[13], pw3[0]=PKW(P1,8), pw3[1]=PKW(P1,10), pw3); \
    VRD(7); SBAR(); GAPA(C1=__builtin_amdgcn_mfma_f32_32x32x16_bf16(kf[7],qr[3],C1,0,0,0),   P1[14],P1[15],0.f,0.f,       pw3[2]=PKW(P1,12),pw3[3]=PKW(P1,14), pw3); \
    l_reg+=sacc; \
    if(GK){DMA_K((t)+3,sl_cur);} if(GV){DMA_V((t)+1,sl_next);} \
    BIASMASK(C0,C1,t); \
    SBAR(); \
    GAPB(o[0]=__builtin_amdgcn_mfma_f32_32x32x16_bf16(PAF(0),VFR(0),o[0],0,0,0), C0,0); \
    GAPB(o[1]=__builtin_amdgcn_mfma_f32_32x32x16_bf16(PAF(0),VFR(4),o[1],0,0,0), C0,4); \
    KRD(GL,0); GAPB(o[0]=__builtin_amdgcn_mfma_f32_32x32x16_bf16(PAF(1),VFR(1),o[0],0,0,0), C0,8); \
    KRD(GL,1); GAPB(o[1]=__builtin_amdgcn_mfma_f32_32x32x16_bf16(PAF(1),VFR(5),o[1],0,0,0), C0,12); \
    KRD(GL,2); GAPB(o[0]=__builtin_amdgcn_mfma_f32_32x32x16_bf16(PAF(2),VFR(2),o[0],0,0,0), C1,0); \
    KRD(GL,3); GAPB(o[1]=__builtin_amdgcn_mfma_f32_32x32x16_bf16(PAF(2),VFR(6),o[1],0,0,0), C1,4); \
    GAPB(o[0]=__builtin_amdgcn_mfma_f32_32x32x16_bf16(PAF(3),VFR(3),o[0],0,0,0), C1,8); \
    GAPB(o[1]=__builtin_amdgcn_mfma_f32_32x32x16_bf16(PAF(3),VFR(7),o[1],0,0,0), C1,12); \
    }while(0)
  int t=1;
  for(;t+5<NT;t+=2){
    STEP(pB0,pB1,pA0,pA1,t,true,true,true);     WAIT_BAR(2); RESC(); ROT();
    STEP(pA0,pA1,pB0,pB1,t+1,true,true,true);   WAIT_BAR(2); RESC(); ROT();
  }
  #define ENDW(tt) do{ if((tt)+3<NT){WAIT_BAR(2);} else if((tt)+2<NT){WAIT_BAR(1);} else {WAIT_BAR(0);} }while(0)
  for(;t+1<NT;t+=2){
    STEP(pB0,pB1,pA0,pA1,t,(t+3<NT),(t+1<NT),(t+1<NT));       ENDW(t);   RESC(); ROT();
    STEP(pA0,pA1,pB0,pB1,t+1,(t+4<NT),(t+2<NT),(t+2<NT));     ENDW(t+1); RESC(); ROT();
  }
  STEP(pB0,pB1,pA0,pA1,NT-1,false,false,false); RESC();
  { float sacc=pB0[0]+pB0[1]; _Pragma("unroll") for(int r=2;r<16;++r)sacc+=pB0[r]; _Pragma("unroll") for(int r=0;r<16;++r)sacc+=pB1[r]; l_reg+=sacc;
    pw0=(u32x4){PKW(pB0,0),PKW(pB0,2),PKW(pB0,4),PKW(pB0,6)};pw1=(u32x4){PKW(pB0,8),PKW(pB0,10),PKW(pB0,12),PKW(pB0,14)};pw2=(u32x4){PKW(pB1,0),PKW(pB1,2),PKW(pB1,4),PKW(pB1,6)};pw3=(u32x4){PKW(pB1,8),PKW(pB1,10),PKW(pB1,12),PKW(pB1,14)};
    SBAR(); pv(o,vb0+sl_cur,PAF(0),PAF(1),PAF(2),PAF(3)); }
  #undef PKW
  #undef PAF
  #undef VFR
  #undef PIN
  #undef MX3
  #undef GAPA
  #undef GAPB
  #undef EX
  #undef VRD
  #undef KRD
  #undef STEP
  #undef ENDW
  {auto rr=__builtin_amdgcn_permlane32_swap(__float_as_uint(l_reg),__float_as_uint(l_reg),false,false);l_reg=__uint_as_float(rr[0])+__uint_as_float(rr[1]);}
  if(hi==0)wsf[32+r32]=l_reg;asm volatile("s_waitcnt lgkmcnt(0)":::"memory");
  float rli[16];
  #pragma unroll
  for(int r=0;r<16;++r)rli[r]=__builtin_amdgcn_rcpf(wsf[32+crow(r,hi)]);
  bf16*Ow=O+(rowbase+q0+wid*QBLK)*OPITCH+h*D;
  { bf16*stg=(bf16*)(shm+LDS_OST)+wid*2048;
    #pragma unroll
    for(int r=0;r<16;++r){const int orow=crow(r,hi);
      #pragma unroll
      for(int d0=0;d0<2;++d0)stg[orow*64+d0*32+r32]=__float2bfloat16(o[d0][r]*rli[r]);}
    asm volatile("s_waitcnt lgkmcnt(0)":::"memory");
    #pragma unroll
    for(int i=0;i<4;++i){const int row=i*8+(lane>>3),ch=lane&7; const u32x4 v=*(const u32x4*)(stg+row*64+ch*8); ATTN_STORE16(Ow+(long)row*OPITCH+ch*8,v);} }
  asm volatile("s_waitcnt lgkmcnt(0)\n\ts_barrier":::"memory");
  #undef DMA_K
  #undef DMA_V
  #undef BIASMASK
  #undef START
  #undef RESC
  #undef ROT
}
constexpr int ATTN_LDS_BYTES=LDS_BYTES;
struct AttnUnit { int bh; int qb; };
__device__ __forceinline__ void attn_phase(char*lds,const bf16*Q,const bf16*K,const bf16*V,bf16*O,const float*gtab,const float*gcinit,int grid,int block,int tid){
  const int vcu=(block%8)*(grid/8)+block/8, s_=vcu&3, bh=vcu>>2, h=bh&7, b=bh>>3;
  { const f32x4_t* src=(const f32x4_t*)(gtab+(size_t)h*(4*BT_COPY)); __attribute__((address_space(3))) f32x4_t* dst=(__attribute__((address_space(3))) f32x4_t*)((lds_cptr)lds+LDS_BT);
    if(tid<BT_BYTES/16)dst[tid]=src[tid]; }
  const float cinit=__builtin_bit_cast(float,__builtin_amdgcn_readfirstlane(__builtin_bit_cast(int,gcinit[h])));
  asm volatile("s_waitcnt vmcnt(0) lgkmcnt(0)\n\ts_barrier":::"memory");
  for(int i=0;i<4;++i){ const int qb=(i==0)?s_:(i==1)?7-s_:(i==2)?8+s_:15-s_; attn_unit(b,h,qb,Q,K,V,O,lds,cinit,tid); }
}
#undef SBAR
#undef WAIT_BAR
}

struct Args {
    const float *x, *p, *g_mix, *w_in, *b_in, *g_q, *g_k, *rel_bias, *conv_w, *conv_b, *w_pa, *w_pc, *w_o, *g_ffn, *w_group, *b_group, *w_router, *b_router, *w1, *w3, *w2, *g_ple, *w_pg, *b_pg, *w_pp;
    float* out; unsigned char* ws;
};
constexpr int NWAVES = 8, NTHREADS = 512;
constexpr int RING_BYTES = 131072, MISC_OFF = 139264, WSCR = 16640;
constexpr int LDS_BYTES = 163840; static_assert(META_HI + 2048 <= LDS_BYTES, "MoE metadata area");

__device__ __forceinline__ void transpose_item(const float* src, int ldw, bf16_t* dst, int ldT, LAS float* scr, int lane, const float* gain = nullptr, int hi_off = 0) {
    float v[64];
#pragma unroll
    for (int i = 0; i < 64; ++i) v[i] = __builtin_nontemporal_load(src + (size_t)i * ldw + lane);
    if (gain) {
#pragma unroll
        for (int i = 0; i < 64; ++i) v[i] *= gain[i];
    }
#pragma unroll
    for (int i = 0; i < 64; ++i) scr[i * 65 + lane] = v[i];
    LDS_WAIT(); asm volatile("" ::: "memory");
    const int c = lane & 7;
#pragma unroll
    for (int j = 0; j < 8; ++j) { const int n = (lane >> 3) + 8 * j; const LAS float* s = scr + (8 * c) * 65 + n;
        u32x4 o; o.x = pk2(s[0 * 65], s[1 * 65]); o.y = pk2(s[2 * 65], s[3 * 65]); o.z = pk2(s[4 * 65], s[5 * 65]); o.w = pk2(s[6 * 65], s[7 * 65]);
        *(u32x4*)(dst + (size_t)(n + (n >= 32 ? hi_off : 0)) * ldT + 8 * c) = o; }
    LDS_WAIT(); asm volatile("" ::: "memory");
}
__device__ __forceinline__ void transpose_item_f8(const float* src, int ldw, unsigned char* dst, int ldTb, LAS float* scr, int lane, const float* gain, float sc) {
    float v[64];
#pragma unroll
    for (int i = 0; i < 64; ++i) v[i] = __builtin_nontemporal_load(src + (size_t)i * ldw + lane);
#pragma unroll
    for (int i = 0; i < 64; ++i) scr[i * 65 + lane] = v[i] * (gain ? gain[i] : 1.0f) * sc;
    LDS_WAIT(); asm volatile("" ::: "memory");
    const int c = lane & 3;
#pragma unroll
    for (int j = 0; j < 4; ++j) { const int n = (lane >> 2) + 16 * j; const LAS float* s = scr + (16 * c) * 65 + n; unsigned w[4];
#pragma unroll
        for (int e = 0; e < 4; ++e) w[e] = pk4_fp8(s[(4 * e) * 65], s[(4 * e + 1) * 65], s[(4 * e + 2) * 65], s[(4 * e + 3) * 65]);
        *(u32x4*)(dst + (size_t)n * ldTb + 16 * c) = (u32x4){w[0], w[1], w[2], w[3]}; }
    LDS_WAIT(); asm volatile("" ::: "memory");
}
__device__ __forceinline__ void transpose_item_q8(const float* src, int ldw, signed char* dst, int ldTb, LAS float* scr, int lane, const float* gain, const float* cmax) {
    float v[64];
#pragma unroll
    for (int i = 0; i < 64; ++i) v[i] = __builtin_nontemporal_load(src + (size_t)i * ldw + lane);
    const float sc = 127.0f / fmaxf(__builtin_bit_cast(float, __hip_atomic_load((const unsigned*)cmax + lane, __ATOMIC_RELAXED, __HIP_MEMORY_SCOPE_AGENT)), 1e-30f);
#pragma unroll
    for (int i = 0; i < 64; ++i) scr[i * 65 + lane] = v[i] * gain[i] * sc;
    LDS_WAIT(); asm volatile("" ::: "memory");
    const int c = lane & 3;
#pragma unroll
    for (int j = 0; j < 4; ++j) { const int n = (lane >> 2) + 16 * j; const LAS float* s = scr + (16 * c) * 65 + n; unsigned w[4];
#pragma unroll
        for (int e = 0; e < 4; ++e) { const int q0 = __float2int_rn(s[(4 * e) * 65]), q1 = __float2int_rn(s[(4 * e + 1) * 65]), q2 = __float2int_rn(s[(4 * e + 2) * 65]), q3 = __float2int_rn(s[(4 * e + 3) * 65]);
            w[e] = (unsigned)(q0 & 0xff) | ((unsigned)(q1 & 0xff) << 8) | ((unsigned)(q2 & 0xff) << 16) | ((unsigned)(q3 & 0xff) << 24); }
        *(u32x4*)(dst + (size_t)n * ldTb + 16 * c) = (u32x4){w[0], w[1], w[2], w[3]}; }
    LDS_WAIT(); asm volatile("" ::: "memory");
}
__device__ __forceinline__ void colmax_item(const float* src, int ldw, int lane, const float* gain, unsigned* cmax) {
    float v[64]; float m = 0.f;
#pragma unroll
    for (int i = 0; i < 64; ++i) v[i] = __builtin_nontemporal_load(src + (size_t)i * ldw + lane);
#pragma unroll
    for (int i = 0; i < 64; ++i) m = fmaxf(m, fabsf(v[i] * gain[i]));
    atomicMax(cmax + lane, __builtin_bit_cast(unsigned, m));
}
__device__ __forceinline__ int win_phys_row(int n) { const int l = n & 255; return (n & ~255) | (((l >> 5) & 1) << 7) | (((l >> 6) & 3) << 5) | (l & 31); }

__device__ __forceinline__ void row2_to_bf16_rstd(const float* xrow, bf16_t* orow, float* rstd2, int lane, unsigned char* qrow = nullptr) {
    const f32x4* xr = (const f32x4*)xrow + lane;
    f32x4 v[2][4]; float s0 = 0.f, s1 = 0.f;
#pragma unroll
    for (int j = 0; j < 4; ++j) { v[0][j] = __builtin_nontemporal_load(xr + 64 * j); v[1][j] = __builtin_nontemporal_load(xr + 256 + 64 * j); }
    unsigned long long* o8 = (unsigned long long*)orow + lane;
#pragma unroll
    for (int j = 0; j < 4; ++j) { s0 += (v[0][j].x * v[0][j].x + v[0][j].y * v[0][j].y) + (v[0][j].z * v[0][j].z + v[0][j].w * v[0][j].w); s1 += (v[1][j].x * v[1][j].x + v[1][j].y * v[1][j].y) + (v[1][j].z * v[1][j].z + v[1][j].w * v[1][j].w);
        o8[64 * j] = (unsigned long long)pk2(v[0][j].x, v[0][j].y) | ((unsigned long long)pk2(v[0][j].z, v[0][j].w) << 32);
        o8[256 + 64 * j] = (unsigned long long)pk2(v[1][j].x, v[1][j].y) | ((unsigned long long)pk2(v[1][j].z, v[1][j].w) << 32);
        if (qrow) { ((unsigned*)qrow)[64 * j + lane] = pk4_fp8(v[0][j].x, v[0][j].y, v[0][j].z, v[0][j].w); ((unsigned*)qrow)[256 + 64 * j + lane] = pk4_fp8(v[1][j].x, v[1][j].y, v[1][j].z, v[1][j].w); } }
    s0 = wave_sum(s0); s1 = wave_sum(s1);
    if (lane == 0) { rstd2[0] = rsqrtf(s0 * (1.f / D) + EPS); rstd2[1] = rsqrtf(s1 * (1.f / D) + EPS); }
}


typedef __attribute__((address_space(4))) const Args* KArgPtr;
__device__ __forceinline__ KArgPtr kargs() { KArgPtr p = (KArgPtr)__builtin_amdgcn_kernarg_segment_ptr(); asm volatile("" : "+s"(p)); return p; }
#define ctl ((unsigned*)(ws + WS_CTL))
#define wrt ((float*)(ws + WS_TAB))
#define eslot ((int*)(ws + WS_ESLOT))
#define ew ((float*)(ws + WS_EW))
#define Win_t ((bf16_t*)(ws + WS_WIN))
#define Wm_t ((bf16_t*)(ws + WS_WM))
#define Wo_t ((bf16_t*)(ws + WS_WO))
#define Wgp8 ((unsigned char*)(ws + WS_WGP))
#define hp8 ((unsigned char*)(ws + WS_HP))
#define h2b ((bf16_t*)(ws + WS_H2B))
#define xb ((bf16_t*)(ws + WS_XB))
#define A1 ((bf16_t*)(ws + WS_A1))
#define B1 ((bf16_t*)(ws + WS_B1))
#define C1 ((bf16_t*)(ws + WS_C1))
#define sga ((bf16_t*)(ws + WS_SGA))
#define sgc ((bf16_t*)(ws + WS_SGC))
#define mbuf ((bf16_t*)(ws + WS_M))
#define h1b ((bf16_t*)(ws + WS_H1B))
#define rstdv ((float*)(ws + WS_RSTD))
#define W13_t ((bf16_t*)(ws + WS_W13))
#define W2_t ((bf16_t*)(ws + WS_W2))
#define xs ((bf16_t*)(ws + WS_XS))
#define hdn ((bf16_t*)(ws + WS_HDN))
#define contrib ((bf16_t*)(ws + WS_CONTRIB))
#define tile0 ((LAS float*)lds)
#define tile1 (tile0 + 64 * 65)
#define pref ((LAS int*)(lds + MISC_OFF))
#define cnts (pref + 64)
__global__ void __launch_bounds__(NTHREADS, 2) fwd_kernel(Args a) {
    extern __shared__ __attribute__((aligned(16))) unsigned char lds_raw[];
    cg::grid_group grid = cg::this_grid();
    LAS unsigned char* lds = (LAS unsigned char*)lds_raw;
    const int G = gridDim.x; int bx = blockIdx.x;
    const int wave_s = __builtin_amdgcn_readfirstlane((int)threadIdx.x >> 6);
    volatile LAS unsigned* bst = (volatile LAS unsigned*)(lds + MISC_OFF + 512);
    if (threadIdx.x < 2) bst[threadIdx.x] = 0u;
    __syncthreads();
    const XcdBarrier bar = xcd_barrier_post((unsigned*)(a.ws + WS_CTL) + CW_BAR, bst);
#ifndef PROBE_A
#define PROBE_A -1
#endif
#ifndef PROBE_B
#define PROBE_B -1
#endif
#define STAMP(i) do { if (PROBE_A >= 0 && bx == 0) { int t_ = lane_id_fresh(); if (wave_s == 0 && t_ == 0) ((volatile LAS unsigned long long*)(lds + MISC_OFF + 1024))[i] = __builtin_amdgcn_s_memrealtime(); } } while (0)
#define XBAR() do { int t_ = (wave_s << 6) | lane_id_fresh(); xcd_barrier(bar, t_); } while (0)
    STAMP(0);
#define PHASE_VARS() const KArgPtr ap = kargs(); unsigned char* const ws = ap->ws; (void)ws; int tid = (wave_s << 6) | lane_id_fresh(); asm volatile("" : "+v"(tid)); const int lane = tid & 63, wave = __builtin_amdgcn_readfirstlane(tid >> 6); \
    const int gw = bx * NWAVES + wave, NGW = G * NWAVES; const size_t gtid = (size_t)bx * NTHREADS + tid, GT = (size_t)G * NTHREADS; (void)lane; (void)gw; (void)NGW; (void)gtid; (void)GT
    {
        PHASE_VARS();
        LAS float* scr = (LAS float*)(lds + wave * WSCR);
        constexpr int I_IN = 16 * 80, I_PA = 8 * 16, I_PC = 8 * 16, I_O = 16 * 16, I_PG = 16 * 16;
        constexpr int NIT = I_IN + I_PA + I_PC + I_O + I_PG; static_assert(NIT == 256 * NWAVES, "P0: exactly one conversion item per wave (w_pp is transposed in the tail filler of the MoE-up phase)");
        for (int it = gw; it < NIT; it += NGW) {
            int r = it;
            if (r < I_IN) { const int kb_ = r / 80, nb = r % 80;
#if F8_GATES
                if (nb >= 48) { transpose_item_f8(ap->w_in + (size_t)(kb_ * 64) * NIN + nb * 64, NIN, (unsigned char*)(Win_t + (size_t)3072 * D) + (size_t)((nb - 48) * 64) * D + kb_ * 64, D, scr, lane, ap->g_mix + kb_ * 64, F8W); continue; }
#endif
#if CU_PAIR
                if ((nb >= 24 && nb < 32) || (nb >= 40 && nb < 48)) { const int cg_ = nb >= 40, c = (nb - (cg_ ? 40 : 24)) * 64, t4 = c >> 7, pn_ = t4 < 2 ? 6 + t4 : 8 + t4;
                    transpose_item(ap->w_in + (size_t)(kb_ * 64) * NIN + nb * 64, NIN, Win_t + (size_t)(pn_ * 256 + cg_ * 128 + (c & 127)) * D + kb_ * 64, D, scr, lane, ap->g_mix + kb_ * 64, 0); continue; }
#endif
                transpose_item(ap->w_in + (size_t)(kb_ * 64) * NIN + nb * 64, NIN, Win_t + (size_t)win_phys_row(nb * 64) * D + kb_ * 64, D, scr, lane, ap->g_mix + kb_ * 64, 96); continue; } r -= I_IN;
            if (r < I_PA) { const int kb_ = r / 16, nb = r % 16; transpose_item(ap->w_pa + (size_t)(kb_ * 64) * D + nb * 64, D, Wm_t + (size_t)(nb * 64) * D + kb_ * 64, D, scr, lane); continue; } r -= I_PA;
            if (r < I_PC) { const int kb_ = r / 16, nb = r % 16; transpose_item(ap->w_pc + (size_t)(kb_ * 64) * D + nb * 64, D, Wm_t + (size_t)(nb * 64) * D + 512 + kb_ * 64, D, scr, lane); continue; } r -= I_PC;
            if (r < I_O) { const int kb_ = r / 16, nb = r % 16; transpose_item(ap->w_o + (size_t)(kb_ * 64) * D + nb * 64, D, Wo_t + (size_t)(nb * 64) * D + kb_ * 64, D, scr, lane); continue; } r -= I_O;
            if (r < I_PG) { const int kb_ = r / 16, nb = r % 16; colmax_item(ap->w_pg + (size_t)(kb_ * 64) * D + nb * 64, D, lane, ap->g_ple + kb_ * 64, ctl + CW_CMAXP + nb * 64); continue; } r -= I_PG;
            (void)r;
        }
        const size_t rtid = (size_t)(G - 1 - bx) * NTHREADS + tid; const int rgw = (G - 1 - bx) * NWAVES + wave;
        for (size_t i = rtid; i < (size_t)3 * 32 * 64 * 8; i += GT) { const int j = (int)(i & 7), ln = (int)((i >> 3) & 63), s_ = (int)((i >> 9) & 31), nt = (int)(i >> 14);
            const int k = 32 * s_ + 8 * (ln >> 4) + j, col = 16 * nt + (ln & 15);
            const float wv_ = ap->g_ffn[k] * (col < 4 ? ap->w_group[k * 4 + col] : (col < 36 ? ap->w_router[k * 32 + (col - 4)] : 0.f));
            const unsigned hi_ = f2bf(wv_); const float lo_ = wv_ - __builtin_bit_cast(float, hi_ << 16);
            ((unsigned short*)wrt)[i] = (unsigned short)hi_; ((unsigned short*)wrt)[(size_t)3 * 32 * 64 * 8 + i] = (unsigned short)f2bf(lo_); }
        { float* gtab = (float*)(ws + WS_GTAB); float* gcinit = (float*)(ws + WS_GCINIT);
          for (size_t i = rtid; i < (size_t)NH * 4 * 384; i += GT) { const int h = (int)(i / 1536), s_ = (int)((i / 384) & 3), y = (int)(i % 384), x = y + s_;
              int dd = 319 - x; dd = dd < -63 ? -63 : (dd > 256 ? 256 : dd);
              gtab[i] = x <= 382 ? (ap->rel_bias[h * NREL + dd + 63] - ap->rel_bias[h * NREL + 319]) * LOG2E : 0.f; }
          if (rgw < NH) { const int h = rgw;
              float gq = fabsf(ap->g_q[lane]), gk = fabsf(ap->g_k[lane]), mb = -3.0e38f;
#pragma unroll
              for (int j = 0; j < 5; ++j) mb = fmaxf(mb, ap->rel_bias[h * NREL + lane + 64 * j]);
#pragma unroll
              for (int o = 1; o < 64; o <<= 1) { gq = fmaxf(gq, __shfl_xor(gq, o)); gk = fmaxf(gk, __shfl_xor(gk, o)); mb = fmaxf(mb, __shfl_xor(mb, o)); }
              if (lane == 0) gcinit[h] = ap->rel_bias[h * NREL + 319] * LOG2E - (64.f * C2 * gq * gk + mb * LOG2E); } }
        STAMP(12);
        for (int m = 2 * gw; m < T; m += 2 * NGW) row2_to_bf16_rstd(ap->x + (size_t)m * D, xb + (size_t)m * D, rstdv + m, lane, F8_GATES ? ws + WS_XQ + (size_t)m * D : nullptr);
    }
    if (G == 0x7fffff) grid.sync();
    XBAR();
    const int even_ = __builtin_amdgcn_readfirstlane((int)bst[3]);
    if (even_) bx = __builtin_amdgcn_readfirstlane((int)(bar.x + 8u * bst[2]));
#define XLBAR() do { int t_ = (wave_s << 6) | lane_id_fresh(); if (even_) xcd_barrier_local(bar, t_); else xcd_barrier(bar, t_); } while (0)
    STAMP(1);

#if F8_GATES
    { PHASE_VARS(); pg8::Gemm g{xb, Win_t, T, 3072, D, D}; pg8::StaticOrder S; S.init(T, 3072, G, bx); EpiInproj E{ws, ap->b_in, ap->g_q, ap->g_k, rstdv};
      pg8::gemm_phase<EpiInproj, pg8::StaticOrder, true, true>(lds, g, S, E, tid); }
    { PHASE_VARS(); pg8::Gemm g{(const bf16_t*)(ws + WS_XQ), Win_t + (size_t)3072 * D, T, 2048, D / 2, D / 2}; StaticOrderId S; S.init(T, 2048, G, bx);
      EpiGateF8 E{(unsigned char*)sga, (unsigned char*)sgc, ap->b_in + 3072, rstdv};
      pg8::gemm_phase<EpiGateF8, StaticOrderId, true, true, 0, 3>(lds, g, S, E, tid); }
#else
    { PHASE_VARS(); pg8::Gemm g{xb, Win_t, T, NIN, D, D}; pg8::StaticOrder S; S.init(T, NIN, G, bx); EpiInproj E{ws, ap->b_in, ap->g_q, ap->g_k, rstdv};
      pg8::gemm_phase<EpiInproj, pg8::StaticOrder, true, true>(lds, g, S, E, tid); }
#endif
    XLBAR();
    STAMP(2);

    {
        PHASE_VARS();
        static_assert(NTHREADS % 64 == 0, "conv: a thread keeps its eight channels on every trip");
        float cwv[3][8], cbv[8];
        { const int c8_ = (tid & 63) * 8;
#pragma unroll
          for (int j = 0; j < 8; ++j) { cbv[j] = ap->conv_b[c8_ + j]; cwv[0][j] = ap->conv_w[c8_ + j]; cwv[1][j] = ap->conv_w[CW + c8_ + j]; cwv[2][j] = ap->conv_w[2 * CW + c8_ + j]; } }
        static_assert(T == 8 * SEQ && CW / 8 == 64, "conv: the eighth of workgroups with equal bx % 8 handles one batch element (the rows its own in-projection units wrote)");
        for (int i = (bx >> 3) * NTHREADS + tid; i < SEQ * 64; i += (G >> 3) * NTHREADS) {
            const int t = (bx & 7) * SEQ + (i >> 6), c8 = (i & 63) * 8, s = t & (SEQ - 1);
            const size_t o = (size_t)t * D + c8;
#if CU_PAIR
            const u32x4 u0 = *(const u32x4*)(C1 + o), b0 = *(const u32x4*)(A1 + o + 512);
            u32x4 u1 = {0u, 0u, 0u, 0u}, u2 = u1;
            if (s >= 1) u1 = *(const u32x4*)(C1 + o - D);
            if (s >= 2) u2 = *(const u32x4*)(C1 + o - 2 * D);
#else
            const u32x4 u0 = *(const u32x4*)(C1 + o), g0 = *(const u32x4*)(C1 + o + 512), b0 = *(const u32x4*)(A1 + o + 512);
            u32x4 u1 = {0u, 0u, 0u, 0u}, g1 = u1, u2 = u1, g2 = u1;
            if (s >= 1) { u1 = *(const u32x4*)(C1 + o - D); g1 = *(const u32x4*)(C1 + o + 512 - D); }
            if (s >= 2) { u2 = *(const u32x4*)(C1 + o - 2 * D); g2 = *(const u32x4*)(C1 + o + 512 - 2 * D); }
#endif
            float y[8];
#pragma unroll
            for (int e = 0; e < 4; ++e) {
#pragma unroll
                for (int hh = 0; hh < 2; ++hh) {
                    const int c = c8 + 2 * e + hh;
#if CU_PAIR
                    const float cu0 = hh ? bf_hi(u0[e]) : bf_lo(u0[e]), cu1 = hh ? bf_hi(u1[e]) : bf_lo(u1[e]), cu2 = hh ? bf_hi(u2[e]) : bf_lo(u2[e]);
#else
                    const float cu0 = hh ? bf_hi(u0[e]) * bf_hi(g0[e]) : bf_lo(u0[e]) * bf_lo(g0[e]);
                    const float cu1 = hh ? bf_hi(u1[e]) * bf_hi(g1[e]) : bf_lo(u1[e]) * bf_lo(g1[e]);
                    const float cu2 = hh ? bf_hi(u2[e]) * bf_hi(g2[e]) : bf_lo(u2[e]) * bf_lo(g2[e]);
#endif
                    const float bgv = hh ? bf_hi(b0[e]) : bf_lo(b0[e]);
                    (void)c; y[2 * e + hh] = bgv * (cbv[2 * e + hh] + cwv[0][2 * e + hh] * cu2 + cwv[1][2 * e + hh] * cu1 + cwv[2][2 * e + hh] * cu0);
                }
            }
            u32x4 w; w.x = pk2(y[0], y[1]); w.y = pk2(y[2], y[3]); w.z = pk2(y[4], y[5]); w.w = pk2(y[6], y[7]);
            *(u32x4*)(A1 + o + 512) = w;
        }
        __syncthreads();
        attn_body::attn_phase((char*)lds_raw, (const attn_body::bf16*)A1, (const attn_body::bf16*)B1, (const attn_body::bf16*)(B1 + 512), (attn_body::bf16*)A1, (const float*)(ws + WS_GTAB), (const float*)(ws + WS_GCINIT), G, bx, tid);
    }
    XLBAR();
    STAMP(3);

    { PHASE_VARS(); pg8::Gemm g{A1, Wm_t, T, D, D, D}; pg8::PairOrder S; S.init(T, D, G, bx); EpiMerge2 E{(const unsigned char*)sga, (const unsigned char*)sgc, mbuf};
      pg8::gemm_phase<EpiMerge2, pg8::PairOrder, true, true>(lds, g, S, E, tid); }
    XLBAR();
    STAMP(4);

    { PHASE_VARS(); pg8::Gemm g{mbuf, Wo_t, T, D, D, D}; pg8::StaticOrder S; S.init(T, D, G, bx); EpiResBf16 E{xb, h1b, F8_MOE ? (unsigned char*)(ws + WS_H1F8) : (unsigned char*)nullptr};
      pg8::gemm_phase<EpiResBf16, pg8::StaticOrder, true, true>(lds, g, S, E, tid); }
    XLBAR();
    STAMP(5);

    {
        PHASE_VARS();
        {
            LAS int* lcnt = (LAS int*)(lds + MISC_OFF + 2048); LAS int* lbase = lcnt + 32;
            if (tid < 32) lcnt[tid] = 0;
            __syncthreads();
            int ea = 0, eb = 0, ra = 0, rb = 0; float wa = 0.f, wb = 0.f;
            LAS float* lsc = (LAS float*)(lds + 98304 + wave * 4096);
            static_assert(T / 16 == 256 * NWAVES, "routing: exactly one 16-token task per wave (the weight stage below is filled with workgroup barriers inside the task loop)");
            const int r = lane & 15, q = lane >> 4;
            const int task0 = (bx & 7) * (T / 128) + (bx >> 3) * NWAVES + wave;
            for (int task = task0; task < T / 16; task += NGW) {
                const int row0 = task * 16;
                const GAS bf16_t* arow = (const GAS bf16_t*)h1b + (size_t)(row0 + r) * D + 8 * q;
                const GAS bf16x8* bp = (const GAS bf16x8*)wrt + lane;
                constexpr int LO = 3 * 32 * 64;
                f32x4 acc0 = {0.f, 0.f, 0.f, 0.f}, acc1 = acc0, acc2 = acc0; float ss = 0.f;
                u32x4 acur[8], anxt[8];
#pragma unroll
                for (int i = 0; i < 8; ++i) acur[i] = *(const GAS u32x4*)(arow + 32 * i);
#pragma unroll 1
                for (int ch = 0; ch < 4; ++ch) {
                    const int chn = ch < 3 ? ch + 1 : 3;
                    if ((ch & 1) == 0) {
                        __syncthreads();
#pragma unroll
                        for (int i = 0; i < 12; ++i) { const int row_ = wave * 12 + i, part = row_ / 48, nt = (row_ / 16) % 3, sl = row_ & 15;
                            __builtin_amdgcn_global_load_lds((const GAS unsigned*)(bp + part * LO + (nt * 32 + 8 * ch + sl) * 64), (LAS unsigned*)(lds + row_ * 1024), 16, 0, 0); }
                    }
#pragma unroll
                    for (int i = 0; i < 8; ++i) anxt[i] = *(const GAS u32x4*)(arow + 32 * (8 * chn + i));
                    if ((ch & 1) == 0) { asm volatile("s_waitcnt vmcnt(8)" ::: "memory"); __syncthreads(); }
#pragma unroll
                    for (int st = 0; st < 8; ++st) {
                        const int sl = 8 * (ch & 1) + st;
                        const u32x4 aw = acur[st]; const bf16x8 af = __builtin_bit_cast(bf16x8, aw);
                        const float av[8] = {bf_lo(aw.x), bf_hi(aw.x), bf_lo(aw.y), bf_hi(aw.y), bf_lo(aw.z), bf_hi(aw.z), bf_lo(aw.w), bf_hi(aw.w)};
#pragma unroll
                        for (int j = 0; j < 8; ++j) ss += av[j] * av[j];
                        const LAS bf16x8* bl = (const LAS bf16x8*)(lds + sl * 1024) + lane;
                        acc0 = __builtin_amdgcn_mfma_f32_16x16x32_bf16(af, bl[(0 * 16) * 64], acc0, 0, 0, 0); acc0 = __builtin_amdgcn_mfma_f32_16x16x32_bf16(af, bl[(3 * 16) * 64], acc0, 0, 0, 0);
                        acc1 = __builtin_amdgcn_mfma_f32_16x16x32_bf16(af, bl[(1 * 16) * 64], acc1, 0, 0, 0); acc1 = __builtin_amdgcn_mfma_f32_16x16x32_bf16(af, bl[(4 * 16) * 64], acc1, 0, 0, 0);
                        acc2 = __builtin_amdgcn_mfma_f32_16x16x32_bf16(af, bl[(2 * 16) * 64], acc2, 0, 0, 0); acc2 = __builtin_amdgcn_mfma_f32_16x16x32_bf16(af, bl[(5 * 16) * 64], acc2, 0, 0, 0);
                    }
#pragma unroll
                    for (int i = 0; i < 8; ++i) acur[i] = anxt[i];
                }
                ss += __shfl_xor(ss, 16); ss += __shfl_xor(ss, 32);
                const float rstd = rsqrtf(ss * (1.f / D) + EPS);
#pragma unroll
                for (int g_ = 0; g_ < 4; ++g_) { const float rs = __shfl(rstd, 4 * q + g_);
                    lsc[(4 * q + g_) * 48 + r] = acc0[g_] * rs; lsc[(4 * q + g_) * 48 + 16 + r] = acc1[g_] * rs; lsc[(4 * q + g_) * 48 + 32 + r] = acc2[g_] * rs; }
                LDS_WAIT(); asm volatile("" ::: "memory");
                if (lane < 16) {
                    const int m = row0 + lane; float lg[36];
#pragma unroll
                    for (int c = 0; c < 36; ++c) lg[c] = lsc[lane * 48 + c];
                    float gl[4];
#pragma unroll
                    for (int c = 0; c < 4; ++c) gl[c] = lg[c] + ap->b_group[c];
                    int grp = 0; float gmax = gl[0];
#pragma unroll
                    for (int c = 1; c < 4; ++c) if (gl[c] > gmax) { gmax = gl[c]; grp = c; }
                    float gs = 0.f;
#pragma unroll
                    for (int c = 0; c < 4; ++c) gs += __expf(gl[c] - gmax);
                    const float pgrp = 1.f / gs;
                    float el[8];
#pragma unroll
                    for (int c = 0; c < 8; ++c) { const float x0 = lg[4 + c], x1 = lg[12 + c], x2 = lg[20 + c], x3 = lg[28 + c]; el[c] = (grp == 0 ? x0 : grp == 1 ? x1 : grp == 2 ? x2 : x3) + ap->b_router[grp * 8 + c]; }
                    int i0 = 0; float l0 = el[0];
#pragma unroll
                    for (int c = 1; c < 8; ++c) if (el[c] > l0) { l0 = el[c]; i0 = c; }
                    int i1 = -1; float l1 = -3.0e38f;
#pragma unroll
                    for (int c = 0; c < 8; ++c) if (c != i0 && el[c] > l1) { l1 = el[c]; i1 = c; }
                    if (i1 < 0) i1 = i0 ? 0 : 1;
                    const float e1 = __expf(l1 - l0), w0 = pgrp / (1.f + e1), w1 = pgrp * e1 / (1.f + e1);
                    ea = grp * 8 + i0; eb = grp * 8 + i1;
                    ra = (int)__hip_atomic_fetch_add(&lcnt[ea], 1, __ATOMIC_RELAXED, __HIP_MEMORY_SCOPE_WORKGROUP); rb = (int)__hip_atomic_fetch_add(&lcnt[eb], 1, __ATOMIC_RELAXED, __HIP_MEMORY_SCOPE_WORKGROUP);
                    wa = w0; wb = w1;
                    rstdv[m] = rstd;
                }
                LDS_WAIT(); asm volatile("" ::: "memory");
            }
            __syncthreads();
            if (tid < 32) lbase[tid] = (int)atomicAdd(&ctl[tid * CNT_STRIDE], (unsigned)lcnt[tid]);
            __syncthreads();
            if (lane < 16) { const int m = task0 * 16 + lane; const int ia = (ea << 15) | (lbase[ea] + ra), ib = (eb << 15) | (lbase[eb] + rb);
                eslot[ia] = 2 * m; ew[ia] = wa; eslot[ib] = 2 * m + 1; ew[ib] = wb; }
        }
        STAMP(11);
        LAS float* scr = (LAS float*)(lds + wave * WSCR);
        constexpr int I_13 = 16 * 8, PER_E = 2 * I_13;
        for (int it = gw; it < NE * PER_E; it += NGW) {
            const int e = it / PER_E; int r = it % PER_E;
            const int which = r / I_13; r %= I_13; const int kb_ = r / 8, nb = r % 8, j0 = nb * 64;
            const float* src = (which ? ap->w3 : ap->w1) + (size_t)e * D * DE + (size_t)(kb_ * 64) * DE + j0;
#if F8_MOE
            transpose_item_f8(src, DE, (unsigned char*)W13_t + (size_t)(e * 1024 + (j0 >> 7) * 256 + which * 128 + (j0 & 127)) * D + kb_ * 64, D, scr, lane, ap->g_ffn + kb_ * 64, F8W);
#else
            transpose_item(src, DE, W13_t + (size_t)(e * 1024 + (j0 >> 7) * 256 + which * 128 + (j0 & 127)) * D + kb_ * 64, D, scr, lane, ap->g_ffn + kb_ * 64);
#endif
        }
    }
    XBAR();
    STAMP(6);

    {
        PHASE_VARS();
        if (tid < NE) cnts[tid] = (int)__hip_atomic_load(&ctl[tid * CNT_STRIDE], __ATOMIC_RELAXED, __HIP_MEMORY_SCOPE_AGENT);
        __syncthreads();
        if (tid == 0) { int acc_ = 0; for (int e = 0; e < NE; ++e) { pref[e] = acc_; acc_ += (cnts[e] + 255) >> 8; } pref[NE] = acc_; }
        __syncthreads();
    }
    STAMP(7);
    const int ntiles = __builtin_amdgcn_readfirstlane(pref[NE]);

#if F8_MOE
    { PHASE_VARS(); pg8::Gemm g{(const bf16_t*)(ws + WS_H1F8), W13_t, XS_ROWS, NE * 1024, D / 2, D / 2}; moe_meta_preload(lds, pref, ntiles * 4, G, bx, eslot, rstdv, true, tid); MoeOrderT<true> S{pref, ntiles * 4, G, bx, lds}; EpiSwigluT<1> E{hdn, lds};
      pg8::gemm_phase<EpiSwigluT<1>, MoeOrderT<true>, true, true, 0, 3>(lds, g, S, E, tid); }
#else
    { PHASE_VARS(); pg8::Gemm g{h1b, W13_t, XS_ROWS, NE * 1024, D, D}; moe_meta_preload(lds, pref, ntiles * 4, G, bx, eslot, rstdv, true, tid); MoeOrderT<true> S{pref, ntiles * 4, G, bx, lds}; EpiSwigluT<0> E{hdn, lds};
      pg8::gemm_phase<EpiSwigluT<0>, MoeOrderT<true>, true, true>(lds, g, S, E, tid); }
#endif
    { PHASE_VARS();
      { const int nun = ntiles * 4, rem = nun % G, nf = rem ? G - rem : G, fb = rem ? bx - rem : bx;
        if (fb >= 0) {
            LAS float* scr = (LAS float*)(lds + wave * WSCR);
            for (int it = fb * NWAVES + wave; it < NE * 128; it += nf * NWAVES) { const int e = it >> 7, r = it & 127, kb_ = r / 16, nb = r % 16;
#if F8_MOE && F8_DOWN
                transpose_item_f8(ap->w2 + (size_t)e * DE * D + (size_t)(kb_ * 64) * D + nb * 64, D, (unsigned char*)W2_t + (size_t)(e * 1024 + nb * 64) * DE + kb_ * 64, DE, scr, lane, nullptr, F8W); }
#else
                transpose_item(ap->w2 + (size_t)e * DE * D + (size_t)(kb_ * 64) * D + nb * 64, D, W2_t + (size_t)(e * 1024 + nb * 64) * DE + kb_ * 64, DE, scr, lane); }
#endif
            for (size_t i = (size_t)fb * NTHREADS + tid; i < 1024; i += (size_t)nf * NTHREADS) ((float*)(ws + WS_CMAXF))[i] = __builtin_bit_cast(float, __hip_atomic_load(ctl + CW_CMAXP + i, __ATOMIC_RELAXED, __HIP_MEMORY_SCOPE_AGENT));
            for (int it = fb * NWAVES + wave; it < 4 * 16; it += nf * NWAVES) { const int kb_ = it / 16, nb = it % 16;
                transpose_item(ap->w_pp + (size_t)(kb_ * 64) * D + nb * 64, D, (bf16_t*)Wgp8 + (size_t)(nb * 64) * HPE + 512 + kb_ * 64, HPE, scr, lane); }
            for (int it = fb * NWAVES + wave; it < 16 * 16; it += nf * NWAVES) { const int kb_ = it / 16, nb = it % 16;
                transpose_item_q8(ap->w_pg + (size_t)(kb_ * 64) * D + nb * 64, D, (signed char*)Wgp8 + (size_t)(nb * 64) * HPB + kb_ * 64, HPB, scr, lane, ap->g_ple + kb_ * 64, (const float*)(ctl + CW_CMAXP) + nb * 64); }
            for (size_t i = (size_t)fb * NTHREADS + tid; i < (size_t)T * PLE / 8; i += (size_t)nf * NTHREADS) { const f32x4 v0 = __builtin_nontemporal_load((const f32x4*)ap->p + 2 * i), v1 = __builtin_nontemporal_load((const f32x4*)ap->p + 2 * i + 1);
                u32x4 o; o.x = pk2(v0.x, v0.y); o.y = pk2(v0.z, v0.w); o.z = pk2(v1.x, v1.y); o.w = pk2(v1.z, v1.w); *(u32x4*)(hp8 + (i >> 5) * HPB + 1024 + (i & 31) * 16) = o; }
        } } }
    XBAR();
    STAMP(8);

#if F8_MOE && F8_DOWN
    { PHASE_VARS(); pg8::Gemm g{hdn, W2_t, XS_ROWS, NE * 1024, DE / 2, DE / 2}; moe_meta_preload(lds, pref, ntiles * 4, G, bx, eslot, ew, false, tid); MoeOrderId S{{pref, ntiles * 4, G, bx, lds}}; EpiDownT<1> E{contrib, lds};
      pg8::gemm_phase<EpiDownT<1>, MoeOrderId, true, true, 0, 3>(lds, g, S, E, tid); }
#else
    { PHASE_VARS(); pg8::Gemm g{hdn, W2_t, XS_ROWS, NE * 1024, DE, DE}; moe_meta_preload(lds, pref, ntiles * 4, G, bx, eslot, ew, false, tid); MoeOrderT<false> S{pref, ntiles * 4, G, bx, lds}; EpiDownT<0> E{contrib, lds};
      pg8::gemm_phase<EpiDownT<0>, MoeOrderT<false>, true, true>(lds, g, S, E, tid); }
#endif
    XBAR();
    STAMP(9);

    { PHASE_VARS();
    static_assert(T == 8 * 4096 && NWAVES == 8, "combine pass: rows by eighths");
    for (int it9 = 0; it9 < 8; ++it9) { const int m0 = 2 * ((bx & 7) * 2048 + it9 * 256 + (bx >> 3) * NWAVES + wave);
#if F8_CONTRIB
        u32x2 hv[2][4]; unsigned p0[2][4], p1[2][4];
#pragma unroll
        for (int rr = 0; rr < 2; ++rr) { const int m = m0 + rr;
            const u32x2* xr = (const u32x2*)(h1b + (size_t)m * D) + lane;
            const unsigned* c0 = (const unsigned*)((const unsigned char*)contrib + (size_t)(2 * m) * D) + lane; const unsigned* c1 = (const unsigned*)((const unsigned char*)contrib + (size_t)(2 * m + 1) * D) + lane;
#pragma unroll
            for (int j = 0; j < 4; ++j) { hv[rr][j] = __builtin_nontemporal_load(xr + 64 * j); p0[rr][j] = __builtin_nontemporal_load(c0 + 64 * j); p1[rr][j] = __builtin_nontemporal_load(c1 + 64 * j); } }
#else
        u32x2 hv[2][4], p0[2][4], p1[2][4];
#pragma unroll
        for (int rr = 0; rr < 2; ++rr) { const int m = m0 + rr;
            const u32x2* xr = (const u32x2*)(h1b + (size_t)m * D) + lane;
            const u32x2* c0 = (const u32x2*)(contrib + (size_t)(2 * m) * D) + lane; const u32x2* c1 = (const u32x2*)(contrib + (size_t)(2 * m + 1) * D) + lane;
#pragma unroll
            for (int j = 0; j < 4; ++j) { hv[rr][j] = __builtin_nontemporal_load(xr + 64 * j); p0[rr][j] = __builtin_nontemporal_load(c0 + 64 * j); p1[rr][j] = __builtin_nontemporal_load(c1 + 64 * j); } }
#endif
#pragma unroll
        for (int rr = 0; rr < 2; ++rr) { const int m = m0 + rr; float s = 0.f, am = 0.f; f32x4 h[4];
            unsigned long long* o8 = (unsigned long long*)(h2b + (size_t)m * D) + lane;
#pragma unroll
            for (int j = 0; j < 4; ++j) {
#if F8_CONTRIB
                { const f32x2 a0 = __builtin_amdgcn_cvt_pk_f32_fp8((int)p0[rr][j], false), a1 = __builtin_amdgcn_cvt_pk_f32_fp8((int)p0[rr][j], true), b0 = __builtin_amdgcn_cvt_pk_f32_fp8((int)p1[rr][j], false), b1 = __builtin_amdgcn_cvt_pk_f32_fp8((int)p1[rr][j], true);
                  constexpr float k = 1.0f / CSC;
                  h[j].x = bf_lo(hv[rr][j].x) + (a0[0] + b0[0]) * k; h[j].y = bf_hi(hv[rr][j].x) + (a0[1] + b0[1]) * k; h[j].z = bf_lo(hv[rr][j].y) + (a1[0] + b1[0]) * k; h[j].w = bf_hi(hv[rr][j].y) + (a1[1] + b1[1]) * k; }
#else
                h[j].x = bf_lo(hv[rr][j].x) + bf_lo(p0[rr][j].x) + bf_lo(p1[rr][j].x); h[j].y = bf_hi(hv[rr][j].x) + bf_hi(p0[rr][j].x) + bf_hi(p1[rr][j].x);
                h[j].z = bf_lo(hv[rr][j].y) + bf_lo(p0[rr][j].y) + bf_lo(p1[rr][j].y); h[j].w = bf_hi(hv[rr][j].y) + bf_hi(p0[rr][j].y) + bf_hi(p1[rr][j].y);
#endif
                s += (h[j].x * h[j].x + h[j].y * h[j].y) + (h[j].z * h[j].z + h[j].w * h[j].w);
                am = fmaxf(fmaxf(am, fmaxf(fabsf(h[j].x), fabsf(h[j].y))), fmaxf(fabsf(h[j].z), fabsf(h[j].w)));
                if (!RES8) o8[64 * j] = (unsigned long long)pk2(h[j].x, h[j].y) | ((unsigned long long)pk2(h[j].z, h[j].w) << 32); }
            s = wave_sum(s);
#pragma unroll
            for (int o = 1; o < 64; o <<= 1) am = fmaxf(am, __shfl_xor(am, o));
            const float qs = 127.0f / fmaxf(am, 1e-30f);
            unsigned* q4 = (unsigned*)(hp8 + (size_t)m * HPB) + lane;
#pragma unroll
            for (int j = 0; j < 4; ++j) { const int q0 = __float2int_rn(h[j].x * qs), q1 = __float2int_rn(h[j].y * qs), q2 = __float2int_rn(h[j].z * qs), q3 = __float2int_rn(h[j].w * qs);
                q4[64 * j] = (unsigned)(q0 & 0xff) | ((unsigned)(q1 & 0xff) << 8) | ((unsigned)(q2 & 0xff) << 16) | ((unsigned)(q3 & 0xff) << 24); }
            if (lane == 0) { rstdv[m] = rsqrtf(s * (1.f / D) + EPS) * am * (1.0f / 127.0f); if (RES8) rstdv[T + m] = am * (1.0f / 127.0f); } }
    } }
    XLBAR();
    STAMP(10);

    { PHASE_VARS(); pg8::Gemm g{(const bf16_t*)hp8, (const bf16_t*)Wgp8, T, 2 * D, HPE, HPE}; pg8::StaticOrder S; S.init(T, 2 * D, G, bx);
      EpiGateDual E{h2b, rstdv, (const float*)(ws + WS_CMAXF), ap->b_pg, ap->out, hp8, rstdv + T};
      pg8::gemm_phase<EpiGateDual, pg8::StaticOrder, true, true, 8, 2>(lds, g, S, E, tid); }
    STAMP(15);
    if (PROBE_A >= 0 && bx == 0) { int t_ = lane_id_fresh(); if (wave_s == 0 && t_ == 0) { volatile LAS unsigned long long* ts = (volatile LAS unsigned long long*)(lds + MISC_OFF + 1024);
        const unsigned long long d = 4ull * (ts[PROBE_B] - ts[PROBE_A]), t0 = __builtin_amdgcn_s_memrealtime(); while (__builtin_amdgcn_s_memrealtime() - t0 < d) __builtin_amdgcn_s_sleep(8); } }
}

extern "C" void kernel_launch(void* const* d_in, const int* in_sizes, int n_in, void* d_out, int out_size, void* d_ws, size_t ws_size, hipStream_t stream) {
    static int grid = 0;
    if (grid == 0) {
        if (n_in != 25 || out_size != T * D || ws_size < WS_END) { fprintf(stderr, "kernel_launch: unexpected shapes (n_in %d out %d ws %zu); nothing launched\n", n_in, out_size, ws_size); grid = -1; return; }
        int dev = 0, cus = 0, per_cu = 0;
        if (hipGetDevice(&dev) != hipSuccess || hipDeviceGetAttribute(&cus, hipDeviceAttributeMultiprocessorCount, dev) != hipSuccess) { grid = -1; return; }
        if (hipFuncSetAttribute((const void*)fwd_kernel, hipFuncAttributeMaxDynamicSharedMemorySize, LDS_BYTES) != hipSuccess) { fprintf(stderr, "kernel_launch: hipFuncSetAttribute failed\n"); grid = -1; return; }
        if (hipOccupancyMaxActiveBlocksPerMultiprocessor(&per_cu, (const void*)fwd_kernel, NTHREADS, LDS_BYTES) != hipSuccess || per_cu < 1) { fprintf(stderr, "kernel_launch: occupancy query says %d\n", per_cu); (void)hipGetLastError(); grid = -1; return; }
        if (cus != 256) { fprintf(stderr, "kernel_launch: built for a 256-CU device (got %d)\n", cus); grid = -1; return; }
        grid = cus;
    }
    if (grid < 0) return;
    if (hipMemsetAsync((char*)d_ws + WS_CTL, 0, CTL_ZERO_BYTES, stream) != hipSuccess) { fprintf(stderr, "kernel_launch: memset failed\n"); return; }
    Args a{};
    const float** f = (const float**)&a;
    for (int i = 0; i < 25; ++i) f[i] = (const float*)d_in[i];
    a.out = (float*)d_out; a.ws = (unsigned char*)d_ws;
    void* args[] = {&a};
    hipError_t e = hipLaunchCooperativeKernel((const void*)fwd_kernel, dim3(grid), dim3(NTHREADS), args, LDS_BYTES, stream);
    if (e != hipSuccess) fprintf(stderr, "kernel_launch: cooperative launch failed: %s (grid %d)\n", hipGetErrorString(e), grid);
}
```
